# Optimizing an MI355X kernel written in HIP

```python
import jax, jax.numpy as jnp
from jax import lax
import numpy as np

D_MODEL = 1024
BATCH = 2
SEQ = 16384
DEPTH = 4

HEAD_DIM = 64
Q_BLOCK = 128
NSA_HEADS = 8
NSA_KV = 1
NSA_GROUP = NSA_HEADS // NSA_KV
CMP_STRIDE = 16
CMP_LEN = 2 * CMP_STRIDE
CMP_HID = 256
SEL_BLOCK = 64
SEL_TOPK = 8
NSA_WINDOW = 512
SB_HEADS = 4
SWA_HEADS = 4
SWA_KV = 2
SWA_GROUP = SWA_HEADS // SWA_KV
SWA_WINDOW = 128
N_EXPERTS = 16
N_GROUPS = 4
EXPERTS_PER_GROUP = N_EXPERTS // N_GROUPS
TOP_K = 2
D_EXPERT = D_MODEL // 2
MOE_BLOCK = 512
N_BRANCH = 3
EPS = 1e-6
NEG = -1e30
BIG = 1e30

A_WIDTH = NSA_HEADS * HEAD_DIM
B_WIDTH = SB_HEADS * HEAD_DIM
C_WIDTH = SWA_HEADS * HEAD_DIM
IN_WIDTHS = (A_WIDTH, 6 * NSA_KV * HEAD_DIM, 3 * NSA_HEADS, 3 * B_WIDTH, C_WIDTH, 2 * SWA_KV * HEAD_DIM, N_BRANCH * D_MODEL)
N_IN = sum(IN_WIDTHS)

kernel_name = "hybrid_nsa_stickbreak_swa_moe"

f32 = jnp.float32


def rmsnorm(x, g):
    xf = x.astype(f32)
    y = xf * lax.rsqrt(jnp.mean(xf * xf, axis=-1, keepdims=True) + EPS)
    return (y * g.astype(f32)).astype(x.dtype)


def alibi_slopes(n):
    return 2.0 ** (-8.0 * jnp.arange(1, n + 1, dtype=f32) / n)


def masked_softmax(s, mask):
    s = jnp.where(mask, s, NEG)
    m = jnp.max(s, axis=-1, keepdims=True)
    p = jnp.where(mask, jnp.exp(s - m), 0.0)
    return p / jnp.maximum(jnp.sum(p, axis=-1, keepdims=True), 1e-30)


def split_cols(z, widths):
    return jnp.split(z, np.cumsum(widths)[:-1].tolist(), axis=-1)


def nsa_compress(k, pe, w1, w2):
    B, S, G, HD = k.shape
    ch = k.reshape(B, S // CMP_STRIDE, CMP_STRIDE, G, HD)
    blk = jnp.concatenate([ch[:, :-1], ch[:, 1:]], axis=2) + pe[None, None, :, None, :]
    flat = jnp.transpose(blk, (0, 1, 3, 2, 4)).reshape(B, S // CMP_STRIDE - 1, G, CMP_LEN * HD)
    return jax.nn.gelu(flat @ w1) @ w2


def nsa_attention(q, kv, gates, cmp_pe_k, cmp_w1_k, cmp_w2_k, cmp_pe_v, cmp_w1_v, cmp_w2_v, q_gain, k_gain, slopes):
    B, S, G, HG, HD = q.shape
    NB = S // Q_BLOCK
    NC = S // CMP_STRIDE - 1
    NSEL = S // SEL_BLOCK
    KSEL = min(SEL_TOPK, NSEL)
    R = SEL_BLOCK // CMP_STRIDE
    scale = HD ** -0.5
    q = rmsnorm(q, q_gain)
    k_cmp = rmsnorm(nsa_compress(kv[:, :, 0], cmp_pe_k, cmp_w1_k, cmp_w2_k), k_gain[0])
    v_cmp = nsa_compress(kv[:, :, 1], cmp_pe_v, cmp_w1_v, cmp_w2_v)
    k_slc = jnp.transpose(rmsnorm(kv[:, :, 2], k_gain[1]), (0, 2, 1, 3))
    v_slc = jnp.transpose(kv[:, :, 3], (0, 2, 1, 3))
    pad = ((0, 0), (NSA_WINDOW, 0), (0, 0), (0, 0))
    k_win = jnp.pad(rmsnorm(kv[:, :, 4], k_gain[2]), pad)
    v_win = jnp.pad(kv[:, :, 5], pad)
    c_end = jnp.arange(NC) * CMP_STRIDE + (CMP_LEN - 1)
    blk_ids = jnp.arange(NSEL)
    ov_w = (0.5,) + (1.0,) * (R - 1) + (0.5,)
    alibi = slopes.astype(f32)[None, :, :, None, None]
    gather = jax.vmap(jax.vmap(lambda src, idx: src[idx]))

    def one_block(args):
        n, qb, gb = args
        t = n * Q_BLOCK + jnp.arange(Q_BLOCK)
        s = jnp.einsum('bqghd,bcgd->bghqc', qb, k_cmp, preferred_element_type=f32) * scale
        dist = (t[:, None] - c_end[None, :]).astype(f32)
        p_cmp = masked_softmax(s - alibi * dist, dist >= 0)
        o_cmp = jnp.einsum('bghqc,bcgd->bqghd', p_cmp.astype(v_cmp.dtype), v_cmp)
        imp = jnp.pad(p_cmp.sum(axis=2), ((0, 0), (0, 0), (0, 0), (1, R * NSEL - NC)))
        imp = sum(w * imp[..., r: r + R * NSEL: R] for r, w in enumerate(ov_w))
        cur = (t // SEL_BLOCK)[:, None]
        forced = (blk_ids == 0) | (blk_ids == cur) | (blk_ids == cur - 1)
        score = jnp.where(blk_ids <= cur, jnp.where(forced, BIG, imp), -jnp.inf)
        _, sel = lax.top_k(score, KSEL)
        tok = (sel[..., None] * SEL_BLOCK + jnp.arange(SEL_BLOCK)).reshape(B, G, Q_BLOCK, KSEL * SEL_BLOCK)
        ks = gather(k_slc, tok)
        vs = gather(v_slc, tok)
        s = jnp.einsum('bqghd,bgqtd->bghqt', qb, ks, preferred_element_type=f32) * scale
        dist = (t[:, None] - tok).astype(f32)[:, :, None]
        p = masked_softmax(s - alibi * dist, dist >= 0)
        o_slc = jnp.einsum('bghqt,bgqtd->bqghd', p.astype(vs.dtype), vs)
        kw = lax.dynamic_slice_in_dim(k_win, n * Q_BLOCK, Q_BLOCK + NSA_WINDOW, axis=1)
        vw = lax.dynamic_slice_in_dim(v_win, n * Q_BLOCK, Q_BLOCK + NSA_WINDOW, axis=1)
        pos = n * Q_BLOCK - NSA_WINDOW + jnp.arange(Q_BLOCK + NSA_WINDOW)
        dist = (t[:, None] - pos[None, :]).astype(f32)
        mask = (dist >= 0) & (dist < NSA_WINDOW) & (pos[None, :] >= 0)
        s = jnp.einsum('bqghd,bkgd->bghqk', qb, kw, preferred_element_type=f32) * scale
        p = masked_softmax(s - alibi * dist, mask)
        o_win = jnp.einsum('bghqk,bkgd->bqghd', p.astype(vw.dtype), vw)
        return gb[..., 0:1] * o_cmp + gb[..., 1:2] * o_slc + gb[..., 2:3] * o_win

    to_blocks = lambda z: jnp.swapaxes(z.reshape(B, NB, Q_BLOCK, *z.shape[2:]), 0, 1)
    o = lax.map(one_block, (jnp.arange(NB), to_blocks(q), to_blocks(gates)))
    return jnp.swapaxes(o, 0, 1).reshape(B, S, G * HG * HD)


def stick_breaking(q, k, v):
    B, S, H, HD = q.shape
    NB = S // Q_BLOCK
    q = q * HD ** -0.5
    j = jnp.arange(Q_BLOCK)
    tri_incl = (j[:, None] >= j[None, :]).astype(f32)
    outs = []
    for n in range(NB):
        L = (n + 1) * Q_BLOCK
        z = jnp.einsum('bqhd,bshd->bhqs', q[:, n * Q_BLOCK:L], k[:, :L], preferred_element_type=f32)
        mask = jnp.arange(L)[None, :] < (n * Q_BLOCK + j)[:, None]
        lk = jnp.where(mask, -jax.nn.softplus(z), 0.0).reshape(B, H, Q_BLOCK, n + 1, Q_BLOCK)
        within = jnp.einsum('bhqcj,js->bhqcs', lk, tri_incl)
        cb = jnp.arange(n + 1)
        later = jnp.einsum('bhqc,cd->bhqd', lk.sum(axis=-1), (cb[:, None] > cb[None, :]).astype(f32))
        r = (within + later[..., None]).reshape(B, H, Q_BLOCK, L)
        a = jnp.where(mask, jnp.exp(z + r), 0.0)
        outs.append(jnp.einsum('bhqs,bshd->bqhd', a.astype(v.dtype), v[:, :L]))
    return jnp.concatenate(outs, axis=1).reshape(B, S, H * HD)


def swa_with_sinks(q, k, v, sinks, slopes):
    B, S, G, HG, HD = q.shape
    NB = S // Q_BLOCK
    qb = q.reshape(B, NB, Q_BLOCK, G, HG, HD)

    def band(z):
        zp = jnp.pad(z, ((0, 0), (Q_BLOCK, 0), (0, 0), (0, 0))).reshape(B, NB + 1, Q_BLOCK, G, HD)
        return jnp.concatenate([zp[:, :-1], zp[:, 1:]], axis=2)

    kb, vb = band(k), band(v)
    r = jnp.arange(2 * Q_BLOCK)
    dist = Q_BLOCK + jnp.arange(Q_BLOCK)[:, None] - r[None, :]
    key_pos = (jnp.arange(NB) * Q_BLOCK - Q_BLOCK)[:, None] + r[None, :]
    mask = ((dist >= 0) & (dist < SWA_WINDOW))[None] & (key_pos >= 0)[:, None, :]
    mask = mask[None, :, None, None]
    s = jnp.einsum('bnqghd,bnkgd->bnghqk', qb, kb, preferred_element_type=f32) * HD ** -0.5
    s = jnp.where(mask, s - slopes.astype(f32)[:, :, None, None] * dist.astype(f32), NEG)
    sink = sinks.astype(f32)[:, :, None, None]
    m = jnp.maximum(jnp.max(s, axis=-1, keepdims=True), sink)
    p = jnp.where(mask, jnp.exp(s - m), 0.0)
    p = p / (jnp.sum(p, axis=-1, keepdims=True) + jnp.exp(sink - m))
    o = jnp.einsum('bnghqk,bnkgd->bnqghd', p.astype(vb.dtype), vb)
    return o.reshape(B, S, G * HG * HD)


def hybrid_mixer(h, w_in, cmp_pe_k, cmp_w1_k, cmp_w2_k, cmp_pe_v, cmp_w1_v, cmp_w2_v, nsa_q_gain, nsa_k_gain,
                 swa_q_gain, swa_k_gain, swa_sinks, w_branch_a, w_branch_b, w_branch_c, w_out, nsa_slopes, swa_slopes):
    B, S, D = h.shape
    q_a, kv_a, gate_a, qkv_b, q_c, kv_c, merge = split_cols(h @ w_in, IN_WIDTHS)
    o_a = nsa_attention(q_a.reshape(B, S, NSA_KV, NSA_GROUP, HEAD_DIM),
                        kv_a.reshape(B, S, 6, NSA_KV, HEAD_DIM),
                        jax.nn.sigmoid(gate_a).reshape(B, S, NSA_KV, NSA_GROUP, 3),
                        cmp_pe_k, cmp_w1_k, cmp_w2_k, cmp_pe_v, cmp_w1_v, cmp_w2_v,
                        nsa_q_gain, nsa_k_gain, nsa_slopes)
    qkv_b = qkv_b.reshape(B, S, 3, SB_HEADS, HEAD_DIM)
    o_b = stick_breaking(qkv_b[:, :, 0], qkv_b[:, :, 1], qkv_b[:, :, 2])
    kv_c = kv_c.reshape(B, S, 2, SWA_KV, HEAD_DIM)
    o_c = swa_with_sinks(rmsnorm(q_c.reshape(B, S, SWA_KV, SWA_GROUP, HEAD_DIM), swa_q_gain),
                         rmsnorm(kv_c[:, :, 0], swa_k_gain), kv_c[:, :, 1],
                         swa_sinks.reshape(SWA_KV, SWA_GROUP), swa_slopes)
    g = jax.nn.sigmoid(merge).reshape(B, S, N_BRANCH, D)
    y = g[:, :, 0] * (o_a @ w_branch_a) + g[:, :, 1] * (o_b @ w_branch_b) + g[:, :, 2] * (o_c @ w_branch_c)
    return y @ w_out


def grouped_moe(h, w_router, router_bias, w_gate, w_up, w_down):
    B, S, D = h.shape
    hf = h.reshape(-1, D)
    N = hf.shape[0]
    scores = jax.nn.sigmoid((hf @ w_router).astype(f32))
    sel = (scores + router_bias.astype(f32)).reshape(N, N_GROUPS, EXPERTS_PER_GROUP)
    grp_score = lax.top_k(sel, TOP_K)[0].sum(axis=-1)
    g_idx = jnp.argmax(grp_score, axis=-1)
    in_grp = jnp.take_along_axis(sel, g_idx[:, None, None], axis=1)[:, 0]
    _, e_local = lax.top_k(in_grp, TOP_K)
    e_idx = (g_idx[:, None] * EXPERTS_PER_GROUP + e_local).astype(jnp.int32)
    w = jnp.take_along_axis(scores, e_idx, axis=-1)
    w = w / jnp.sum(w, axis=-1, keepdims=True)
    NK = N * TOP_K
    n_blk = -(-NK // MOE_BLOCK) + N_EXPERTS
    flat_e = e_idx.reshape(-1)
    order = jnp.argsort(flat_e)
    e_sorted = flat_e[order]
    counts = jnp.bincount(flat_e, length=N_EXPERTS)
    padded = (counts + MOE_BLOCK - 1) // MOE_BLOCK * MOE_BLOCK
    p_end = jnp.cumsum(padded)
    p_start = p_end - padded
    start = jnp.cumsum(counts) - counts
    dest = p_start[e_sorted] + jnp.arange(NK) - start[e_sorted]
    slot_tok = jnp.full((n_blk * MOE_BLOCK,), N, jnp.int32).at[dest].set((order // TOP_K).astype(jnp.int32))
    slot_w = jnp.zeros((n_blk * MOE_BLOCK,), hf.dtype).at[dest].set(w.reshape(-1)[order].astype(hf.dtype))
    blk_e = jnp.minimum(jnp.searchsorted(p_end, jnp.arange(n_blk) * MOE_BLOCK, side='right'), N_EXPERTS - 1)
    xs = jnp.concatenate([hf, jnp.zeros((1, D), hf.dtype)], axis=0)[slot_tok].reshape(n_blk, MOE_BLOCK, D)
    a = jax.nn.silu(jnp.einsum('nrd,ndf->nrf', xs, w_gate[blk_e])) * jnp.einsum('nrd,ndf->nrf', xs, w_up[blk_e])
    y = jnp.einsum('nrf,nfd->nrd', a, w_down[blk_e]).reshape(-1, D) * slot_w[:, None]
    out = jnp.zeros((N + 1, D), hf.dtype).at[slot_tok].add(y)[:N]
    return out.reshape(B, S, D)


def setup_inputs(seed: int = 0) -> dict:
    key = jax.random.key(seed)
    ks = jax.random.split(key, 27)
    nrm = lambda k, shape, s: jax.random.normal(k, shape, f32) * s
    L, D, HD = DEPTH, D_MODEL, HEAD_DIM
    return {
        "x": nrm(ks[0], (BATCH, SEQ, D), 1.0),
        "c": nrm(ks[1], (BATCH, D), 1.0),
        "w_ada": nrm(ks[2], (L, D, 6 * D), 0.5 * D ** -0.5),
        "b_ada": nrm(ks[3], (L, 6 * D), 0.02),
        "g_norm_mix": 1.0 + nrm(ks[4], (L, D), 0.02),
        "g_norm_moe": 1.0 + nrm(ks[5], (L, D), 0.02),
        "w_in": nrm(ks[6], (L, D, N_IN), D ** -0.5),
        "cmp_pe_k": nrm(ks[7], (L, CMP_LEN, HD), 0.02),
        "cmp_w1_k": nrm(ks[8], (L, CMP_LEN * HD, CMP_HID), (CMP_LEN * HD) ** -0.5),
        "cmp_w2_k": nrm(ks[9], (L, CMP_HID, HD), CMP_HID ** -0.5),
        "cmp_pe_v": nrm(ks[10], (L, CMP_LEN, HD), 0.02),
        "cmp_w1_v": nrm(ks[11], (L, CMP_LEN * HD, CMP_HID), (CMP_LEN * HD) ** -0.5),
        "cmp_w2_v": nrm(ks[12], (L, CMP_HID, HD), CMP_HID ** -0.5),
        "nsa_q_gain": 1.0 + nrm(ks[13], (L, HD), 0.02),
        "nsa_k_gain": 1.0 + nrm(ks[14], (L, 3, HD), 0.02),
        "swa_q_gain": 1.0 + nrm(ks[15], (L, HD), 0.02),
        "swa_k_gain": 1.0 + nrm(ks[16], (L, HD), 0.02),
        "swa_sinks": nrm(ks[17], (L, SWA_HEADS), 1.0),
        "w_branch_a": nrm(ks[18], (L, A_WIDTH, D), A_WIDTH ** -0.5),
        "w_branch_b": nrm(ks[19], (L, B_WIDTH, D), B_WIDTH ** -0.5),
        "w_branch_c": nrm(ks[20], (L, C_WIDTH, D), C_WIDTH ** -0.5),
        "w_out": nrm(ks[21], (L, D, D), D ** -0.5),
        "w_router": nrm(ks[22], (D, N_EXPERTS), D ** -0.5),
        "router_bias": nrm(ks[23], (N_EXPERTS,), 0.01),
        "w_exp_gate": nrm(ks[24], (L, N_EXPERTS, D, D_EXPERT), D ** -0.5),
        "w_exp_up": nrm(ks[25], (L, N_EXPERTS, D, D_EXPERT), D ** -0.5),
        "w_exp_down": nrm(ks[26], (L, N_EXPERTS, D_EXPERT, D), D_EXPERT ** -0.5),
    }


def reference(x, c, w_ada, b_ada, g_norm_mix, g_norm_moe, w_in, cmp_pe_k, cmp_w1_k, cmp_w2_k, cmp_pe_v, cmp_w1_v,
              cmp_w2_v, nsa_q_gain, nsa_k_gain, swa_q_gain, swa_k_gain, swa_sinks, w_branch_a, w_branch_b,
              w_branch_c, w_out, w_router, router_bias, w_exp_gate, w_exp_up, w_exp_down):
    slopes = alibi_slopes(SWA_HEADS + NSA_HEADS)
    swa_slopes = slopes[:SWA_HEADS].reshape(SWA_KV, SWA_GROUP)
    nsa_slopes = slopes[SWA_HEADS:].reshape(NSA_KV, NSA_GROUP)
    cond = jax.nn.silu(c)
    for l in range(DEPTH):
        mod = cond @ w_ada[l] + b_ada[l]
        sh_a, sc_a, g_a, sh_m, sc_m, g_m = [m[:, None, :] for m in jnp.split(mod, 6, axis=-1)]
        h = rmsnorm(x, g_norm_mix[l]) * (1.0 + sc_a) + sh_a
        x = x + g_a * hybrid_mixer(h, w_in[l], cmp_pe_k[l], cmp_w1_k[l], cmp_w2_k[l], cmp_pe_v[l], cmp_w1_v[l],
                                   cmp_w2_v[l], nsa_q_gain[l], nsa_k_gain[l], swa_q_gain[l], swa_k_gain[l],
                                   swa_sinks[l], w_branch_a[l], w_branch_b[l], w_branch_c[l], w_out[l],
                                   nsa_slopes, swa_slopes)
        h = rmsnorm(x, g_norm_moe[l]) * (1.0 + sc_m) + sh_m
        x = x + g_m * grouped_moe(h, w_router, router_bias, w_exp_gate[l], w_exp_up[l], w_exp_down[l])
    return x
```

```cpp
#include <hip/hip_runtime.h>
#include <stdio.h>
#include <stdint.h>

#define LAS __attribute__((address_space(3)))
#define GAS __attribute__((address_space(1)))
typedef unsigned short bf16_t;
typedef short bf16x8 __attribute__((ext_vector_type(8)));
typedef float f32x4 __attribute__((ext_vector_type(4)));
typedef unsigned u32x4 __attribute__((ext_vector_type(4)));
typedef unsigned u32x2 __attribute__((ext_vector_type(2)));

constexpr int NTOK = 32768, SEQ = 16384, DM = 1024, NL = 4, NB = 2;
constexpr int NIN = 5272;
constexpr int ZLD = 2304;
constexpr int ZC_QA = 0, ZC_KCS = 512, ZC_VCS = 576, ZC_KSL = 640, ZC_VSL = 704, ZC_KWN = 768, ZC_VWN = 832,
              ZC_QB = 896, ZC_KB = 1152, ZC_VB = 1408, ZC_QC = 1664, ZC_KC = 1920, ZC_VC = 2048, ZC_GA = 2176;
constexpr int LCAP = 32768;
constexpr int AROWS = 65536 + 16 * 256;
constexpr float LOG2E = 1.4426950408889634f;
constexpr float LN2 = 0.6931471805599453f;
constexpr int LDS_BYTES = 147456;
constexpr int LDS_MISC = 131072;

constexpr size_t KiB = 1024, MiB = 1024 * 1024;
constexpr size_t WS_CTL = 0;
constexpr size_t WS_MOD = WS_CTL + 64 * KiB;
constexpr size_t WS_CB = WS_MOD + 192 * KiB;
constexpr size_t WS_LISTT = WS_CB + 8 * KiB;
constexpr size_t WS_LISTW = WS_LISTT + 2 * MiB;
constexpr size_t WS_KCMP = WS_LISTW + 2 * MiB;
constexpr size_t WS_VCMPT = WS_KCMP + 256 * KiB;
constexpr size_t WS_HID = WS_VCMPT + 256 * KiB;
constexpr size_t WS_WIN = WS_HID + 2 * MiB;
constexpr size_t WS_WM = WS_WIN + (size_t)NL * 2304 * 1024 * 2;
constexpr size_t WS_WB = WS_WM + (size_t)NL * 3072 * 1024 * 2;
constexpr size_t WS_WO = WS_WB + (size_t)NL * 1024 * 1024 * 2;
constexpr size_t WS_W1 = WS_WO + (size_t)NL * 1024 * 1024 * 2;
constexpr size_t WS_W2 = WS_W1 + (size_t)NL * 2 * 256 * 2048 * 2;
constexpr size_t WS_WGU = WS_W2 + (size_t)NL * 2 * 64 * 256 * 2;
constexpr size_t WS_WD = WS_WGU + (size_t)NL * 16 * 1024 * 1024 * 2;
constexpr size_t WS_H = WS_WD + (size_t)NL * 16 * 1024 * 512 * 2;
constexpr size_t WS_Z = WS_H + (size_t)NTOK * 1024 * 2;
constexpr size_t Z_BYTES = (size_t)(NTOK + 64) * ZLD * 2;
constexpr size_t WS_Y = WS_Z;
constexpr size_t WS_SB = WS_Z + 64 * MiB;
constexpr size_t WS_AB = WS_Z + 64 * MiB;
constexpr size_t WS_R3 = WS_Z + Z_BYTES;
constexpr size_t WS_YB = WS_R3;
constexpr size_t WS_VT = WS_R3;
constexpr size_t WS_O = WS_R3 + 32 * MiB;
constexpr size_t WS_END = WS_R3 + 128 * MiB;
static_assert(64 * MiB + (size_t)AROWS * 512 * 2 <= Z_BYTES, "alias map");

constexpr int CW_Q = 4096;
constexpr int CW_GCNT = 6144;

__device__ __forceinline__ unsigned cvt_pk_bf16(float lo, float hi) { unsigned r; asm("v_cvt_pk_bf16_f32 %0, %1, %2" : "=v"(r) : "v"(lo), "v"(hi)); return r; }
__device__ __forceinline__ bf16_t f2bf(float f) { return (bf16_t)(cvt_pk_bf16(f, 0.f) & 0xffffu); }
__device__ __forceinline__ float bf_lo(unsigned u) { return __uint_as_float(u << 16); }
__device__ __forceinline__ float bf_hi(unsigned u) { return __uint_as_float(u & 0xffff0000u); }
__device__ __forceinline__ float bf2f(bf16_t b) { return __uint_as_float(((unsigned)b) << 16); }
__device__ __forceinline__ float fexp2(float x) { return __builtin_amdgcn_exp2f(x); }
__device__ __forceinline__ float flog2(float x) { return __builtin_amdgcn_logf(x); }
__device__ __forceinline__ float frcp(float x) { return __builtin_amdgcn_rcpf(x); }
__device__ __forceinline__ float sigmoidf_(float x) { return frcp(1.f + fexp2(-x * LOG2E)); }
template <int M> __device__ __forceinline__ int shxi(int v, int lane) {
    if constexpr (M < 32) return __builtin_amdgcn_ds_swizzle(v, (M << 10) | 0x1f);
    else return __builtin_amdgcn_ds_bpermute((lane ^ 32) << 2, v);
}
template <int M> __device__ __forceinline__ float shx(float v, int lane) { return __int_as_float(shxi<M>(__float_as_int(v), lane)); }
__device__ __forceinline__ float wave_sum(float v, int lane) {
    v += shx<32>(v, lane); v += shx<16>(v, lane); v += shx<8>(v, lane); v += shx<4>(v, lane); v += shx<2>(v, lane); v += shx<1>(v, lane);
    return v;
}
__device__ __forceinline__ bf16x8 ldg8(const bf16_t* p) { return *(const GAS bf16x8*)p; }
__device__ __forceinline__ u32x4 ldg4u(const void* p) { return *(const GAS u32x4*)p; }
__device__ __forceinline__ u32x2 ldg2u(const void* p) { return *(const GAS u32x2*)p; }
__device__ __forceinline__ f32x4 ldg4f(const float* p) { return *(const GAS f32x4*)p; }
__device__ __forceinline__ void stg4u(void* p, u32x4 v) { *(GAS u32x4*)p = v; }
__device__ __forceinline__ void stg2u(void* p, u32x2 v) { *(GAS u32x2*)p = v; }
__device__ __forceinline__ void stg4f(float* p, f32x4 v) { *(GAS f32x4*)p = v; }

#define XB_TMO      128
#define XB_XCNT(j)  (256  + 64 * (j))
#define XB_XSUB(j)  (1280 + 64 * (j))
#define XB_XGEN(j)  (2304 + 64 * (j))
#define XB_TOP      3328
#define XB_TOPGEN   3392
#define XCD_BAR_WORDS 3456
#define XB_SPIN_CAP (1u << 18)
__device__ __forceinline__ unsigned xb_ld(unsigned* p)              { return __hip_atomic_load(p, __ATOMIC_RELAXED, __HIP_MEMORY_SCOPE_AGENT); }
__device__ __forceinline__ unsigned xb_add(unsigned* p, unsigned v) { return __hip_atomic_fetch_add(p, v, __ATOMIC_RELAXED, __HIP_MEMORY_SCOPE_AGENT); }
__device__ __forceinline__ unsigned xb_xcc_id() { return (unsigned)__builtin_amdgcn_s_getreg((3 << 11) | 20) & 0xFu; }
#define XB_SPIN(cond, bar) do { unsigned _sp = 0; while (cond) { __builtin_amdgcn_s_sleep(1); \
    if ((++_sp & 255u) == 0u) { if (xb_ld(&(bar)[XB_TMO])) break; if (_sp > XB_SPIN_CAP) { atomicAdd(&(bar)[XB_TMO], 1u); break; } } } } while (0)
struct XcdBarrier { unsigned* bar; unsigned x; volatile LAS unsigned* st; };
__device__ __forceinline__ XcdBarrier xcd_barrier_post(unsigned* bar, volatile LAS unsigned* st) {
    XcdBarrier b; b.bar = bar; b.x = xb_xcc_id(); b.st = st;
    if (threadIdx.x == 0) (void)xb_add(&bar[XB_XCNT(b.x)], 1u);
    return b;
}
__device__ __forceinline__ void xcd_barrier_complete(unsigned* bar, unsigned x, unsigned& nloc, unsigned& nx) {
    const unsigned G = gridDim.x * gridDim.y * gridDim.z;
    unsigned sum, cnt, mine, sp = 0u;
    for (;;) {
        sum = 0u; cnt = 0u; mine = 0u;
#pragma unroll
        for (unsigned j = 0; j < 16; ++j) { const unsigned c = xb_ld(&bar[XB_XCNT(j)]); sum += c; cnt += (c > 0u) ? 1u : 0u; mine = (j == x) ? c : mine; }
        if (sum == G) break;
        __builtin_amdgcn_s_sleep(1);
        if ((++sp & 255u) == 0u) { if (xb_ld(&bar[XB_TMO])) break; if (sp > XB_SPIN_CAP) { atomicAdd(&bar[XB_TMO], 1u); break; } }
    }
    nloc = mine > 0u ? mine : 1u; nx = cnt > 0u ? cnt : 1u;
}
__device__ __forceinline__ void xcd_barrier(const XcdBarrier& b) {
    asm volatile("s_waitcnt vmcnt(0)" ::: "memory");
    __syncthreads();
    if (threadIdx.x == 0) {
        unsigned* bar = b.bar;
        __builtin_amdgcn_s_waitcnt(0);
        unsigned nloc = b.st[0], nx = b.st[1];
        if (nloc == 0u) { xcd_barrier_complete(bar, b.x, nloc, nx); b.st[0] = nloc; b.st[1] = nx; }
        const unsigned old = xb_add(&bar[XB_XSUB(b.x)], 1u);
        const unsigned gen = old / nloc;
        if (old + 1u == (gen + 1u) * nloc) {
            __builtin_amdgcn_fence(__ATOMIC_RELEASE, "agent");
            asm volatile("s_waitcnt vmcnt(0)" ::: "memory");
            const unsigned og = xb_add(&bar[XB_TOP], 1u);
            const unsigned tg = og / nx;
            if (og + 1u == (tg + 1u) * nx) xb_add(&bar[XB_TOPGEN], 1u);
            else XB_SPIN(xb_ld(&bar[XB_TOPGEN]) == tg, bar);
            __builtin_amdgcn_fence(__ATOMIC_ACQUIRE, "agent");
            xb_add(&bar[XB_XGEN(b.x)], 1u);
            asm volatile("s_waitcnt vmcnt(0)" ::: "memory");
        } else {
            XB_SPIN(xb_ld(&bar[XB_XGEN(b.x)]) == gen, bar);
            __builtin_amdgcn_fence(__ATOMIC_ACQUIRE, "agent");
            asm volatile("s_waitcnt vmcnt(0)" ::: "memory");
        }
    }
    __syncthreads();
}

struct Params { const float* in[27]; float* out; unsigned char* ws; int step_lo, step_hi; };
struct Ctx { unsigned char* ws; float* out; LAS unsigned char* lds; int tid, bid, G; };
constexpr int LDS_PTAB = 131072 + 2048;
__device__ __forceinline__ unsigned long long uni64(unsigned long long v) {
    const unsigned lo = __builtin_amdgcn_readfirstlane((unsigned)v), hi = __builtin_amdgcn_readfirstlane((unsigned)(v >> 32)); return ((unsigned long long)hi << 32) | lo; }
__device__ __forceinline__ Ctx uni(Ctx X) { Ctx Y = X; int t = threadIdx.x; asm volatile("" : "+v"(t)); Y.tid = t;
    unsigned long long w = (unsigned long long)X.ws; asm volatile("" : "+s"(w)); Y.ws = (unsigned char*)w;
    unsigned long long o = (unsigned long long)X.out; asm volatile("" : "+s"(o)); Y.out = (float*)o;
    int bb = blockIdx.x; asm volatile("" : "+s"(bb)); Y.bid = bb; int gg = gridDim.x; asm volatile("" : "+s"(gg)); Y.G = gg; return Y; }
__device__ __forceinline__ const float* ctx_in(const Ctx& X, int i) { return (const float*)uni64(*(const LAS unsigned long long*)(X.lds + LDS_PTAB + 8 * i)); }
#define INP(i) ctx_in(X, (i))
enum { I_X = 0, I_C, I_WADA, I_BADA, I_GMIX, I_GMOE, I_WIN, I_PEK, I_W1K, I_W2K, I_PEV, I_W1V, I_W2V, I_NQG, I_NKG, I_SQG, I_SKG, I_SINK,
       I_WBA, I_WBB, I_WBC, I_WOUT, I_WR, I_RB, I_WEG, I_WEU, I_WED };

__device__ __forceinline__ void p0_prologue(const Ctx& X, LAS unsigned char* lds) {
    unsigned char* ws = X.ws;
    const int tid = X.tid, G = X.G, bid = X.bid;
    {
        const int lane = tid & 63, wave = tid >> 6;
        LAS float* sc = (LAS float*)lds;
        LAS float* red = (LAS float*)(lds + 8192);
        for (int i = tid; i < 2048; i += 512) { const float cv = INP(I_C)[i]; sc[i] = cv * sigmoidf_(cv); }
        __syncthreads();
        for (int u = bid; u < 256; u += G) {
            const int l = u >> 6, j0 = (u & 63) * 96;
            f32x4 a0 = (f32x4){0.f, 0.f, 0.f, 0.f}, a1 = a0;
            if (lane < 24) {
                const float* w = INP(I_WADA) + (size_t)l * 1024 * 6144 + j0 + 4 * lane;
#pragma unroll 8
                for (int k = wave * 128; k < wave * 128 + 128; ++k) { const f32x4 wv = ldg4f(w + (size_t)k * 6144); a0 += wv * sc[k]; a1 += wv * sc[1024 + k]; }
#pragma unroll
                for (int j = 0; j < 4; ++j) { red[(wave * 2 + 0) * 96 + 4 * lane + j] = a0[j]; red[(wave * 2 + 1) * 96 + 4 * lane + j] = a1[j]; }
            }
            __syncthreads();
            if (tid < 192) {
                const int b = tid / 96, j = tid % 96; float sm = 0.f;
#pragma unroll
                for (int w = 0; w < 8; ++w) sm += red[(w * 2 + b) * 96 + j];
                ((float*)(ws + WS_MOD))[((size_t)l * 2 + b) * 6144 + j0 + j] = sm + INP(I_BADA)[l * 6144 + j0 + j];
            }
            __syncthreads();
        }
        for (int u = bid; u < 256; u += G) {
            const int l = u >> 6, mat = (u >> 5) & 1, cc = u & 31;
            const float* pe = INP(mat ? I_PEV : I_PEK) + (size_t)l * 2048;
            const float* w = INP(mat ? I_W1V : I_W1K) + (size_t)l * 2048 * 256 + cc * 8 + (lane & 1) * 4;
            f32x4 a = (f32x4){0.f, 0.f, 0.f, 0.f};
#pragma unroll
            for (int it = 0; it < 8; ++it) { const int row = wave * 256 + it * 32 + (lane >> 1); a += ldg4f(w + (size_t)row * 256) * pe[row]; }
#pragma unroll
            for (int j = 0; j < 4; ++j) { float v = a[j]; v += shx<2>(v, lane); v += shx<4>(v, lane); v += shx<8>(v, lane); v += shx<16>(v, lane); v += shx<32>(v, lane); a[j] = v; }
            if (lane < 2) {
#pragma unroll
                for (int j = 0; j < 4; ++j) red[wave * 8 + lane * 4 + j] = a[j];
            }
            __syncthreads();
            if (tid < 8) { float sm = 0.f;
#pragma unroll
                for (int w2 = 0; w2 < 8; ++w2) sm += red[w2 * 8 + tid];
                ((float*)(ws + WS_CB))[(l * 2 + mat) * 256 + cc * 8 + tid] = sm; }
            __syncthreads();
        }
    }
    {
        LAS float* t32 = (LAS float*)lds;
        constexpr int PER_L = 576 + 768 + 256 + 256 + 256 + 8 + 4096 + 2048;
        const int total = NL * PER_L;
        const int lk = tid >> 3, lc8 = (tid & 7) * 8;
        const float* src = nullptr; const float* srcn = nullptr; bf16_t* dst = nullptr; bf16_t* dstn = nullptr;
        int src_ld = 0, dst_ld = 0, nvalid = 0, src_ldn = 0, dst_ldn = 0, nvalidn = 0;
        f32x4 va = (f32x4){0.f, 0.f, 0.f, 0.f}, vb = va, vna = va, vnb = va;
#define TDECODE(u, SRC, DST, SLD, DLD, NV) do { \
            const int l = (u) / PER_L; int r = (u) % PER_L; NV = 64; \
            if (r < 576) { const int n0 = (r / 16) * 64, k0 = (r % 16) * 64; int c0; \
                if (n0 < 896) c0 = n0; else if (n0 < 2176) c0 = n0 + 24; else if (n0 == 2176) { c0 = 896; NV = 24; } else { c0 = 0; NV = 0; } \
                SRC = INP(I_WIN) + ((size_t)l * 1024 + k0) * NIN + c0; SLD = NIN; DST = (bf16_t*)(ws + WS_WIN) + ((size_t)l * 2304 + n0) * 1024 + k0; DLD = 1024; } \
            else if ((r -= 576) < 768) { const int n0 = (r / 16) * 64, k0 = (r % 16) * 64; \
                SRC = INP(I_WIN) + ((size_t)l * 1024 + k0) * NIN + 2200 + n0; SLD = NIN; DST = (bf16_t*)(ws + WS_WM) + ((size_t)l * 3072 + n0) * 1024 + k0; DLD = 1024; } \
            else if ((r -= 768) < 256) { const int n0 = (r / 16) * 64, k0 = (r % 16) * 64; \
                if (k0 < 512) SRC = INP(I_WBA) + ((size_t)l * 512 + k0) * 1024 + n0; \
                else if (k0 < 768) SRC = INP(I_WBB) + ((size_t)l * 256 + (k0 - 512)) * 1024 + n0; \
                else SRC = INP(I_WBC) + ((size_t)l * 256 + (k0 - 768)) * 1024 + n0; \
                SLD = 1024; DST = (bf16_t*)(ws + WS_WB) + ((size_t)l * 1024 + n0) * 1024 + k0; DLD = 1024; } \
            else if ((r -= 256) < 256) { const int n0 = (r / 16) * 64, k0 = (r % 16) * 64; \
                SRC = INP(I_WOUT) + ((size_t)l * 1024 + k0) * 1024 + n0; SLD = 1024; DST = (bf16_t*)(ws + WS_WO) + ((size_t)l * 1024 + n0) * 1024 + k0; DLD = 1024; } \
            else if ((r -= 256) < 256) { const int mat = r / 128, rr = r % 128, n0 = (rr / 32) * 64, k0 = (rr % 32) * 64; \
                SRC = INP(mat ? I_W1V : I_W1K) + ((size_t)l * 2048 + k0) * 256 + n0; SLD = 256; DST = (bf16_t*)(ws + WS_W1) + (((size_t)l * 2 + mat) * 256 + n0) * 2048 + k0; DLD = 2048; } \
            else if ((r -= 256) < 8) { const int mat = r / 4, k0 = (r % 4) * 64; \
                SRC = INP(mat ? I_W2V : I_W2K) + ((size_t)l * 256 + k0) * 64; SLD = 64; DST = (bf16_t*)(ws + WS_W2) + (((size_t)l * 2 + mat) * 64) * 256 + k0; DLD = 256; } \
            else if ((r -= 8) < 4096) { const int e = r / 256, rr = r % 256, n0 = (rr / 16) * 64, k0 = (rr % 16) * 64; \
                const int blk = n0 / 256, half = (n0 % 256) / 128, c0 = blk * 128 + (n0 % 128); \
                SRC = INP(half ? I_WEU : I_WEG) + (((size_t)l * 16 + e) * 1024 + k0) * 512 + c0; SLD = 512; DST = (bf16_t*)(ws + WS_WGU) + (((size_t)l * 16 + e) * 1024 + n0) * 1024 + k0; DLD = 1024; } \
            else { r -= 4096; const int e = r / 128, rr = r % 128, n0 = (rr / 8) * 64, k0 = (rr % 8) * 64; \
                SRC = INP(I_WED) + (((size_t)l * 16 + e) * 512 + k0) * 1024 + n0; SLD = 1024; DST = (bf16_t*)(ws + WS_WD) + (((size_t)l * 16 + e) * 1024 + n0) * 512 + k0; DLD = 512; } \
        } while (0)
#define TLOAD(SRC, SLD, NV, A, B) do { if (lc8 + 8 <= (NV)) { A = ldg4f((SRC) + (size_t)lk * (SLD) + lc8); B = ldg4f((SRC) + (size_t)lk * (SLD) + lc8 + 4); } \
            else { A = (f32x4){0.f, 0.f, 0.f, 0.f}; B = A; } } while (0)
        int u = bid;
        if (u < total) { TDECODE(u, src, dst, src_ld, dst_ld, nvalid); TLOAD(src, src_ld, nvalid, va, vb); }
        while (u < total) {
            const int un = u + G;
            if (un < total) { TDECODE(un, srcn, dstn, src_ldn, dst_ldn, nvalidn); TLOAD(srcn, src_ldn, nvalidn, vna, vnb); }
            {
                LAS float* w = t32 + lk * 65 + lc8;
                w[0] = va[0]; w[1] = va[1]; w[2] = va[2]; w[3] = va[3]; w[4] = vb[0]; w[5] = vb[1]; w[6] = vb[2]; w[7] = vb[3];
            }
            __syncthreads();
            {
                const int n = tid >> 3, k8 = (tid & 7) * 8;
                const LAS float* r_ = t32 + k8 * 65 + n;
                u32x4 o;
                o[0] = cvt_pk_bf16(r_[0 * 65], r_[1 * 65]); o[1] = cvt_pk_bf16(r_[2 * 65], r_[3 * 65]);
                o[2] = cvt_pk_bf16(r_[4 * 65], r_[5 * 65]); o[3] = cvt_pk_bf16(r_[6 * 65], r_[7 * 65]);
                stg4u(dst + (size_t)n * dst_ld + k8, o);
            }
            __syncthreads();
            u = un; src = srcn; dst = dstn; src_ld = src_ldn; dst_ld = dst_ldn; nvalid = nvalidn; va = vna; vb = vnb;
        }
#undef TDECODE
#undef TLOAD
    }
}

template <int MODE>
__device__ __forceinline__ void norm_phase(const Ctx& X, LAS unsigned char* lds, int layer) {
    unsigned char* ws = X.ws;
    const int tid = X.tid, lane = tid & 63, wave = tid >> 6, G = X.G;
    const float* xsrc = (MODE == 0) ? INP(I_X) : X.out;
    float* xdst = X.out;
    const float* modl = (const float*)(ws + WS_MOD) + (size_t)layer * 2 * 6144;
    const float* modp = (const float*)(ws + WS_MOD) + (size_t)(layer - 1) * 2 * 6144;
    const bf16_t* yb = (const bf16_t*)(ws + WS_YB);
    bf16_t* h = (bf16_t*)(ws + WS_H);
    const float* gn = INP(MODE == 2 ? I_GMOE : I_GMIX) + (size_t)layer * 1024;
    const int sh_off = (MODE == 2) ? 3072 : 0, sc_off = (MODE == 2) ? 4096 : 1024;
    LAS float* wrT = (LAS float*)lds;
    LAS int* lcnt = (LAS int*)(lds + LDS_MISC + 64);
    LAS int* lbase = (LAS int*)(lds + LDS_MISC + 128);
    if (MODE == 2) {
        for (int i = tid; i < 16384; i += 512) { const int k = i >> 4, e = i & 15; wrT[e * 1024 + k] = INP(I_WR)[i]; }
        if (tid < 16) lcnt[tid] = 0;
        __syncthreads();
    }
    int my_e = 0, my_r0 = 0, my_r1 = 0, my_tok = 0; float my_w0 = 0.f, my_w1 = 0.f;
    int it = 0;
    f32x4 vn[4]; u32x2 y0n[4], y1n[4];
#define NORM_LOAD(r) do { _Pragma("unroll") for (int i = 0; i < 4; ++i) { const int col_ = 4 * (lane + 64 * i); vn[i] = ldg4f(xsrc + (size_t)(r) * 1024 + col_); \
        if (MODE == 1 || MODE == 3) { y0n[i] = ldg2u(yb + (size_t)(2 * (r)) * 1024 + col_); y1n[i] = ldg2u(yb + (size_t)(2 * (r) + 1) * 1024 + col_); } } } while (0)
    { const int r0 = X.bid * 8 + wave; if (r0 < NTOK) NORM_LOAD(r0); }
    for (int row = X.bid * 8 + wave; row < NTOK; row += G * 8, ++it) {
        const int b = row >> 14;
        f32x4 v[4]; u32x2 y0c[4], y1c[4];
#pragma unroll
        for (int i = 0; i < 4; ++i) { v[i] = vn[i]; y0c[i] = y0n[i]; y1c[i] = y1n[i]; }
        if (row + G * 8 < NTOK) NORM_LOAD(row + G * 8);
        if (MODE == 1 || MODE == 3) {
#pragma unroll
            for (int i = 0; i < 4; ++i) {
                const int col = 4 * (lane + 64 * i);
                const f32x4 g = ldg4f(modp + b * 6144 + 5120 + col);
                const u32x2 y0 = y0c[i], y1 = y1c[i];
                v[i][0] += g[0] * (bf_lo(y0[0]) + bf_lo(y1[0])); v[i][1] += g[1] * (bf_hi(y0[0]) + bf_hi(y1[0]));
                v[i][2] += g[2] * (bf_lo(y0[1]) + bf_lo(y1[1])); v[i][3] += g[3] * (bf_hi(y0[1]) + bf_hi(y1[1]));
                stg4f(xdst + (size_t)row * 1024 + col, v[i]);
            }
        }
        if (MODE == 3) continue;
        float ss = 0.f;
#pragma unroll
        for (int i = 0; i < 4; ++i) ss += v[i][0] * v[i][0] + v[i][1] * v[i][1] + v[i][2] * v[i][2] + v[i][3] * v[i][3];
        ss = wave_sum(ss, lane);
        const float rinv = rsqrtf(ss * (1.f / 1024.f) + 1e-6f);
        f32x4 hv[4];
#pragma unroll
        for (int i = 0; i < 4; ++i) {
            const int col = 4 * (lane + 64 * i);
            const f32x4 g = ldg4f(gn + col), sc = ldg4f(modl + b * 6144 + sc_off + col), sh = ldg4f(modl + b * 6144 + sh_off + col);
#pragma unroll
            for (int j = 0; j < 4; ++j) hv[i][j] = v[i][j] * rinv * g[j] * (1.f + sc[j]) + sh[j];
            u32x2 o; o[0] = cvt_pk_bf16(hv[i][0], hv[i][1]); o[1] = cvt_pk_bf16(hv[i][2], hv[i][3]);
            stg2u(h + (size_t)row * 1024 + col, o);
        }
        if (MODE == 2) {
            float lg[16];
#pragma unroll
            for (int e = 0; e < 16; ++e) {
                float a = 0.f;
#pragma unroll
                for (int i = 0; i < 4; ++i) { const f32x4 w = *(const LAS f32x4*)(wrT + e * 1024 + 4 * (lane + 64 * i)); a += hv[i][0] * w[0] + hv[i][1] * w[1] + hv[i][2] * w[2] + hv[i][3] * w[3]; }
                lg[e] = a;
            }
            float r8[8], r4[4], r2[2], r1;
            { const bool hi = (lane & 32) != 0;
#pragma unroll
              for (int j = 0; j < 8; ++j) { const float keep = hi ? lg[8 + j] : lg[j], send = hi ? lg[j] : lg[8 + j]; r8[j] = keep + shx<32>(send, lane); } }
            { const bool hi = (lane & 16) != 0;
#pragma unroll
              for (int j = 0; j < 4; ++j) { const float keep = hi ? r8[4 + j] : r8[j], send = hi ? r8[j] : r8[4 + j]; r4[j] = keep + shx<16>(send, lane); } }
            { const bool hi = (lane & 8) != 0;
#pragma unroll
              for (int j = 0; j < 2; ++j) { const float keep = hi ? r4[2 + j] : r4[j], send = hi ? r4[j] : r4[2 + j]; r2[j] = keep + shx<8>(send, lane); } }
            { const bool hi = (lane & 4) != 0; const float keep = hi ? r2[1] : r2[0], send = hi ? r2[0] : r2[1]; r1 = keep + shx<4>(send, lane); }
            r1 += shx<1>(r1, lane); r1 += shx<2>(r1, lane);
            float sco[16], sel[16];
#pragma unroll
            for (int e = 0; e < 16; ++e) {
                const float lgt = __int_as_float(__builtin_amdgcn_readlane(__float_as_int(r1), 4 * e));
                sco[e] = 1.f / (1.f + __expf(-lgt)); sel[e] = sco[e] + INP(I_RB)[e];
            }
            float gs[4];
#pragma unroll
            for (int g = 0; g < 4; ++g) {
                const float a = sel[4 * g], bq = sel[4 * g + 1], c = sel[4 * g + 2], d = sel[4 * g + 3];
                const float m1 = fmaxf(fmaxf(a, bq), fmaxf(c, d));
                int i1 = (a == m1) ? 0 : (bq == m1) ? 1 : (c == m1) ? 2 : 3;
                float m2 = -3.0e38f;
                m2 = (i1 != 0) ? fmaxf(m2, a) : m2; m2 = (i1 != 1) ? fmaxf(m2, bq) : m2; m2 = (i1 != 2) ? fmaxf(m2, c) : m2; m2 = (i1 != 3) ? fmaxf(m2, d) : m2;
                gs[g] = m1 + m2;
            }
            int gi = 0; float gb = gs[0];
#pragma unroll
            for (int g = 1; g < 4; ++g) if (gs[g] > gb) { gb = gs[g]; gi = g; }
            float s0 = (gi == 0) ? sel[0] : (gi == 1) ? sel[4] : (gi == 2) ? sel[8] : sel[12];
            float s1 = (gi == 0) ? sel[1] : (gi == 1) ? sel[5] : (gi == 2) ? sel[9] : sel[13];
            float s2 = (gi == 0) ? sel[2] : (gi == 1) ? sel[6] : (gi == 2) ? sel[10] : sel[14];
            float s3 = (gi == 0) ? sel[3] : (gi == 1) ? sel[7] : (gi == 2) ? sel[11] : sel[15];
            float c0 = (gi == 0) ? sco[0] : (gi == 1) ? sco[4] : (gi == 2) ? sco[8] : sco[12];
            float c1 = (gi == 0) ? sco[1] : (gi == 1) ? sco[5] : (gi == 2) ? sco[9] : sco[13];
            float c2 = (gi == 0) ? sco[2] : (gi == 1) ? sco[6] : (gi == 2) ? sco[10] : sco[14];
            float c3 = (gi == 0) ? sco[3] : (gi == 1) ? sco[7] : (gi == 2) ? sco[11] : sco[15];
            const float m1 = fmaxf(fmaxf(s0, s1), fmaxf(s2, s3));
            const int i1 = (s0 == m1) ? 0 : (s1 == m1) ? 1 : (s2 == m1) ? 2 : 3;
            float m2 = -3.0e38f;
            m2 = (i1 != 0) ? fmaxf(m2, s0) : m2; m2 = (i1 != 1) ? fmaxf(m2, s1) : m2; m2 = (i1 != 2) ? fmaxf(m2, s2) : m2; m2 = (i1 != 3) ? fmaxf(m2, s3) : m2;
            const int i2 = (i1 != 0 && s0 == m2) ? 0 : (i1 != 1 && s1 == m2) ? 1 : (i1 != 2 && s2 == m2) ? 2 : 3;
            const float w1v = (i1 == 0) ? c0 : (i1 == 1) ? c1 : (i1 == 2) ? c2 : c3;
            const float w2v = (i2 == 0) ? c0 : (i2 == 1) ? c1 : (i2 == 2) ? c2 : c3;
            const float wn = 1.f / (w1v + w2v);
            const int e0 = gi * 4 + i1, e1 = gi * 4 + i2;
            if (lane == it) {
                my_e = e0 | (e1 << 8); my_tok = row; my_w0 = w1v * wn; my_w1 = w2v * wn;
                my_r0 = __hip_atomic_fetch_add(lcnt + e0, 1, __ATOMIC_RELAXED, __HIP_MEMORY_SCOPE_WORKGROUP); my_r1 = __hip_atomic_fetch_add(lcnt + e1, 1, __ATOMIC_RELAXED, __HIP_MEMORY_SCOPE_WORKGROUP);
            }
        }
    }
#undef NORM_LOAD
    if (MODE == 2) {
        __syncthreads();
        unsigned* gcnt = (unsigned*)(ws + WS_CTL) + CW_GCNT + 16 * (layer * 16);
        if (tid < 16) lbase[tid] = (int)atomicAdd(gcnt + 16 * tid, (unsigned)lcnt[tid]);
        __syncthreads();
        if (lane < it) {
            const int e0 = my_e & 255, e1 = my_e >> 8;
            int* lt = (int*)(ws + WS_LISTT); float* lw = (float*)(ws + WS_LISTW);
            const int p0 = lbase[e0] + my_r0, p1 = lbase[e1] + my_r1;
            lt[e0 * LCAP + p0] = my_tok * 2; lw[e0 * LCAP + p0] = my_w0;
            lt[e1 * LCAP + p1] = my_tok * 2 + 1; lw[e1 * LCAP + p1] = my_w1;
        }
    }
    __syncthreads();
}

constexpr int BM = 256, BK = 64, HALF = 128, HTB = HALF * BK * 2, STAGE_BYTES = 8 * HTB;
__host__ __device__ __forceinline__ int lds_byte(int r, int c) { const int st = (r >> 4) * 2 + (c >> 5), rr = r & 15, cc = c & 31, ob = rr * 64 + cc * 2; return st * 1024 + (ob ^ (((ob >> 9) & 1) << 5)); }
__host__ __device__ __forceinline__ void stage_rc(int b, int& R, int& C) { const int st = b / 1024, sb = b % 1024, swz = sb ^ (((sb >> 9) & 1) << 5); R = (st >> 1) * 16 + swz / 64; C = (st & 1) * 32 + (swz % 64) / 2; }
__host__ __device__ __forceinline__ int perm32(int rho) { const int n = rho >> 4, i = rho & 15; return 8 * (i >> 2) + 4 * n + (i & 3); }

struct GU { const char* A; const char* B; int nt, kind, pm, pn, e, aux; };

__device__ __forceinline__ bool tile_map(long L, int nM, int nN, int& pm, int& pn) {
    const int nwg = nM * nN; if (L >= nwg) return false;
    int wgid = (int)L; { const int q = nwg / 8, r = nwg % 8, xcd = wgid % 8, off = wgid / 8; wgid = (xcd < r ? xcd * (q + 1) : r * (q + 1) + (xcd - r) * q) + off; }
    const int nig = 8 * nN, gid = wgid / nig, fm = gid * 8, gsz = (nM - fm) < 8 ? (nM - fm) : 8;
    pm = fm + ((wgid % nig) % gsz); pn = (wgid % nig) / gsz; return true;
}

template <class Epi, class Sched>
__device__ __forceinline__ void gemm_run(LAS unsigned char* lds, const Sched& S, const Epi& E, const int tid) {
    const int wid = __builtin_amdgcn_readfirstlane(tid >> 6), lane = tid & 63, wr = wid >> 2, wc = wid & 3, fr = lane & 15, fq = lane >> 4;
    unsigned vA[2][2], vAn[2][2], voffB[2];
#pragma unroll
    for (int i = 0; i < 2; ++i) { int R, C; stage_rc(tid * 16 + i * 8192, R, C); const int Rb = Epi::HEADMAP ? ((R >> 5) * 64 + perm32(R & 31)) : (Epi::PERM ? ((R & ~31) + perm32(R & 31)) : R);
        voffB[i] = (unsigned)Rb * (unsigned)S.ldb2 + (unsigned)C * 2u;
        vA[0][i] = (unsigned)R * (unsigned)S.lda2 + (unsigned)C * 2u; vA[1][i] = (unsigned)(R + HALF) * (unsigned)S.lda2 + (unsigned)C * 2u;
        vAn[0][i] = vA[0][i]; vAn[1][i] = vA[1][i]; }
    const size_t akstep = (size_t)S.akstep, bkstep = (size_t)(BK * 2), hstepB = (size_t)(Epi::HEADMAP ? 32 : HALF) * S.ldb2;
    const unsigned ldsw = (unsigned)wid * 1024u;
    const int aoff = lds_byte(wr * 64 + fr, fq * 8), boff = lds_byte(wc * 32 + fr, fq * 8);
#define G_SA(b, h) (((b) * 2 + (h)) * HTB)
#define G_SB(b, h) ((4 + (b) * 2 + (h)) * HTB)
#define G_STAGE2(bufoff, gbase, o0, o1) do { \
        __builtin_amdgcn_global_load_lds((const unsigned*)((const char*)(gbase) + (o0)), (LAS unsigned*)(lds + (bufoff) + ldsw), 16, 0, 0); \
        __builtin_amdgcn_global_load_lds((const unsigned*)((const char*)(gbase) + (o1)), (LAS unsigned*)(lds + (bufoff) + ldsw + 8192), 16, 0, 0); } while (0)
#define G_STAGE_B(bufoff, gbase) G_STAGE2(bufoff, gbase, voffB[0], voffB[1])
#define G_LDA(dst, b, h) do { _Pragma("unroll") for (int m = 0; m < 4; ++m) _Pragma("unroll") for (int k = 0; k < 2; ++k) dst[m][k] = *(const LAS bf16x8*)(lds + G_SA(b, h) + aoff + m * 2048 + k * 1024); } while (0)
#define G_LDB(dst, b, h) do { _Pragma("unroll") for (int n = 0; n < 2; ++n) _Pragma("unroll") for (int k = 0; k < 2; ++k) dst[n][k] = *(const LAS bf16x8*)(lds + G_SB(b, h) + boff + n * 2048 + k * 1024); } while (0)
#define G_MMA(ai, bj, At, Bt) do { __builtin_amdgcn_s_setprio(1); _Pragma("unroll") for (int m = 0; m < 4; ++m) _Pragma("unroll") for (int n = 0; n < 2; ++n) _Pragma("unroll") for (int k = 0; k < 2; ++k) \
        acc[ai][bj][m][n] = __builtin_amdgcn_mfma_f32_16x16x32_bf16(Bt[n][k], At[m][k], acc[ai][bj][m][n], 0, 0, 0); __builtin_amdgcn_s_setprio(0); } while (0)
#define G_WAIT_V(n) asm volatile("s_waitcnt vmcnt(" #n ")" ::: "memory")
#define G_WAIT_L(n) asm volatile("s_waitcnt lgkmcnt(" #n ")" ::: "memory")
#define G_BAR __builtin_amdgcn_s_barrier()
#define G_SCHED __builtin_amdgcn_sched_barrier(0)
    GU cur, nxt; int ui = 0;
    if (!S.next(0, cur)) return;
    if (Sched::GATHER) S.rowoff(cur, tid, vA);
    f32x4 acc[2][2][4][2];
#pragma unroll
    for (int a = 0; a < 2; ++a)
#pragma unroll
        for (int b = 0; b < 2; ++b)
#pragma unroll
            for (int m = 0; m < 4; ++m)
#pragma unroll
                for (int n = 0; n < 2; ++n) acc[a][b][m][n] = (f32x4){0.f, 0.f, 0.f, 0.f};
    bf16x8 At[4][2], B0[2][2], B1[2][2];
    const char* cA = cur.A; const char* cB = cur.B;
    G_STAGE_B(G_SB(0, 0), cB); G_STAGE2(G_SA(0, 0), cA, vA[0][0], vA[0][1]); G_STAGE_B(G_SB(0, 1), cB + hstepB); G_STAGE2(G_SA(0, 1), cA, vA[1][0], vA[1][1]);
    if (wr == 1) G_BAR;
    G_WAIT_V(4); G_BAR;
    G_STAGE_B(G_SB(1, 0), cB + bkstep); G_STAGE2(G_SA(1, 0), cA + akstep, vA[0][0], vA[0][1]); G_STAGE_B(G_SB(1, 1), cB + hstepB + bkstep);
    G_WAIT_V(6); G_BAR;
    for (;;) {
        const bool has_next = S.next(ui + 1, nxt);
        const char* nA = has_next ? nxt.A : cA; const char* nB = has_next ? nxt.B : cB;
        if (Sched::GATHER) { if (has_next) S.rowoff(nxt, tid, vAn); else {
#pragma unroll
            for (int h = 0; h < 2; ++h) { vAn[h][0] = vA[h][0]; vAn[h][1] = vA[h][1]; } } }
        const int nt = cur.nt;
        for (int t = 0; t < nt; t += 2) {
            const bool last = (t == nt - 2);
            const char* a1 = cA + (size_t)(t + 1) * akstep;
            const char* a2 = last ? nA : cA + (size_t)(t + 2) * akstep; const char* b2 = last ? nB : cB + (size_t)(t + 2) * bkstep;
            const char* a3 = a2 + akstep; const char* b3 = b2 + bkstep;
            unsigned w00, w01, w10, w11;
            if (Sched::GATHER) { w00 = last ? vAn[0][0] : vA[0][0]; w01 = last ? vAn[0][1] : vA[0][1]; w10 = last ? vAn[1][0] : vA[1][0]; w11 = last ? vAn[1][1] : vA[1][1]; }
            else { w00 = vA[0][0]; w01 = vA[0][1]; w10 = vA[1][0]; w11 = vA[1][1]; }
            G_LDB(B0, 0, 0); G_SCHED; G_LDA(At, 0, 0); G_STAGE2(G_SA(1, 1), a1, vA[1][0], vA[1][1]);
            G_WAIT_L(8); G_BAR; G_WAIT_L(0); G_MMA(0, 0, At, B0); G_BAR; G_SCHED;
            G_LDB(B1, 0, 1); G_STAGE_B(G_SB(0, 0), b2);
            G_BAR; G_WAIT_L(0); G_MMA(0, 1, At, B1); G_BAR;
            G_LDA(At, 0, 1); G_STAGE2(G_SA(0, 0), a2, w00, w01);
            G_BAR; G_WAIT_L(0); G_MMA(1, 0, At, B0); G_BAR; G_SCHED;
            G_STAGE_B(G_SB(0, 1), b2 + hstepB);
            G_WAIT_V(6); G_BAR; G_MMA(1, 1, At, B1); G_BAR;
            G_LDB(B0, 1, 0); G_SCHED; G_LDA(At, 1, 0); G_STAGE2(G_SA(0, 1), a2, w10, w11);
            G_WAIT_L(8); G_BAR; G_WAIT_L(0); G_MMA(0, 0, At, B0); G_BAR; G_SCHED;
            G_LDB(B1, 1, 1); G_STAGE_B(G_SB(1, 0), b3);
            G_BAR; G_WAIT_L(0); G_MMA(0, 1, At, B1); G_BAR;
            G_LDA(At, 1, 1); G_STAGE2(G_SA(1, 0), a3, w00, w01);
            G_BAR; G_WAIT_L(0); G_MMA(1, 0, At, B0); G_BAR; G_SCHED;
            G_STAGE_B(G_SB(1, 1), b3 + hstepB);
            G_WAIT_V(6); G_BAR; G_MMA(1, 1, At, B1); G_BAR;
        }
        E(acc, cur, wr, wc, fr, fq);
        if (!has_next) break;
#pragma unroll
        for (int a = 0; a < 2; ++a)
#pragma unroll
            for (int b = 0; b < 2; ++b)
#pragma unroll
                for (int m = 0; m < 4; ++m)
#pragma unroll
                    for (int n = 0; n < 2; ++n) acc[a][b][m][n] = (f32x4){0.f, 0.f, 0.f, 0.f};
        cur = nxt; cA = nA; cB = nB; ++ui;
        if (Sched::GATHER) {
#pragma unroll
            for (int h = 0; h < 2; ++h) { vA[h][0] = vAn[h][0]; vA[h][1] = vAn[h][1]; } }
    }
    G_WAIT_V(0);
    if (wr == 0) G_BAR;
    G_BAR;
#undef G_SA
#undef G_SB
#undef G_STAGE2
#undef G_STAGE_B
#undef G_LDA
#undef G_LDB
#undef G_MMA
#undef G_WAIT_V
#undef G_WAIT_L
#undef G_BAR
#undef G_SCHED
}

struct SchedDense {
    static constexpr bool GATHER = false;
    int lda2, akstep, ldb2; const char* A; const char* B; int nM, nN, nt, G, c;
    __device__ __forceinline__ bool next(int i, GU& u) const {
        int pm, pn; if (!tile_map((long)i * G + c, nM, nN, pm, pn)) return false;
        u.A = A + (size_t)pm * 256 * lda2; u.B = B + (size_t)pn * 256 * ldb2; u.nt = nt; u.kind = 0; u.pm = pm; u.pn = pn; u.e = 0; u.aux = 0; return true;
    }
    __device__ __forceinline__ void rowoff(const GU&, int, unsigned (&)[2][2]) const {}
};
struct SchedE1 {
    static constexpr bool GATHER = false;
    int lda2, akstep, ldb2; const char* O; const char* H; const char* WB; const char* WM; int G, c;
    __device__ __forceinline__ bool next(int i, GU& u) const {
        const int T = i / 6, sub = i % 6, br = sub >> 1, typ = sub & 1;
        int pm, pn; if (!tile_map((long)T * G + c, 128, 4, pm, pn)) return false;
        const int koff = (br == 0) ? 0 : (br == 1) ? 512 : 768;
        if (typ == 0) { u.A = O + (size_t)pm * 256 * 2048 + koff * 2; u.B = WB + (size_t)pn * 256 * 2048 + koff * 2; u.nt = (br == 0) ? 8 : 4; }
        else { u.A = H + (size_t)pm * 256 * 2048; u.B = WM + (size_t)(br * 1024 + pn * 256) * 2048; u.nt = 16; }
        u.kind = typ; u.pm = pm; u.pn = pn; u.e = br; u.aux = 0; return true;
    }
    __device__ __forceinline__ void rowoff(const GU&, int, unsigned (&)[2][2]) const {}
};
struct SchedMoE {
    static constexpr bool GATHER = true;
    int lda2, akstep, ldb2; const char* A; const char* B; size_t bstride; int ncol, nt, G, c, phase  ;
    const LAS int* tpre;
    const int* listT;
    __device__ __forceinline__ bool next(int i, GU& u) const {
        const long L = (long)i * G + c; const int ntile = tpre[16];
        if (L >= (long)ntile * ncol) return false;
        const int rt = (int)(L / ncol), pn = (int)(L % ncol);
        int e = 0;
#pragma unroll
        for (int k = 1; k < 16; ++k) e += (rt >= tpre[k]) ? 1 : 0;
        const int lt = rt - tpre[e];
        u.e = e; u.pm = lt; u.pn = pn; u.nt = nt; u.kind = 0; u.aux = tpre[34 + e] + lt * 256;
        u.B = B + (size_t)e * bstride + (size_t)pn * 256 * ldb2;
        u.A = (phase == 1) ? A : A + (size_t)u.aux * lda2;
        return true;
    }
    __device__ __forceinline__ void rowoff(const GU& u, int tid, unsigned (&vo)[2][2]) const {
        const int cnt = tpre[17 + u.e];
#pragma unroll
        for (int i = 0; i < 2; ++i) { int R, C; stage_rc(tid * 16 + i * 8192, R, C);
#pragma unroll
            for (int h = 0; h < 2; ++h) {
                const int r = u.pm * 256 + h * 128 + R;
                if (phase == 1) { const int tok = (r < cnt) ? (listT[u.e * LCAP + r] >> 1) : 0; vo[h][i] = (unsigned)tok * 2048u + (unsigned)C * 2u; }
                else vo[h][i] = (unsigned)(h * 128 + R) * (unsigned)lda2 + (unsigned)C * 2u;
            } }
    }
};

__device__ __forceinline__ u32x4 pack8(const f32x4 a, const f32x4 b) { u32x4 o; o[0] = cvt_pk_bf16(a[0], a[1]); o[1] = cvt_pk_bf16(a[2], a[3]); o[2] = cvt_pk_bf16(b[0], b[1]); o[3] = cvt_pk_bf16(b[2], b[3]); return o; }
__device__ __forceinline__ void unpack8(const u32x4 u, f32x4& a, f32x4& b) { a[0] = bf_lo(u[0]); a[1] = bf_hi(u[0]); a[2] = bf_lo(u[1]); a[3] = bf_hi(u[1]); b[0] = bf_lo(u[2]); b[1] = bf_hi(u[2]); b[2] = bf_lo(u[3]); b[3] = bf_hi(u[3]); }

struct EpiBf16 {
    static constexpr bool PERM = true, HEADMAP = false;
    bf16_t* O; int ldc;
    __device__ __forceinline__ void operator()(const f32x4 (&acc)[2][2][4][2], const GU& u, int wr, int wc, int fr, int fq) const {
#pragma unroll
        for (int ai = 0; ai < 2; ++ai)
#pragma unroll
            for (int m = 0; m < 4; ++m) { bf16_t* rowp = O + (size_t)(u.pm * 256 + ai * 128 + wr * 64 + m * 16 + fr) * ldc + u.pn * 256 + wc * 32 + 8 * fq;
#pragma unroll
                for (int bj = 0; bj < 2; ++bj) stg4u(rowp + bj * 128, pack8(acc[ai][bj][m][0], acc[ai][bj][m][1])); }
    }
};
struct EpiZ {
    static constexpr bool PERM = true, HEADMAP = true;
    bf16_t* Z; bf16_t* VT; const float* nqg; const float* nkg; const float* sqg; const float* skg;
    __device__ __forceinline__ void operator()(const f32x4 (&acc)[2][2][4][2], const GU& u, int wr, int wc, int fr, int fq) const {
        const int hidx = u.pn * 4 + wc, lane = fq * 16 + fr;
        int typ; const float* gain = nqg; float cst = 1.f; int vm = 0;
        if (hidx < 8) { typ = 1; gain = nqg; cst = 0.125f * LOG2E; }
        else if (hidx < 10) typ = 0;
        else if (hidx == 10) { typ = 1; gain = nkg + 64; }
        else if (hidx == 11) { typ = 3; vm = 0; }
        else if (hidx == 12) { typ = 1; gain = nkg + 128; }
        else if (hidx == 13) { typ = 3; vm = 1; }
        else if (hidx < 18) { typ = 2; cst = 0.125f; }
        else if (hidx < 22) typ = 0;
        else if (hidx < 26) { typ = 3; vm = 2 + (hidx - 22); }
        else if (hidx < 30) { typ = 1; gain = sqg; cst = 0.125f * LOG2E; }
        else if (hidx < 32) { typ = 1; gain = skg; }
        else if (hidx < 34) { typ = 3; vm = 6 + (hidx - 32); }
        else if (hidx == 34) typ = 4;
        else typ = 0;
        f32x4 g0 = (f32x4){1.f, 1.f, 1.f, 1.f}, g1 = g0, g2 = g0, g3 = g0;
        if (typ == 1) { g0 = ldg4f(gain + 8 * fq) * cst; g1 = ldg4f(gain + 8 * fq + 4) * cst; g2 = ldg4f(gain + 32 + 8 * fq) * cst; g3 = ldg4f(gain + 36 + 8 * fq) * cst; }
        const int b = u.pm >> 6;
#pragma unroll
        for (int ai = 0; ai < 2; ++ai)
#pragma unroll
            for (int m = 0; m < 4; ++m) {
                const int row = u.pm * 256 + ai * 128 + wr * 64 + m * 16 + fr;
                f32x4 v0 = acc[ai][0][m][0], v1 = acc[ai][0][m][1], v2 = acc[ai][1][m][0], v3 = acc[ai][1][m][1];
                if (typ == 3) {
                    bf16_t* vt = VT + (((size_t)b * 8 + vm) * 64 + 8 * fq) * SEQ + (row & (SEQ - 1));
#pragma unroll
                    for (int j = 0; j < 4; ++j) {
                        vt[(size_t)j * SEQ] = f2bf(v0[j]); vt[(size_t)(4 + j) * SEQ] = f2bf(v1[j]);
                        vt[(size_t)(32 + j) * SEQ] = f2bf(v2[j]); vt[(size_t)(36 + j) * SEQ] = f2bf(v3[j]);
                    }
                } else {
                    if (typ == 1) {
                        float ss = 0.f;
#pragma unroll
                        for (int j = 0; j < 4; ++j) ss += v0[j] * v0[j] + v1[j] * v1[j] + v2[j] * v2[j] + v3[j] * v3[j];
                        ss += shx<16>(ss, lane); ss += shx<32>(ss, lane);
                        const float rn = rsqrtf(ss * (1.f / 64.f) + 1e-6f);
                        v0 = v0 * g0 * rn; v1 = v1 * g1 * rn; v2 = v2 * g2 * rn; v3 = v3 * g3 * rn;
                    } else if (typ == 2) { v0 *= cst; v1 *= cst; v2 *= cst; v3 *= cst; }
                    else if (typ == 4) {
#pragma unroll
                        for (int j = 0; j < 4; ++j) { v0[j] = sigmoidf_(v0[j]); v1[j] = sigmoidf_(v1[j]); v2[j] = sigmoidf_(v2[j]); v3[j] = sigmoidf_(v3[j]); }
                    }
                    bf16_t* rowp = Z + (size_t)row * ZLD + hidx * 64 + 8 * fq;
                    stg4u(rowp, pack8(v0, v1)); stg4u(rowp + 32, pack8(v2, v3));
                }
            }
    }
};
struct EpiC1 {
    static constexpr bool PERM = true, HEADMAP = false;
    bf16_t* O; const float* cb;
    __device__ __forceinline__ void operator()(const f32x4 (&acc)[2][2][4][2], const GU& u, int wr, int wc, int fr, int fq) const {
        const int mat = u.e;
#pragma unroll
        for (int bj = 0; bj < 2; ++bj) {
            const int col = bj * 128 + wc * 32 + 8 * fq;
            const f32x4 b0 = ldg4f(cb + mat * 256 + col), b1 = ldg4f(cb + mat * 256 + col + 4);
#pragma unroll
            for (int ai = 0; ai < 2; ++ai)
#pragma unroll
                for (int m = 0; m < 4; ++m) {
                    f32x4 v0 = acc[ai][bj][m][0] + b0, v1 = acc[ai][bj][m][1] + b1;
#pragma unroll
                    for (int j = 0; j < 4; ++j) {
                        { const float x = v0[j], t = 0.7978845608f * (x + 0.044715f * x * x * x); v0[j] = x * frcp(1.f + fexp2(-2.f * LOG2E * t)); }
                        { const float x = v1[j], t = 0.7978845608f * (x + 0.044715f * x * x * x); v1[j] = x * frcp(1.f + fexp2(-2.f * LOG2E * t)); }
                    }
                    stg4u(O + ((size_t)mat * 2048 + u.pm * 256 + ai * 128 + wr * 64 + m * 16 + fr) * 256 + col, pack8(v0, v1));
                }
        }
    }
};
struct EpiE1 {
    static constexpr bool PERM = true, HEADMAP = false;
    bf16_t* S; bf16_t* Y;
    __device__ __forceinline__ void operator()(const f32x4 (&acc)[2][2][4][2], const GU& u, int wr, int wc, int fr, int fq) const {
        if (u.kind == 1) asm volatile("s_waitcnt vmcnt(0)" ::: "memory");
#pragma unroll
        for (int ai = 0; ai < 2; ++ai)
#pragma unroll
            for (int m = 0; m < 4; ++m) {
                const int r = ai * 128 + wr * 64 + m * 16 + fr;
#pragma unroll
                for (int bj = 0; bj < 2; ++bj) {
                    const int c = bj * 128 + wc * 32 + 8 * fq;
                    bf16_t* sp = S + r * 256 + c;
                    if (u.kind == 0) stg4u(sp, pack8(acc[ai][bj][m][0], acc[ai][bj][m][1]));
                    else {
                        bf16_t* yp = Y + (size_t)(u.pm * 256 + r) * 1024 + u.pn * 256 + c;
                        f32x4 t0, t1; unpack8(ldg4u(sp), t0, t1);
                        f32x4 v0, v1;
#pragma unroll
                        for (int j = 0; j < 4; ++j) { v0[j] = sigmoidf_(acc[ai][bj][m][0][j]) * t0[j]; v1[j] = sigmoidf_(acc[ai][bj][m][1][j]) * t1[j]; }
                        if (u.e > 0) { f32x4 y0, y1; unpack8(ldg4u(yp), y0, y1); v0 += y0; v1 += y1; }
                        stg4u(yp, pack8(v0, v1));
                    }
                }
            }
    }
};
struct EpiE2 {
    static constexpr bool PERM = false, HEADMAP = false;
    const float* xin; float* xout; const float* ga;
    __device__ __forceinline__ void operator()(const f32x4 (&acc)[2][2][4][2], const GU& u, int wr, int wc, int fr, int fq) const {
        const int b = u.pm >> 6;
#pragma unroll
        for (int bj = 0; bj < 2; ++bj)
#pragma unroll
            for (int n = 0; n < 2; ++n) {
                const int col = u.pn * 256 + bj * 128 + wc * 32 + 16 * n + 4 * fq;
                const f32x4 g = ldg4f(ga + b * 6144 + col);
#pragma unroll
                for (int ai = 0; ai < 2; ++ai)
#pragma unroll
                    for (int m = 0; m < 4; ++m) {
                        const size_t off = (size_t)(u.pm * 256 + ai * 128 + wr * 64 + m * 16 + fr) * 1024 + col;
                        const f32x4 xv = ldg4f(xin + off);
                        stg4f(xout + off, xv + g * acc[ai][bj][m][n]);
                    }
            }
    }
};
struct EpiG1 {
    static constexpr bool PERM = true, HEADMAP = false;
    bf16_t* Ab;
    __device__ __forceinline__ void operator()(const f32x4 (&acc)[2][2][4][2], const GU& u, int wr, int wc, int fr, int fq) const {
#pragma unroll
        for (int ai = 0; ai < 2; ++ai)
#pragma unroll
            for (int m = 0; m < 4; ++m) {
                f32x4 v0, v1;
#pragma unroll
                for (int j = 0; j < 4; ++j) { const float g0 = acc[ai][0][m][0][j], g1 = acc[ai][0][m][1][j];
                    v0[j] = g0 * sigmoidf_(g0) * acc[ai][1][m][0][j]; v1[j] = g1 * sigmoidf_(g1) * acc[ai][1][m][1][j]; }
                stg4u(Ab + (size_t)(u.aux + ai * 128 + wr * 64 + m * 16 + fr) * 512 + u.pn * 128 + wc * 32 + 8 * fq, pack8(v0, v1));
            }
    }
};
struct EpiG2 {
    static constexpr bool PERM = true, HEADMAP = false;
    bf16_t* Yb; const int* listT; const float* listW; const LAS int* tpre;
    __device__ __forceinline__ void operator()(const f32x4 (&acc)[2][2][4][2], const GU& u, int wr, int wc, int fr, int fq) const {
        const int cnt = tpre[17 + u.e];
#pragma unroll
        for (int ai = 0; ai < 2; ++ai)
#pragma unroll
            for (int m = 0; m < 4; ++m) {
                const int r = u.pm * 256 + ai * 128 + wr * 64 + m * 16 + fr;
                if (r < cnt) {
                    const int t2 = listT[u.e * LCAP + r]; const float w = listW[u.e * LCAP + r];
                    bf16_t* rowp = Yb + (size_t)t2 * 1024 + u.pn * 256 + wc * 32 + 8 * fq;
#pragma unroll
                    for (int bj = 0; bj < 2; ++bj) stg4u(rowp + bj * 128, pack8(acc[ai][bj][m][0] * w, acc[ai][bj][m][1] * w));
                }
            }
    }
};

__device__ __forceinline__ void cmp2_unit(const Ctx& X, int layer, int u) {
    unsigned char* ws = X.ws;
    const int lane = X.tid & 63, c = lane & 15, g = lane >> 4;
    const int mat = u >> 7, r0 = (u & 127) * 16;
    const bf16_t* hid = (const bf16_t*)(ws + WS_HID) + ((size_t)mat * 2048 + r0) * 256;
    const bf16_t* w2 = (const bf16_t*)(ws + WS_W2) + ((size_t)layer * 2 + mat) * 64 * 256;
    f32x4 acc[4];
#pragma unroll
    for (int nt = 0; nt < 4; ++nt) acc[nt] = (f32x4){0.f, 0.f, 0.f, 0.f};
#pragma unroll
    for (int ks = 0; ks < 8; ++ks) {
        const bf16x8 a = ldg8(hid + c * 256 + ks * 32 + 8 * g);
#pragma unroll
        for (int nt = 0; nt < 4; ++nt) { const bf16x8 b = ldg8(w2 + (nt * 16 + c) * 256 + ks * 32 + 8 * g); acc[nt] = __builtin_amdgcn_mfma_f32_16x16x32_bf16(a, b, acc[nt], 0, 0, 0); }
    }
    if (mat == 0) {
        const float* kg = INP(I_NKG) + layer * 192;
        bf16_t* kc = (bf16_t*)(ws + WS_KCMP);
#pragma unroll
        for (int i = 0; i < 4; ++i) {
            float ss = acc[0][i] * acc[0][i] + acc[1][i] * acc[1][i] + acc[2][i] * acc[2][i] + acc[3][i] * acc[3][i];
            ss += shx<1>(ss, lane); ss += shx<2>(ss, lane); ss += shx<4>(ss, lane); ss += shx<8>(ss, lane);
            const float rn = rsqrtf(ss * (1.f / 64.f) + 1e-6f);
#pragma unroll
            for (int nt = 0; nt < 4; ++nt) kc[(size_t)(r0 + 4 * g + i) * 64 + nt * 16 + c] = f2bf(acc[nt][i] * rn * kg[nt * 16 + c]);
        }
    } else {
        bf16_t* vt = (bf16_t*)(ws + WS_VCMPT);
        const int b = r0 >> 10, cb0 = (r0 & 1023) + 4 * g;
#pragma unroll
        for (int nt = 0; nt < 4; ++nt) { u32x2 o; o[0] = cvt_pk_bf16(acc[nt][0], acc[nt][1]); o[1] = cvt_pk_bf16(acc[nt][2], acc[nt][3]);
            stg2u(vt + ((size_t)b * 64 + nt * 16 + c) * 1024 + cb0, o); }
    }
}

template <int NCT>
__device__ __forceinline__ void qk_tile(const bf16_t* kp, int kstride, const bf16x8 (&qf)[NCT][2], f32x4 (&s)[2][2][NCT]) {
#pragma unroll
    for (int ch = 0; ch < 2; ++ch)
#pragma unroll
        for (int T = 0; T < 2; ++T) {
            const bf16_t* p = kp + (size_t)(32 * ch + 4 * T) * kstride;
            const bf16x8 k0 = ldg8(p), k1 = ldg8(p + 32);
#pragma unroll
            for (int ct = 0; ct < NCT; ++ct) {
                f32x4 a = (f32x4){0.f, 0.f, 0.f, 0.f};
                a = __builtin_amdgcn_mfma_f32_16x16x32_bf16(k0, qf[ct][0], a, 0, 0, 0);
                a = __builtin_amdgcn_mfma_f32_16x16x32_bf16(k1, qf[ct][1], a, 0, 0, 0);
                s[ch][T][ct] = a;
            }
        }
}
template <int NCT>
__device__ __forceinline__ void pv_tile(const bf16_t* vp, size_t vstride, const bf16x8 (&pb)[2][NCT], f32x4 (&o)[4][NCT]) {
#pragma unroll
    for (int ch = 0; ch < 2; ++ch)
#pragma unroll
        for (int dt = 0; dt < 4; ++dt) {
            const bf16x8 v = ldg8(vp + (size_t)(16 * dt) * vstride + 32 * ch);
#pragma unroll
            for (int ct = 0; ct < NCT; ++ct) o[dt][ct] = __builtin_amdgcn_mfma_f32_16x16x32_bf16(v, pb[ch][ct], o[dt][ct], 0, 0, 0);
        }
}
__device__ __forceinline__ bf16x8 pack_p(const f32x4 a, const f32x4 b) {
    union { u32x4 u; bf16x8 h; } x; x.u = pack8(a, b); return x.h;
}
template <int NCT> struct SmState { f32x4 o[4][NCT]; float m[NCT], l[NCT]; };

template <int NCT> __device__ __forceinline__ void sm_init(SmState<NCT>& st) {
#pragma unroll
    for (int ct = 0; ct < NCT; ++ct) { st.m[ct] = -1e30f; st.l[ct] = 0.f;
#pragma unroll
        for (int dt = 0; dt < 4; ++dt) st.o[dt][ct] = (f32x4){0.f, 0.f, 0.f, 0.f}; }
}
template <int NCT> __device__ __forceinline__ void sm_finish(SmState<NCT>& st, const int lane) {
#pragma unroll
    for (int ct = 0; ct < NCT; ++ct) {
        float l = st.l[ct]; l += shx<16>(l, lane); l += shx<32>(l, lane);
        const float inv = (l > 0.f) ? 1.f / l : 0.f;
#pragma unroll
        for (int dt = 0; dt < 4; ++dt) st.o[dt][ct] *= inv;
    }
}

constexpr int TROW = 72, TILE_E = 64 * TROW;
template <int NCT>
__device__ __forceinline__ void qk_tile_l(const LAS bf16_t* Kb, int c, int g, const bf16x8 (&qf)[NCT][2], f32x4 (&s)[2][2][NCT]) {
#pragma unroll
    for (int ch = 0; ch < 2; ++ch)
#pragma unroll
        for (int T = 0; T < 2; ++T) {
            const LAS bf16_t* p = Kb + (32 * ch + 8 * (c >> 2) + 4 * T + (c & 3)) * TROW + 8 * g;
            const bf16x8 k0 = *(const LAS bf16x8*)p, k1 = *(const LAS bf16x8*)(p + 32);
#pragma unroll
            for (int ct = 0; ct < NCT; ++ct) {
                f32x4 a = (f32x4){0.f, 0.f, 0.f, 0.f};
                a = __builtin_amdgcn_mfma_f32_16x16x32_bf16(k0, qf[ct][0], a, 0, 0, 0);
                a = __builtin_amdgcn_mfma_f32_16x16x32_bf16(k1, qf[ct][1], a, 0, 0, 0);
                s[ch][T][ct] = a;
            }
        }
}
template <int NCT>
__device__ __forceinline__ void pv_tile_l(const LAS bf16_t* Vb, int c, int g, const bf16x8 (&pb)[2][NCT], f32x4 (&o)[4][NCT]) {
#pragma unroll
    for (int ch = 0; ch < 2; ++ch)
#pragma unroll
        for (int dt = 0; dt < 4; ++dt) {
            const bf16x8 v = *(const LAS bf16x8*)(Vb + (16 * dt + c) * TROW + 32 * ch + 8 * g);
#pragma unroll
            for (int ct = 0; ct < NCT; ++ct) o[dt][ct] = __builtin_amdgcn_mfma_f32_16x16x32_bf16(v, pb[ch][ct], o[dt][ct], 0, 0, 0);
        }
}
template <int NCT, int STEP>
__device__ __forceinline__ void sm_soft(SmState<NCT>& st, f32x4 (&s)[2][2][NCT], bf16x8 (&pb)[2][NCT], const int (&d0)[NCT], const float (&slope)[NCT], const unsigned (&W)[NCT], const int lane) {
#pragma unroll
    for (int ct = 0; ct < NCT; ++ct) {
        float mx = -1e30f;
#pragma unroll
        for (int ch = 0; ch < 2; ++ch)
#pragma unroll
            for (int T = 0; T < 2; ++T)
#pragma unroll
                for (int i = 0; i < 4; ++i) {
                    const int dist = d0[ct] - STEP * (32 * ch + 4 * T + i);
                    const float v = ((unsigned)dist < W[ct]) ? (s[ch][T][ct][i] - slope[ct] * (float)dist) : -1e30f;
                    s[ch][T][ct][i] = v; mx = fmaxf(mx, v);
                }
        mx = fmaxf(mx, shx<16>(mx, lane)); mx = fmaxf(mx, shx<32>(mx, lane));
        const float mn = fmaxf(st.m[ct], mx), alpha = fexp2(st.m[ct] - mn);
        float sum = 0.f;
#pragma unroll
        for (int ch = 0; ch < 2; ++ch) {
#pragma unroll
            for (int T = 0; T < 2; ++T)
#pragma unroll
                for (int i = 0; i < 4; ++i) { const float v = s[ch][T][ct][i]; const float p = (v > -1e29f) ? fexp2(v - mn) : 0.f; s[ch][T][ct][i] = p; sum += p; }
            pb[ch][ct] = pack_p(s[ch][0][ct], s[ch][1][ct]);
        }
        st.m[ct] = mn; st.l[ct] = st.l[ct] * alpha + sum;
#pragma unroll
        for (int dt = 0; dt < 4; ++dt) st.o[dt][ct] *= alpha;
    }
}

template <int NCT, int STEP>
__device__ __forceinline__ void sm_tile(SmState<NCT>& st, f32x4 (&s)[2][2][NCT], const int (&d0)[NCT], const float (&slope)[NCT], unsigned W, const bf16_t* vp, size_t vstride, const int lane) {
    bf16x8 pb[2][NCT]; unsigned Wv[NCT];
#pragma unroll
    for (int ct = 0; ct < NCT; ++ct) Wv[ct] = W;
    sm_soft<NCT, STEP>(st, s, pb, d0, slope, Wv, lane);
    pv_tile<NCT>(vp, vstride, pb, st.o);
}

__device__ __forceinline__ f32x4 add_sle(const f32x4 v, const float sl, const int e0, const int step) {
    f32x4 r; r[0] = fmaf(sl, (float)(step * e0), v[0]); r[1] = fmaf(sl, (float)(step * (e0 + 1)), v[1]); r[2] = fmaf(sl, (float)(step * (e0 + 2)), v[2]); r[3] = fmaf(sl, (float)(step * (e0 + 3)), v[3]); return r; }
template <int NCT>
__device__ __forceinline__ void sm_fast(SmState<NCT>& st, f32x4 (&s)[2][2][NCT], bf16x8 (&pb)[2][NCT], const float sl, const float (&base)[NCT], const bool (&en)[NCT], const int lane) {
#pragma unroll
    for (int ct = 0; ct < NCT; ++ct) {
        const f32x4 u00 = add_sle(s[0][0][ct], sl, 0, 1), u01 = add_sle(s[0][1][ct], sl, 4, 1), u10 = add_sle(s[1][0][ct], sl, 32, 1), u11 = add_sle(s[1][1][ct], sl, 36, 1);
        const f32x4 m4 = __builtin_elementwise_max(__builtin_elementwise_max(u00, u01), __builtin_elementwise_max(u10, u11));
        float mx = fmaxf(fmaxf(m4[0], m4[1]), fmaxf(m4[2], m4[3])) + base[ct];
        mx = fmaxf(mx, shx<16>(mx, lane)); mx = fmaxf(mx, shx<32>(mx, lane));
        const float mn = en[ct] ? fmaxf(st.m[ct], mx) : st.m[ct], alpha = fexp2(st.m[ct] - mn);
        const float off = en[ct] ? (base[ct] - mn) : -1e30f;
        f32x4 p00 = u00 + off, p01 = u01 + off, p10 = u10 + off, p11 = u11 + off;
#pragma unroll
        for (int i = 0; i < 4; ++i) { p00[i] = fexp2(p00[i]); p01[i] = fexp2(p01[i]); p10[i] = fexp2(p10[i]); p11[i] = fexp2(p11[i]); }
        const f32x4 s4 = (p00 + p01) + (p10 + p11);
        const float sum = (s4[0] + s4[1]) + (s4[2] + s4[3]);
        pb[0][ct] = pack_p(p00, p01); pb[1][ct] = pack_p(p10, p11);
        st.m[ct] = mn; st.l[ct] = st.l[ct] * alpha + sum;
#pragma unroll
        for (int dt = 0; dt < 4; ++dt) st.o[dt][ct] *= alpha;
    }
}

__device__ __forceinline__ void nsa_block(const Ctx& X, LAS unsigned char* lds, int unit, int layer) {
    unsigned char* ws = X.ws;
    const int tid = X.tid, lane = tid & 63, wave = tid >> 6, c = lane & 15, g = lane >> 4, h = c & 7, qq = c >> 3;
    const int b = unit >> 9, t0 = (unit & 511) * 32;
    const bf16_t* z = (const bf16_t*)(ws + WS_Z) + (size_t)b * SEQ * ZLD;
    const bf16_t* vT = (const bf16_t*)(ws + WS_VT) + (size_t)b * 8 * 64 * SEQ;
    const bf16_t* kcmp = (const bf16_t*)(ws + WS_KCMP) + (size_t)b * 1024 * 64;
    const bf16_t* vcT = (const bf16_t*)(ws + WS_VCMPT) + (size_t)b * 64 * 1024;
    LAS float* impA = (LAS float*)(lds + wave * 8192);
    LAS float* impB = impA + 1024;
    LAS bf16_t* KV = (LAS bf16_t*)(lds + 65536);
    LAS int* sell = (LAS int*)(lds + 114688);
    LAS unsigned* qmask = (LAS unsigned*)(lds + 115712);
    LAS unsigned* ubits = (LAS unsigned*)(lds + 116736);
    LAS int* ulist = (LAS int*)(lds + 116800);
    const int prho = tid >> 3, pcp = tid & 7;
    const int krow = (prho & ~9) | ((prho >> 3) & 1) | ((prho & 1) << 3), kchk = pcp ^ (2 * (krow & 3));
    const int vrow = (prho & ~5) | ((prho >> 2) & 1) | ((prho & 1) << 2), vchk = pcp ^ (2 * (vrow & 3));
    const int wv512 = __builtin_amdgcn_readfirstlane(wave) * 512;
    const int fp = c & 3, fcl = g ^ (2 * (fp & 1)), fph = fp >> 1;
    const int krow0 = 8 * (c >> 2) + fp, krho0 = (krow0 & ~9) | ((krow0 >> 3) & 1) | ((krow0 & 1) << 3);
    const int kofA = krho0 * 64 + (fcl + 4 * (0 ^ fph)) * 8, kofB = krho0 * 64 + (fcl + 4 * (1 ^ fph)) * 8;
    const int vrho0 = (c & ~5) | ((c >> 2) & 1) | ((c & 1) << 2);
    const int vofA = vrho0 * 64 + (fcl + 4 * (0 ^ fph)) * 8, vofB = vrho0 * 64 + (fcl + 4 * (1 ^ fph)) * 8;
#define T_DMAK(kbase, kstride, k0, buf) __builtin_amdgcn_global_load_lds((const unsigned*)((kbase) + (size_t)((k0) + krow) * (kstride) + kchk * 8), (LAS unsigned*)(KV + (buf) * 8192 + wv512), 16, 0, 0)
#define T_DMAV(vbase, vstride, k0, buf) __builtin_amdgcn_global_load_lds((const unsigned*)((vbase) + (size_t)vrow * (vstride) + (k0) + vchk * 8), (LAS unsigned*)(KV + (buf) * 8192 + 4096 + wv512), 16, 0, 0)
#define T_KB(buf) (KV + (buf) * 8192)
#define T_VB(buf) (KV + (buf) * 8192 + 4096)
#define T_WAIT(n) asm volatile("s_waitcnt vmcnt(" #n ")" ::: "memory")
#define T_BAR() do { asm volatile("" ::: "memory"); __builtin_amdgcn_s_barrier(); asm volatile("" ::: "memory"); } while (0)
#define QK2I(buf, S, OFF, STEP) do { _Pragma("unroll") for (int ch = 0; ch < 2; ++ch) _Pragma("unroll") for (int T = 0; T < 2; ++T) { \
        const LAS bf16_t* p_ = T_KB(buf) + (4 * T + 32 * ch) * 64; const bf16x8 k0_ = *(const LAS bf16x8*)(p_ + kofA), k1_ = *(const LAS bf16x8*)(p_ + kofB); \
        _Pragma("unroll") for (int ct = 0; ct < 2; ++ct) { f32x4 a_; \
            _Pragma("unroll") for (int i = 0; i < 4; ++i) a_[i] = fmaf(sl, (float)((STEP) * (32 * ch + 4 * T + i)), OFF[ct]); \
            a_ = __builtin_amdgcn_mfma_f32_16x16x32_bf16(k0_, qf[ct][0], a_, 0, 0, 0); a_ = __builtin_amdgcn_mfma_f32_16x16x32_bf16(k1_, qf[ct][1], a_, 0, 0, 0); S[ch][T][ct] = a_; } } } while (0)
#define PV2(buf, PB, O) do { _Pragma("unroll") for (int dt = 0; dt < 4; ++dt) { const LAS bf16_t* p_ = T_VB(buf) + 16 * dt * 64; \
        const bf16x8 v0_ = *(const LAS bf16x8*)(p_ + vofA), v1_ = *(const LAS bf16x8*)(p_ + vofB); \
        _Pragma("unroll") for (int ct = 0; ct < 2; ++ct) { O[dt][ct] = __builtin_amdgcn_mfma_f32_16x16x32_bf16(v0_, PB[0][ct], O[dt][ct], 0, 0, 0); \
            O[dt][ct] = __builtin_amdgcn_mfma_f32_16x16x32_bf16(v1_, PB[1][ct], O[dt][ct], 0, 0, 0); } } } while (0)
#define LSUM(PB, L) do { _Pragma("unroll") for (int ct = 0; ct < 2; ++ct) { L[ct] = __builtin_amdgcn_mfma_f32_16x16x32_bf16(ones, PB[0][ct], L[ct], 0, 0, 0); \
        L[ct] = __builtin_amdgcn_mfma_f32_16x16x32_bf16(ones, PB[1][ct], L[ct], 0, 0, 0); } } while (0)
#define PEXP(S, PB, FULL, D0, W, STEP) do { _Pragma("unroll") for (int ct = 0; ct < 2; ++ct) { _Pragma("unroll") for (int ch = 0; ch < 2; ++ch) { \
        _Pragma("unroll") for (int T = 0; T < 2; ++T) _Pragma("unroll") for (int i = 0; i < 4; ++i) { const float e_ = fexp2(S[ch][T][ct][i]); \
            S[ch][T][ct][i] = (FULL) ? e_ : (((unsigned)(D0[ct] - (STEP) * (32 * ch + 4 * T + i)) < W[ct]) ? e_ : 0.f); } \
        PB[ch][ct] = pack_p(S[ch][0][ct], S[ch][1][ct]); } } } while (0)
    if (tid < 256) qmask[tid] = 0u;
    if (tid < 8) ubits[tid] = 0u;
    int tq[2]; bf16x8 qf[2][2];
    const float sl = exp2f(-8.f * (float)(h + 5) / 12.f) * LOG2E;
#pragma unroll
    for (int ct = 0; ct < 2; ++ct) {
        tq[ct] = t0 + 4 * wave + 2 * ct + qq;
        const bf16_t* qp = z + (size_t)tq[ct] * ZLD + ZC_QA + h * 64 + 8 * g;
        qf[ct][0] = ldg8(qp); qf[ct][1] = ldg8(qp + 32);
    }
    float mref;
    {
        float gq = fabsf(INP(I_NQG)[layer * 64 + lane]);
        const float* kg = INP(I_NKG) + layer * 192;
        float gk = fmaxf(fmaxf(fabsf(kg[lane]), fabsf(kg[64 + lane])), fabsf(kg[128 + lane]));
        gq = fmaxf(gq, shx<32>(gq, lane)); gq = fmaxf(gq, shx<16>(gq, lane)); gq = fmaxf(gq, shx<8>(gq, lane)); gq = fmaxf(gq, shx<4>(gq, lane)); gq = fmaxf(gq, shx<2>(gq, lane)); gq = fmaxf(gq, shx<1>(gq, lane));
        gk = fmaxf(gk, shx<32>(gk, lane)); gk = fmaxf(gk, shx<16>(gk, lane)); gk = fmaxf(gk, shx<8>(gk, lane)); gk = fmaxf(gk, shx<4>(gk, lane)); gk = fmaxf(gk, shx<2>(gk, lane)); gk = fmaxf(gk, shx<1>(gk, lane));
        mref = 8.f * LOG2E * 1.01f * gq * gk;
    }
    bf16x8 ones;
#pragma unroll
    for (int j = 0; j < 8; ++j) ones[j] = (c == 0) ? (short)0x3F80 : (short)0;
    const int t_lo = t0 + 4 * wave, t_hi = t_lo + 3;
    bf16_t* const og = (bf16_t*)(ws + WS_O) + (size_t)b * SEQ * 1024 + h * 64 + 4 * g;
    const int ncb = (t0 >> 4) + 1;
    const int ntile = (ncb + 63) >> 6;
    const unsigned WALL[2] = {0x7fffffffu, 0x7fffffffu};
    float l2inv[2];
    {
        f32x4 lacc[2] = {(f32x4){0.f, 0.f, 0.f, 0.f}, (f32x4){0.f, 0.f, 0.f, 0.f}};
        T_BAR();
        T_DMAK(kcmp, 64, 0, 0); if (ntile > 1) T_DMAK(kcmp, 64, 64, 1);
        for (int kt = 0; kt < ntile; ++kt) {
            f32x4 s[2][2][2]; bf16x8 pb[2][2];
            const int k0 = kt * 64, bi = kt % 3;
            if (kt + 1 < ntile) T_WAIT(1); else T_WAIT(0);
            T_BAR();
            if (kt + 2 < ntile) T_DMAK(kcmp, 64, k0 + 128, (kt + 2) % 3);
            const int d0[2] = {tq[0] - 31 - 16 * (k0 + 8 * g), tq[1] - 31 - 16 * (k0 + 8 * g)};
            const float off[2] = {-sl * (float)d0[0] - mref, -sl * (float)d0[1] - mref};
            QK2I(bi, s, off, 16);
            const bool full = (16 * (k0 + 63) + 31 <= t_lo);
            PEXP(s, pb, full, d0, WALL, 16);
            LSUM(pb, lacc);
        }
#pragma unroll
        for (int ct = 0; ct < 2; ++ct) { float lt = lacc[ct][0]; lt += shx<16>(lt, lane); lt += shx<32>(lt, lane); l2inv[ct] = (lt > 0.f) ? -flog2(lt) : -1e30f; }
    }
    {
        f32x4 o[4][2];
#pragma unroll
        for (int dt = 0; dt < 4; ++dt) { o[dt][0] = (f32x4){0.f, 0.f, 0.f, 0.f}; o[dt][1] = (f32x4){0.f, 0.f, 0.f, 0.f}; }
        T_BAR();
        T_DMAK(kcmp, 64, 0, 0); T_DMAV(vcT, 1024, 0, 0); if (ntile > 1) { T_DMAK(kcmp, 64, 64, 1); T_DMAV(vcT, 1024, 64, 1); }
        for (int kt = 0; kt < ntile; ++kt) {
            f32x4 s[2][2][2]; bf16x8 pb[2][2];
            const int k0 = kt * 64, bi = kt % 3;
            if (kt + 1 < ntile) T_WAIT(2); else T_WAIT(0);
            T_BAR();
            if (kt + 2 < ntile) { T_DMAK(kcmp, 64, k0 + 128, (kt + 2) % 3); T_DMAV(vcT, 1024, k0 + 128, (kt + 2) % 3); }
            const int d0[2] = {tq[0] - 31 - 16 * (k0 + 8 * g), tq[1] - 31 - 16 * (k0 + 8 * g)};
            const float off[2] = {-sl * (float)d0[0] - mref + l2inv[0], -sl * (float)d0[1] - mref + l2inv[1]};
            QK2I(bi, s, off, 16);
            const bool full = (16 * (k0 + 63) + 31 <= t_lo);
            PEXP(s, pb, full, d0, WALL, 16);
#pragma unroll
            for (int ct = 0; ct < 2; ++ct)
#pragma unroll
                for (int ch = 0; ch < 2; ++ch) {
                    float a0 = s[ch][0][ct][0] + s[ch][0][ct][1] + s[ch][0][ct][2] + 0.5f * s[ch][0][ct][3], b0 = 0.5f * s[ch][0][ct][3];
                    float a1 = s[ch][1][ct][0] + s[ch][1][ct][1] + s[ch][1][ct][2] + 0.5f * s[ch][1][ct][3], b1 = 0.5f * s[ch][1][ct][3];
                    a0 += shx<1>(a0, lane); b0 += shx<1>(b0, lane); a1 += shx<1>(a1, lane); b1 += shx<1>(b1, lane);
                    a0 += shx<2>(a0, lane); b0 += shx<2>(b0, lane); a1 += shx<2>(a1, lane); b1 += shx<2>(b1, lane);
                    a0 += shx<4>(a0, lane); b0 += shx<4>(b0, lane); a1 += shx<4>(a1, lane); b1 += shx<4>(b1, lane);
                    if (h == 0) {
                        const int js = (k0 + 32 * ch) / 4 + 2 * g, ql = 2 * ct + qq;
                        impA[ql * 256 + js] = a0; impB[ql * 256 + js] = b0; impA[ql * 256 + js + 1] = a1; impB[ql * 256 + js + 1] = b1;
                    }
                }
            PV2(bi, pb, o);
        }
#pragma unroll
        for (int ct = 0; ct < 2; ++ct) {
            const float g0 = bf2f(z[(size_t)tq[ct] * ZLD + ZC_GA + h * 3 + 0]);
#pragma unroll
            for (int dt = 0; dt < 4; ++dt) { const f32x4 v = o[dt][ct] * g0; u32x2 w; w[0] = cvt_pk_bf16(v[0], v[1]); w[1] = cvt_pk_bf16(v[2], v[3]); stg2u(og + (size_t)tq[ct] * 1024 + 16 * dt, w); }
        }
    }
    {
        f32x4 o[4][2]; f32x4 lacc[2] = {(f32x4){0.f, 0.f, 0.f, 0.f}, (f32x4){0.f, 0.f, 0.f, 0.f}};
#pragma unroll
        for (int dt = 0; dt < 4; ++dt) { o[dt][0] = (f32x4){0.f, 0.f, 0.f, 0.f}; o[dt][1] = (f32x4){0.f, 0.f, 0.f, 0.f}; }
        int kt0 = (t0 - 511) >> 6; if (kt0 < 0) kt0 = 0;
        const int kt1 = (t0 + 31) >> 6;
        const bf16_t* kb = z + ZC_KWN; const bf16_t* vb = vT + (size_t)(1 * 64) * SEQ;
        const unsigned W2[2] = {512u, 512u};
        T_BAR();
        T_DMAK(kb, ZLD, kt0 * 64, 0); T_DMAV(vb, SEQ, kt0 * 64, 0); if (kt0 < kt1) { T_DMAK(kb, ZLD, kt0 * 64 + 64, 1); T_DMAV(vb, SEQ, kt0 * 64 + 64, 1); }
        for (int kt = kt0; kt <= kt1; ++kt) {
            const int k0 = kt * 64, bi = (kt - kt0) % 3;
            f32x4 s[2][2][2]; bf16x8 pb[2][2];
            if (kt < kt1) T_WAIT(2); else T_WAIT(0);
            T_BAR();
            if (kt + 2 <= kt1) { T_DMAK(kb, ZLD, k0 + 128, (kt - kt0 + 2) % 3); T_DMAV(vb, SEQ, k0 + 128, (kt - kt0 + 2) % 3); }
            const int d0[2] = {tq[0] - (k0 + 8 * g), tq[1] - (k0 + 8 * g)};
            const float off[2] = {-sl * (float)d0[0] - mref, -sl * (float)d0[1] - mref};
            QK2I(bi, s, off, 1);
            const bool full = (k0 + 63 <= t_lo && k0 >= t_hi - 511);
            PEXP(s, pb, full, d0, W2, 1);
            PV2(bi, pb, o); LSUM(pb, lacc);
        }
        asm volatile("s_waitcnt vmcnt(0)" ::: "memory");
#pragma unroll
        for (int ct = 0; ct < 2; ++ct) {
            float lt = lacc[ct][0]; lt += shx<16>(lt, lane); lt += shx<32>(lt, lane);
            const float g2 = bf2f(z[(size_t)tq[ct] * ZLD + ZC_GA + h * 3 + 2]) * ((lt > 0.f) ? 1.f / lt : 0.f);
#pragma unroll
            for (int dt = 0; dt < 4; ++dt) { const f32x4 v = o[dt][ct] * g2; bf16_t* op = og + (size_t)tq[ct] * 1024 + 16 * dt; const u32x2 t = ldg2u(op); u32x2 w;
                w[0] = cvt_pk_bf16(bf_lo(t[0]) + v[0], bf_hi(t[0]) + v[1]); w[1] = cvt_pk_bf16(bf_lo(t[1]) + v[2], bf_hi(t[1]) + v[3]); stg2u(op, w); }
        }
    }
#pragma unroll
    for (int ql = 0; ql < 4; ++ql) {
        const int qi = 4 * wave + ql, t = t0 + qi, cur = t >> 6;
        if (cur <= 7) {
            if (lane < 8) sell[qi * 8 + lane] = (lane <= cur) ? lane : -1;
        } else {
            float v[4];
#pragma unroll
            for (int i = 0; i < 4; ++i) { const int j = lane + 64 * i; v[i] = (j >= 1 && j <= cur - 2) ? impA[ql * 256 + j] + impB[ql * 256 + j - 1] : -1.f; }
            if (lane == 0) { sell[qi * 8 + 0] = 0; sell[qi * 8 + 1] = cur - 1; sell[qi * 8 + 2] = cur; }
#pragma unroll
            for (int r = 0; r < 5; ++r) {
                float bv = v[0]; int bi = lane;
#pragma unroll
                for (int i = 1; i < 4; ++i) if (v[i] > bv) { bv = v[i]; bi = lane + 64 * i; }
#define AMAX_STEP(M) { const float ov = shx<M>(bv, lane); const int oi = shxi<M>(bi, lane); if (ov > bv || (ov == bv && oi < bi)) { bv = ov; bi = oi; } }
                AMAX_STEP(1) AMAX_STEP(2) AMAX_STEP(4) AMAX_STEP(8) AMAX_STEP(16) AMAX_STEP(32)
#undef AMAX_STEP
#pragma unroll
                for (int i = 0; i < 4; ++i) if (bi == lane + 64 * i) v[i] = -2.f;
                if (lane == 0) sell[qi * 8 + 3 + r] = bi;
            }
        }
        if (lane < 8) {
            const int blk = sell[qi * 8 + lane];
            if (blk >= 0) { __hip_atomic_fetch_or(qmask + qi * 8 + (blk >> 5), 1u << (blk & 31), __ATOMIC_RELAXED, __HIP_MEMORY_SCOPE_WORKGROUP);
                            __hip_atomic_fetch_or(ubits + (blk >> 5), 1u << (blk & 31), __ATOMIC_RELAXED, __HIP_MEMORY_SCOPE_WORKGROUP); }
        }
    }
    __syncthreads();
    int nU = 0;
    {
        unsigned wbits[8]; int below = 0;
#pragma unroll
        for (int w = 0; w < 8; ++w) { wbits[w] = ubits[w]; nU += __builtin_popcount(wbits[w]); }
        if (tid < 256) {
            unsigned mine = 0u;
#pragma unroll
            for (int w = 0; w < 8; ++w) { if (w < (tid >> 5)) below += __builtin_popcount(wbits[w]); if (w == (tid >> 5)) mine = wbits[w]; }
            if ((mine >> (tid & 31)) & 1u) { below += __builtin_popcount(mine & ((1u << (tid & 31)) - 1u)); ulist[below] = tid; }
        }
    }
    __syncthreads();
    {
        f32x4 o[4][2]; f32x4 lacc[2] = {(f32x4){0.f, 0.f, 0.f, 0.f}, (f32x4){0.f, 0.f, 0.f, 0.f}};
#pragma unroll
        for (int dt = 0; dt < 4; ++dt) { o[dt][0] = (f32x4){0.f, 0.f, 0.f, 0.f}; o[dt][1] = (f32x4){0.f, 0.f, 0.f, 0.f}; }
        const bf16_t* kb = z + ZC_KSL; const bf16_t* vb = vT;
        const int q0i = 4 * wave + qq;
        T_BAR();
        { const int k0 = ulist[0] * 64; T_DMAK(kb, ZLD, k0, 0); T_DMAV(vb, SEQ, k0, 0); }
        if (nU > 1) { const int k1 = ulist[1] * 64; T_DMAK(kb, ZLD, k1, 1); T_DMAV(vb, SEQ, k1, 1); }
        for (int it = 0; it < nU; ++it) {
            const int blk = ulist[it], k0 = blk * 64, bi = it % 3;
            f32x4 s[2][2][2]; bf16x8 pb[2][2];
            if (it + 1 < nU) T_WAIT(2); else T_WAIT(0);
            T_BAR();
            if (it + 2 < nU) { const int k2 = ulist[it + 2] * 64; T_DMAK(kb, ZLD, k2, (it + 2) % 3); T_DMAV(vb, SEQ, k2, (it + 2) % 3); }
            unsigned W2[2]; float off[2];
            const int d0[2] = {tq[0] - (k0 + 8 * g), tq[1] - (k0 + 8 * g)};
#pragma unroll
            for (int ct = 0; ct < 2; ++ct) {
                const bool member = ((qmask[(q0i + 2 * ct) * 8 + (blk >> 5)] >> (blk & 31)) & 1u) != 0u;
                W2[ct] = member ? 0x7fffffffu : 0u;
                off[ct] = member ? (-sl * (float)d0[ct] - mref) : -1e30f;
            }
            QK2I(bi, s, off, 1);
            const bool full = (k0 + 63 <= t_lo);
            PEXP(s, pb, full, d0, W2, 1);
            PV2(bi, pb, o); LSUM(pb, lacc);
        }
        asm volatile("s_waitcnt vmcnt(0)" ::: "memory");
#pragma unroll
        for (int ct = 0; ct < 2; ++ct) {
            float lt = lacc[ct][0]; lt += shx<16>(lt, lane); lt += shx<32>(lt, lane);
            const float g1 = bf2f(z[(size_t)tq[ct] * ZLD + ZC_GA + h * 3 + 1]) * ((lt > 0.f) ? 1.f / lt : 0.f);
#pragma unroll
            for (int dt = 0; dt < 4; ++dt) { const f32x4 v = o[dt][ct] * g1; bf16_t* op = og + (size_t)tq[ct] * 1024 + 16 * dt; const u32x2 t = ldg2u(op); u32x2 w;
                w[0] = cvt_pk_bf16(bf_lo(t[0]) + v[0], bf_hi(t[0]) + v[1]); w[1] = cvt_pk_bf16(bf_lo(t[1]) + v[2], bf_hi(t[1]) + v[3]); stg2u(op, w); }
        }
    }
#undef T_DMAK
#undef T_DMAV
#undef T_KB
#undef T_VB
#undef T_WAIT
#undef T_BAR
#undef QK2I
#undef PV2
#undef LSUM
#undef PEXP
}

__device__ __forceinline__ void sb_unit(const Ctx& X, int unit) {
    unsigned char* ws = X.ws;
    const int lane = X.tid & 63, c = lane & 15, g = lane >> 4;
    const int b = unit >> 11, hd = (unit >> 9) & 3, t0 = (unit & 511) * 32;
    const bf16_t* z = (const bf16_t*)(ws + WS_Z) + (size_t)b * SEQ * ZLD;
    const bf16_t* vT = (const bf16_t*)(ws + WS_VT) + ((size_t)b * 8 + 2 + hd) * 64 * SEQ;
    int tq[2]; bf16x8 qf[2][2]; float R[2] = {0.f, 0.f};
    f32x4 o[4][2];
#pragma unroll
    for (int ct = 0; ct < 2; ++ct) {
        tq[ct] = t0 + 16 * ct + c;
        const bf16_t* qp = z + (size_t)tq[ct] * ZLD + ZC_QB + hd * 64 + 8 * g;
        qf[ct][0] = ldg8(qp); qf[ct][1] = ldg8(qp + 32);
#pragma unroll
        for (int dt = 0; dt < 4; ++dt) o[dt][ct] = (f32x4){0.f, 0.f, 0.f, 0.f};
    }
    for (int kt = (t0 + 31) >> 6; kt >= 0; --kt) {
        const int k0 = kt * 64;
        f32x4 s[2][2][2]; bf16x8 pb[2][2];
        qk_tile<2>(z + (size_t)(k0 + 8 * (c >> 2) + (c & 3)) * ZLD + ZC_KB + hd * 64 + 8 * g, ZLD, qf, s);
#pragma unroll
        for (int ct = 0; ct < 2; ++ct) {
            const int d0 = tq[ct] - (k0 + 8 * g);
            float suf[2][8], tot[2], above[2];
#pragma unroll
            for (int ch = 1; ch >= 0; --ch) {
                float run = 0.f;
#pragma unroll
                for (int jj = 7; jj >= 0; --jj) {
                    const int T = jj >> 2, i = jj & 3;
                    const float zv = s[ch][T][ct][i];
                    const bool ok = (d0 - (32 * ch + jj)) > 0;
                    const float sp = fmaxf(zv, 0.f) + LN2 * flog2(1.f + fexp2(-fabsf(zv) * LOG2E));
                    run += ok ? -sp : 0.f;
                    suf[ch][jj] = run;
                }
                const float x16 = shx<16>(run, lane), a2 = run + x16, x32 = shx<32>(a2, lane);
                above[ch] = (g == 3) ? 0.f : (g == 2) ? x16 : (g == 1) ? x32 : x16 + x32;
                tot[ch] = a2 + x32;
            }
#pragma unroll
            for (int ch = 0; ch < 2; ++ch) {
                const float base = R[ct] + above[ch] + ((ch == 0) ? tot[1] : 0.f);
#pragma unroll
                for (int jj = 0; jj < 8; ++jj) {
                    const int T = jj >> 2, i = jj & 3;
                    const bool ok = (d0 - (32 * ch + jj)) > 0;
                    s[ch][T][ct][i] = ok ? fexp2((s[ch][T][ct][i] + base + suf[ch][jj]) * LOG2E) : 0.f;
                }
                pb[ch][ct] = pack_p(s[ch][0][ct], s[ch][1][ct]);
            }
            R[ct] += tot[0] + tot[1];
        }
        pv_tile<2>(vT + (size_t)c * SEQ + k0 + 8 * g, SEQ, pb, o);
        if (__all((R[0] < -104.f) && (R[1] < -104.f))) break;
    }
    bf16_t* ob = (bf16_t*)(ws + WS_O) + (size_t)b * SEQ * 1024 + 512 + hd * 64;
#pragma unroll
    for (int ct = 0; ct < 2; ++ct)
#pragma unroll
        for (int dt = 0; dt < 4; ++dt) {
            u32x2 w; w[0] = cvt_pk_bf16(o[dt][ct][0], o[dt][ct][1]); w[1] = cvt_pk_bf16(o[dt][ct][2], o[dt][ct][3]);
            stg2u(ob + (size_t)tq[ct] * 1024 + 16 * dt + 4 * g, w);
        }
}

__device__ __forceinline__ void swa_unit(const Ctx& X, int layer, int unit) {
    unsigned char* ws = X.ws;
    const int lane = X.tid & 63, c = lane & 15, g = lane >> 4, hg = c & 1;
    const int b = unit >> 11, gk = (unit >> 10) & 1, t0 = (unit & 1023) * 16;
    const int hd = gk * 2 + hg;
    const bf16_t* z = (const bf16_t*)(ws + WS_Z) + (size_t)b * SEQ * ZLD;
    const bf16_t* vT = (const bf16_t*)(ws + WS_VT) + ((size_t)b * 8 + 6 + gk) * 64 * SEQ;
    int tq[2]; float slope[2]; bf16x8 qf[2][2];
    const float sl = exp2f(-8.f * (float)(hd + 1) / 12.f) * LOG2E;
    const float sink = INP(I_SINK)[layer * 4 + hd] * LOG2E;
    SmState<2> st; sm_init<2>(st);
#pragma unroll
    for (int ct = 0; ct < 2; ++ct) {
        tq[ct] = t0 + 8 * ct + (c >> 1); slope[ct] = sl;
        const bf16_t* qp = z + (size_t)tq[ct] * ZLD + ZC_QC + hd * 64 + 8 * g;
        qf[ct][0] = ldg8(qp); qf[ct][1] = ldg8(qp + 32);
        st.m[ct] = sink; st.l[ct] = (g == 0) ? 1.f : 0.f;
    }
    int kt0 = (t0 - 127) >> 6; if (kt0 < 0) kt0 = 0;
    const int kt1 = (t0 + 15) >> 6;
    for (int kt = kt0; kt <= kt1; ++kt) {
        const int k0 = kt * 64;
        f32x4 s[2][2][2];
        qk_tile<2>(z + (size_t)(k0 + 8 * (c >> 2) + (c & 3)) * ZLD + ZC_KC + gk * 64 + 8 * g, ZLD, qf, s);
        const int d0[2] = {tq[0] - (k0 + 8 * g), tq[1] - (k0 + 8 * g)};
        sm_tile<2, 1>(st, s, d0, slope, 128u, vT + (size_t)c * SEQ + k0 + 8 * g, SEQ, lane);
    }
    sm_finish<2>(st, lane);
    bf16_t* oc = (bf16_t*)(ws + WS_O) + (size_t)b * SEQ * 1024 + 768 + hd * 64;
#pragma unroll
    for (int ct = 0; ct < 2; ++ct)
#pragma unroll
        for (int dt = 0; dt < 4; ++dt) {
            u32x2 w; w[0] = cvt_pk_bf16(st.o[dt][ct][0], st.o[dt][ct][1]); w[1] = cvt_pk_bf16(st.o[dt][ct][2], st.o[dt][ct][3]);
            stg2u(oc + (size_t)tq[ct] * 1024 + 16 * dt + 4 * g, w);
        }
}

struct SchedC1 {
    static constexpr bool GATHER = false;
    int lda2, akstep, ldb2; const char* Z; const char* W1; int G, c;
    __device__ __forceinline__ bool next(int i, GU& u) const {
        const int L = i * G + c; if (L >= 16) return false;
        const int mat = L >> 3, pm = L & 7;
        u.A = Z + (size_t)pm * 256 * lda2 + (mat ? ZC_VCS : ZC_KCS) * 2; u.B = W1 + (size_t)mat * 256 * 2048 * 2; u.nt = 32; u.kind = 0; u.pm = pm; u.pn = 0; u.e = mat; u.aux = 0; return true;
    }
    __device__ __forceinline__ void rowoff(const GU&, int, unsigned (&)[2][2]) const {}
};

#ifndef MK_PER_STEP
#define MK_PER_STEP 0
#endif
constexpr int NSTEP = 2 + 10 * NL;
#define PHASE_FN __device__ __forceinline__

PHASE_FN void f_prologue(Ctx Xa) { const Ctx X = uni(Xa); p0_prologue(X, X.lds); }
PHASE_FN void f_norm0(Ctx Xa, int l) { const Ctx X = uni(Xa); norm_phase<0>(X, X.lds, l); }
PHASE_FN void f_norm1(Ctx Xa, int l) { const Ctx X = uni(Xa); norm_phase<1>(X, X.lds, l); }
PHASE_FN void f_norm2(Ctx Xa, int l) { const Ctx X = uni(Xa); norm_phase<2>(X, X.lds, l); }
PHASE_FN void f_norm3(Ctx Xa, int l) { const Ctx X = uni(Xa); norm_phase<3>(X, X.lds, l); }
PHASE_FN void f_inproj(Ctx Xa, int la) {
    const Ctx X = uni(Xa); const int l = la; unsigned char* ws = X.ws;
    SchedDense S{2048, 128, 2048, (const char*)(ws + WS_H), (const char*)(ws + WS_WIN) + (size_t)l * 2304 * 2048, 128, 9, 16, X.G, X.bid};
    EpiZ E{(bf16_t*)(ws + WS_Z), (bf16_t*)(ws + WS_VT), INP(I_NQG) + l * 64, INP(I_NKG) + l * 192, INP(I_SQG) + l * 64, INP(I_SKG) + l * 64};
    gemm_run(X.lds, S, E, X.tid);
}
PHASE_FN void f_cmp1(Ctx Xa, int la) {
    const Ctx X = uni(Xa); const int l = la; unsigned char* ws = X.ws;
    SchedC1 S{16 * ZLD * 2, ZLD * 2, 4096, (const char*)(ws + WS_Z), (const char*)(ws + WS_W1) + (size_t)l * 2 * 256 * 2048 * 2, X.G, X.bid};
    EpiC1 E{(bf16_t*)(ws + WS_HID), (const float*)(ws + WS_CB) + l * 512};
    gemm_run(X.lds, S, E, X.tid);
    if (X.bid < 16) {
        __builtin_amdgcn_fence(__ATOMIC_RELEASE, "workgroup"); __syncthreads(); __builtin_amdgcn_fence(__ATOMIC_ACQUIRE, "workgroup");
        for (int L = X.bid; L < 16; L += X.G)
            for (int j = X.tid >> 6; j < 16; j += 8) cmp2_unit(X, l, (L >> 3) * 128 + (L & 7) * 16 + j);
    }
}
PHASE_FN void f_cmp2(Ctx Xa, int la) {
    const Ctx X = uni(Xa); const int l = la;
    for (int u = X.bid * 8 + (X.tid >> 6); u < 256; u += X.G * 8) cmp2_unit(X, l, u);
}
PHASE_FN void f_nsa(Ctx Xa, int la, int qk) {
    const Ctx X = uni(Xa); const int l = la;
    unsigned* ctl = (unsigned*)(X.ws + WS_CTL);
    LAS int* bc = (LAS int*)(X.lds + LDS_MISC + 32);
    for (;;) {
        if (X.tid == 0) bc[0] = (int)atomicAdd(ctl + CW_Q + 64 * (l * 4 + qk), 1u);
        __syncthreads();
        const int idx = bc[0];
        __syncthreads();
        if (idx >= 1024) break;
        nsa_block(X, X.lds, (idx & 1) * 512 + (511 - (idx >> 1)), l);
    }
}
PHASE_FN void f_sbswa(Ctx Xa, int la, int qk) {
    const Ctx X = uni(Xa); const int l = la;
    unsigned* ctl = (unsigned*)(X.ws + WS_CTL);
    const int lane = X.tid & 63;
    for (;;) {
        int idx = 0;
        if (lane == 0) idx = (int)atomicAdd(ctl + CW_Q + 64 * (l * 4 + qk) + 16, 1u);
        idx = __builtin_amdgcn_readfirstlane(idx);
        if (idx >= 8192) break;
        if (idx < 4096) sb_unit(X, idx);
        else swa_unit(X, l, idx - 4096);
    }
}
PHASE_FN void f_e1(Ctx Xa, int la) {
    const Ctx X = uni(Xa); const int l = la; unsigned char* ws = X.ws;
    SchedE1 S{2048, 128, 2048, (const char*)(ws + WS_O), (const char*)(ws + WS_H), (const char*)(ws + WS_WB) + (size_t)l * 1024 * 2048,
              (const char*)(ws + WS_WM) + (size_t)l * 3072 * 2048, X.G, X.bid};
    EpiE1 E{(bf16_t*)(ws + WS_SB) + (size_t)X.bid * 65536, (bf16_t*)(ws + WS_Y)};
    gemm_run(X.lds, S, E, X.tid);
}
PHASE_FN void f_e2(Ctx Xa, int la) {
    const Ctx X = uni(Xa); const int l = la; unsigned char* ws = X.ws;
    const float* modl = (const float*)(ws + WS_MOD) + (size_t)l * 2 * 6144;
    SchedDense S{2048, 128, 2048, (const char*)(ws + WS_Y), (const char*)(ws + WS_WO) + (size_t)l * 1024 * 2048, 128, 4, 16, X.G, X.bid};
    EpiE2 E{(l == 0) ? INP(I_X) : (const float*)X.out, X.out, modl + 2048};
    gemm_run(X.lds, S, E, X.tid);
}
__device__ __forceinline__ void moe_table(const Ctx& X, int l) {
    LAS int* tpre = (LAS int*)(X.lds + LDS_MISC + 256);
    if (X.tid == 0) {
        const unsigned* gcnt = (const unsigned*)(X.ws + WS_CTL) + CW_GCNT + 16 * (l * 16);
        int run = 0, prow = 0;
        for (int e = 0; e < 16; ++e) { const int cnt = (int)__hip_atomic_load(gcnt + 16 * e, __ATOMIC_RELAXED, __HIP_MEMORY_SCOPE_AGENT); const int tl = (cnt + 255) >> 8;
            tpre[e] = run; tpre[17 + e] = cnt; tpre[34 + e] = prow; run += tl; prow += tl * 256; }
        tpre[16] = run;
    }
    __syncthreads();
}
PHASE_FN void f_g1(Ctx Xa, int la) {
    const Ctx X = uni(Xa); const int l = la; unsigned char* ws = X.ws;
    moe_table(X, l);
    const LAS int* tpre = (const LAS int*)(X.lds + LDS_MISC + 256);
    SchedMoE S{2048, 128, 2048, (const char*)(ws + WS_H), (const char*)(ws + WS_WGU) + (size_t)l * 16 * 1024 * 2048, (size_t)1024 * 2048, 4, 16, X.G, X.bid, 1, tpre, (const int*)(ws + WS_LISTT)};
    EpiG1 E{(bf16_t*)(ws + WS_AB)};
    gemm_run(X.lds, S, E, X.tid);
}
PHASE_FN void f_g2(Ctx Xa, int la) {
    const Ctx X = uni(Xa); const int l = la; unsigned char* ws = X.ws;
    moe_table(X, l);
    const LAS int* tpre = (const LAS int*)(X.lds + LDS_MISC + 256);
    SchedMoE S{1024, 128, 1024, (const char*)(ws + WS_AB), (const char*)(ws + WS_WD) + (size_t)l * 16 * 1024 * 1024, (size_t)1024 * 1024, 4, 8, X.G, X.bid, 2, tpre, (const int*)(ws + WS_LISTT)};
    EpiG2 E{(bf16_t*)(ws + WS_YB), (const int*)(ws + WS_LISTT), (const float*)(ws + WS_LISTW), tpre};
    gemm_run(X.lds, S, E, X.tid);
}

__global__ void __launch_bounds__(512, 2) mega_fwd(Params P) {
    extern __shared__ __attribute__((aligned(16))) unsigned char lds_raw[];
    LAS unsigned char* lds = (LAS unsigned char*)lds_raw;
    const int tid = threadIdx.x;
    unsigned* ctl = (unsigned*)(P.ws + WS_CTL);
    if (tid < 64) ((LAS unsigned*)(lds + LDS_MISC))[tid] = 0u;
    if (tid < 27) *(LAS unsigned long long*)(lds + LDS_PTAB + 8 * tid) = (unsigned long long)P.in[tid];
    __syncthreads();
    XcdBarrier bar = xcd_barrier_post(ctl, (volatile LAS unsigned*)(lds + LDS_MISC));
    Ctx X; X.ws = P.ws; X.out = P.out; X.lds = lds; X.tid = 0; X.bid = 0; X.G = 0;
    const int lo = P.step_lo, hi = P.step_hi;
#define IN(s) (lo <= (s) && (s) < hi)
#define SEAM(s) do { if ((s) + 1 < hi) xcd_barrier(bar); } while (0)
#ifndef DBL
#define DBL 0
#endif
    if (IN(0)) { f_prologue(X); if (DBL & 1) f_prologue(X); SEAM(0); }
    for (int l = 0; l < NL; ++l) {
        const int s0 = 1 + 10 * l;
        if (IN(s0 + 0)) { if (l == 0) f_norm0(X, l); else f_norm1(X, l); SEAM(s0 + 0); }
        if (IN(s0 + 1)) { f_inproj(X, l); if (DBL & 2) f_inproj(X, l); SEAM(s0 + 1); }
        if (IN(s0 + 2)) { f_cmp1(X, l); __syncthreads(); f_sbswa(X, l, 1); if (DBL & 64) f_sbswa(X, l, 2); SEAM(s0 + 2); }
        if (IN(s0 + 4)) { f_nsa(X, l, 1); if (DBL & 4) f_nsa(X, l, 2); SEAM(s0 + 4); }
        if (IN(s0 + 5)) { f_e1(X, l); if (DBL & 8) f_e1(X, l); SEAM(s0 + 5); }
        if (IN(s0 + 6)) { f_e2(X, l); SEAM(s0 + 6); }
        if (IN(s0 + 7)) { f_norm2(X, l); SEAM(s0 + 7); }
        if (IN(s0 + 8)) { f_g1(X, l); if (DBL & 16) f_g1(X, l); SEAM(s0 + 8); }
        if (IN(s0 + 9)) { f_g2(X, l); if (DBL & 32) f_g2(X, l); SEAM(s0 + 9); }
    }
    if (IN(NSTEP - 1)) f_norm3(X, NL);
#undef IN
#undef SEAM
}

extern "C" void kernel_launch(void* const* d_in, const int* in_sizes, int n_in, void* d_out, int out_size, void* d_ws, size_t ws_size, hipStream_t stream) {
    static int grid = 0;
    if (grid == 0) {
        if (n_in != 27 || out_size != NTOK * DM || ws_size < WS_END) { fprintf(stderr, "kernel_launch: unexpected shapes/workspace (n_in %d out %d ws %zu need %zu)\n", n_in, out_size, ws_size, (size_t)WS_END); grid = -1; return; }
        int dev = 0, cus = 0, per_cu = 0;
        if (hipGetDevice(&dev) != hipSuccess || hipDeviceGetAttribute(&cus, hipDeviceAttributeMultiprocessorCount, dev) != hipSuccess) { grid = -1; return; }
        if (hipFuncSetAttribute((const void*)mega_fwd, hipFuncAttributeMaxDynamicSharedMemorySize, LDS_BYTES) != hipSuccess) { fprintf(stderr, "kernel_launch: hipFuncSetAttribute failed\n"); grid = -1; return; }
        if (hipOccupancyMaxActiveBlocksPerMultiprocessor(&per_cu, (const void*)mega_fwd, 512, LDS_BYTES) != hipSuccess || per_cu < 1) { fprintf(stderr, "kernel_launch: occupancy query says %d\n", per_cu); }
        (void)hipGetLastError();
        grid = cus;
        if (grid > 256) grid = 256;
        if (grid < 64) { grid = -1; return; }
    }
    if (grid < 0) return;
    if (hipMemsetAsync((char*)d_ws + WS_CTL, 0, 64 * 1024, stream) != hipSuccess) return;
    Params p{};
    for (int i = 0; i < 27; ++i) p.in[i] = (const float*)d_in[i];
    p.out = (float*)d_out; p.ws = (unsigned char*)d_ws;
#if MK_PER_STEP
    for (int s = 0; s < NSTEP; ++s) { p.step_lo = s; p.step_hi = s + 1; hipLaunchKernelGGL(mega_fwd, dim3(grid), dim3(512), LDS_BYTES, stream, p); }
#else
    p.step_lo = 0; p.step_hi = NSTEP;
    hipLaunchKernelGGL(mega_fwd, dim3(grid), dim3(512), LDS_BYTES, stream, p);
#endif
}
```

```cpp
#include <hip/hip_runtime.h>
#include <stdio.h>
#include <stdint.h>

#define LAS __attribute__((address_space(3)))
#define GAS __attribute__((address_space(1)))
typedef unsigned short bf16_t;
typedef short bf16x8 __attribute__((ext_vector_type(8)));
typedef float f32x4 __attribute__((ext_vector_type(4)));
typedef unsigned u32x4 __attribute__((ext_vector_type(4)));
typedef unsigned u32x2 __attribute__((ext_vector_type(2)));

constexpr int NTOK = 32768, SEQ = 16384, DM = 1024, NL = 4, NB = 2;
constexpr int NIN = 5272;
constexpr int ZLD = 2304;
constexpr int ZC_QA = 0, ZC_KCS = 512, ZC_VCS = 576, ZC_KSL = 640, ZC_VSL = 704, ZC_KWN = 768, ZC_VWN = 832,
              ZC_QB = 896, ZC_KB = 1152, ZC_VB = 1408, ZC_QC = 1664, ZC_KC = 1920, ZC_VC = 2048, ZC_GA = 2176;
constexpr int LCAP = 32768;
constexpr int AROWS = 65536 + 16 * 256;
constexpr float LOG2E = 1.4426950408889634f;
constexpr float LN2 = 0.6931471805599453f;
constexpr int LDS_BYTES = 147456;
constexpr int LDS_MISC = 131072;

constexpr size_t KiB = 1024, MiB = 1024 * 1024;
constexpr size_t WS_CTL = 0;
constexpr size_t WS_MOD = WS_CTL + 64 * KiB;
constexpr size_t WS_CB = WS_MOD + 192 * KiB;
constexpr size_t WS_LISTT = WS_CB + 8 * KiB;
constexpr size_t WS_LISTW = WS_LISTT + 2 * MiB;
constexpr size_t WS_KCMP = WS_LISTW + 2 * MiB;
constexpr size_t WS_VCMPT = WS_KCMP + 256 * KiB;
constexpr size_t WS_HID = WS_VCMPT + 256 * KiB;
constexpr size_t WS_SSP = WS_HID + 2 * MiB;
constexpr size_t WS_WIN = WS_SSP + 2 * MiB;
constexpr size_t WS_WM = WS_WIN + (size_t)NL * 2304 * 1024 * 2;
constexpr size_t WS_WB = WS_WM + (size_t)NL * 3072 * 1024 * 2;
constexpr size_t WS_WO = WS_WB + (size_t)NL * 1024 * 1024 * 2;
constexpr size_t WS_W1 = WS_WO + (size_t)NL * 1024 * 1024 * 2;
constexpr size_t WS_W2 = WS_W1 + (size_t)NL * 2 * 256 * 2048 * 2;
constexpr size_t WS_WGU = WS_W2 + (size_t)NL * 2 * 64 * 256 * 2;
constexpr size_t WS_WD = WS_WGU + (size_t)NL * 16 * 1024 * 1024 * 2;
constexpr size_t WS_H = WS_WD + (size_t)NL * 16 * 1024 * 512 * 2;
constexpr size_t WS_Z = WS_H + (size_t)NTOK * 1024 * 2;
constexpr size_t Z_BYTES = (size_t)(NTOK + 64) * ZLD * 2;
constexpr size_t WS_Y = WS_Z;
constexpr size_t WS_SB = WS_Z + 64 * MiB;
constexpr size_t WS_AB = WS_Z + 64 * MiB;
constexpr size_t WS_R3 = WS_Z + Z_BYTES;
constexpr size_t WS_YB = WS_R3;
constexpr size_t WS_VT = WS_R3;
constexpr size_t WS_O = WS_R3 + 32 * MiB;
constexpr size_t WS_XB = WS_R3 + 136 * MiB;
constexpr size_t WS_TINFO = WS_XB + 64 * MiB;
constexpr size_t WS_YS = WS_R3;
constexpr size_t WS_H8 = WS_TINFO + 1 * MiB;
constexpr size_t WS_WM8 = WS_H8 + 32 * MiB;
constexpr size_t WS_END = WS_WM8 + 12 * MiB;
static_assert(64 * MiB + (size_t)AROWS * 512 * 2 <= Z_BYTES, "alias map");

constexpr int CW_Q = 4096;
constexpr int CW_GCNT = 6144;

__device__ __forceinline__ unsigned cvt_pk_bf16(float lo, float hi) { unsigned r; asm("v_cvt_pk_bf16_f32 %0, %1, %2" : "=v"(r) : "v"(lo), "v"(hi)); return r; }
__device__ __forceinline__ bf16_t f2bf(float f) { return (bf16_t)(cvt_pk_bf16(f, 0.f) & 0xffffu); }
__device__ __forceinline__ float bf_lo(unsigned u) { return __uint_as_float(u << 16); }
__device__ __forceinline__ float bf_hi(unsigned u) { return __uint_as_float(u & 0xffff0000u); }
__device__ __forceinline__ float bf2f(bf16_t b) { return __uint_as_float(((unsigned)b) << 16); }
__device__ __forceinline__ float fexp2(float x) { return __builtin_amdgcn_exp2f(x); }
__device__ __forceinline__ float flog2(float x) { return __builtin_amdgcn_logf(x); }
__device__ __forceinline__ float frcp(float x) { return __builtin_amdgcn_rcpf(x); }
__device__ __forceinline__ float sigmoidf_(float x) { return frcp(1.f + fexp2(-x * LOG2E)); }
template <int M> __device__ __forceinline__ int shxi(int v, int lane) {
    if constexpr (M < 32) return __builtin_amdgcn_ds_swizzle(v, (M << 10) | 0x1f);
    else return __builtin_amdgcn_ds_bpermute((lane ^ 32) << 2, v);
}
template <int M> __device__ __forceinline__ float shx(float v, int lane) { return __int_as_float(shxi<M>(__float_as_int(v), lane)); }
__device__ __forceinline__ float sum8_dpp(float v) {
    v += __int_as_float(__builtin_amdgcn_update_dpp(__float_as_int(v), __float_as_int(v), 0xB1, 0xf, 0xf, true));
    v += __int_as_float(__builtin_amdgcn_update_dpp(__float_as_int(v), __float_as_int(v), 0x4E, 0xf, 0xf, true));
    v += __int_as_float(__builtin_amdgcn_update_dpp(__float_as_int(v), __float_as_int(v), 0x141, 0xf, 0xf, true));
    return v;
}
__device__ __forceinline__ unsigned wave_umax(unsigned k, int lane) {
    unsigned o;
    o = (unsigned)__builtin_amdgcn_update_dpp((int)k, (int)k, 0xB1, 0xf, 0xf, true); k = k > o ? k : o;
    o = (unsigned)__builtin_amdgcn_update_dpp((int)k, (int)k, 0x4E, 0xf, 0xf, true); k = k > o ? k : o;
    o = (unsigned)__builtin_amdgcn_update_dpp((int)k, (int)k, 0x141, 0xf, 0xf, true); k = k > o ? k : o;
    o = (unsigned)__builtin_amdgcn_update_dpp((int)k, (int)k, 0x140, 0xf, 0xf, true); k = k > o ? k : o;
    o = (unsigned)shxi<16>((int)k, lane); k = k > o ? k : o;
    o = (unsigned)shxi<32>((int)k, lane); k = k > o ? k : o;
    return k;
}
__device__ __forceinline__ float wave_sum(float v, int lane) {
    v += shx<32>(v, lane); v += shx<16>(v, lane); v += shx<8>(v, lane); v += shx<4>(v, lane); v += shx<2>(v, lane); v += shx<1>(v, lane);
    return v;
}
__device__ __forceinline__ bf16x8 ldg8(const bf16_t* p) { return *(const GAS bf16x8*)p; }
__device__ __forceinline__ u32x4 ldg4u(const void* p) { return *(const GAS u32x4*)p; }
__device__ __forceinline__ u32x2 ldg2u(const void* p) { return *(const GAS u32x2*)p; }
__device__ __forceinline__ f32x4 ldg4f(const float* p) { return *(const GAS f32x4*)p; }
__device__ __forceinline__ void stg4u(void* p, u32x4 v) { *(GAS u32x4*)p = v; }
__device__ __forceinline__ void stg2u(void* p, u32x2 v) { *(GAS u32x2*)p = v; }
__device__ __forceinline__ void stg4f(float* p, f32x4 v) { *(GAS f32x4*)p = v; }

#define XB_TMO      128
#define XB_XCNT(j)  (256  + 64 * (j))
#define XB_XSUB(j)  (1280 + 64 * (j))
#define XB_XGEN(j)  (2304 + 64 * (j))
#define XB_TOP      3328
#define XB_TOPGEN   3392
#define XCD_BAR_WORDS 3456
#define XB_SPIN_CAP (1u << 18)
__device__ __forceinline__ unsigned xb_ld(unsigned* p)              { return __hip_atomic_load(p, __ATOMIC_RELAXED, __HIP_MEMORY_SCOPE_AGENT); }
__device__ __forceinline__ unsigned xb_add(unsigned* p, unsigned v) { return __hip_atomic_fetch_add(p, v, __ATOMIC_RELAXED, __HIP_MEMORY_SCOPE_AGENT); }
__device__ __forceinline__ unsigned xb_xcc_id() { return (unsigned)__builtin_amdgcn_s_getreg((3 << 11) | 20) & 0xFu; }
#define XB_SPIN(cond, bar) do { unsigned _sp = 0; while (cond) { __builtin_amdgcn_s_sleep(1); \
    if ((++_sp & 255u) == 0u) { if (xb_ld(&(bar)[XB_TMO])) break; if (_sp > XB_SPIN_CAP) { atomicAdd(&(bar)[XB_TMO], 1u); break; } } } } while (0)
constexpr int LDS_WTAB = 131072 + 12288;
__device__ __forceinline__ int tid_rebuild(const LAS unsigned char* lds) {
    const unsigned hw = (unsigned)__builtin_amdgcn_s_getreg((5 << 11) | 4) & 63u;
    const int wv = __builtin_amdgcn_readfirstlane(*(const LAS int*)(lds + LDS_WTAB + 4 * hw));
    int ln; asm volatile("v_mbcnt_lo_u32_b32 %0, -1, 0\n\tv_mbcnt_hi_u32_b32 %0, -1, %0" : "=v"(ln));
    return wv * 64 + ln;
}
struct XcdBarrier { unsigned* bar; unsigned x; volatile LAS unsigned* st; };
__device__ __forceinline__ XcdBarrier xcd_barrier_post(unsigned* bar, volatile LAS unsigned* st) {
    XcdBarrier b; b.bar = bar; b.x = xb_xcc_id(); b.st = st;
    if (tid_rebuild((const LAS unsigned char*)st - 131072) == 0) (void)xb_add(&bar[XB_XCNT(b.x)], 1u);
    return b;
}
__device__ __forceinline__ void xcd_barrier_complete(unsigned* bar, unsigned x, unsigned& nloc, unsigned& nx) {
    const unsigned G = gridDim.x * gridDim.y * gridDim.z;
    unsigned sum, cnt, mine, sp = 0u;
    for (;;) {
        sum = 0u; cnt = 0u; mine = 0u;
#pragma unroll
        for (unsigned j = 0; j < 16; ++j) { const unsigned c = xb_ld(&bar[XB_XCNT(j)]); sum += c; cnt += (c > 0u) ? 1u : 0u; mine = (j == x) ? c : mine; }
        if (sum == G) break;
        __builtin_amdgcn_s_sleep(1);
        if ((++sp & 255u) == 0u) { if (xb_ld(&bar[XB_TMO])) break; if (sp > XB_SPIN_CAP) { atomicAdd(&bar[XB_TMO], 1u); break; } }
    }
    nloc = mine > 0u ? mine : 1u; nx = cnt > 0u ? cnt : 1u;
}
__device__ __forceinline__ void xcd_barrier(const XcdBarrier& b) {
    asm volatile("s_waitcnt vmcnt(0)" ::: "memory");
    __syncthreads();
    if (tid_rebuild((const LAS unsigned char*)b.st - 131072) == 0) {
        unsigned* bar = b.bar;
        __builtin_amdgcn_s_waitcnt(0);
        unsigned nloc = b.st[0], nx = b.st[1];
        if (nloc == 0u) { xcd_barrier_complete(bar, b.x, nloc, nx); b.st[0] = nloc; b.st[1] = nx; }
        const unsigned old = xb_add(&bar[XB_XSUB(b.x)], 1u);
        const unsigned gen = old / nloc;
        if (old + 1u == (gen + 1u) * nloc) {
            __builtin_amdgcn_fence(__ATOMIC_RELEASE, "agent");
            asm volatile("s_waitcnt vmcnt(0)" ::: "memory");
            const unsigned og = xb_add(&bar[XB_TOP], 1u);
            const unsigned tg = og / nx;
            if (og + 1u == (tg + 1u) * nx) xb_add(&bar[XB_TOPGEN], 1u);
            else XB_SPIN(xb_ld(&bar[XB_TOPGEN]) == tg, bar);
            __builtin_amdgcn_fence(__ATOMIC_ACQUIRE, "agent");
            xb_add(&bar[XB_XGEN(b.x)], 1u);
            asm volatile("s_waitcnt vmcnt(0)" ::: "memory");
        } else {
            XB_SPIN(xb_ld(&bar[XB_XGEN(b.x)]) == gen, bar);
            __builtin_amdgcn_fence(__ATOMIC_ACQUIRE, "agent");
            asm volatile("s_waitcnt vmcnt(0)" ::: "memory");
        }
    }
    __syncthreads();
}

struct Params { const float* in[27]; float* out; unsigned char* ws; int step_lo, step_hi; };
struct Ctx { unsigned char* ws; float* out; LAS unsigned char* lds; int tid, bid, G; };
constexpr int LDS_PTAB = 131072 + 2048;
__device__ __forceinline__ unsigned long long uni64(unsigned long long v) {
    const unsigned lo = __builtin_amdgcn_readfirstlane((unsigned)v), hi = __builtin_amdgcn_readfirstlane((unsigned)(v >> 32)); return ((unsigned long long)hi << 32) | lo; }
__device__ __forceinline__ Ctx uni(Ctx X) { Ctx Y = X; int t = tid_rebuild(X.lds); asm volatile("" : "+v"(t)); Y.tid = t;
    unsigned long long w = (unsigned long long)X.ws; asm volatile("" : "+s"(w)); Y.ws = (unsigned char*)w;
    unsigned long long o = (unsigned long long)X.out; asm volatile("" : "+s"(o)); Y.out = (float*)o;
    int bb = blockIdx.x; asm volatile("" : "+s"(bb)); Y.bid = bb; int gg = gridDim.x; asm volatile("" : "+s"(gg)); Y.G = gg; return Y; }
__device__ __forceinline__ const float* ctx_in(const Ctx& X, int i) { return (const float*)uni64(*(const LAS unsigned long long*)(X.lds + LDS_PTAB + 8 * i)); }
#define INP(i) ctx_in(X, (i))
enum { I_X = 0, I_C, I_WADA, I_BADA, I_GMIX, I_GMOE, I_WIN, I_PEK, I_W1K, I_W2K, I_PEV, I_W1V, I_W2V, I_NQG, I_NKG, I_SQG, I_SKG, I_SINK,
       I_WBA, I_WBB, I_WBC, I_WOUT, I_WR, I_RB, I_WEG, I_WEU, I_WED };

#ifndef PRB_SEL
#define PRB_SEL 0
#endif
constexpr int CW_PRB = 7168;
#if PRB_SEL
#define PRB_DECL() unsigned long long prb_acc = 0ull, prb_t0 = 0ull; const unsigned long long prb_start = __builtin_readcyclecounter()
#define PRB_BEGIN(n) do { if ((n) == PRB_SEL) prb_t0 = __builtin_readcyclecounter(); } while (0)
#define PRB_END(n) do { if ((n) == PRB_SEL) prb_acc += __builtin_readcyclecounter() - prb_t0; } while (0)
#define PRB_FLUSH(X) do { if (((X).tid & 63) == 0) { unsigned* c_ = (unsigned*)((X).ws + WS_CTL); atomicAdd(c_ + CW_PRB, (unsigned)(prb_acc >> 8)); \
        atomicAdd(c_ + CW_PRB + 16, (unsigned)((__builtin_readcyclecounter() - prb_start) >> 8)); } } while (0)
#else
#define PRB_DECL() do {} while (0)
#define PRB_BEGIN(n) do {} while (0)
#define PRB_END(n) do {} while (0)
#define PRB_FLUSH(X) do {} while (0)
#endif

constexpr int CONV_PER_L = 576 + 768 + 256 + 256 + 256 + 8 + 4096 + 2048;
constexpr int CW_CVQ = 7680;
__device__ __forceinline__ void conv_tiles(const Ctx& X, LAS unsigned char* lds, int u0, int ustep, int uend) {
    unsigned char* ws = X.ws;
    const int tid = X.tid;
    LAS float* t32 = (LAS float*)lds;
    constexpr int PER_L = CONV_PER_L;
    const int lk = tid >> 3, lc8 = (tid & 7) * 8;
    const float* src = nullptr; const float* srcn = nullptr; bf16_t* dst = nullptr; bf16_t* dstn = nullptr; unsigned char* d8 = nullptr; unsigned char* d8n = nullptr;
    int src_ld = 0, dst_ld = 0, nvalid = 0, src_ldn = 0, dst_ldn = 0, nvalidn = 0;
    f32x4 va = (f32x4){0.f, 0.f, 0.f, 0.f}, vb = va, vna = va, vnb = va;
#define TDECODE(u, SRC, DST, SLD, DLD, NV, D8) do { \
            const int l = (u) / PER_L; int r = (u) % PER_L; NV = 64; D8 = nullptr; \
            if (r < 576) { const int n0 = (r / 16) * 64, k0 = (r % 16) * 64; int c0; \
                if (n0 < 896) c0 = n0; else if (n0 < 2176) c0 = n0 + 24; else if (n0 == 2176) { c0 = 896; NV = 24; } else { c0 = 0; NV = 0; } \
                SRC = INP(I_WIN) + ((size_t)l * 1024 + k0) * NIN + c0; SLD = NIN; DST = (bf16_t*)(ws + WS_WIN) + ((size_t)l * 2304 + n0) * 1024 + k0; DLD = 1024; } \
            else if ((r -= 576) < 768) { const int n0 = (r / 16) * 64, k0 = (r % 16) * 64; \
                SRC = INP(I_WIN) + ((size_t)l * 1024 + k0) * NIN + 2200 + n0; SLD = NIN; DST = (bf16_t*)(ws + WS_WM) + ((size_t)l * 3072 + n0) * 1024 + k0; DLD = 1024; \
                D8 = ws + WS_WM8 + ((size_t)l * 3072 + n0) * 1024 + k0; } \
            else if ((r -= 768) < 256) { const int n0 = (r / 16) * 64, k0 = (r % 16) * 64; \
                if (k0 < 512) SRC = INP(I_WBA) + ((size_t)l * 512 + k0) * 1024 + n0; \
                else if (k0 < 768) SRC = INP(I_WBB) + ((size_t)l * 256 + (k0 - 512)) * 1024 + n0; \
                else SRC = INP(I_WBC) + ((size_t)l * 256 + (k0 - 768)) * 1024 + n0; \
                SLD = 1024; DST = (bf16_t*)(ws + WS_WB) + ((size_t)l * 1024 + n0) * 1024 + k0; DLD = 1024; } \
            else if ((r -= 256) < 256) { const int n0 = (r / 16) * 64, k0 = (r % 16) * 64; \
                SRC = INP(I_WOUT) + ((size_t)l * 1024 + k0) * 1024 + n0; SLD = 1024; DST = (bf16_t*)(ws + WS_WO) + ((size_t)l * 1024 + n0) * 1024 + k0; DLD = 1024; } \
            else if ((r -= 256) < 256) { const int mat = r / 128, rr = r % 128, n0 = (rr / 32) * 64, k0 = (rr % 32) * 64; \
                SRC = INP(mat ? I_W1V : I_W1K) + ((size_t)l * 2048 + k0) * 256 + n0; SLD = 256; DST = (bf16_t*)(ws + WS_W1) + (((size_t)l * 2 + mat) * 256 + n0) * 2048 + k0; DLD = 2048; } \
            else if ((r -= 256) < 8) { const int mat = r / 4, k0 = (r % 4) * 64; \
                SRC = INP(mat ? I_W2V : I_W2K) + ((size_t)l * 256 + k0) * 64; SLD = 64; DST = (bf16_t*)(ws + WS_W2) + (((size_t)l * 2 + mat) * 64) * 256 + k0; DLD = 256; } \
            else if ((r -= 8) < 4096) { const int e = r / 256, rr = r % 256, n0 = (rr / 16) * 64, k0 = (rr % 16) * 64; \
                const int blk = n0 / 256, half = (n0 % 256) / 128, c0 = blk * 128 + (n0 % 128); \
                SRC = INP(half ? I_WEU : I_WEG) + (((size_t)l * 16 + e) * 1024 + k0) * 512 + c0; SLD = 512; DST = (bf16_t*)(ws + WS_WGU) + (((size_t)l * 16 + e) * 1024 + n0) * 1024 + k0; DLD = 1024; } \
            else { r -= 4096; const int e = r / 128, rr = r % 128, n0 = (rr / 8) * 64, k0 = (rr % 8) * 64; \
                SRC = INP(I_WED) + (((size_t)l * 16 + e) * 512 + k0) * 1024 + n0; SLD = 1024; DST = (bf16_t*)(ws + WS_WD) + (((size_t)l * 16 + e) * 1024 + n0) * 512 + k0; DLD = 512; } \
    } while (0)
#define TLOAD(SRC, SLD, NV, A, B) do { if (lc8 + 8 <= (NV)) { A = ldg4f((SRC) + (size_t)lk * (SLD) + lc8); B = ldg4f((SRC) + (size_t)lk * (SLD) + lc8 + 4); } \
            else { A = (f32x4){0.f, 0.f, 0.f, 0.f}; B = A; } } while (0)
    int u = u0;
    if (u < uend) { TDECODE(u, src, dst, src_ld, dst_ld, nvalid, d8); TLOAD(src, src_ld, nvalid, va, vb); }
    while (u < uend) {
        const int un = u + ustep;
        if (un < uend) { TDECODE(un, srcn, dstn, src_ldn, dst_ldn, nvalidn, d8n); TLOAD(srcn, src_ldn, nvalidn, vna, vnb); }
        {
            LAS float* w = t32 + lk * 65 + lc8;
            w[0] = va[0]; w[1] = va[1]; w[2] = va[2]; w[3] = va[3]; w[4] = vb[0]; w[5] = vb[1]; w[6] = vb[2]; w[7] = vb[3];
        }
        __syncthreads();
        {
            const int n = tid >> 3, k8 = (tid & 7) * 8;
            const LAS float* r_ = t32 + k8 * 65 + n;
            u32x4 o;
            o[0] = cvt_pk_bf16(r_[0 * 65], r_[1 * 65]); o[1] = cvt_pk_bf16(r_[2 * 65], r_[3 * 65]);
            o[2] = cvt_pk_bf16(r_[4 * 65], r_[5 * 65]); o[3] = cvt_pk_bf16(r_[6 * 65], r_[7 * 65]);
            stg4u(dst + (size_t)n * dst_ld + k8, o);
            if (d8 != nullptr) { u32x2 o8; int w8 = 0;
                w8 = __builtin_amdgcn_cvt_pk_fp8_f32(64.f * r_[0 * 65], 64.f * r_[1 * 65], w8, false); w8 = __builtin_amdgcn_cvt_pk_fp8_f32(64.f * r_[2 * 65], 64.f * r_[3 * 65], w8, true); o8[0] = (unsigned)w8; w8 = 0;
                w8 = __builtin_amdgcn_cvt_pk_fp8_f32(64.f * r_[4 * 65], 64.f * r_[5 * 65], w8, false); w8 = __builtin_amdgcn_cvt_pk_fp8_f32(64.f * r_[6 * 65], 64.f * r_[7 * 65], w8, true); o8[1] = (unsigned)w8;
                stg2u(d8 + (size_t)n * 1024 + k8, o8); }
        }
        __syncthreads();
        u = un; src = srcn; dst = dstn; src_ld = src_ldn; dst_ld = dst_ldn; nvalid = nvalidn; va = vna; vb = vnb; d8 = d8n;
    }
#undef TDECODE
#undef TLOAD
}
__device__ __forceinline__ void conv_fill(const Ctx& X, LAS unsigned char* lds, int l, int max_batches, bool drain) {
    if (l >= NL) return;
    unsigned* q = (unsigned*)(X.ws + WS_CTL) + CW_CVQ + 16 * l;
    LAS int* bc = (LAS int*)(lds + LDS_MISC + 32);
    for (int b = 0; drain || b < max_batches; ++b) {
        if (X.tid == 0) bc[0] = (int)atomicAdd(q, 4u);
        __syncthreads();
        const int idx0 = bc[0];
        __syncthreads();
        if (idx0 >= CONV_PER_L) break;
        const int iend = (idx0 + 4 < CONV_PER_L) ? idx0 + 4 : CONV_PER_L;
        conv_tiles(X, lds, l * CONV_PER_L + idx0, 1, l * CONV_PER_L + iend);
    }
}

__device__ __forceinline__ void p0_prologue(const Ctx& X, LAS unsigned char* lds) {
    unsigned char* ws = X.ws;
    const int tid = X.tid, G = X.G, bid = X.bid;
    {
        const int lane = tid & 63, wave = tid >> 6;
        LAS float* sc = (LAS float*)lds;
        LAS float* red = (LAS float*)(lds + 8192);
        for (int i = tid; i < 2048; i += 512) { const float cv = INP(I_C)[i]; sc[i] = cv * sigmoidf_(cv); }
        __syncthreads();
        for (int u = bid; u < 256; u += G) {
            const int l = u >> 6, j0 = (u & 63) * 96;
            f32x4 a0 = (f32x4){0.f, 0.f, 0.f, 0.f}, a1 = a0;
            if (lane < 24) {
                const float* w = INP(I_WADA) + (size_t)l * 1024 * 6144 + j0 + 4 * lane;
#pragma unroll 8
                for (int k = wave * 128; k < wave * 128 + 128; ++k) { const f32x4 wv = ldg4f(w + (size_t)k * 6144); a0 += wv * sc[k]; a1 += wv * sc[1024 + k]; }
#pragma unroll
                for (int j = 0; j < 4; ++j) { red[(wave * 2 + 0) * 96 + 4 * lane + j] = a0[j]; red[(wave * 2 + 1) * 96 + 4 * lane + j] = a1[j]; }
            }
            __syncthreads();
            if (tid < 192) {
                const int b = tid / 96, j = tid % 96; float sm = 0.f;
#pragma unroll
                for (int w = 0; w < 8; ++w) sm += red[(w * 2 + b) * 96 + j];
                ((float*)(ws + WS_MOD))[((size_t)l * 2 + b) * 6144 + j0 + j] = sm + INP(I_BADA)[l * 6144 + j0 + j];
            }
            __syncthreads();
        }
        for (int u = bid; u < 256; u += G) {
            const int l = u >> 6, mat = (u >> 5) & 1, cc = u & 31;
            const float* pe = INP(mat ? I_PEV : I_PEK) + (size_t)l * 2048;
            const float* w = INP(mat ? I_W1V : I_W1K) + (size_t)l * 2048 * 256 + cc * 8 + (lane & 1) * 4;
            f32x4 a = (f32x4){0.f, 0.f, 0.f, 0.f};
#pragma unroll
            for (int it = 0; it < 8; ++it) { const int row = wave * 256 + it * 32 + (lane >> 1); a += ldg4f(w + (size_t)row * 256) * pe[row]; }
#pragma unroll
            for (int j = 0; j < 4; ++j) { float v = a[j]; v += shx<2>(v, lane); v += shx<4>(v, lane); v += shx<8>(v, lane); v += shx<16>(v, lane); v += shx<32>(v, lane); a[j] = v; }
            if (lane < 2) {
#pragma unroll
                for (int j = 0; j < 4; ++j) red[wave * 8 + lane * 4 + j] = a[j];
            }
            __syncthreads();
            if (tid < 8) { float sm = 0.f;
#pragma unroll
                for (int w2 = 0; w2 < 8; ++w2) sm += red[w2 * 8 + tid];
                ((float*)(ws + WS_CB))[(l * 2 + mat) * 256 + cc * 8 + tid] = sm; }
            __syncthreads();
        }
    }
    __syncthreads();
    conv_tiles(X, lds, bid, G, CONV_PER_L);
}

template <int N> struct IC { static constexpr int value = N; };
template <int MODE>
__device__ __forceinline__ void norm_phase(const Ctx& X, LAS unsigned char* lds, int layer) {
    unsigned char* ws = X.ws;
    const int tid = X.tid, lane = tid & 63, wave = tid >> 6, G = X.G;
    const float* xsrc = INP(I_X);
    float* xdst = X.out;
    bf16_t* xb = (bf16_t*)(ws + WS_XB);
    const float* modl = (const float*)(ws + WS_MOD) + (size_t)layer * 2 * 6144;
    const float* modp = (const float*)(ws + WS_MOD) + (size_t)(layer - 1) * 2 * 6144;
    const bf16_t* yb = (const bf16_t*)(ws + WS_YS);
    const u32x4* tinfo = (const u32x4*)(ws + WS_TINFO);
    LAS int* tpad = (LAS int*)(lds + LDS_MISC + 1024);
    LAS int* ttmp = (LAS int*)(lds + LDS_MISC + 1088);
    bf16_t* h = (bf16_t*)(ws + WS_H);
    const float* gn = INP(MODE == 2 ? I_GMOE : I_GMIX) + (size_t)layer * 1024;
    const int sh_off = (MODE == 2) ? 3072 : 0, sc_off = (MODE == 2) ? 4096 : 1024;
    LAS float* wrT = (LAS float*)lds;
    LAS int* lcnt = (LAS int*)(lds + LDS_MISC + 64);
    LAS int* lbase = (LAS int*)(lds + LDS_MISC + 128);
    LAS float* lgl = (LAS float*)(lds + 65536);
    if (MODE == 2) {
        for (int i = tid; i < 16384; i += 512) { const int k = i >> 4, e = i & 15; wrT[e * 1024 + k] = INP(I_WR)[i]; }
        if (tid < 16) lcnt[tid] = 0;
        __syncthreads();
    }
    if (MODE == 1 || MODE == 3) {
        const unsigned* gcnt = (const unsigned*)(ws + WS_CTL) + CW_GCNT + 16 * ((layer - 1) * 16);
        if (tid < 16) ttmp[tid] = (((int)__hip_atomic_load(gcnt + 16 * tid, __ATOMIC_RELAXED, __HIP_MEMORY_SCOPE_AGENT) + 255) >> 8) * 256;
        __syncthreads();
        if (tid < 16) { int p = 0; for (int k = 0; k < tid; ++k) p += ttmp[k]; tpad[tid] = p; }
        __syncthreads();
    }
    int it = 0; (void)it;
    const int stride = G * 8, r0 = X.bid * 8 + wave;
    f32x4 vn[2][4]; u32x2 xbn[2][4], y0n[2][4], y1n[2][4]; float w0n[2] = {0.f, 0.f}, w1n[2] = {0.f, 0.f}; u32x4 tin[2] = {(u32x4){0u, 0u, 0u, 0u}, (u32x4){0u, 0u, 0u, 0u}};
#define NORM_LOAD(S, r) do { size_t yr0_ = 0, yr1_ = 0; \
        if (MODE == 1 || MODE == 3) { const unsigned a0_ = __builtin_amdgcn_readfirstlane(tin[S][0]), a1_ = __builtin_amdgcn_readfirstlane(tin[S][2]); \
            w0n[S] = __uint_as_float(__builtin_amdgcn_readfirstlane(tin[S][1])); w1n[S] = __uint_as_float(__builtin_amdgcn_readfirstlane(tin[S][3])); \
            yr0_ = (size_t)(__builtin_amdgcn_readfirstlane(tpad[a0_ & 15u]) + (int)(a0_ >> 4)) * 1024; yr1_ = (size_t)(__builtin_amdgcn_readfirstlane(tpad[a1_ & 15u]) + (int)(a1_ >> 4)) * 1024; } \
        _Pragma("unroll") for (int i = 0; i < 4; ++i) { const int col_ = 4 * (lane + 64 * i); \
        if (MODE == 0 || MODE == 2) vn[S][i] = ldg4f(xsrc + (size_t)(r) * 1024 + col_); \
        if (MODE == 1 || MODE == 3) { xbn[S][i] = ldg2u(xb + (size_t)(r) * 1024 + col_); y0n[S][i] = ldg2u(yb + yr0_ + col_); y1n[S][i] = ldg2u(yb + yr1_ + col_); } } } while (0)
    if (MODE == 1 || MODE == 3) { if (r0 < NTOK) tin[0] = ldg4u(tinfo + (r0)); if (r0 + stride < NTOK) tin[1] = ldg4u(tinfo + (r0 + stride)); }
    if (r0 < NTOK) { NORM_LOAD(0, r0); if ((MODE == 1 || MODE == 3) && r0 + 2 * stride < NTOK) tin[0] = ldg4u(tinfo + (r0 + 2 * stride)); }
    if (r0 + stride < NTOK) { NORM_LOAD(1, r0 + stride); if ((MODE == 1 || MODE == 3) && r0 + 3 * stride < NTOK) tin[1] = ldg4u(tinfo + (r0 + 3 * stride)); }
    int bcur = -1; f32x4 gmv[4], gscv[4], shv4[4];
    auto body = [&](auto SC, const int row) __attribute__((always_inline)) {
        constexpr int S = decltype(SC)::value;
        const int b = row >> 14;
        if (b != bcur) {
            bcur = b;
#pragma unroll
            for (int i = 0; i < 4; ++i) { const int col = 4 * (lane + 64 * i);
                if (MODE == 1 || MODE == 3) gmv[i] = ldg4f(modp + b * 6144 + 5120 + col);
                if (MODE != 3) { const f32x4 g = ldg4f(gn + col), sc = ldg4f(modl + b * 6144 + sc_off + col); gscv[i] = g * (1.f + sc); shv4[i] = ldg4f(modl + b * 6144 + sh_off + col); } }
        }
        f32x4 v[4];
#pragma unroll
        for (int i = 0; i < 4; ++i) {
            if (MODE == 1 || MODE == 3) {
                const u32x2 xq = xbn[S][i], y0 = y0n[S][i], y1 = y1n[S][i]; const f32x4 g = gmv[i]; const float w0c = w0n[S], w1c = w1n[S];
                v[i][0] = bf_lo(xq[0]) + g[0] * (w0c * bf_lo(y0[0]) + w1c * bf_lo(y1[0])); v[i][1] = bf_hi(xq[0]) + g[1] * (w0c * bf_hi(y0[0]) + w1c * bf_hi(y1[0]));
                v[i][2] = bf_lo(xq[1]) + g[2] * (w0c * bf_lo(y0[1]) + w1c * bf_lo(y1[1])); v[i][3] = bf_hi(xq[1]) + g[3] * (w0c * bf_hi(y0[1]) + w1c * bf_hi(y1[1]));
            } else v[i] = vn[S][i];
        }
        asm volatile("" ::: "memory");
        if (row + 2 * stride < NTOK) { NORM_LOAD(S, row + 2 * stride); if ((MODE == 1 || MODE == 3) && row + 4 * stride < NTOK) tin[S] = ldg4u(tinfo + (row + 4 * stride)); }
        asm volatile("" ::: "memory");
#pragma unroll
        for (int i = 0; i < 4; ++i) {
            const int col = 4 * (lane + 64 * i);
#if PRB_SEL
            if (MODE == 3) { const unsigned* c_ = (const unsigned*)(ws + WS_CTL); const float fr_ = (float)c_[CW_PRB] / fmaxf((float)c_[CW_PRB + 16], 1.f);
                v[i] *= 1.f + sqrtf(0.02f + 0.5f * fr_); }
#endif
            if (MODE == 3) stg4f(xdst + (size_t)row * 1024 + col, v[i]);
            else { u32x2 o; o[0] = cvt_pk_bf16(v[i][0], v[i][1]); o[1] = cvt_pk_bf16(v[i][2], v[i][3]); stg2u(xb + (size_t)row * 1024 + col, o); }
        }
        if (MODE == 3) return;
        float ss = 0.f;
#pragma unroll
        for (int i = 0; i < 4; ++i) ss += v[i][0] * v[i][0] + v[i][1] * v[i][1] + v[i][2] * v[i][2] + v[i][3] * v[i][3];
        ss = wave_sum(ss, lane);
        const float rinv = rsqrtf(ss * (1.f / 1024.f) + 1e-6f);
#pragma unroll
        for (int i = 0; i < 4; ++i) {
            const int col = 4 * (lane + 64 * i);
            f32x4 hv;
#pragma unroll
            for (int j = 0; j < 4; ++j) hv[j] = v[i][j] * rinv * gscv[i][j] + shv4[i][j];
            u32x2 o; o[0] = cvt_pk_bf16(hv[0], hv[1]); o[1] = cvt_pk_bf16(hv[2], hv[3]);
            stg2u(h + (size_t)row * 1024 + col, o);
            { int w8 = 0; w8 = __builtin_amdgcn_cvt_pk_fp8_f32(hv[0], hv[1], w8, false); w8 = __builtin_amdgcn_cvt_pk_fp8_f32(hv[2], hv[3], w8, true);
              *(GAS int*)(ws + WS_H8 + (size_t)row * 1024 + col) = w8; }
        }
    };
    for (int rowp = r0; rowp < NTOK; rowp += 2 * stride) { body(IC<0>{}, rowp); if (rowp + stride < NTOK) body(IC<1>{}, rowp + stride); }
#undef NORM_LOAD
    if (MODE == 2) {
        __syncthreads();
        const int slot = tid, srow = X.bid * 8 + (slot & 7) + (slot >> 3) * G * 8;
        const bool have = (slot < 512) && (srow < NTOK) && ((slot >> 3) < 64);
        int e0 = 0, e1 = 0, r0 = 0, r1i = 0; float w0 = 0.f, w1 = 0.f;
        if (have) {
            float sco[16], sel[16];
            f32x4 rb4[4];
#pragma unroll
            for (int q = 0; q < 4; ++q) rb4[q] = ldg4f(INP(I_RB) + 4 * q);
#pragma unroll
            for (int q = 0; q < 4; ++q) { const f32x4 lg4 = *(const LAS f32x4*)(lgl + slot * 16 + 4 * q);
#pragma unroll
                for (int j = 0; j < 4; ++j) { const int e = 4 * q + j; sco[e] = 1.f / (1.f + __expf(-lg4[j])); sel[e] = sco[e] + rb4[q][j]; } }
            float gs[4];
#pragma unroll
            for (int g = 0; g < 4; ++g) {
                const float a = sel[4 * g], bq = sel[4 * g + 1], c = sel[4 * g + 2], d = sel[4 * g + 3];
                const float m1 = fmaxf(fmaxf(a, bq), fmaxf(c, d));
                int i1 = (a == m1) ? 0 : (bq == m1) ? 1 : (c == m1) ? 2 : 3;
                float m2 = -3.0e38f;
                m2 = (i1 != 0) ? fmaxf(m2, a) : m2; m2 = (i1 != 1) ? fmaxf(m2, bq) : m2; m2 = (i1 != 2) ? fmaxf(m2, c) : m2; m2 = (i1 != 3) ? fmaxf(m2, d) : m2;
                gs[g] = m1 + m2;
            }
            int gi = 0; float gb = gs[0];
#pragma unroll
            for (int g = 1; g < 4; ++g) if (gs[g] > gb) { gb = gs[g]; gi = g; }
            float s0 = (gi == 0) ? sel[0] : (gi == 1) ? sel[4] : (gi == 2) ? sel[8] : sel[12];
            float s1 = (gi == 0) ? sel[1] : (gi == 1) ? sel[5] : (gi == 2) ? sel[9] : sel[13];
            float s2 = (gi == 0) ? sel[2] : (gi == 1) ? sel[6] : (gi == 2) ? sel[10] : sel[14];
            float s3 = (gi == 0) ? sel[3] : (gi == 1) ? sel[7] : (gi == 2) ? sel[11] : sel[15];
            float c0 = (gi == 0) ? sco[0] : (gi == 1) ? sco[4] : (gi == 2) ? sco[8] : sco[12];
            float c1 = (gi == 0) ? sco[1] : (gi == 1) ? sco[5] : (gi == 2) ? sco[9] : sco[13];
            float c2 = (gi == 0) ? sco[2] : (gi == 1) ? sco[6] : (gi == 2) ? sco[10] : sco[14];
            float c3 = (gi == 0) ? sco[3] : (gi == 1) ? sco[7] : (gi == 2) ? sco[11] : sco[15];
            const float m1 = fmaxf(fmaxf(s0, s1), fmaxf(s2, s3));
            const int i1 = (s0 == m1) ? 0 : (s1 == m1) ? 1 : (s2 == m1) ? 2 : 3;
            float m2 = -3.0e38f;
            m2 = (i1 != 0) ? fmaxf(m2, s0) : m2; m2 = (i1 != 1) ? fmaxf(m2, s1) : m2; m2 = (i1 != 2) ? fmaxf(m2, s2) : m2; m2 = (i1 != 3) ? fmaxf(m2, s3) : m2;
            const int i2 = (i1 != 0 && s0 == m2) ? 0 : (i1 != 1 && s1 == m2) ? 1 : (i1 != 2 && s2 == m2) ? 2 : 3;
            const float w1v = (i1 == 0) ? c0 : (i1 == 1) ? c1 : (i1 == 2) ? c2 : c3;
            const float w2v = (i2 == 0) ? c0 : (i2 == 1) ? c1 : (i2 == 2) ? c2 : c3;
            const float wn = 1.f / (w1v + w2v);
            e0 = gi * 4 + i1; e1 = gi * 4 + i2; w0 = w1v * wn; w1 = w2v * wn;
            r0 = __hip_atomic_fetch_add(lcnt + e0, 1, __ATOMIC_RELAXED, __HIP_MEMORY_SCOPE_WORKGROUP); r1i = __hip_atomic_fetch_add(lcnt + e1, 1, __ATOMIC_RELAXED, __HIP_MEMORY_SCOPE_WORKGROUP);
        }
        __syncthreads();
        unsigned* gcnt = (unsigned*)(ws + WS_CTL) + CW_GCNT + 16 * (layer * 16);
        if (tid < 16) lbase[tid] = (int)atomicAdd(gcnt + 16 * tid, (unsigned)lcnt[tid]);
        __syncthreads();
        if (have) {
            int* lt = (int*)(ws + WS_LISTT); float* lw = (float*)(ws + WS_LISTW);
            const int p0 = lbase[e0] + r0, p1 = lbase[e1] + r1i;
            lt[e0 * LCAP + p0] = srow * 2; lw[e0 * LCAP + p0] = w0;
            lt[e1 * LCAP + p1] = srow * 2 + 1; lw[e1 * LCAP + p1] = w1;
        }
    }
    __syncthreads();
}

constexpr int BM = 256, BK = 64, HALF = 128, HTB = HALF * BK * 2, STAGE_BYTES = 8 * HTB;
__host__ __device__ __forceinline__ int lds_byte(int r, int c) { const int st = (r >> 4) * 2 + (c >> 5), rr = r & 15, cc = c & 31, ob = rr * 64 + cc * 2; return st * 1024 + (ob ^ (((ob >> 9) & 1) << 5)); }
__host__ __device__ __forceinline__ void stage_rc(int b, int& R, int& C) { const int st = b / 1024, sb = b % 1024, swz = sb ^ (((sb >> 9) & 1) << 5); R = (st >> 1) * 16 + swz / 64; C = (st & 1) * 32 + (swz % 64) / 2; }
__host__ __device__ __forceinline__ int perm32(int rho) { const int n = rho >> 4, i = rho & 15; return 8 * (i >> 2) + 4 * n + (i & 3); }

struct GU { const char* A; const char* B; int nt, kind, pm, pn, e, aux; };
typedef int i32x8 __attribute__((ext_vector_type(8)));
typedef int i32x4_ __attribute__((ext_vector_type(4)));

__device__ __forceinline__ bool tile_map(long L, int nM, int nN, int& pm, int& pn) {
    const int nwg = nM * nN; if (L >= nwg) return false;
    int wgid = (int)L; { const int q = nwg / 8, r = nwg % 8, xcd = wgid % 8, off = wgid / 8; wgid = (xcd < r ? xcd * (q + 1) : r * (q + 1) + (xcd - r) * q) + off; }
    const int nig = 8 * nN, gid = wgid / nig, fm = gid * 8, gsz = (nM - fm) < 8 ? (nM - fm) : 8;
    pm = fm + ((wgid % nig) % gsz); pn = (wgid % nig) / gsz; return true;
}

template <class Epi, class Sched>
__device__ __forceinline__ void gemm_run(LAS unsigned char* lds, const Sched& S, const Epi& E, const int tid) {
    const int wid = __builtin_amdgcn_readfirstlane(tid >> 6), lane = tid & 63, wr = wid >> 2, wc = wid & 3, fr = lane & 15, fq = lane >> 4;
    unsigned vA[2][2], vAn[2][2], voffB[2];
#pragma unroll
    for (int i = 0; i < 2; ++i) { int R, C; stage_rc(tid * 16 + i * 8192, R, C); const int Rb = Epi::HEADMAP ? ((R >> 5) * 64 + perm32(R & 31)) : (Epi::PERM ? ((R & ~31) + perm32(R & 31)) : R);
        voffB[i] = (unsigned)Rb * (unsigned)S.ldb2 + (unsigned)C * 2u;
        vA[0][i] = (unsigned)R * (unsigned)S.lda2 + (unsigned)C * 2u; vA[1][i] = (unsigned)(R + HALF) * (unsigned)S.lda2 + (unsigned)C * 2u;
        vAn[0][i] = vA[0][i]; vAn[1][i] = vA[1][i]; }
    const size_t akstep = (size_t)S.akstep, bkstep = (size_t)(BK * 2), hstepB = (size_t)(Epi::HEADMAP ? 32 : HALF) * S.ldb2;
    const unsigned ldsw = (unsigned)wid * 1024u;
    const int aoff = lds_byte(wr * 64 + fr, fq * 8), boff = lds_byte(wc * 32 + fr, fq * 8);
    unsigned voffB8[2] = {0u, 0u}; size_t hstepB8 = 0;
    int aoff8a = 0, aoff8b = 0, boff8a = 0, boff8b = 0;
    if (Sched::FP8) {
#pragma unroll
        for (int i = 0; i < 2; ++i) { int R, C; stage_rc(tid * 16 + i * 8192, R, C); const int Rb = Epi::PERM ? ((R & ~31) + perm32(R & 31)) : R; voffB8[i] = (unsigned)Rb * (unsigned)(S.ldb2 / 2) + (unsigned)C * 2u; }
        hstepB8 = (size_t)HALF * (S.ldb2 / 2);
        aoff8a = aoff; aoff8b = aoff + 1024; boff8a = boff; boff8b = boff + 1024;
    }
#define G_SA(b, h) (((b) * 2 + (h)) * HTB)
#define G_SB(b, h) ((4 + (b) * 2 + (h)) * HTB)
#define G_STAGE2(bufoff, gbase, o0, o1) do { \
        __builtin_amdgcn_global_load_lds((const unsigned*)((const char*)(gbase) + (o0)), (LAS unsigned*)(lds + (bufoff) + ldsw), 16, 0, 0); \
        __builtin_amdgcn_global_load_lds((const unsigned*)((const char*)(gbase) + (o1)), (LAS unsigned*)(lds + (bufoff) + ldsw + 8192), 16, 0, 0); } while (0)
#define G_STAGE_B(bufoff, gbase) G_STAGE2(bufoff, gbase, voffB[0], voffB[1])
#define G_LDA(dst, b, h) do { _Pragma("unroll") for (int m = 0; m < 4; ++m) _Pragma("unroll") for (int k = 0; k < 2; ++k) dst[m][k] = *(const LAS bf16x8*)(lds + G_SA(b, h) + aoff + m * 2048 + k * 1024); } while (0)
#define G_LDB(dst, b, h) do { _Pragma("unroll") for (int n = 0; n < 2; ++n) _Pragma("unroll") for (int k = 0; k < 2; ++k) dst[n][k] = *(const LAS bf16x8*)(lds + G_SB(b, h) + boff + n * 2048 + k * 1024); } while (0)
#define G_MMA(ai, bj, At, Bt) do { __builtin_amdgcn_s_setprio(1); _Pragma("unroll") for (int m = 0; m < 4; ++m) _Pragma("unroll") for (int n = 0; n < 2; ++n) _Pragma("unroll") for (int k = 0; k < 2; ++k) \
        acc[ai][bj][m][n] = __builtin_amdgcn_mfma_f32_16x16x32_bf16(Bt[n][k], At[m][k], acc[ai][bj][m][n], 0, 0, 0); __builtin_amdgcn_s_setprio(0); } while (0)
#define G_RD8(dst, base, oa, ob) do { const u32x4 lo_ = *(const LAS u32x4*)(lds + (base) + (oa)), hi_ = *(const LAS u32x4*)(lds + (base) + (ob)); \
        dst[0] = (int)lo_[0]; dst[1] = (int)lo_[1]; dst[2] = (int)lo_[2]; dst[3] = (int)lo_[3]; dst[4] = (int)hi_[0]; dst[5] = (int)hi_[1]; dst[6] = (int)hi_[2]; dst[7] = (int)hi_[3]; } while (0)
#define G_LDA8(dst, b, h) do { _Pragma("unroll") for (int m = 0; m < 4; ++m) G_RD8(dst[m], G_SA(b, h) + m * 2048, aoff8a, aoff8b); } while (0)
#define G_LDB8(dst, b, h) do { _Pragma("unroll") for (int n = 0; n < 2; ++n) G_RD8(dst[n], G_SB(b, h) + n * 2048, boff8a, boff8b); } while (0)
#define G_MMA8(ai, bj, At, Bt) do { __builtin_amdgcn_s_setprio(1); _Pragma("unroll") for (int m = 0; m < 4; ++m) _Pragma("unroll") for (int n = 0; n < 2; ++n) \
        asm volatile("v_mfma_scale_f32_16x16x128_f8f6f4 %0, %1, %2, %0, %3, %3 op_sel_hi:[0,0,0]" : "+v"(acc[ai][bj][m][n]) : "v"(Bt[n]), "v"(At[m]), "v"(sc1_)); __builtin_amdgcn_s_setprio(0); } while (0)
#define G_WAIT_V(n) asm volatile("s_waitcnt vmcnt(" #n ")" ::: "memory")
#define G_WAIT_L(n) asm volatile("s_waitcnt lgkmcnt(" #n ")" ::: "memory")
#define G_BAR __builtin_amdgcn_s_barrier()
#define G_SCHED __builtin_amdgcn_sched_barrier(0)
    GU cur, nxt; int ui = 0;
    if (!S.next(0, cur)) return;
    if (Sched::GATHER) S.rowoff(cur, tid, vA);
    f32x4 acc[2][2][4][2];
#pragma unroll
    for (int a = 0; a < 2; ++a)
#pragma unroll
        for (int b = 0; b < 2; ++b)
#pragma unroll
            for (int m = 0; m < 4; ++m)
#pragma unroll
                for (int n = 0; n < 2; ++n) acc[a][b][m][n] = (f32x4){0.f, 0.f, 0.f, 0.f};
    bf16x8 At[4][2], B0[2][2], B1[2][2];
    i32x8 At8[4], B08[2], B18[2]; int sc1_ = 0x7f7f7f7f; asm volatile("" : "+v"(sc1_));
    const char* cA = cur.A; const char* cB = cur.B;
    { constexpr bool f8 = Sched::FP8; const unsigned p0 = f8 ? voffB8[0] : voffB[0], p1 = f8 ? voffB8[1] : voffB[1]; const size_t hs = f8 ? hstepB8 : hstepB;
      G_STAGE2(G_SB(0, 0), cB, p0, p1); G_STAGE2(G_SA(0, 0), cA, vA[0][0], vA[0][1]); G_STAGE2(G_SB(0, 1), cB + hs, p0, p1); G_STAGE2(G_SA(0, 1), cA, vA[1][0], vA[1][1]);
      if (wr == 1) G_BAR;
      G_WAIT_V(4); G_BAR;
      G_STAGE2(G_SB(1, 0), cB + bkstep, p0, p1); G_STAGE2(G_SA(1, 0), cA + akstep, vA[0][0], vA[0][1]); G_STAGE2(G_SB(1, 1), cB + hs + bkstep, p0, p1);
      G_WAIT_V(6); G_BAR; }
    for (;;) {
        const bool has_next = S.next(ui + 1, nxt);
        const char* nA = has_next ? nxt.A : cA; const char* nB = has_next ? nxt.B : cB;
        if (Sched::GATHER) { if (has_next) S.rowoff(nxt, tid, vAn); else {
#pragma unroll
            for (int h = 0; h < 2; ++h) { vAn[h][0] = vA[h][0]; vAn[h][1] = vA[h][1]; } } }
        const int nt = cur.nt;
        constexpr bool c8 = Sched::FP8, n8 = Sched::FP8;
        const unsigned obc0 = c8 ? voffB8[0] : voffB[0], obc1 = c8 ? voffB8[1] : voffB[1], obn0 = n8 ? voffB8[0] : voffB[0], obn1 = n8 ? voffB8[1] : voffB[1];
        const size_t hsc = c8 ? hstepB8 : hstepB, hsn = n8 ? hstepB8 : hstepB;
        for (int t = 0; t < nt; t += 2) {
            const bool last = (t == nt - 2);
            const char* a1 = cA + (size_t)(t + 1) * akstep;
            const char* a2 = last ? nA : cA + (size_t)(t + 2) * akstep; const char* b2 = last ? nB : cB + (size_t)(t + 2) * bkstep;
            const char* a3 = a2 + akstep; const char* b3 = b2 + bkstep;
            const unsigned ob0 = last ? obn0 : obc0, ob1 = last ? obn1 : obc1; const size_t hsx = last ? hsn : hsc;
            unsigned w00, w01, w10, w11;
            if (Sched::GATHER) { w00 = last ? vAn[0][0] : vA[0][0]; w01 = last ? vAn[0][1] : vA[0][1]; w10 = last ? vAn[1][0] : vA[1][0]; w11 = last ? vAn[1][1] : vA[1][1]; }
            else { w00 = vA[0][0]; w01 = vA[0][1]; w10 = vA[1][0]; w11 = vA[1][1]; }
            if constexpr (c8) {
            G_LDB8(B08, 0, 0); G_SCHED; G_LDA8(At8, 0, 0); G_STAGE2(G_SA(1, 1), a1, vA[1][0], vA[1][1]);
            G_WAIT_L(8); G_BAR; G_WAIT_L(0); G_MMA8(0, 0, At8, B08); G_BAR; G_SCHED;
            G_LDB8(B18, 0, 1); G_STAGE2(G_SB(0, 0), b2, ob0, ob1);
            G_BAR; G_WAIT_L(0); G_MMA8(0, 1, At8, B18); G_BAR;
            G_LDA8(At8, 0, 1); G_STAGE2(G_SA(0, 0), a2, w00, w01);
            G_BAR; G_WAIT_L(0); G_MMA8(1, 0, At8, B08); G_BAR; G_SCHED;
            G_STAGE2(G_SB(0, 1), b2 + hsx, ob0, ob1);
            G_WAIT_V(6); G_BAR; G_MMA8(1, 1, At8, B18); G_BAR;
            G_LDB8(B08, 1, 0); G_SCHED; G_LDA8(At8, 1, 0); G_STAGE2(G_SA(0, 1), a2, w10, w11);
            G_WAIT_L(8); G_BAR; G_WAIT_L(0); G_MMA8(0, 0, At8, B08); G_BAR; G_SCHED;
            G_LDB8(B18, 1, 1); G_STAGE2(G_SB(1, 0), b3, ob0, ob1);
            G_BAR; G_WAIT_L(0); G_MMA8(0, 1, At8, B18); G_BAR;
            G_LDA8(At8, 1, 1); G_STAGE2(G_SA(1, 0), a3, w00, w01);
            G_BAR; G_WAIT_L(0); G_MMA8(1, 0, At8, B08); G_BAR; G_SCHED;
            G_STAGE2(G_SB(1, 1), b3 + hsx, ob0, ob1);
            G_WAIT_V(6); G_BAR; G_MMA8(1, 1, At8, B18); G_BAR;
            } else {
            G_LDB(B0, 0, 0); G_SCHED; G_LDA(At, 0, 0); G_STAGE2(G_SA(1, 1), a1, vA[1][0], vA[1][1]);
            G_WAIT_L(8); G_BAR; G_WAIT_L(0); G_MMA(0, 0, At, B0); G_BAR; G_SCHED;
            G_LDB(B1, 0, 1); G_STAGE2(G_SB(0, 0), b2, ob0, ob1);
            G_BAR; G_WAIT_L(0); G_MMA(0, 1, At, B1); G_BAR;
            G_LDA(At, 0, 1); G_STAGE2(G_SA(0, 0), a2, w00, w01);
            G_BAR; G_WAIT_L(0); G_MMA(1, 0, At, B0); G_BAR; G_SCHED;
            G_STAGE2(G_SB(0, 1), b2 + hsx, ob0, ob1);
            G_WAIT_V(6); G_BAR; G_MMA(1, 1, At, B1); G_BAR;
            G_LDB(B0, 1, 0); G_SCHED; G_LDA(At, 1, 0); G_STAGE2(G_SA(0, 1), a2, w10, w11);
            G_WAIT_L(8); G_BAR; G_WAIT_L(0); G_MMA(0, 0, At, B0); G_BAR; G_SCHED;
            G_LDB(B1, 1, 1); G_STAGE2(G_SB(1, 0), b3, ob0, ob1);
            G_BAR; G_WAIT_L(0); G_MMA(0, 1, At, B1); G_BAR;
            G_LDA(At, 1, 1); G_STAGE2(G_SA(1, 0), a3, w00, w01);
            G_BAR; G_WAIT_L(0); G_MMA(1, 0, At, B0); G_BAR; G_SCHED;
            G_STAGE2(G_SB(1, 1), b3 + hsx, ob0, ob1);
            G_WAIT_V(6); G_BAR; G_MMA(1, 1, At, B1); G_BAR;
            }
        }
        { int fr2 = fr, fq2 = fq; asm volatile("" : "+v"(fr2), "+v"(fq2));
          E(acc, cur, wr, wc, fr2, fq2); }
        if (!has_next) break;
        if (!(Sched::CHAIN && cur.aux != 0)) {
#pragma unroll
            for (int a = 0; a < 2; ++a)
#pragma unroll
                for (int b = 0; b < 2; ++b)
#pragma unroll
                    for (int m = 0; m < 4; ++m)
#pragma unroll
                        for (int n = 0; n < 2; ++n) acc[a][b][m][n] = (f32x4){0.f, 0.f, 0.f, 0.f};
        }
        cur = nxt; cA = nA; cB = nB; ++ui;
        if (Sched::GATHER) {
#pragma unroll
            for (int h = 0; h < 2; ++h) { vA[h][0] = vAn[h][0]; vA[h][1] = vAn[h][1]; } }
    }
    G_WAIT_V(0);
    if (wr == 0) G_BAR;
    G_BAR;
#undef G_SA
#undef G_SB
#undef G_STAGE2
#undef G_STAGE_B
#undef G_LDA
#undef G_LDB
#undef G_MMA
#undef G_MMA8
#undef G_LDA8
#undef G_LDB8
#undef G_RD8
#undef G_WAIT_V
#undef G_WAIT_L
#undef G_BAR
#undef G_SCHED
}

struct SchedDense {
    static constexpr bool GATHER = false, FP8 = false, CHAIN = false;
    int lda2, akstep, ldb2; const char* A; const char* B; int nM, nN, nt, G, c;
    __device__ __forceinline__ bool next(int i, GU& u) const {
        int pm, pn; if (!tile_map((long)i * G + c, nM, nN, pm, pn)) return false;
        u.A = A + (size_t)pm * 256 * lda2; u.B = B + (size_t)pn * 256 * ldb2; u.nt = nt; u.kind = 0; u.pm = pm; u.pn = pn; u.e = 0; u.aux = 0; return true;
    }
    __device__ __forceinline__ void rowoff(const GU&, int, unsigned (&)[2][2]) const {}
};
struct SchedE1G {
    static constexpr bool GATHER = false, FP8 = true, CHAIN = false;
    int lda2, akstep, ldb2; const char* H8; const char* WM8; int G, c, T;
    __device__ __forceinline__ bool next(int i, GU& u) const {
        if (i >= 3) return false;
        int pm, pn; if (!tile_map((long)T * G + c, 128, 4, pm, pn)) return false;
        u.A = H8 + (size_t)pm * 256 * 1024; u.B = WM8 + (size_t)(i * 1024 + pn * 256) * 1024; u.nt = 8;
        u.kind = 0; u.pm = pm; u.pn = pn; u.e = i; u.aux = 0; return true;
    }
    __device__ __forceinline__ void rowoff(const GU&, int, unsigned (&)[2][2]) const {}
};
struct SchedE1T {
    static constexpr bool GATHER = false, FP8 = false, CHAIN = true;
    int lda2, akstep, ldb2; const char* O; const char* WB; int G, c, T;
    __device__ __forceinline__ bool next(int i, GU& u) const {
        if (i >= 3) return false;
        int pm, pn; if (!tile_map((long)T * G + c, 128, 4, pm, pn)) return false;
        const int koff = (i == 0) ? 0 : (i == 1) ? 512 : 768;
        u.A = O + (size_t)pm * 256 * 2048 + koff * 2; u.B = WB + (size_t)pn * 256 * 2048 + koff * 2; u.nt = (i == 0) ? 8 : 4;
        u.kind = 1; u.pm = pm; u.pn = pn; u.e = i; u.aux = (i < 2) ? 1 : 0; return true;
    }
    __device__ __forceinline__ void rowoff(const GU&, int, unsigned (&)[2][2]) const {}
};
struct SchedMoE {
    static constexpr bool GATHER = true, FP8 = false, CHAIN = false;
    int lda2, akstep, ldb2; const char* A; const char* B; size_t bstride; int ncol, nt, G, c, phase  ;
    const LAS int* tpre;
    const int* listT;
    __device__ __forceinline__ bool next(int i, GU& u) const {
        const int cx = (G % 8 == 0) ? (c % 8) * (G / 8) + c / 8 : c;
        const long L = (long)i * G + cx; const int ntile = tpre[16];
        if (L >= (long)ntile * ncol) return false;
        const int rt = (int)(L / ncol), pn = (int)(L % ncol);
        int e = 0;
#pragma unroll
        for (int k = 1; k < 16; ++k) e += (rt >= tpre[k]) ? 1 : 0;
        const int lt = rt - tpre[e];
        u.e = e; u.pm = lt; u.pn = pn; u.nt = nt; u.kind = 0; u.aux = tpre[34 + e] + lt * 256;
        u.B = B + (size_t)e * bstride + (size_t)pn * 256 * ldb2;
        u.A = (phase == 1) ? A : A + (size_t)u.aux * lda2;
        return true;
    }
    __device__ __forceinline__ void rowoff(const GU& u, int tid, unsigned (&vo)[2][2]) const {
        const int cnt = tpre[17 + u.e];
#pragma unroll
        for (int i = 0; i < 2; ++i) { int R, C; stage_rc(tid * 16 + i * 8192, R, C);
#pragma unroll
            for (int h = 0; h < 2; ++h) {
                const int r = u.pm * 256 + h * 128 + R;
                if (phase == 1) { const int tok = (r < cnt) ? (*(const GAS int*)(listT + u.e * LCAP + r) >> 1) : 0; vo[h][i] = (unsigned)tok * 2048u + (unsigned)C * 2u; }
                else vo[h][i] = (unsigned)(h * 128 + R) * (unsigned)lda2 + (unsigned)C * 2u;
            } }
    }
};

__device__ __forceinline__ u32x4 pack8(const f32x4 a, const f32x4 b) { u32x4 o; o[0] = cvt_pk_bf16(a[0], a[1]); o[1] = cvt_pk_bf16(a[2], a[3]); o[2] = cvt_pk_bf16(b[0], b[1]); o[3] = cvt_pk_bf16(b[2], b[3]); return o; }
__device__ __forceinline__ void unpack8(const u32x4 u, f32x4& a, f32x4& b) { a[0] = bf_lo(u[0]); a[1] = bf_hi(u[0]); a[2] = bf_lo(u[1]); a[3] = bf_hi(u[1]); b[0] = bf_lo(u[2]); b[1] = bf_hi(u[2]); b[2] = bf_lo(u[3]); b[3] = bf_hi(u[3]); }

struct EpiBf16 {
    static constexpr bool PERM = true, HEADMAP = false;
    bf16_t* O; int ldc;
    __device__ __forceinline__ void operator()(const f32x4 (&acc)[2][2][4][2], const GU& u, int wr, int wc, int fr, int fq) const {
#pragma unroll
        for (int ai = 0; ai < 2; ++ai)
#pragma unroll
            for (int m = 0; m < 4; ++m) { bf16_t* rowp = O + (size_t)(u.pm * 256 + ai * 128 + wr * 64 + m * 16 + fr) * ldc + u.pn * 256 + wc * 32 + 8 * fq;
#pragma unroll
                for (int bj = 0; bj < 2; ++bj) stg4u(rowp + bj * 128, pack8(acc[ai][bj][m][0], acc[ai][bj][m][1])); }
    }
};
struct EpiZ {
    static constexpr bool PERM = true, HEADMAP = true;
    bf16_t* Z; bf16_t* VT; const float* nqg; const float* nkg; const float* sqg; const float* skg;
    __device__ __forceinline__ void operator()(const f32x4 (&acc)[2][2][4][2], const GU& u, int wr, int wc, int fr, int fq) const {
        const int hidx = u.pn * 4 + wc, lane = fq * 16 + fr;
        int typ; const float* gain = nqg; float cst = 1.f; int vm = 0;
        if (hidx < 8) { typ = 1; gain = nqg; cst = 0.125f * LOG2E; }
        else if (hidx < 10) typ = 0;
        else if (hidx == 10) { typ = 1; gain = nkg + 64; }
        else if (hidx == 11) { typ = 3; vm = 0; }
        else if (hidx == 12) { typ = 1; gain = nkg + 128; }
        else if (hidx == 13) { typ = 3; vm = 1; }
        else if (hidx < 18) { typ = 2; cst = 0.125f; }
        else if (hidx < 22) typ = 0;
        else if (hidx < 26) { typ = 3; vm = 2 + (hidx - 22); }
        else if (hidx < 30) { typ = 1; gain = sqg; cst = 0.125f * LOG2E; }
        else if (hidx < 32) { typ = 1; gain = skg; }
        else if (hidx < 34) { typ = 3; vm = 6 + (hidx - 32); }
        else if (hidx == 34) typ = 4;
        else typ = 0;
        f32x4 g0 = (f32x4){1.f, 1.f, 1.f, 1.f}, g1 = g0, g2 = g0, g3 = g0;
        if (typ == 1) { g0 = ldg4f(gain + 8 * fq) * cst; g1 = ldg4f(gain + 8 * fq + 4) * cst; g2 = ldg4f(gain + 32 + 8 * fq) * cst; g3 = ldg4f(gain + 36 + 8 * fq) * cst; }
        const int b = u.pm >> 6;
#pragma unroll
        for (int ai = 0; ai < 2; ++ai)
#pragma unroll
            for (int m = 0; m < 4; ++m) {
                const int row = u.pm * 256 + ai * 128 + wr * 64 + m * 16 + fr;
                f32x4 v0 = acc[ai][0][m][0], v1 = acc[ai][0][m][1], v2 = acc[ai][1][m][0], v3 = acc[ai][1][m][1];
                if (typ == 3) {
                    bf16_t* vt = VT + (((size_t)b * 8 + vm) * 64 + 8 * fq) * SEQ + (row & (SEQ - 1));
#pragma unroll
                    for (int j = 0; j < 4; ++j) {
                        vt[(size_t)j * SEQ] = f2bf(v0[j]); vt[(size_t)(4 + j) * SEQ] = f2bf(v1[j]);
                        vt[(size_t)(32 + j) * SEQ] = f2bf(v2[j]); vt[(size_t)(36 + j) * SEQ] = f2bf(v3[j]);
                    }
                } else {
                    if (typ == 1) {
                        float ss = 0.f;
#pragma unroll
                        for (int j = 0; j < 4; ++j) ss += v0[j] * v0[j] + v1[j] * v1[j] + v2[j] * v2[j] + v3[j] * v3[j];
                        ss += shx<16>(ss, lane); ss += shx<32>(ss, lane);
                        const float rn = rsqrtf(ss * (1.f / 64.f) + 1e-6f);
                        v0 = v0 * g0 * rn; v1 = v1 * g1 * rn; v2 = v2 * g2 * rn; v3 = v3 * g3 * rn;
                    } else if (typ == 2) { v0 *= cst; v1 *= cst; v2 *= cst; v3 *= cst; }
                    else if (typ == 4) {
#pragma unroll
                        for (int j = 0; j < 4; ++j) { v0[j] = sigmoidf_(v0[j]); v1[j] = sigmoidf_(v1[j]); v2[j] = sigmoidf_(v2[j]); v3[j] = sigmoidf_(v3[j]); }
                    }
                    bf16_t* rowp = Z + (size_t)row * ZLD + hidx * 64 + 8 * fq;
                    stg4u(rowp, pack8(v0, v1)); stg4u(rowp + 32, pack8(v2, v3));
                }
            }
    }
};
struct EpiC1 {
    static constexpr bool PERM = true, HEADMAP = false;
    bf16_t* O; const float* cb;
    __device__ __forceinline__ void operator()(const f32x4 (&acc)[2][2][4][2], const GU& u, int wr, int wc, int fr, int fq) const {
        const int mat = u.e;
#pragma unroll
        for (int bj = 0; bj < 2; ++bj) {
            const int col = bj * 128 + wc * 32 + 8 * fq;
            const f32x4 b0 = ldg4f(cb + mat * 256 + col), b1 = ldg4f(cb + mat * 256 + col + 4);
#pragma unroll
            for (int ai = 0; ai < 2; ++ai)
#pragma unroll
                for (int m = 0; m < 4; ++m) {
                    f32x4 v0 = acc[ai][bj][m][0] + b0, v1 = acc[ai][bj][m][1] + b1;
#pragma unroll
                    for (int j = 0; j < 4; ++j) {
                        { const float x = v0[j], t = 0.7978845608f * (x + 0.044715f * x * x * x); v0[j] = x * frcp(1.f + fexp2(-2.f * LOG2E * t)); }
                        { const float x = v1[j], t = 0.7978845608f * (x + 0.044715f * x * x * x); v1[j] = x * frcp(1.f + fexp2(-2.f * LOG2E * t)); }
                    }
                    stg4u(O + ((size_t)mat * 2048 + u.pm * 256 + ai * 128 + wr * 64 + m * 16 + fr) * 256 + col, pack8(v0, v1));
                }
        }
    }
};
struct EpiE1G {
    static constexpr bool PERM = true, HEADMAP = false;
    unsigned char* Sg;
    __device__ __forceinline__ void operator()(const f32x4 (&acc)[2][2][4][2], const GU& u, int wr, int wc, int fr, int fq) const {
        const int t8 = (((wr * 4 + wc) * 64) + fq * 16 + fr) * 8;
        unsigned char* sg = Sg + u.e * 65536 + t8;
#pragma unroll
        for (int ai = 0; ai < 2; ++ai)
#pragma unroll
            for (int m = 0; m < 4; ++m)
#pragma unroll
                for (int bj = 0; bj < 2; ++bj) {
                    u32x2 w;
#pragma unroll
                    for (int n = 0; n < 2; ++n) { unsigned p = 0u;
#pragma unroll
                        for (int j = 0; j < 4; ++j) { const float g = fmaxf(255.f * sigmoidf_(acc[ai][bj][m][n][j] * (1.f / 64.f)) + 0.5f, 1.f); p |= ((unsigned)g) << (8 * j); }
                        w[n] = p; }
                    stg2u(sg + (ai * 8 + m * 2 + bj) * 4096, w);
                }
    }
};
struct EpiE1T {
    static constexpr bool PERM = true, HEADMAP = false;
    unsigned char* Sg; bf16_t* Y;
    __device__ __forceinline__ void operator()(f32x4 (&acc)[2][2][4][2], const GU& u, int wr, int wc, int fr, int fq) const {
        const int t8 = (((wr * 4 + wc) * 64) + fq * 16 + fr) * 8;
        __builtin_amdgcn_s_waitcnt(0x0070);
        asm volatile("" ::: "memory");
        if (u.e < 2) {
            const unsigned char* ga = Sg + u.e * 65536;
            const unsigned char* gb = ga + 65536;
#pragma unroll
            for (int idx = 0; idx < 16; ++idx) {
                const int ai = idx >> 3, m = (idx >> 1) & 3, bj = idx & 1;
                const u32x2 qa = ldg2u(ga + (unsigned)(t8 + idx * 4096)), qb = ldg2u(gb + (unsigned)(t8 + idx * 4096));
#pragma unroll
                for (int n = 0; n < 2; ++n) {
                    f32x4 r;
#pragma unroll
                    for (int j = 0; j < 4; ++j) r[j] = (float)((qa[n] >> (8 * j)) & 255u) * frcp((float)((qb[n] >> (8 * j)) & 255u));
                    acc[ai][bj][m][n] = acc[ai][bj][m][n] * r;
                }
                __builtin_amdgcn_sched_barrier(0);
            }
        } else {
            const unsigned char* ga = Sg + 2 * 65536;
            bf16_t* yp = Y + (size_t)(u.pm * 256 + wr * 64 + fr) * 1024 + u.pn * 256 + wc * 32 + 8 * fq;
#pragma unroll
            for (int idx = 0; idx < 16; ++idx) {
                const int ai = idx >> 3, m = (idx >> 1) & 3, bj = idx & 1;
                const u32x2 qa = ldg2u(ga + (unsigned)(t8 + idx * 4096));
                f32x4 v0, v1;
#pragma unroll
                for (int j = 0; j < 4; ++j) {
                    v0[j] = (float)((qa[0] >> (8 * j)) & 255u) * (acc[ai][bj][m][0][j] * (1.f / 255.f));
                    v1[j] = (float)((qa[1] >> (8 * j)) & 255u) * (acc[ai][bj][m][1][j] * (1.f / 255.f)); }
                stg4u(yp + (size_t)(ai * 128 + m * 16) * 1024 + bj * 128, pack8(v0, v1));
            }
        }
    }
};
struct EpiE2 {
    static constexpr bool PERM = true, HEADMAP = false;
    bf16_t* xb; const float* ga; float* ssp;
    __device__ __forceinline__ void operator()(const f32x4 (&acc)[2][2][4][2], const GU& u, int wr, int wc, int fr, int fq) const {
        const int b = u.pm >> 6, lane = fq * 16 + fr;
        __builtin_amdgcn_s_waitcnt(0x0070);
        asm volatile("" ::: "memory");
        float ssr[2][4];
#pragma unroll
        for (int ai = 0; ai < 2; ++ai)
#pragma unroll
            for (int m = 0; m < 4; ++m) ssr[ai][m] = 0.f;
        bf16_t* xp = xb + (size_t)(u.pm * 256 + wr * 64 + fr) * 1024 + u.pn * 256 + wc * 32 + 8 * fq;
        u32x4 xv[2][4];
#define E2_LOADB(BUF, BT) do { _Pragma("unroll") for (int m = 0; m < 4; ++m) xv[BUF][m] = ldg4u(xp + (size_t)(((BT) & 1) * 128 + m * 16) * 1024 + ((BT) >> 1) * 128); } while (0)
        E2_LOADB(0, 0);
#pragma unroll
        for (int bt = 0; bt < 4; ++bt) {
            const int bj = bt >> 1, ai = bt & 1;
            const int col = u.pn * 256 + bj * 128 + wc * 32 + 8 * fq;
            const f32x4 g0 = ldg4f(ga + b * 6144 + col), g1 = ldg4f(ga + b * 6144 + col + 4);
            if (bt + 1 < 4) E2_LOADB((bt + 1) & 1, bt + 1);
            asm volatile("" ::: "memory");
#pragma unroll
            for (int m = 0; m < 4; ++m) { f32x4 x0, x1; unpack8(xv[bt & 1][m], x0, x1);
                x0 += g0 * acc[ai][bj][m][0]; x1 += g1 * acc[ai][bj][m][1];
                ssr[ai][m] += (x0[0] * x0[0] + x0[1] * x0[1] + x0[2] * x0[2] + x0[3] * x0[3]) + (x1[0] * x1[0] + x1[1] * x1[1] + x1[2] * x1[2] + x1[3] * x1[3]);
                stg4u(xp + (size_t)(ai * 128 + m * 16) * 1024 + bj * 128, pack8(x0, x1)); }
            asm volatile("" ::: "memory");
        }
#undef E2_LOADB
#pragma unroll
        for (int ai = 0; ai < 2; ++ai)
#pragma unroll
            for (int m = 0; m < 4; ++m) { float v = ssr[ai][m]; v += shx<16>(v, lane); v += shx<32>(v, lane);
                if (fq == 0) ssp[(size_t)(u.pm * 256 + ai * 128 + wr * 64 + m * 16 + fr) * 16 + u.pn * 4 + wc] = v; }
    }
};
struct EpiG1 {
    static constexpr bool PERM = true, HEADMAP = false;
    bf16_t* Ab;
    __device__ __forceinline__ void operator()(const f32x4 (&acc)[2][2][4][2], const GU& u, int wr, int wc, int fr, int fq) const {
#pragma unroll
        for (int ai = 0; ai < 2; ++ai)
#pragma unroll
            for (int m = 0; m < 4; ++m) {
                f32x4 v0, v1;
#pragma unroll
                for (int j = 0; j < 4; ++j) { const float g0 = acc[ai][0][m][0][j], g1 = acc[ai][0][m][1][j];
                    v0[j] = g0 * sigmoidf_(g0) * acc[ai][1][m][0][j]; v1[j] = g1 * sigmoidf_(g1) * acc[ai][1][m][1][j]; }
                stg4u(Ab + (size_t)(u.aux + ai * 128 + wr * 64 + m * 16 + fr) * 512 + u.pn * 128 + wc * 32 + 8 * fq, pack8(v0, v1));
            }
    }
};
struct EpiG2 {
    static constexpr bool PERM = true, HEADMAP = false;
    bf16_t* Ys;
    __device__ __forceinline__ void operator()(const f32x4 (&acc)[2][2][4][2], const GU& u, int wr, int wc, int fr, int fq) const {
#pragma unroll
        for (int ai = 0; ai < 2; ++ai)
#pragma unroll
            for (int m = 0; m < 4; ++m) {
                bf16_t* rowp = Ys + (size_t)(u.aux + ai * 128 + wr * 64 + m * 16 + fr) * 1024 + u.pn * 256 + wc * 32 + 8 * fq;
#pragma unroll
                for (int bj = 0; bj < 2; ++bj) stg4u(rowp + bj * 128, pack8(acc[ai][bj][m][0], acc[ai][bj][m][1]));
            }
    }
};

__device__ __forceinline__ void norm2_mfma(const Ctx& X, LAS unsigned char* lds, int layer) {
    unsigned char* ws = X.ws;
    const int tid = X.tid, lane = tid & 63, wave = tid >> 6, G = X.G, r = lane & 15, kq = lane >> 4;
    const bf16_t* xsrc = (const bf16_t*)(ws + WS_XB);
    const float* modl = (const float*)(ws + WS_MOD) + (size_t)layer * 2 * 6144;
    const float* ssp = (const float*)(ws + WS_SSP);
    bf16_t* h = (bf16_t*)(ws + WS_H);
    const float* gn = INP(I_GMOE) + (size_t)layer * 1024;
    LAS float* Wl = (LAS float*)lds;
    LAS float* gsL = (LAS float*)(lds + 81920);
    LAS float* shL = (LAS float*)(lds + 90112);
    LAS float* cW = (LAS float*)(lds + LDS_MISC + 768);
    LAS float* lgl = (LAS float*)(lds + 98304);
    LAS int* lcnt = (LAS int*)(lds + LDS_MISC + 64);
    LAS int* lbase = (LAS int*)(lds + LDS_MISC + 128);
    const bool fastp = (G * 8 >= NTOK / 16);
    if (fastp) {
        const int b = (X.bid * 8 * 16) >> 14;
        LAS bf16x8* Whi = (LAS bf16x8*)lds;
        LAS bf16x8* Wlo = (LAS bf16x8*)(lds + 32768);
        const GAS float* wrg = (const GAS float*)INP(I_WR); const GAS float* gng = (const GAS float*)gn; const GAS float* mdg = (const GAS float*)modl;
        { const float g0_ = gng[tid], g1_ = gng[tid + 512], c0_ = mdg[b * 6144 + 4096 + tid], c1_ = mdg[b * 6144 + 4096 + tid + 512], h0_ = mdg[b * 6144 + 3072 + tid], h1_ = mdg[b * 6144 + 3072 + tid + 512];
          gsL[b * 1024 + tid] = g0_ * (1.f + c0_); gsL[b * 1024 + tid + 512] = g1_ * (1.f + c1_); shL[b * 1024 + tid] = h0_; shL[b * 1024 + tid + 512] = h1_; }
        if (tid < 16) lcnt[tid] = 0;
        __syncthreads();
        for (int f = tid; f < 2048; f += 512) {
            const int e = f & 15, k0 = (f >> 4) * 8;
            bf16x8 hi, lo; float wv[8];
#pragma unroll
            for (int j = 0; j < 8; ++j) wv[j] = wrg[(k0 + j) * 16 + e];
#pragma unroll
            for (int j = 0; j < 8; ++j) { const float w = gsL[b * 1024 + k0 + j] * wv[j]; const bf16_t hb = f2bf(w); hi[j] = (short)hb; lo[j] = (short)f2bf(w - bf2f(hb)); }
            Whi[f] = hi; Wlo[f] = lo;
        }
        if (tid < 256) {
            const int e = tid >> 4, part = tid & 15;
            float a = 0.f;
            for (int k0 = part * 64; k0 < part * 64 + 64; k0 += 16) { float wv[16];
#pragma unroll
                for (int j = 0; j < 16; ++j) wv[j] = wrg[(k0 + j) * 16 + e];
#pragma unroll
                for (int j = 0; j < 16; ++j) a += shL[b * 1024 + k0 + j] * wv[j]; }
            a += shx<1>(a, lane); a += shx<2>(a, lane); a += shx<4>(a, lane); a += shx<8>(a, lane);
            if (part == 0) cW[b * 16 + e] = a;
        }
        __syncthreads();
        const int batch = X.bid * 8 + wave;
        if (batch < NTOK / 16) {
            const int row = batch * 16 + r;
            float rinv;
            { const f32x4 p4 = ldg4f(ssp + (size_t)row * 16 + 4 * kq); float ssq = (p4[0] + p4[1]) + (p4[2] + p4[3]); ssq += shx<16>(ssq, lane); ssq += shx<32>(ssq, lane);
              rinv = rsqrtf(ssq * (1.f / 1024.f) + 1e-6f); }
            f32x4 acc = (f32x4){0.f, 0.f, 0.f, 0.f};
            const bf16_t* xr = xsrc + (size_t)row * 1024 + kq * 8;
            bf16_t* hr = h + (size_t)row * 1024 + kq * 8;
            for (int kg = 0; kg < 4; ++kg) {
                u32x4 xp[8];
#pragma unroll
                for (int u = 0; u < 8; ++u) { const int kk = (kg * 4 + (u >> 1)) * 64 + (u & 1) * 32; xp[u] = ldg4u(xr + kk); }
                asm volatile("" ::: "memory");
#pragma unroll
                for (int u = 0; u < 8; ++u) {
                    const int kc = kg * 4 + (u >> 1), jh = u & 1, kk = kc * 64 + jh * 32, ch = kc * 2 + jh;
                    const f32x4 g0 = *(const LAS f32x4*)(gsL + b * 1024 + kk + kq * 8), g1 = *(const LAS f32x4*)(gsL + b * 1024 + kk + kq * 8 + 4);
                    const f32x4 s0 = *(const LAS f32x4*)(shL + b * 1024 + kk + kq * 8), s1 = *(const LAS f32x4*)(shL + b * 1024 + kk + kq * 8 + 4);
                    const bf16x8 wh = Whi[(ch * 4 + kq) * 16 + r], wl = Wlo[(ch * 4 + kq) * 16 + r];
                    const bf16x8 xf = __builtin_bit_cast(bf16x8, xp[u]);
                    f32x4 xa, xc; unpack8(xp[u], xa, xc);
                    stg4u(hr + kk, pack8(xa * g0 * rinv + s0, xc * g1 * rinv + s1));
                    acc = __builtin_amdgcn_mfma_f32_16x16x32_bf16(wh, xf, acc, 0, 0, 0);
                    acc = __builtin_amdgcn_mfma_f32_16x16x32_bf16(wl, xf, acc, 0, 0, 0);
                }
                asm volatile("" ::: "memory");
            }
            f32x4 lg;
#pragma unroll
            for (int i = 0; i < 4; ++i) lg[i] = rinv * acc[i] + cW[b * 16 + 4 * kq + i];
            *(LAS f32x4*)(lgl + (wave * 16 + r) * 16 + 4 * kq) = lg;
        }
    } else {
    for (int i = tid; i < 16384; i += 512) { const int k = i >> 4, e = i & 15; Wl[(((k >> 5) * 4 + ((k >> 3) & 3)) * 16 + e) * 8 + (k & 7)] = INP(I_WR)[i]; }
    for (int i = tid; i < 2048; i += 512) { const int b = i >> 10, k = i & 1023; gsL[i] = gn[k] * (1.f + modl[b * 6144 + 4096 + k]); shL[i] = modl[b * 6144 + 3072 + k]; }
    if (tid < 16) lcnt[tid] = 0;
    __syncthreads();
    {
        const int be = tid >> 4, part = tid & 15, b = be >> 4, e = be & 15;
        float a = 0.f;
        for (int k = part * 64; k < part * 64 + 64; ++k) a += shL[b * 1024 + k] * Wl[(((k >> 5) * 4 + ((k >> 3) & 3)) * 16 + e) * 8 + (k & 7)];
        a += shx<1>(a, lane); a += shx<2>(a, lane); a += shx<4>(a, lane); a += shx<8>(a, lane);
        if (part == 0) cW[be] = a;
    }
    __syncthreads();
    int it = 0;
    for (int batch = X.bid * 8 + wave; batch < NTOK / 16; batch += G * 8, ++it) {
        const int row = batch * 16 + r, b = row >> 14;
        float rinv;
        { const f32x4 p4 = ldg4f(ssp + (size_t)row * 16 + 4 * kq); float ssq = (p4[0] + p4[1]) + (p4[2] + p4[3]); ssq += shx<16>(ssq, lane); ssq += shx<32>(ssq, lane);
          rinv = rsqrtf(ssq * (1.f / 1024.f) + 1e-6f); }
        f32x4 acc = (f32x4){0.f, 0.f, 0.f, 0.f};
        const bf16_t* xr = xsrc + (size_t)row * 1024 + kq * 8;
        bf16_t* hr = h + (size_t)row * 1024 + kq * 8;
        for (int kg = 0; kg < 4; ++kg) {
            u32x4 xp[8];
#pragma unroll
            for (int u = 0; u < 8; ++u) { const int kk = (kg * 4 + (u >> 1)) * 64 + (u & 1) * 32; xp[u] = ldg4u(xr + kk); }
            asm volatile("" ::: "memory");
#pragma unroll
            for (int u = 0; u < 8; ++u) {
                const int kc = kg * 4 + (u >> 1), jh = u & 1, kk = kc * 64 + jh * 32;
                const f32x4 g0 = *(const LAS f32x4*)(gsL + b * 1024 + kk + kq * 8), g1 = *(const LAS f32x4*)(gsL + b * 1024 + kk + kq * 8 + 4);
                const f32x4 s0 = *(const LAS f32x4*)(shL + b * 1024 + kk + kq * 8), s1 = *(const LAS f32x4*)(shL + b * 1024 + kk + kq * 8 + 4);
                const LAS float* wp = Wl + (((kc * 2 + jh) * 4 + kq) * 16 + r) * 8;
                const f32x4 w0 = *(const LAS f32x4*)wp, w1 = *(const LAS f32x4*)(wp + 4);
                f32x4 xa, xc; unpack8(xp[u], xa, xc);
                const f32x4 x0 = xa * g0, x1 = xc * g1;
                stg4u(hr + kk, pack8(x0 * rinv + s0, x1 * rinv + s1));
#pragma unroll
                for (int q = 0; q < 4; ++q) acc = __builtin_amdgcn_mfma_f32_16x16x4f32(w0[q], x0[q], acc, 0, 0, 0);
#pragma unroll
                for (int q = 0; q < 4; ++q) acc = __builtin_amdgcn_mfma_f32_16x16x4f32(w1[q], x1[q], acc, 0, 0, 0);
            }
            asm volatile("" ::: "memory");
        }
        if (it < 4) {
            f32x4 lg;
#pragma unroll
            for (int i = 0; i < 4; ++i) lg[i] = rinv * acc[i] + cW[b * 16 + 4 * kq + i];
            *(LAS f32x4*)(lgl + ((it * 8 + wave) * 16 + r) * 16 + 4 * kq) = lg;
        }
    }
    }
    __syncthreads();
    {
        const int slot = tid, sb = slot >> 4, srow = ((X.bid * 8 + (sb & 7)) + (sb >> 3) * G * 8) * 16 + (slot & 15);
        const bool have = (srow < NTOK) && ((sb >> 3) < 4);
        int e0 = 0, e1 = 0, r0 = 0, r1i = 0; float w0 = 0.f, w1 = 0.f;
        if (have) {
            float sco[16], sel[16];
            f32x4 rb4[4];
#pragma unroll
            for (int q = 0; q < 4; ++q) rb4[q] = ldg4f(INP(I_RB) + 4 * q);
#pragma unroll
            for (int q = 0; q < 4; ++q) { const f32x4 lg4 = *(const LAS f32x4*)(lgl + slot * 16 + 4 * q);
#pragma unroll
                for (int j = 0; j < 4; ++j) { const int e = 4 * q + j; sco[e] = 1.f / (1.f + __expf(-lg4[j])); sel[e] = sco[e] + rb4[q][j]; } }
            float gs[4];
#pragma unroll
            for (int g = 0; g < 4; ++g) {
                const float a = sel[4 * g], bq = sel[4 * g + 1], c = sel[4 * g + 2], d = sel[4 * g + 3];
                const float m1 = fmaxf(fmaxf(a, bq), fmaxf(c, d));
                int i1 = (a == m1) ? 0 : (bq == m1) ? 1 : (c == m1) ? 2 : 3;
                float m2 = -3.0e38f;
                m2 = (i1 != 0) ? fmaxf(m2, a) : m2; m2 = (i1 != 1) ? fmaxf(m2, bq) : m2; m2 = (i1 != 2) ? fmaxf(m2, c) : m2; m2 = (i1 != 3) ? fmaxf(m2, d) : m2;
                gs[g] = m1 + m2;
            }
            int gi = 0; float gb = gs[0];
#pragma unroll
            for (int g = 1; g < 4; ++g) if (gs[g] > gb) { gb = gs[g]; gi = g; }
            float s0 = (gi == 0) ? sel[0] : (gi == 1) ? sel[4] : (gi == 2) ? sel[8] : sel[12];
            float s1 = (gi == 0) ? sel[1] : (gi == 1) ? sel[5] : (gi == 2) ? sel[9] : sel[13];
            float s2 = (gi == 0) ? sel[2] : (gi == 1) ? sel[6] : (gi == 2) ? sel[10] : sel[14];
            float s3 = (gi == 0) ? sel[3] : (gi == 1) ? sel[7] : (gi == 2) ? sel[11] : sel[15];
            float c0 = (gi == 0) ? sco[0] : (gi == 1) ? sco[4] : (gi == 2) ? sco[8] : sco[12];
            float c1 = (gi == 0) ? sco[1] : (gi == 1) ? sco[5] : (gi == 2) ? sco[9] : sco[13];
            float c2 = (gi == 0) ? sco[2] : (gi == 1) ? sco[6] : (gi == 2) ? sco[10] : sco[14];
            float c3 = (gi == 0) ? sco[3] : (gi == 1) ? sco[7] : (gi == 2) ? sco[11] : sco[15];
            const float m1 = fmaxf(fmaxf(s0, s1), fmaxf(s2, s3));
            const int i1 = (s0 == m1) ? 0 : (s1 == m1) ? 1 : (s2 == m1) ? 2 : 3;
            float m2 = -3.0e38f;
            m2 = (i1 != 0) ? fmaxf(m2, s0) : m2; m2 = (i1 != 1) ? fmaxf(m2, s1) : m2; m2 = (i1 != 2) ? fmaxf(m2, s2) : m2; m2 = (i1 != 3) ? fmaxf(m2, s3) : m2;
            const int i2 = (i1 != 0 && s0 == m2) ? 0 : (i1 != 1 && s1 == m2) ? 1 : (i1 != 2 && s2 == m2) ? 2 : 3;
            const float w1v = (i1 == 0) ? c0 : (i1 == 1) ? c1 : (i1 == 2) ? c2 : c3;
            const float w2v = (i2 == 0) ? c0 : (i2 == 1) ? c1 : (i2 == 2) ? c2 : c3;
            const float wn = 1.f / (w1v + w2v);
            e0 = gi * 4 + i1; e1 = gi * 4 + i2; w0 = w1v * wn; w1 = w2v * wn;
            r0 = __hip_atomic_fetch_add(lcnt + e0, 1, __ATOMIC_RELAXED, __HIP_MEMORY_SCOPE_WORKGROUP); r1i = __hip_atomic_fetch_add(lcnt + e1, 1, __ATOMIC_RELAXED, __HIP_MEMORY_SCOPE_WORKGROUP);
        }
        __syncthreads();
        unsigned* gcnt = (unsigned*)(ws + WS_CTL) + CW_GCNT + 16 * (layer * 16);
        if (tid < 16) lbase[tid] = (int)atomicAdd(gcnt + 16 * tid, (unsigned)lcnt[tid]);
        __syncthreads();
        if (have) {
            int* lt = (int*)(ws + WS_LISTT); float* lw = (float*)(ws + WS_LISTW);
            const int p0 = lbase[e0] + r0, p1 = lbase[e1] + r1i;
            lt[e0 * LCAP + p0] = srow * 2; lw[e0 * LCAP + p0] = w0;
            lt[e1 * LCAP + p1] = srow * 2 + 1; lw[e1 * LCAP + p1] = w1;
            u32x4 ti; ti[0] = (unsigned)e0 | ((unsigned)p0 << 4); ti[1] = __float_as_uint(w0); ti[2] = (unsigned)e1 | ((unsigned)p1 << 4); ti[3] = __float_as_uint(w1);
            *(GAS u32x4*)((u32x4*)(ws + WS_TINFO) + srow) = ti;
        }
    }
    __syncthreads();
}

__device__ __forceinline__ void cmp2_unit(const Ctx& X, int layer, int u) {
    unsigned char* ws = X.ws;
    const int lane = X.tid & 63, c = lane & 15, g = lane >> 4;
    const int mat = u >> 7, r0 = (u & 127) * 16;
    const bf16_t* hid = (const bf16_t*)(ws + WS_HID) + ((size_t)mat * 2048 + r0) * 256;
    const bf16_t* w2 = (const bf16_t*)(ws + WS_W2) + ((size_t)layer * 2 + mat) * 64 * 256;
    f32x4 acc[4];
#pragma unroll
    for (int nt = 0; nt < 4; ++nt) acc[nt] = (f32x4){0.f, 0.f, 0.f, 0.f};
#pragma unroll
    for (int ks = 0; ks < 8; ++ks) {
        const bf16x8 a = ldg8(hid + c * 256 + ks * 32 + 8 * g);
#pragma unroll
        for (int nt = 0; nt < 4; ++nt) { const bf16x8 b = ldg8(w2 + (nt * 16 + c) * 256 + ks * 32 + 8 * g); acc[nt] = __builtin_amdgcn_mfma_f32_16x16x32_bf16(a, b, acc[nt], 0, 0, 0); }
    }
    if (mat == 0) {
        const GAS float* kg = (const GAS float*)(INP(I_NKG) + layer * 192);
        GAS bf16_t* kc = (GAS bf16_t*)(ws + WS_KCMP);
        float kgv[4];
#pragma unroll
        for (int nt = 0; nt < 4; ++nt) kgv[nt] = kg[nt * 16 + c];
#pragma unroll
        for (int i = 0; i < 4; ++i) {
            float ss = acc[0][i] * acc[0][i] + acc[1][i] * acc[1][i] + acc[2][i] * acc[2][i] + acc[3][i] * acc[3][i];
            ss += shx<1>(ss, lane); ss += shx<2>(ss, lane); ss += shx<4>(ss, lane); ss += shx<8>(ss, lane);
            const float rn = rsqrtf(ss * (1.f / 64.f) + 1e-6f);
#pragma unroll
            for (int nt = 0; nt < 4; ++nt) kc[(size_t)(r0 + 4 * g + i) * 64 + nt * 16 + c] = f2bf(acc[nt][i] * rn * kgv[nt]);
        }
    } else {
        bf16_t* vt = (bf16_t*)(ws + WS_VCMPT);
        const int b = r0 >> 10, cb0 = (r0 & 1023) + 4 * g;
#pragma unroll
        for (int nt = 0; nt < 4; ++nt) { u32x2 o; o[0] = cvt_pk_bf16(acc[nt][0], acc[nt][1]); o[1] = cvt_pk_bf16(acc[nt][2], acc[nt][3]);
            stg2u(vt + ((size_t)b * 64 + nt * 16 + c) * 1024 + cb0, o); }
    }
}

template <int NCT>
__device__ __forceinline__ void qk_tile(const bf16_t* kp, int kstride, const bf16x8 (&qf)[NCT][2], f32x4 (&s)[2][2][NCT]) {
#pragma unroll
    for (int ch = 0; ch < 2; ++ch)
#pragma unroll
        for (int T = 0; T < 2; ++T) {
            const bf16_t* p = kp + (size_t)(32 * ch + 4 * T) * kstride;
            const bf16x8 k0 = ldg8(p), k1 = ldg8(p + 32);
#pragma unroll
            for (int ct = 0; ct < NCT; ++ct) {
                f32x4 a = (f32x4){0.f, 0.f, 0.f, 0.f};
                a = __builtin_amdgcn_mfma_f32_16x16x32_bf16(k0, qf[ct][0], a, 0, 0, 0);
                a = __builtin_amdgcn_mfma_f32_16x16x32_bf16(k1, qf[ct][1], a, 0, 0, 0);
                s[ch][T][ct] = a;
            }
        }
}
template <int NCT>
__device__ __forceinline__ void pv_tile(const bf16_t* vp, size_t vstride, const bf16x8 (&pb)[2][NCT], f32x4 (&o)[4][NCT]) {
#pragma unroll
    for (int ch = 0; ch < 2; ++ch)
#pragma unroll
        for (int dt = 0; dt < 4; ++dt) {
            const bf16x8 v = ldg8(vp + (size_t)(16 * dt) * vstride + 32 * ch);
#pragma unroll
            for (int ct = 0; ct < NCT; ++ct) o[dt][ct] = __builtin_amdgcn_mfma_f32_16x16x32_bf16(v, pb[ch][ct], o[dt][ct], 0, 0, 0);
        }
}
struct KFrag { bf16x8 k[2][2][2]; };
struct VFrag { bf16x8 v[2][4]; };
__device__ __forceinline__ void ld_ktile(const bf16_t* kp, int kstride, KFrag& f) {
#pragma unroll
    for (int ch = 0; ch < 2; ++ch)
#pragma unroll
        for (int T = 0; T < 2; ++T) { const bf16_t* p = kp + (size_t)(32 * ch + 4 * T) * kstride; f.k[ch][T][0] = ldg8(p); f.k[ch][T][1] = ldg8(p + 32); }
}
__device__ __forceinline__ void ld_vtile(const bf16_t* vp, size_t vstride, VFrag& f) {
#pragma unroll
    for (int ch = 0; ch < 2; ++ch)
#pragma unroll
        for (int dt = 0; dt < 4; ++dt) f.v[ch][dt] = ldg8(vp + (size_t)(16 * dt) * vstride + 32 * ch);
}
template <int NCT>
__device__ __forceinline__ void qk_from(const KFrag& f, const bf16x8 (&qf)[NCT][2], f32x4 (&s)[2][2][NCT]) {
#pragma unroll
    for (int ch = 0; ch < 2; ++ch)
#pragma unroll
        for (int T = 0; T < 2; ++T)
#pragma unroll
            for (int ct = 0; ct < NCT; ++ct) {
                f32x4 a = (f32x4){0.f, 0.f, 0.f, 0.f};
                a = __builtin_amdgcn_mfma_f32_16x16x32_bf16(f.k[ch][T][0], qf[ct][0], a, 0, 0, 0);
                a = __builtin_amdgcn_mfma_f32_16x16x32_bf16(f.k[ch][T][1], qf[ct][1], a, 0, 0, 0);
                s[ch][T][ct] = a;
            }
}
template <int NCT>
__device__ __forceinline__ void pv_from(const VFrag& f, const bf16x8 (&pb)[2][NCT], f32x4 (&o)[4][NCT]) {
#pragma unroll
    for (int ch = 0; ch < 2; ++ch)
#pragma unroll
        for (int dt = 0; dt < 4; ++dt)
#pragma unroll
            for (int ct = 0; ct < NCT; ++ct) o[dt][ct] = __builtin_amdgcn_mfma_f32_16x16x32_bf16(f.v[ch][dt], pb[ch][ct], o[dt][ct], 0, 0, 0);
}
__device__ __forceinline__ bf16x8 pack_p(const f32x4 a, const f32x4 b) {
    union { u32x4 u; bf16x8 h; } x; x.u = pack8(a, b); return x.h;
}
template <int NCT> struct SmState { f32x4 o[4][NCT]; float m[NCT], l[NCT]; };

template <int NCT> __device__ __forceinline__ void sm_init(SmState<NCT>& st) {
#pragma unroll
    for (int ct = 0; ct < NCT; ++ct) { st.m[ct] = -1e30f; st.l[ct] = 0.f;
#pragma unroll
        for (int dt = 0; dt < 4; ++dt) st.o[dt][ct] = (f32x4){0.f, 0.f, 0.f, 0.f}; }
}
template <int NCT> __device__ __forceinline__ void sm_finish(SmState<NCT>& st, const int lane) {
#pragma unroll
    for (int ct = 0; ct < NCT; ++ct) {
        float l = st.l[ct]; l += shx<16>(l, lane); l += shx<32>(l, lane);
        const float inv = (l > 0.f) ? 1.f / l : 0.f;
#pragma unroll
        for (int dt = 0; dt < 4; ++dt) st.o[dt][ct] *= inv;
    }
}

constexpr int TROW = 72, TILE_E = 64 * TROW;
template <int NCT>
__device__ __forceinline__ void qk_tile_l(const LAS bf16_t* Kb, int c, int g, const bf16x8 (&qf)[NCT][2], f32x4 (&s)[2][2][NCT]) {
#pragma unroll
    for (int ch = 0; ch < 2; ++ch)
#pragma unroll
        for (int T = 0; T < 2; ++T) {
            const LAS bf16_t* p = Kb + (32 * ch + 8 * (c >> 2) + 4 * T + (c & 3)) * TROW + 8 * g;
            const bf16x8 k0 = *(const LAS bf16x8*)p, k1 = *(const LAS bf16x8*)(p + 32);
#pragma unroll
            for (int ct = 0; ct < NCT; ++ct) {
                f32x4 a = (f32x4){0.f, 0.f, 0.f, 0.f};
                a = __builtin_amdgcn_mfma_f32_16x16x32_bf16(k0, qf[ct][0], a, 0, 0, 0);
                a = __builtin_amdgcn_mfma_f32_16x16x32_bf16(k1, qf[ct][1], a, 0, 0, 0);
                s[ch][T][ct] = a;
            }
        }
}
template <int NCT>
__device__ __forceinline__ void pv_tile_l(const LAS bf16_t* Vb, int c, int g, const bf16x8 (&pb)[2][NCT], f32x4 (&o)[4][NCT]) {
#pragma unroll
    for (int ch = 0; ch < 2; ++ch)
#pragma unroll
        for (int dt = 0; dt < 4; ++dt) {
            const bf16x8 v = *(const LAS bf16x8*)(Vb + (16 * dt + c) * TROW + 32 * ch + 8 * g);
#pragma unroll
            for (int ct = 0; ct < NCT; ++ct) o[dt][ct] = __builtin_amdgcn_mfma_f32_16x16x32_bf16(v, pb[ch][ct], o[dt][ct], 0, 0, 0);
        }
}
template <int NCT, int STEP>
__device__ __forceinline__ void sm_soft(SmState<NCT>& st, f32x4 (&s)[2][2][NCT], bf16x8 (&pb)[2][NCT], const int (&d0)[NCT], const float (&slope)[NCT], const unsigned (&W)[NCT], const int lane) {
#pragma unroll
    for (int ct = 0; ct < NCT; ++ct) {
        float mx = -1e30f;
#pragma unroll
        for (int ch = 0; ch < 2; ++ch)
#pragma unroll
            for (int T = 0; T < 2; ++T)
#pragma unroll
                for (int i = 0; i < 4; ++i) {
                    const int dist = d0[ct] - STEP * (32 * ch + 4 * T + i);
                    const float v = ((unsigned)dist < W[ct]) ? (s[ch][T][ct][i] - slope[ct] * (float)dist) : -1e30f;
                    s[ch][T][ct][i] = v; mx = fmaxf(mx, v);
                }
        mx = fmaxf(mx, shx<16>(mx, lane)); mx = fmaxf(mx, shx<32>(mx, lane));
        const float mn = fmaxf(st.m[ct], mx), alpha = fexp2(st.m[ct] - mn);
        float sum = 0.f;
#pragma unroll
        for (int ch = 0; ch < 2; ++ch) {
#pragma unroll
            for (int T = 0; T < 2; ++T)
#pragma unroll
                for (int i = 0; i < 4; ++i) { const float v = s[ch][T][ct][i]; const float p = (v > -1e29f) ? fexp2(v - mn) : 0.f; s[ch][T][ct][i] = p; sum += p; }
            pb[ch][ct] = pack_p(s[ch][0][ct], s[ch][1][ct]);
        }
        st.m[ct] = mn; st.l[ct] = st.l[ct] * alpha + sum;
#pragma unroll
        for (int dt = 0; dt < 4; ++dt) st.o[dt][ct] *= alpha;
    }
}

template <int NCT, int STEP>
__device__ __forceinline__ void sm_tile(SmState<NCT>& st, f32x4 (&s)[2][2][NCT], const int (&d0)[NCT], const float (&slope)[NCT], unsigned W, const bf16_t* vp, size_t vstride, const int lane) {
    bf16x8 pb[2][NCT]; unsigned Wv[NCT];
#pragma unroll
    for (int ct = 0; ct < NCT; ++ct) Wv[ct] = W;
    sm_soft<NCT, STEP>(st, s, pb, d0, slope, Wv, lane);
    pv_tile<NCT>(vp, vstride, pb, st.o);
}

__device__ __forceinline__ f32x4 add_sle(const f32x4 v, const float sl, const int e0, const int step) {
    f32x4 r; r[0] = fmaf(sl, (float)(step * e0), v[0]); r[1] = fmaf(sl, (float)(step * (e0 + 1)), v[1]); r[2] = fmaf(sl, (float)(step * (e0 + 2)), v[2]); r[3] = fmaf(sl, (float)(step * (e0 + 3)), v[3]); return r; }
template <int NCT>
__device__ __forceinline__ void sm_fast(SmState<NCT>& st, f32x4 (&s)[2][2][NCT], bf16x8 (&pb)[2][NCT], const float sl, const float (&base)[NCT], const bool (&en)[NCT], const int lane) {
#pragma unroll
    for (int ct = 0; ct < NCT; ++ct) {
        const f32x4 u00 = add_sle(s[0][0][ct], sl, 0, 1), u01 = add_sle(s[0][1][ct], sl, 4, 1), u10 = add_sle(s[1][0][ct], sl, 32, 1), u11 = add_sle(s[1][1][ct], sl, 36, 1);
        const f32x4 m4 = __builtin_elementwise_max(__builtin_elementwise_max(u00, u01), __builtin_elementwise_max(u10, u11));
        float mx = fmaxf(fmaxf(m4[0], m4[1]), fmaxf(m4[2], m4[3])) + base[ct];
        mx = fmaxf(mx, shx<16>(mx, lane)); mx = fmaxf(mx, shx<32>(mx, lane));
        const float mn = en[ct] ? fmaxf(st.m[ct], mx) : st.m[ct], alpha = fexp2(st.m[ct] - mn);
        const float off = en[ct] ? (base[ct] - mn) : -1e30f;
        f32x4 p00 = u00 + off, p01 = u01 + off, p10 = u10 + off, p11 = u11 + off;
#pragma unroll
        for (int i = 0; i < 4; ++i) { p00[i] = fexp2(p00[i]); p01[i] = fexp2(p01[i]); p10[i] = fexp2(p10[i]); p11[i] = fexp2(p11[i]); }
        const f32x4 s4 = (p00 + p01) + (p10 + p11);
        const float sum = (s4[0] + s4[1]) + (s4[2] + s4[3]);
        pb[0][ct] = pack_p(p00, p01); pb[1][ct] = pack_p(p10, p11);
        st.m[ct] = mn; st.l[ct] = st.l[ct] * alpha + sum;
#pragma unroll
        for (int dt = 0; dt < 4; ++dt) st.o[dt][ct] *= alpha;
    }
}

__device__ __forceinline__ void nsa_block(const Ctx& X, LAS unsigned char* lds, int unit, int layer, unsigned long long& prb_acc, unsigned* qhead, int& nxt_idx, const float mref_in) {
    unsigned long long prb_t0 = 0ull; (void)prb_t0; (void)prb_acc;
    unsigned char* ws = X.ws;
    const int tid = X.tid, lane = tid & 63, wave = tid >> 6, c = lane & 15, g = lane >> 4, h = c & 7, qq = c >> 3;
    const int b = unit >> 9, t0 = (unit & 511) * 32;
    const bf16_t* z = (const bf16_t*)(ws + WS_Z) + (size_t)b * SEQ * ZLD;
    const bf16_t* vT = (const bf16_t*)(ws + WS_VT) + (size_t)b * 8 * 64 * SEQ;
    const bf16_t* kcmp = (const bf16_t*)(ws + WS_KCMP) + (size_t)b * 1024 * 64;
    const bf16_t* vcT = (const bf16_t*)(ws + WS_VCMPT) + (size_t)b * 64 * 1024;
    LAS float* impA = (LAS float*)(lds + wave * 8192);
    LAS float* impB = impA + 1024;
    LAS bf16_t* KV = (LAS bf16_t*)(lds + 65536);
    LAS int* sell = (LAS int*)(lds + 114688);
    LAS unsigned* qmask = (LAS unsigned*)(lds + 115712);
    LAS unsigned* ubits = (LAS unsigned*)(lds + 116736);
    LAS int* ulist = (LAS int*)(lds + 116800);
    const int prho = tid >> 3, pcp = tid & 7;
    const int krow = (prho & ~9) | ((prho >> 3) & 1) | ((prho & 1) << 3), kchk = pcp ^ (2 * (krow & 3));
    const int vrow = (prho & ~5) | ((prho >> 2) & 1) | ((prho & 1) << 2), vchk = pcp ^ (2 * (vrow & 3));
    const int wv512 = __builtin_amdgcn_readfirstlane(wave) * 512;
    const int fp = c & 3, fcl = g ^ (2 * (fp & 1)), fph = fp >> 1;
    const int krow0 = 8 * (c >> 2) + fp, krho0 = (krow0 & ~9) | ((krow0 >> 3) & 1) | ((krow0 & 1) << 3);
    const int kofA = krho0 * 64 + (fcl + 4 * (0 ^ fph)) * 8, kofB = krho0 * 64 + (fcl + 4 * (1 ^ fph)) * 8;
    const int vrho0 = (c & ~5) | ((c >> 2) & 1) | ((c & 1) << 2);
    const int vofA = vrho0 * 64 + (fcl + 4 * (0 ^ fph)) * 8, vofB = vrho0 * 64 + (fcl + 4 * (1 ^ fph)) * 8;
#define T_DMAK(kbase, kstride, k0, buf) __builtin_amdgcn_global_load_lds((const unsigned*)((kbase) + (size_t)((k0) + krow) * (kstride) + kchk * 8), (LAS unsigned*)(KV + (buf) * 8192 + wv512), 16, 0, 0)
#define T_DMAV(vbase, vstride, k0, buf) __builtin_amdgcn_global_load_lds((const unsigned*)((vbase) + (size_t)vrow * (vstride) + (k0) + vchk * 8), (LAS unsigned*)(KV + (buf) * 8192 + 4096 + wv512), 16, 0, 0)
#define T_KB(buf) (KV + (buf) * 8192)
#define T_DMAKP(kbase, kstride, k0, dst) __builtin_amdgcn_global_load_lds((const unsigned*)((kbase) + (size_t)((k0) + krow) * (kstride) + kchk * 8), (LAS unsigned*)((dst) + wv512), 16, 0, 0)
#define T_VB(buf) (KV + (buf) * 8192 + 4096)
#define T_WAIT(n) asm volatile("s_waitcnt vmcnt(" #n ")" ::: "memory")
#define T_BAR() do { asm volatile("" ::: "memory"); __builtin_amdgcn_s_barrier(); asm volatile("" ::: "memory"); } while (0)
#define QK2I(buf, S, OFF, STEP) QK2IP(T_KB(buf), S, OFF, STEP)
#define QK2IP(kptr, S, OFF, STEP) do { _Pragma("unroll") for (int ch = 0; ch < 2; ++ch) _Pragma("unroll") for (int T = 0; T < 2; ++T) { \
        const LAS bf16_t* p_ = (kptr) + (4 * T + 32 * ch) * 64; const bf16x8 k0_ = *(const LAS bf16x8*)(p_ + kofA), k1_ = *(const LAS bf16x8*)(p_ + kofB); \
        _Pragma("unroll") for (int ct = 0; ct < 2; ++ct) { f32x4 a_; \
            _Pragma("unroll") for (int i = 0; i < 4; ++i) a_[i] = fmaf(sl, (float)((STEP) * (32 * ch + 4 * T + i)), OFF[ct]); \
            a_ = __builtin_amdgcn_mfma_f32_16x16x32_bf16(k0_, qf[ct][0], a_, 0, 0, 0); a_ = __builtin_amdgcn_mfma_f32_16x16x32_bf16(k1_, qf[ct][1], a_, 0, 0, 0); S[ch][T][ct] = a_; } } } while (0)
#define PV2(buf, PB, O) do { _Pragma("unroll") for (int dt = 0; dt < 4; ++dt) { const LAS bf16_t* p_ = T_VB(buf) + 16 * dt * 64; \
        const bf16x8 v0_ = *(const LAS bf16x8*)(p_ + vofA), v1_ = *(const LAS bf16x8*)(p_ + vofB); \
        _Pragma("unroll") for (int ct = 0; ct < 2; ++ct) { O[dt][ct] = __builtin_amdgcn_mfma_f32_16x16x32_bf16(v0_, PB[0][ct], O[dt][ct], 0, 0, 0); \
            O[dt][ct] = __builtin_amdgcn_mfma_f32_16x16x32_bf16(v1_, PB[1][ct], O[dt][ct], 0, 0, 0); } } } while (0)
#define LSUM(PB, L) do { _Pragma("unroll") for (int ct = 0; ct < 2; ++ct) { L[ct] = __builtin_amdgcn_mfma_f32_16x16x32_bf16(ones, PB[0][ct], L[ct], 0, 0, 0); \
        L[ct] = __builtin_amdgcn_mfma_f32_16x16x32_bf16(ones, PB[1][ct], L[ct], 0, 0, 0); } } while (0)
#define PEXP(S, PB, FULL, D0, W, STEP) do { _Pragma("unroll") for (int ct = 0; ct < 2; ++ct) { _Pragma("unroll") for (int ch = 0; ch < 2; ++ch) { \
        _Pragma("unroll") for (int T = 0; T < 2; ++T) _Pragma("unroll") for (int i = 0; i < 4; ++i) { const float e_ = fexp2(S[ch][T][ct][i]); \
            S[ch][T][ct][i] = (FULL) ? e_ : (((unsigned)(D0[ct] - (STEP) * (32 * ch + 4 * T + i)) < W[ct]) ? e_ : 0.f); } \
        PB[ch][ct] = pack_p(S[ch][0][ct], S[ch][1][ct]); } } } while (0)
    PRB_BEGIN(2);
    if (tid < 256) qmask[tid] = 0u;
    if (tid < 8) ubits[tid] = 0u;
    int tq[2]; bf16x8 qf[2][2]; bf16_t gate3[2][3]; u32x2 osum[2][4];
    const float sl = exp2f(-8.f * (float)(h + 5) / 12.f) * LOG2E;
#pragma unroll
    for (int ct = 0; ct < 2; ++ct) {
        tq[ct] = t0 + 4 * wave + 2 * ct + qq;
        const bf16_t* qp = z + (size_t)tq[ct] * ZLD + ZC_QA + h * 64 + 8 * g;
        qf[ct][0] = ldg8(qp); qf[ct][1] = ldg8(qp + 32);
#pragma unroll
        for (int k = 0; k < 3; ++k) gate3[ct][k] = *(const GAS bf16_t*)(z + (size_t)tq[ct] * ZLD + ZC_GA + h * 3 + k);
    }
    const float mref = mref_in;
    bf16x8 ones;
#pragma unroll
    for (int j = 0; j < 8; ++j) ones[j] = (c == 0) ? (short)0x3F80 : (short)0;
    const int t_lo = t0 + 4 * wave, t_hi = t_lo + 3;
    bf16_t* const og = (bf16_t*)(ws + WS_O) + (size_t)b * SEQ * 1024 + h * 64 + 4 * g;
    const int ncb = (t0 >> 4) + 1;
    const int ntile = (ncb + 63) >> 6;
    const unsigned WALL[2] = {0x7fffffffu, 0x7fffffffu};
    float l2inv[2];
    PRB_END(2); PRB_BEGIN(3);
    {
        f32x4 lacc[2] = {(f32x4){0.f, 0.f, 0.f, 0.f}, (f32x4){0.f, 0.f, 0.f, 0.f}};
        if (tid == 0) nxt_idx = (int)__hip_atomic_fetch_add((GAS unsigned*)qhead, 1u, __ATOMIC_RELAXED, __HIP_MEMORY_SCOPE_AGENT);
        T_BAR();
#pragma unroll
        for (int p = 0; p < 5; ++p) if (p < ntile) T_DMAKP(kcmp, 64, p * 64, KV + p * 4096);
        for (int kt = 0; kt < ntile; ++kt) {
            f32x4 s[2][2][2]; bf16x8 pb[2][2];
            const int k0 = kt * 64, s6 = kt % 6, rem = (ntile - 1 - kt < 4) ? ntile - 1 - kt : 4;
            if (rem == 4) T_WAIT(4); else if (rem == 3) T_WAIT(3); else if (rem == 2) T_WAIT(2); else if (rem == 1) T_WAIT(1); else T_WAIT(0);
            T_BAR();
            if (kt + 5 < ntile) T_DMAKP(kcmp, 64, k0 + 320, KV + ((kt + 5) % 6) * 4096);
            const int d0[2] = {tq[0] - 31 - 16 * (k0 + 8 * g), tq[1] - 31 - 16 * (k0 + 8 * g)};
            const float off[2] = {-sl * (float)d0[0] - mref, -sl * (float)d0[1] - mref};
            QK2IP(KV + s6 * 4096, s, off, 16);
            const bool full = (16 * (k0 + 63) + 31 <= t_lo);
            if (full) PEXP(s, pb, true, d0, WALL, 16); else PEXP(s, pb, false, d0, WALL, 16);
            LSUM(pb, lacc);
        }
#pragma unroll
        for (int ct = 0; ct < 2; ++ct) { float lt = lacc[ct][0]; lt += shx<16>(lt, lane); lt += shx<32>(lt, lane); l2inv[ct] = (lt > 0.f) ? -flog2(lt) : -1e30f; }
    }
    PRB_END(3); PRB_BEGIN(4);
    {
        f32x4 o[4][2];
#pragma unroll
        for (int dt = 0; dt < 4; ++dt) { o[dt][0] = (f32x4){0.f, 0.f, 0.f, 0.f}; o[dt][1] = (f32x4){0.f, 0.f, 0.f, 0.f}; }
        T_BAR();
        T_DMAK(kcmp, 64, 0, 0); T_DMAV(vcT, 1024, 0, 0); if (ntile > 1) { T_DMAK(kcmp, 64, 64, 1); T_DMAV(vcT, 1024, 64, 1); }
        for (int kt = 0; kt < ntile; ++kt) {
            f32x4 s[2][2][2]; bf16x8 pb[2][2];
            const int k0 = kt * 64, bi = kt % 3;
            if (kt + 1 < ntile) T_WAIT(2); else T_WAIT(0);
            T_BAR();
            if (kt + 2 < ntile) { T_DMAK(kcmp, 64, k0 + 128, (kt + 2) % 3); T_DMAV(vcT, 1024, k0 + 128, (kt + 2) % 3); }
            const int d0[2] = {tq[0] - 31 - 16 * (k0 + 8 * g), tq[1] - 31 - 16 * (k0 + 8 * g)};
            const float off[2] = {-sl * (float)d0[0] - mref + l2inv[0], -sl * (float)d0[1] - mref + l2inv[1]};
            QK2I(bi, s, off, 16);
            const bool full = (16 * (k0 + 63) + 31 <= t_lo);
            if (full) PEXP(s, pb, true, d0, WALL, 16); else PEXP(s, pb, false, d0, WALL, 16);
#pragma unroll
            for (int ct = 0; ct < 2; ++ct)
#pragma unroll
                for (int ch = 0; ch < 2; ++ch) {
                    float a0 = s[ch][0][ct][0] + s[ch][0][ct][1] + s[ch][0][ct][2] + 0.5f * s[ch][0][ct][3], b0 = 0.5f * s[ch][0][ct][3];
                    float a1 = s[ch][1][ct][0] + s[ch][1][ct][1] + s[ch][1][ct][2] + 0.5f * s[ch][1][ct][3], b1 = 0.5f * s[ch][1][ct][3];
                    a0 = sum8_dpp(a0); b0 = sum8_dpp(b0); a1 = sum8_dpp(a1); b1 = sum8_dpp(b1);
                    if (h == 0) {
                        const int js = (k0 + 32 * ch) / 4 + 2 * g, ql = 2 * ct + qq;
                        impA[ql * 256 + js] = a0; impB[ql * 256 + js] = b0; impA[ql * 256 + js + 1] = a1; impB[ql * 256 + js + 1] = b1;
                    }
                }
            PV2(bi, pb, o);
        }
#pragma unroll
        for (int ct = 0; ct < 2; ++ct) {
            const float g0 = bf2f(gate3[ct][0]);
#pragma unroll
            for (int dt = 0; dt < 4; ++dt) { const f32x4 v = o[dt][ct] * g0; osum[ct][dt][0] = cvt_pk_bf16(v[0], v[1]); osum[ct][dt][1] = cvt_pk_bf16(v[2], v[3]); }
        }
    }
    PRB_END(4); PRB_BEGIN(5);
    {
        f32x4 o[4][2]; f32x4 lacc[2] = {(f32x4){0.f, 0.f, 0.f, 0.f}, (f32x4){0.f, 0.f, 0.f, 0.f}};
#pragma unroll
        for (int dt = 0; dt < 4; ++dt) { o[dt][0] = (f32x4){0.f, 0.f, 0.f, 0.f}; o[dt][1] = (f32x4){0.f, 0.f, 0.f, 0.f}; }
        int kt0 = (t0 - 511) >> 6; if (kt0 < 0) kt0 = 0;
        const int kt1 = (t0 + 31) >> 6;
        const bf16_t* kb = z + ZC_KWN; const bf16_t* vb = vT + (size_t)(1 * 64) * SEQ;
        const unsigned W2[2] = {512u, 512u};
        T_BAR();
        T_DMAK(kb, ZLD, kt0 * 64, 0); T_DMAV(vb, SEQ, kt0 * 64, 0); if (kt0 < kt1) { T_DMAK(kb, ZLD, kt0 * 64 + 64, 1); T_DMAV(vb, SEQ, kt0 * 64 + 64, 1); }
        for (int kt = kt0; kt <= kt1; ++kt) {
            const int k0 = kt * 64, bi = (kt - kt0) % 3;
            f32x4 s[2][2][2]; bf16x8 pb[2][2];
            if (kt < kt1) T_WAIT(2); else T_WAIT(0);
            T_BAR();
            if (kt + 2 <= kt1) { T_DMAK(kb, ZLD, k0 + 128, (kt - kt0 + 2) % 3); T_DMAV(vb, SEQ, k0 + 128, (kt - kt0 + 2) % 3); }
            const int d0[2] = {tq[0] - (k0 + 8 * g), tq[1] - (k0 + 8 * g)};
            const float off[2] = {-sl * (float)d0[0] - mref, -sl * (float)d0[1] - mref};
            QK2I(bi, s, off, 1);
            const bool full = (k0 + 63 <= t_lo && k0 >= t_hi - 511);
            if (full) PEXP(s, pb, true, d0, W2, 1); else PEXP(s, pb, false, d0, W2, 1);
            PV2(bi, pb, o); LSUM(pb, lacc);
        }
        asm volatile("s_waitcnt vmcnt(0)" ::: "memory");
#pragma unroll
        for (int ct = 0; ct < 2; ++ct) {
            float lt = lacc[ct][0]; lt += shx<16>(lt, lane); lt += shx<32>(lt, lane);
            const float g2 = bf2f(gate3[ct][2]) * ((lt > 0.f) ? 1.f / lt : 0.f);
#pragma unroll
            for (int dt = 0; dt < 4; ++dt) { const f32x4 v = o[dt][ct] * g2; const u32x2 t = osum[ct][dt];
                osum[ct][dt][0] = cvt_pk_bf16(bf_lo(t[0]) + v[0], bf_hi(t[0]) + v[1]); osum[ct][dt][1] = cvt_pk_bf16(bf_lo(t[1]) + v[2], bf_hi(t[1]) + v[3]); }
        }
    }
    PRB_END(5); PRB_BEGIN(6);
#pragma unroll
    for (int ql = 0; ql < 4; ++ql) {
        const int qi = 4 * wave + ql, t = t0 + qi, cur = t >> 6;
        if (cur <= 7) {
            if (lane < 8) sell[qi * 8 + lane] = (lane <= cur) ? lane : -1;
        } else {
            unsigned kk[4];
#pragma unroll
            for (int i = 0; i < 4; ++i) { const int j = lane + 64 * i;
                kk[i] = (j >= 1 && j <= cur - 2) ? ((__float_as_uint(impA[ql * 256 + j] + impB[ql * 256 + j - 1]) & 0xFFFFFF00u) | (unsigned)(255 - j)) : 0u; }
            if (lane == 0) { sell[qi * 8 + 0] = 0; sell[qi * 8 + 1] = cur - 1; sell[qi * 8 + 2] = cur; }
#pragma unroll
            for (int r = 0; r < 5; ++r) {
                unsigned m = kk[0] > kk[1] ? kk[0] : kk[1]; const unsigned m2 = kk[2] > kk[3] ? kk[2] : kk[3]; m = m > m2 ? m : m2;
                m = wave_umax(m, lane);
#pragma unroll
                for (int i = 0; i < 4; ++i) kk[i] = (kk[i] == m) ? 0u : kk[i];
                if (lane == 0) sell[qi * 8 + 3 + r] = 255 - (int)(m & 255u);
            }
        }
        if (lane < 8) {
            const int blk = sell[qi * 8 + lane];
            if (blk >= 0) { __hip_atomic_fetch_or(qmask + qi * 8 + (blk >> 5), 1u << (blk & 31), __ATOMIC_RELAXED, __HIP_MEMORY_SCOPE_WORKGROUP);
                            __hip_atomic_fetch_or(ubits + (blk >> 5), 1u << (blk & 31), __ATOMIC_RELAXED, __HIP_MEMORY_SCOPE_WORKGROUP); }
        }
    }
    __syncthreads();
    int nU = 0;
    {
        unsigned wbits[8]; int below = 0;
#pragma unroll
        for (int w = 0; w < 8; ++w) { wbits[w] = ubits[w]; nU += __builtin_popcount(wbits[w]); }
        if (tid < 256) {
            unsigned mine = 0u;
#pragma unroll
            for (int w = 0; w < 8; ++w) { if (w < (tid >> 5)) below += __builtin_popcount(wbits[w]); if (w == (tid >> 5)) mine = wbits[w]; }
            if ((mine >> (tid & 31)) & 1u) { below += __builtin_popcount(mine & ((1u << (tid & 31)) - 1u)); ulist[below] = tid; }
        }
    }
    __syncthreads();
    PRB_END(6); PRB_BEGIN(7);
    {
        f32x4 o[4][2]; f32x4 lacc[2] = {(f32x4){0.f, 0.f, 0.f, 0.f}, (f32x4){0.f, 0.f, 0.f, 0.f}};
#pragma unroll
        for (int dt = 0; dt < 4; ++dt) { o[dt][0] = (f32x4){0.f, 0.f, 0.f, 0.f}; o[dt][1] = (f32x4){0.f, 0.f, 0.f, 0.f}; }
        const bf16_t* kb = z + ZC_KSL; const bf16_t* vb = vT;
        const int q0i = 4 * wave + qq;
        T_BAR();
        { const int k0 = ulist[0] * 64; T_DMAK(kb, ZLD, k0, 0); T_DMAV(vb, SEQ, k0, 0); }
        if (nU > 1) { const int k1 = ulist[1] * 64; T_DMAK(kb, ZLD, k1, 1); T_DMAV(vb, SEQ, k1, 1); }
        for (int it = 0; it < nU; ++it) {
            const int blk = ulist[it], k0 = blk * 64, bi = it % 3;
            f32x4 s[2][2][2]; bf16x8 pb[2][2];
            if (it + 1 < nU) T_WAIT(2); else T_WAIT(0);
            T_BAR();
            if (it + 2 < nU) { const int k2 = ulist[it + 2] * 64; T_DMAK(kb, ZLD, k2, (it + 2) % 3); T_DMAV(vb, SEQ, k2, (it + 2) % 3); }
            unsigned W2[2]; float off[2];
            const int d0[2] = {tq[0] - (k0 + 8 * g), tq[1] - (k0 + 8 * g)};
#pragma unroll
            for (int ct = 0; ct < 2; ++ct) {
                const bool member = ((qmask[(q0i + 2 * ct) * 8 + (blk >> 5)] >> (blk & 31)) & 1u) != 0u;
                W2[ct] = member ? 0x7fffffffu : 0u;
                off[ct] = member ? (-sl * (float)d0[ct] - mref) : -1e30f;
            }
            QK2I(bi, s, off, 1);
            const bool full = (k0 + 63 <= t_lo);
            if (full) PEXP(s, pb, true, d0, W2, 1); else PEXP(s, pb, false, d0, W2, 1);
            PV2(bi, pb, o); LSUM(pb, lacc);
        }
        asm volatile("s_waitcnt vmcnt(0)" ::: "memory");
#pragma unroll
        for (int ct = 0; ct < 2; ++ct) {
            float lt = lacc[ct][0]; lt += shx<16>(lt, lane); lt += shx<32>(lt, lane);
            const float g1 = bf2f(gate3[ct][1]) * ((lt > 0.f) ? 1.f / lt : 0.f);
#pragma unroll
            for (int dt = 0; dt < 4; ++dt) { const f32x4 v = o[dt][ct] * g1; bf16_t* op = og + (size_t)tq[ct] * 1024 + 16 * dt; const u32x2 t = osum[ct][dt]; u32x2 w;
                w[0] = cvt_pk_bf16(bf_lo(t[0]) + v[0], bf_hi(t[0]) + v[1]); w[1] = cvt_pk_bf16(bf_lo(t[1]) + v[2], bf_hi(t[1]) + v[3]); stg2u(op, w); }
        }
    }
    PRB_END(7);
#undef T_DMAK
#undef T_DMAV
#undef T_KB
#undef T_VB
#undef T_WAIT
#undef T_BAR
#undef QK2I
#undef QK2IP
#undef T_DMAKP
#undef PV2
#undef LSUM
#undef PEXP
}

__device__ __forceinline__ void sb_unit(const Ctx& X, int unit) {
    unsigned char* ws = X.ws;
    const int lane = X.tid & 63, c = lane & 15, g = lane >> 4;
    const int b = unit >> 11, hd = (unit >> 9) & 3, t0 = (unit & 511) * 32;
    const bf16_t* z = (const bf16_t*)(ws + WS_Z) + (size_t)b * SEQ * ZLD;
    const bf16_t* vT = (const bf16_t*)(ws + WS_VT) + ((size_t)b * 8 + 2 + hd) * 64 * SEQ;
    int tq[2]; bf16x8 qf[2][2]; float R[2] = {1.f, 1.f};
    f32x4 o[4][2];
#pragma unroll
    for (int ct = 0; ct < 2; ++ct) {
        tq[ct] = t0 + 16 * ct + c;
        const bf16_t* qp = z + (size_t)tq[ct] * ZLD + ZC_QB + hd * 64 + 8 * g;
        qf[ct][0] = ldg8(qp); qf[ct][1] = ldg8(qp + 32);
#pragma unroll
        for (int dt = 0; dt < 4; ++dt) o[dt][ct] = (f32x4){0.f, 0.f, 0.f, 0.f};
    }
    const bf16_t* kbase = z + (size_t)(8 * (c >> 2) + (c & 3)) * ZLD + ZC_KB + hd * 64 + 8 * g;
    KFrag kf; VFrag vf;
    ld_ktile(kbase + (size_t)(((t0 + 31) >> 6) * 64) * ZLD, ZLD, kf);
    for (int kt = (t0 + 31) >> 6; kt >= 0; --kt) {
        const int k0 = kt * 64;
        f32x4 s[2][2][2]; bf16x8 pb[2][2];
        ld_vtile(vT + (size_t)c * SEQ + k0 + 8 * g, SEQ, vf);
        qk_from<2>(kf, qf, s);
        if (kt > 0) ld_ktile(kbase + (size_t)(k0 - 64) * ZLD, ZLD, kf);
#pragma unroll
        for (int ct = 0; ct < 2; ++ct) {
            const int d0 = tq[ct] - (k0 + 8 * g);
            float pex[2][8], tot[2], above[2];
#pragma unroll
            for (int ch = 1; ch >= 0; --ch) {
                float run = 1.f;
#pragma unroll
                for (int jj = 7; jj >= 0; --jj) {
                    const int T = jj >> 2, i = jj & 3;
                    const float zc = __builtin_amdgcn_fmed3f(s[ch][T][ct][i], -80.f, 80.f);
                    const bool ok = (d0 - (32 * ch + jj)) > 0;
                    const float t = fexp2(-zc * LOG2E), r = frcp(1.f + t);
                    s[ch][T][ct][i] = ok ? r : 0.f;
                    pex[ch][jj] = run;
                    run *= ok ? t * r : 1.f;
                }
                const float x16 = shx<16>(run, lane), a2 = run * x16, x32 = shx<32>(a2, lane);
                above[ch] = (g == 3) ? 1.f : (g == 2) ? x16 : (g == 1) ? x32 : x16 * x32;
                tot[ch] = a2 * x32;
            }
#pragma unroll
            for (int ch = 0; ch < 2; ++ch) {
                const float base = R[ct] * above[ch] * ((ch == 0) ? tot[1] : 1.f);
#pragma unroll
                for (int jj = 0; jj < 8; ++jj) { const int T = jj >> 2, i = jj & 3; s[ch][T][ct][i] *= base * pex[ch][jj]; }
                pb[ch][ct] = pack_p(s[ch][0][ct], s[ch][1][ct]);
            }
            R[ct] *= tot[0] * tot[1];
        }
        pv_from<2>(vf, pb, o);
        if (__all((R[0] == 0.f) && (R[1] == 0.f))) break;
    }
    bf16_t* ob = (bf16_t*)(ws + WS_O) + (size_t)b * SEQ * 1024 + 512 + hd * 64;
#pragma unroll
    for (int ct = 0; ct < 2; ++ct)
#pragma unroll
        for (int dt = 0; dt < 4; ++dt) {
            u32x2 w; w[0] = cvt_pk_bf16(o[dt][ct][0], o[dt][ct][1]); w[1] = cvt_pk_bf16(o[dt][ct][2], o[dt][ct][3]);
            stg2u(ob + (size_t)tq[ct] * 1024 + 16 * dt + 4 * g, w);
        }
}

__device__ __forceinline__ void swa_unit(const Ctx& X, int layer, int unit) {
    unsigned char* ws = X.ws;
    const int lane = X.tid & 63, c = lane & 15, g = lane >> 4, hg = c & 1;
    const int b = unit >> 11, gk = (unit >> 10) & 1, t0 = (unit & 1023) * 16;
    const int hd = gk * 2 + hg;
    const bf16_t* z = (const bf16_t*)(ws + WS_Z) + (size_t)b * SEQ * ZLD;
    const bf16_t* vT = (const bf16_t*)(ws + WS_VT) + ((size_t)b * 8 + 6 + gk) * 64 * SEQ;
    int tq[2]; float slope[2]; bf16x8 qf[2][2];
    const float sl = exp2f(-8.f * (float)(hd + 1) / 12.f) * LOG2E;
    const float sink = INP(I_SINK)[layer * 4 + hd] * LOG2E;
    SmState<2> st; sm_init<2>(st);
#pragma unroll
    for (int ct = 0; ct < 2; ++ct) {
        tq[ct] = t0 + 8 * ct + (c >> 1); slope[ct] = sl;
        const bf16_t* qp = z + (size_t)tq[ct] * ZLD + ZC_QC + hd * 64 + 8 * g;
        qf[ct][0] = ldg8(qp); qf[ct][1] = ldg8(qp + 32);
        st.m[ct] = sink; st.l[ct] = (g == 0) ? 1.f : 0.f;
    }
    int kt0 = (t0 - 127) >> 6; if (kt0 < 0) kt0 = 0;
    const int kt1 = (t0 + 15) >> 6;
    const bf16_t* kbase = z + (size_t)(8 * (c >> 2) + (c & 3)) * ZLD + ZC_KC + gk * 64 + 8 * g;
    KFrag kf; VFrag vf;
    ld_ktile(kbase + (size_t)(kt0 * 64) * ZLD, ZLD, kf);
    for (int kt = kt0; kt <= kt1; ++kt) {
        const int k0 = kt * 64;
        f32x4 s[2][2][2]; bf16x8 pb[2][2];
        ld_vtile(vT + (size_t)c * SEQ + k0 + 8 * g, SEQ, vf);
        qk_from<2>(kf, qf, s);
        if (kt < kt1) ld_ktile(kbase + (size_t)(k0 + 64) * ZLD, ZLD, kf);
        const int d0[2] = {tq[0] - (k0 + 8 * g), tq[1] - (k0 + 8 * g)};
        const unsigned Wv[2] = {128u, 128u};
        sm_soft<2, 1>(st, s, pb, d0, slope, Wv, lane);
        pv_from<2>(vf, pb, st.o);
    }
    sm_finish<2>(st, lane);
    bf16_t* oc = (bf16_t*)(ws + WS_O) + (size_t)b * SEQ * 1024 + 768 + hd * 64;
#pragma unroll
    for (int ct = 0; ct < 2; ++ct)
#pragma unroll
        for (int dt = 0; dt < 4; ++dt) {
            u32x2 w; w[0] = cvt_pk_bf16(st.o[dt][ct][0], st.o[dt][ct][1]); w[1] = cvt_pk_bf16(st.o[dt][ct][2], st.o[dt][ct][3]);
            stg2u(oc + (size_t)tq[ct] * 1024 + 16 * dt + 4 * g, w);
        }
}

#define STG_CONSTS() \
    const int prho = tid >> 3, pcp = tid & 7; \
    const int krow = (prho & ~9) | ((prho >> 3) & 1) | ((prho & 1) << 3), kchk = pcp ^ (2 * (krow & 3)); \
    const int vrow = (prho & ~5) | ((prho >> 2) & 1) | ((prho & 1) << 2), vchk = pcp ^ (2 * (vrow & 3)); \
    const int wv512 = __builtin_amdgcn_readfirstlane(wave) * 512; \
    const int fp = c & 3, fcl = g ^ (2 * (fp & 1)), fph = fp >> 1; \
    const int krow0 = 8 * (c >> 2) + fp, krho0 = (krow0 & ~9) | ((krow0 >> 3) & 1) | ((krow0 & 1) << 3); \
    const int kofA = krho0 * 64 + (fcl + 4 * (0 ^ fph)) * 8, kofB = krho0 * 64 + (fcl + 4 * (1 ^ fph)) * 8; \
    const int vrho0 = (c & ~5) | ((c >> 2) & 1) | ((c & 1) << 2); \
    const int vofA = vrho0 * 64 + (fcl + 4 * (0 ^ fph)) * 8, vofB = vrho0 * 64 + (fcl + 4 * (1 ^ fph)) * 8
#define T_DMAK(kbase, kstride, k0, buf) __builtin_amdgcn_global_load_lds((const unsigned*)((kbase) + (size_t)((k0) + krow) * (kstride) + kchk * 8), (LAS unsigned*)(KV + (buf) * 8192 + wv512), 16, 0, 0)
#define T_DMAV(vbase, vstride, k0, buf) __builtin_amdgcn_global_load_lds((const unsigned*)((vbase) + (size_t)vrow * (vstride) + (k0) + vchk * 8), (LAS unsigned*)(KV + (buf) * 8192 + 4096 + wv512), 16, 0, 0)
#define T_KB(buf) (KV + (buf) * 8192)
#define T_VB(buf) (KV + (buf) * 8192 + 4096)
#define T_WAIT(n) asm volatile("s_waitcnt vmcnt(" #n ")" ::: "memory")
#define T_BAR() do { asm volatile("" ::: "memory"); __builtin_amdgcn_s_barrier(); asm volatile("" ::: "memory"); } while (0)
#define QK2Z(buf, S) do { _Pragma("unroll") for (int ch = 0; ch < 2; ++ch) _Pragma("unroll") for (int T = 0; T < 2; ++T) { \
        const LAS bf16_t* p_ = T_KB(buf) + (4 * T + 32 * ch) * 64; const bf16x8 k0_ = *(const LAS bf16x8*)(p_ + kofA), k1_ = *(const LAS bf16x8*)(p_ + kofB); \
        _Pragma("unroll") for (int ct = 0; ct < 2; ++ct) { f32x4 a_ = (f32x4){0.f, 0.f, 0.f, 0.f}; \
            a_ = __builtin_amdgcn_mfma_f32_16x16x32_bf16(k0_, qf[ct][0], a_, 0, 0, 0); a_ = __builtin_amdgcn_mfma_f32_16x16x32_bf16(k1_, qf[ct][1], a_, 0, 0, 0); S[ch][T][ct] = a_; } } } while (0)
#define PV2(buf, PB, O) do { _Pragma("unroll") for (int dt = 0; dt < 4; ++dt) { const LAS bf16_t* p_ = T_VB(buf) + 16 * dt * 64; \
        const bf16x8 v0_ = *(const LAS bf16x8*)(p_ + vofA), v1_ = *(const LAS bf16x8*)(p_ + vofB); \
        _Pragma("unroll") for (int ct = 0; ct < 2; ++ct) { O[dt][ct] = __builtin_amdgcn_mfma_f32_16x16x32_bf16(v0_, PB[0][ct], O[dt][ct], 0, 0, 0); \
            O[dt][ct] = __builtin_amdgcn_mfma_f32_16x16x32_bf16(v1_, PB[1][ct], O[dt][ct], 0, 0, 0); } } } while (0)

__device__ __forceinline__ void sb_block(const Ctx& X, LAS unsigned char* lds, int unit) {
    unsigned char* ws = X.ws;
    const int tid = X.tid, lane = tid & 63, wave = tid >> 6, c = lane & 15, g = lane >> 4;
    const int b = unit >> 8, hd = (unit >> 6) & 3, t0 = (unit & 63) * 256;
    const bf16_t* z = (const bf16_t*)(ws + WS_Z) + (size_t)b * SEQ * ZLD;
    const bf16_t* vb = (const bf16_t*)(ws + WS_VT) + ((size_t)b * 8 + 2 + hd) * 64 * SEQ;
    const bf16_t* kb = z + ZC_KB + hd * 64;
    LAS bf16_t* KV = (LAS bf16_t*)lds;
    LAS int* flg = (LAS int*)(lds + LDS_MISC + 4096);
    STG_CONSTS();
    int tq[2]; bf16x8 qf[2][2]; float R[2] = {1.f, 1.f};
    f32x4 o[4][2];
#pragma unroll
    for (int ct = 0; ct < 2; ++ct) {
        tq[ct] = t0 + 32 * wave + 16 * ct + c;
        const bf16_t* qp = z + (size_t)tq[ct] * ZLD + ZC_QB + hd * 64 + 8 * g;
        qf[ct][0] = ldg8(qp); qf[ct][1] = ldg8(qp + 32);
#pragma unroll
        for (int dt = 0; dt < 4; ++dt) o[dt][ct] = (f32x4){0.f, 0.f, 0.f, 0.f};
    }
    const int kt_hi = (t0 + 255) >> 6, ktw = (t0 + 32 * wave + 31) >> 6;
    bool mydone = false;
    T_BAR();
    T_DMAK(kb, ZLD, kt_hi * 64, 0); T_DMAV(vb, SEQ, kt_hi * 64, 0);
    if (kt_hi >= 1) { T_DMAK(kb, ZLD, (kt_hi - 1) * 64, 1); T_DMAV(vb, SEQ, (kt_hi - 1) * 64, 1); }
    int stp = 0;
    for (int kt = kt_hi; kt >= 0; --kt, ++stp) {
        const int k0 = kt * 64, bi = stp % 3;
        if (kt >= 1) T_WAIT(2); else T_WAIT(0);
        T_BAR();
        if (stp > 0) {
            const LAS int* f = flg + ((stp - 1) & 1) * 8;
            if ((f[0] | f[1] | f[2] | f[3] | f[4] | f[5] | f[6] | f[7]) == 0) break;
        }
        if (kt >= 2) { T_DMAK(kb, ZLD, k0 - 128, (stp + 2) % 3); T_DMAV(vb, SEQ, k0 - 128, (stp + 2) % 3); }
        if (kt <= ktw && !mydone) {
            f32x4 s[2][2][2]; bf16x8 pb[2][2];
            QK2Z(bi, s);
#pragma unroll
            for (int ct = 0; ct < 2; ++ct) {
                const int d0 = tq[ct] - (k0 + 8 * g);
                float pex[2][8], tot[2], above[2];
                const bool allk = (k0 + 63 < t0 + 32 * wave);
#pragma unroll
                for (int ch = 1; ch >= 0; --ch) {
                    float run = 1.f;
                    if (allk) {
#pragma unroll
                        for (int jj = 7; jj >= 0; --jj) {
                            const int T = jj >> 2, i = jj & 3;
                            const float zc = __builtin_amdgcn_fmed3f(s[ch][T][ct][i], -80.f, 80.f);
                            const float t = fexp2(-zc * LOG2E), r = frcp(1.f + t);
                            s[ch][T][ct][i] = r;
                            pex[ch][jj] = run;
                            run *= t * r;
                        }
                    } else {
#pragma unroll
                    for (int jj = 7; jj >= 0; --jj) {
                        const int T = jj >> 2, i = jj & 3;
                        const float zc = __builtin_amdgcn_fmed3f(s[ch][T][ct][i], -80.f, 80.f);
                        const bool ok = (d0 - (32 * ch + jj)) > 0;
                        const float t = fexp2(-zc * LOG2E), r = frcp(1.f + t);
                        s[ch][T][ct][i] = ok ? r : 0.f;
                        pex[ch][jj] = run;
                        run *= ok ? t * r : 1.f;
                    }
                    }
                    const float x16 = shx<16>(run, lane), a2 = run * x16, x32 = shx<32>(a2, lane);
                    above[ch] = (g == 3) ? 1.f : (g == 2) ? x16 : (g == 1) ? x32 : x16 * x32;
                    tot[ch] = a2 * x32;
                }
#pragma unroll
                for (int ch = 0; ch < 2; ++ch) {
                    const float base = R[ct] * above[ch] * ((ch == 0) ? tot[1] : 1.f);
#pragma unroll
                    for (int jj = 0; jj < 8; ++jj) { const int T = jj >> 2, i = jj & 3; s[ch][T][ct][i] *= base * pex[ch][jj]; }
                    pb[ch][ct] = pack_p(s[ch][0][ct], s[ch][1][ct]);
                }
                R[ct] *= tot[0] * tot[1];
            }
            PV2(bi, pb, o);
            mydone = __all((R[0] == 0.f) && (R[1] == 0.f)) != 0;
        }
        if (lane == 0) flg[(stp & 1) * 8 + wave] = (!mydone && kt > 0) ? 1 : 0;
        asm volatile("s_waitcnt lgkmcnt(0)" ::: "memory");
    }
    T_WAIT(0);
    bf16_t* ob = (bf16_t*)(ws + WS_O) + (size_t)b * SEQ * 1024 + 512 + hd * 64;
#pragma unroll
    for (int ct = 0; ct < 2; ++ct)
#pragma unroll
        for (int dt = 0; dt < 4; ++dt) {
            u32x2 w; w[0] = cvt_pk_bf16(o[dt][ct][0], o[dt][ct][1]); w[1] = cvt_pk_bf16(o[dt][ct][2], o[dt][ct][3]);
            stg2u(ob + (size_t)tq[ct] * 1024 + 16 * dt + 4 * g, w);
        }
}

__device__ __forceinline__ void swa_block(const Ctx& X, LAS unsigned char* lds, int layer, int unit) {
    unsigned char* ws = X.ws;
    const int tid = X.tid, lane = tid & 63, wave = tid >> 6, c = lane & 15, g = lane >> 4, hg = c & 1;
    const int b = unit >> 8, gk = (unit >> 7) & 1, t0 = (unit & 127) * 128;
    const int hd = gk * 2 + hg;
    const bf16_t* z = (const bf16_t*)(ws + WS_Z) + (size_t)b * SEQ * ZLD;
    const bf16_t* vb = (const bf16_t*)(ws + WS_VT) + ((size_t)b * 8 + 6 + gk) * 64 * SEQ;
    const bf16_t* kb = z + ZC_KC + gk * 64;
    LAS bf16_t* KV = (LAS bf16_t*)lds;
    STG_CONSTS();
    int tq[2]; float slope[2]; bf16x8 qf[2][2];
    const float sl = exp2f(-8.f * (float)(hd + 1) / 12.f) * LOG2E;
    const float sink = INP(I_SINK)[layer * 4 + hd] * LOG2E;
    SmState<2> st; sm_init<2>(st);
#pragma unroll
    for (int ct = 0; ct < 2; ++ct) {
        tq[ct] = t0 + 16 * wave + 8 * ct + (c >> 1); slope[ct] = sl;
        const bf16_t* qp = z + (size_t)tq[ct] * ZLD + ZC_QC + hd * 64 + 8 * g;
        qf[ct][0] = ldg8(qp); qf[ct][1] = ldg8(qp + 32);
        st.m[ct] = sink; st.l[ct] = (g == 0) ? 1.f : 0.f;
    }
    const int t_lo = t0 + 16 * wave, t_hi = t_lo + 15;
    int kt0 = (t0 - 127) >> 6; if (kt0 < 0) kt0 = 0;
    const int kt1 = (t0 + 127) >> 6;
    const unsigned Wv[2] = {128u, 128u};
    T_BAR();
    T_DMAK(kb, ZLD, kt0 * 64, 0); T_DMAV(vb, SEQ, kt0 * 64, 0); if (kt0 < kt1) { T_DMAK(kb, ZLD, kt0 * 64 + 64, 1); T_DMAV(vb, SEQ, kt0 * 64 + 64, 1); }
    for (int kt = kt0; kt <= kt1; ++kt) {
        const int k0 = kt * 64, bi = (kt - kt0) % 3;
        if (kt < kt1) T_WAIT(2); else T_WAIT(0);
        T_BAR();
        if (kt + 2 <= kt1) { T_DMAK(kb, ZLD, k0 + 128, (kt - kt0 + 2) % 3); T_DMAV(vb, SEQ, k0 + 128, (kt - kt0 + 2) % 3); }
        if (k0 <= t_hi && k0 + 63 >= t_lo - 127) {
            f32x4 s[2][2][2]; bf16x8 pb[2][2];
            QK2Z(bi, s);
            const int d0[2] = {tq[0] - (k0 + 8 * g), tq[1] - (k0 + 8 * g)};
            sm_soft<2, 1>(st, s, pb, d0, slope, Wv, lane);
            PV2(bi, pb, st.o);
        }
    }
    sm_finish<2>(st, lane);
    bf16_t* oc = (bf16_t*)(ws + WS_O) + (size_t)b * SEQ * 1024 + 768 + hd * 64;
#pragma unroll
    for (int ct = 0; ct < 2; ++ct)
#pragma unroll
        for (int dt = 0; dt < 4; ++dt) {
            u32x2 w; w[0] = cvt_pk_bf16(st.o[dt][ct][0], st.o[dt][ct][1]); w[1] = cvt_pk_bf16(st.o[dt][ct][2], st.o[dt][ct][3]);
            stg2u(oc + (size_t)tq[ct] * 1024 + 16 * dt + 4 * g, w);
        }
}
#undef STG_CONSTS
#undef T_DMAK
#undef T_DMAV
#undef T_KB
#undef T_VB
#undef T_WAIT
#undef T_BAR
#undef QK2Z
#undef PV2

struct SchedC1 {
    static constexpr bool GATHER = false, FP8 = false, CHAIN = false;
    int lda2, akstep, ldb2; const char* Z; const char* W1; int G, c;
    __device__ __forceinline__ bool next(int i, GU& u) const {
        const int L = i * G + c; if (L >= 16) return false;
        const int mat = L >> 3, pm = L & 7;
        u.A = Z + (size_t)pm * 256 * lda2 + (mat ? ZC_VCS : ZC_KCS) * 2; u.B = W1 + (size_t)mat * 256 * 2048 * 2; u.nt = 32; u.kind = 0; u.pm = pm; u.pn = 0; u.e = mat; u.aux = 0; return true;
    }
    __device__ __forceinline__ void rowoff(const GU&, int, unsigned (&)[2][2]) const {}
};

#ifndef MK_PER_STEP
#define MK_PER_STEP 0
#endif
constexpr int NSTEP = 2 + 10 * NL;
#define PHASE_FN __device__ __forceinline__

PHASE_FN void f_prologue(Ctx Xa) { const Ctx X = uni(Xa); p0_prologue(X, X.lds); }
PHASE_FN void f_norm0(Ctx Xa, int l) { const Ctx X = uni(Xa); norm_phase<0>(X, X.lds, l); }
PHASE_FN void f_norm1(Ctx Xa, int l) { const Ctx X = uni(Xa); norm_phase<1>(X, X.lds, l); }
PHASE_FN void f_norm2(Ctx Xa, int l) { const Ctx X = uni(Xa); norm2_mfma(X, X.lds, l); }
PHASE_FN void f_norm3(Ctx Xa, int l) { const Ctx X = uni(Xa); norm_phase<3>(X, X.lds, l); }
PHASE_FN void f_inproj(Ctx Xa, int la) {
    const Ctx X = uni(Xa); const int l = la; unsigned char* ws = X.ws;
    SchedDense S{2048, 128, 2048, (const char*)(ws + WS_H), (const char*)(ws + WS_WIN) + (size_t)l * 2304 * 2048, 128, 9, 16, X.G, X.bid};
    EpiZ E{(bf16_t*)(ws + WS_Z), (bf16_t*)(ws + WS_VT), INP(I_NQG) + l * 64, INP(I_NKG) + l * 192, INP(I_SQG) + l * 64, INP(I_SKG) + l * 64};
    gemm_run(X.lds, S, E, X.tid);
    { const int nunits = 128 * 9, rounds = (nunits + X.G - 1) / X.G;
      if (nunits % X.G != 0 && X.bid >= nunits - (rounds - 1) * X.G) conv_fill(X, X.lds, l + 1, 4, false); }
}
PHASE_FN void f_cmp1(Ctx Xa, int la) {
    const Ctx X = uni(Xa); const int l = la; unsigned char* ws = X.ws;
    SchedC1 S{16 * ZLD * 2, ZLD * 2, 4096, (const char*)(ws + WS_Z), (const char*)(ws + WS_W1) + (size_t)l * 2 * 256 * 2048 * 2, X.G, X.bid};
    EpiC1 E{(bf16_t*)(ws + WS_HID), (const float*)(ws + WS_CB) + l * 512};
    gemm_run(X.lds, S, E, X.tid);
    if (X.bid < 16) {
        __builtin_amdgcn_fence(__ATOMIC_RELEASE, "workgroup"); __syncthreads(); __builtin_amdgcn_fence(__ATOMIC_ACQUIRE, "workgroup");
        for (int L = X.bid; L < 16; L += X.G)
            for (int j = X.tid >> 6; j < 16; j += 8) cmp2_unit(X, l, (L >> 3) * 128 + (L & 7) * 16 + j);
    }
}
PHASE_FN void f_cmp2(Ctx Xa, int la) {
    const Ctx X = uni(Xa); const int l = la;
    for (int u = X.bid * 8 + (X.tid >> 6); u < 256; u += X.G * 8) cmp2_unit(X, l, u);
}
PHASE_FN void f_nsa(Ctx Xa, int la, int qk) {
    const Ctx X = uni(Xa); const int l = la;
    unsigned* ctl = (unsigned*)(X.ws + WS_CTL);
    LAS int* bc = (LAS int*)(X.lds + LDS_MISC + 32);
    PRB_DECL();
#if !PRB_SEL
    unsigned long long prb_acc = 0ull;
#endif
    unsigned* qhead = ctl + CW_Q + 64 * (l * 4 + qk);
    float mref;
    { const int lane = X.tid & 63, layer = l;
        float gq = fabsf(INP(I_NQG)[layer * 64 + lane]);
        const float* kg = INP(I_NKG) + layer * 192;
        float gk = fmaxf(fmaxf(fabsf(kg[lane]), fabsf(kg[64 + lane])), fabsf(kg[128 + lane]));
        gq = fmaxf(gq, shx<32>(gq, lane)); gq = fmaxf(gq, shx<16>(gq, lane)); gq = fmaxf(gq, shx<8>(gq, lane)); gq = fmaxf(gq, shx<4>(gq, lane)); gq = fmaxf(gq, shx<2>(gq, lane)); gq = fmaxf(gq, shx<1>(gq, lane));
        gk = fmaxf(gk, shx<32>(gk, lane)); gk = fmaxf(gk, shx<16>(gk, lane)); gk = fmaxf(gk, shx<8>(gk, lane)); gk = fmaxf(gk, shx<4>(gk, lane)); gk = fmaxf(gk, shx<2>(gk, lane)); gk = fmaxf(gk, shx<1>(gk, lane));
        mref = 8.f * LOG2E * 1.01f * gq * gk;
    }
    int nxt = 0;
    if (X.tid == 0) nxt = (int)atomicAdd(qhead, 1u);
    for (;;) {
        PRB_BEGIN(1);
        if (X.tid == 0) bc[0] = nxt;
        __syncthreads();
        const int idx = bc[0];
        __syncthreads();
        PRB_END(1);
        if (idx >= 1024) break;
        nsa_block(X, X.lds, (idx & 1) * 512 + (511 - (idx >> 1)), l, prb_acc, qhead, nxt, mref);
    }
    PRB_FLUSH(X);
}
PHASE_FN void f_sbswa(Ctx Xa, int la, int qk) {
    const Ctx X = uni(Xa); const int l = la;
    unsigned* ctl = (unsigned*)(X.ws + WS_CTL);
    LAS int* bc = (LAS int*)(X.lds + LDS_MISC + 32);
    unsigned* qhead = ctl + CW_Q + 64 * (l * 4 + qk) + 16;
    int nxt = 0;
    if (X.tid == 0) nxt = (int)atomicAdd(qhead, 1u);
    for (;;) {
        if (X.tid == 0) bc[0] = nxt;
        __syncthreads();
        const int idx = bc[0];
        __syncthreads();
        if (idx >= 1024) break;
        if (X.tid == 0) nxt = (int)__hip_atomic_fetch_add((GAS unsigned*)qhead, 1u, __ATOMIC_RELAXED, __HIP_MEMORY_SCOPE_AGENT);
        if (idx < 512) sb_block(X, X.lds, idx);
        else swa_block(X, X.lds, l, idx - 512);
    }
}
PHASE_FN void f_e1(Ctx Xa, int la) {
    const Ctx X = uni(Xa); const int l = la; unsigned char* ws = X.ws;
    EpiE1G EG{(unsigned char*)(ws + WS_SB) + (size_t)X.bid * 262144};
    EpiE1T ET{(unsigned char*)(ws + WS_SB) + (size_t)X.bid * 262144, (bf16_t*)(ws + WS_Y)};
    for (int T = 0; T * X.G < 512; ++T) {
        SchedE1G SG{1024, 128, 2048, (const char*)(ws + WS_H8), (const char*)(ws + WS_WM8) + (size_t)l * 3072 * 1024, X.G, X.bid, T};
        gemm_run(X.lds, SG, EG, X.tid);
        SchedE1T ST{2048, 128, 2048, (const char*)(ws + WS_O), (const char*)(ws + WS_WB) + (size_t)l * 1024 * 2048, X.G, X.bid, T};
        gemm_run(X.lds, ST, ET, X.tid);
    }
}
PHASE_FN void f_e2(Ctx Xa, int la) {
    const Ctx X = uni(Xa); const int l = la; unsigned char* ws = X.ws;
    const float* modl = (const float*)(ws + WS_MOD) + (size_t)l * 2 * 6144;
    SchedDense S{2048, 128, 2048, (const char*)(ws + WS_Y), (const char*)(ws + WS_WO) + (size_t)l * 1024 * 2048, 128, 4, 16, X.G, X.bid};
    EpiE2 E{(bf16_t*)(ws + WS_XB), modl + 2048, (float*)(ws + WS_SSP)};
    gemm_run(X.lds, S, E, X.tid);
}
__device__ __forceinline__ void moe_table(const Ctx& X, int l) {
    LAS int* tpre = (LAS int*)(X.lds + LDS_MISC + 256);
    if (X.tid < 16) {
        const unsigned* gcnt = (const unsigned*)(X.ws + WS_CTL) + CW_GCNT + 16 * (l * 16);
        tpre[17 + X.tid] = (int)__hip_atomic_load((GAS unsigned*)(gcnt + 16 * X.tid), __ATOMIC_RELAXED, __HIP_MEMORY_SCOPE_AGENT);
    }
    __syncthreads();
    if (X.tid < 17) {
        int run = 0;
        for (int e = 0; e < X.tid; ++e) run += (tpre[17 + e] + 255) >> 8;
        tpre[X.tid] = run;
        if (X.tid < 16) tpre[34 + X.tid] = run * 256;
    }
    __syncthreads();
}
PHASE_FN void f_g1(Ctx Xa, int la) {
    const Ctx X = uni(Xa); const int l = la; unsigned char* ws = X.ws;
    moe_table(X, l);
    const LAS int* tpre = (const LAS int*)(X.lds + LDS_MISC + 256);
    SchedMoE S{2048, 128, 2048, (const char*)(ws + WS_H), (const char*)(ws + WS_WGU) + (size_t)l * 16 * 1024 * 2048, (size_t)1024 * 2048, 4, 16, X.G, X.bid, 1, tpre, (const int*)(ws + WS_LISTT)};
    EpiG1 E{(bf16_t*)(ws + WS_AB)};
    gemm_run(X.lds, S, E, X.tid);
    { const int nunits = tpre[16] * 4, rounds = (nunits + X.G - 1) / X.G, cx = (X.G % 8 == 0) ? (X.bid % 8) * (X.G / 8) + X.bid / 8 : X.bid;
      if (nunits % X.G != 0 && cx >= nunits - (rounds - 1) * X.G) conv_fill(X, X.lds, l + 1, 4, false); }
}
PHASE_FN void f_g2(Ctx Xa, int la) {
    const Ctx X = uni(Xa); const int l = la; unsigned char* ws = X.ws;
    moe_table(X, l);
    const LAS int* tpre = (const LAS int*)(X.lds + LDS_MISC + 256);
    SchedMoE S{1024, 128, 1024, (const char*)(ws + WS_AB), (const char*)(ws + WS_WD) + (size_t)l * 16 * 1024 * 1024, (size_t)1024 * 1024, 4, 8, X.G, X.bid, 2, tpre, (const int*)(ws + WS_LISTT)};
    EpiG2 E{(bf16_t*)(ws + WS_YS)};
    gemm_run(X.lds, S, E, X.tid);
    conv_fill(X, X.lds, l + 1, 0, true);
}

__global__ void __launch_bounds__(512, 2) mega_fwd(Params P) {
    extern __shared__ __attribute__((aligned(16))) unsigned char lds_raw[];
    LAS unsigned char* lds = (LAS unsigned char*)lds_raw;
    const int tid = threadIdx.x;
    unsigned* ctl = (unsigned*)(P.ws + WS_CTL);
    if (tid < 64) ((LAS unsigned*)(lds + LDS_MISC))[tid] = 0u;
    if (tid < 27) *(LAS unsigned long long*)(lds + LDS_PTAB + 8 * tid) = (unsigned long long)P.in[tid];
    if ((tid & 63) == 0) *(LAS int*)(lds + LDS_WTAB + 4 * ((unsigned)__builtin_amdgcn_s_getreg((5 << 11) | 4) & 63u)) = tid >> 6;
    __syncthreads();
    XcdBarrier bar = xcd_barrier_post(ctl, (volatile LAS unsigned*)(lds + LDS_MISC));
    Ctx X; X.ws = P.ws; X.out = P.out; X.lds = lds; X.tid = 0; X.bid = 0; X.G = 0;
    const int lo = P.step_lo, hi = P.step_hi;
#define IN(s) (lo <= (s) && (s) < hi)
#define SEAM(s) do { if ((s) + 1 < hi) xcd_barrier(bar); } while (0)
#ifndef DBL
#define DBL 0
#endif
    if (IN(0)) { f_prologue(X); if (DBL & 1) f_prologue(X); SEAM(0); }
    for (int l = 0; l < NL; ++l) {
        const int s0 = 1 + 10 * l;
        if (IN(s0 + 0)) { if (l == 0) f_norm0(X, l); else f_norm1(X, l); SEAM(s0 + 0); }
        if (IN(s0 + 1)) { f_inproj(X, l); if (DBL & 2) f_inproj(X, l); SEAM(s0 + 1); }
        if (IN(s0 + 2)) { f_cmp1(X, l); __syncthreads(); f_sbswa(X, l, 1); if (DBL & 64) f_sbswa(X, l, 2); SEAM(s0 + 2); }
        if (IN(s0 + 4)) { f_nsa(X, l, 1); if (DBL & 4) f_nsa(X, l, 2); SEAM(s0 + 4); }
        if (IN(s0 + 5)) { f_e1(X, l); if (DBL & 8) f_e1(X, l); SEAM(s0 + 5); }
        if (IN(s0 + 6)) { f_e2(X, l); SEAM(s0 + 6); }
        if (IN(s0 + 7)) { f_norm2(X, l); SEAM(s0 + 7); }
        if (IN(s0 + 8)) { f_g1(X, l); if (DBL & 16) f_g1(X, l); SEAM(s0 + 8); }
        if (IN(s0 + 9)) { f_g2(X, l); if (DBL & 32) f_g2(X, l); SEAM(s0 + 9); }
    }
    if (IN(NSTEP - 1)) f_norm3(X, NL);
#undef IN
#undef SEAM
}

extern "C" void kernel_launch(void* const* d_in, const int* in_sizes, int n_in, void* d_out, int out_size, void* d_ws, size_t ws_size, hipStream_t stream) {
    static int grid = 0;
    if (grid == 0) {
        if (n_in != 27 || out_size != NTOK * DM || ws_size < WS_END) { fprintf(stderr, "kernel_launch: unexpected shapes/workspace (n_in %d out %d ws %zu need %zu)\n", n_in, out_size, ws_size, (size_t)WS_END); grid = -1; return; }
        int dev = 0, cus = 0, per_cu = 0;
        if (hipGetDevice(&dev) != hipSuccess || hipDeviceGetAttribute(&cus, hipDeviceAttributeMultiprocessorCount, dev) != hipSuccess) { grid = -1; return; }
        if (hipFuncSetAttribute((const void*)mega_fwd, hipFuncAttributeMaxDynamicSharedMemorySize, LDS_BYTES) != hipSuccess) { fprintf(stderr, "kernel_launch: hipFuncSetAttribute failed\n"); grid = -1; return; }
        if (hipOccupancyMaxActiveBlocksPerMultiprocessor(&per_cu, (const void*)mega_fwd, 512, LDS_BYTES) != hipSuccess || per_cu < 1) { fprintf(stderr, "kernel_launch: occupancy query says %d\n", per_cu); }
        (void)hipGetLastError();
        grid = cus;
        if (grid > 256) grid = 256;
        if (grid < 64) { grid = -1; return; }
    }
    if (grid < 0) return;
    if (hipMemsetAsync((char*)d_ws + WS_CTL, 0, 64 * 1024, stream) != hipSuccess) return;
    Params p{};
    for (int i = 0; i < 27; ++i) p.in[i] = (const float*)d_in[i];
    p.out = (float*)d_out; p.ws = (unsigned char*)d_ws;
#if MK_PER_STEP
    for (int s = 0; s < NSTEP; ++s) { p.step_lo = s; p.step_hi = s + 1; hipLaunchKernelGGL(mega_fwd, dim3(grid), dim3(512), LDS_BYTES, stream, p); }
#else
    p.step_lo = 0; p.step_hi = NSTEP;
    hipLaunchKernelGGL(mega_fwd, dim3(grid), dim3(512), LDS_BYTES, stream, p);
#endif
}
```

```cpp
#include <hip/hip_runtime.h>
#include <stdio.h>
#include <stdint.h>

#define LAS __attribute__((address_space(3)))
#define GAS __attribute__((address_space(1)))
typedef unsigned short bf16_t;
typedef short bf16x8 __attribute__((ext_vector_type(8)));
typedef float f32x4 __attribute__((ext_vector_type(4)));
typedef unsigned u32x4 __attribute__((ext_vector_type(4)));
typedef unsigned u32x2 __attribute__((ext_vector_type(2)));

constexpr int NTOK = 32768, SEQ = 16384, DM = 1024, NL = 4, NB = 2;
constexpr int NIN = 5272;
constexpr int ZLD = 2304;
constexpr int ZC_QA = 0, ZC_KCS = 512, ZC_VCS = 576, ZC_KSL = 640, ZC_VSL = 704, ZC_KWN = 768, ZC_VWN = 832,
              ZC_QB = 896, ZC_KB = 1152, ZC_VB = 1408, ZC_QC = 1664, ZC_KC = 1920, ZC_VC = 2048, ZC_GA = 2176;
constexpr int LCAP = 32768;
constexpr int AROWS = 65536 + 16 * 256;
constexpr float LOG2E = 1.4426950408889634f;
constexpr float LN2 = 0.6931471805599453f;
constexpr int LDS_BYTES = 147456;
constexpr int LDS_MISC = 131072;

constexpr size_t KiB = 1024, MiB = 1024 * 1024;
constexpr size_t WS_CTL = 0;
constexpr size_t WS_MOD = WS_CTL + 64 * KiB;
constexpr size_t WS_CB = WS_MOD + 192 * KiB;
constexpr size_t WS_LISTT = WS_CB + 8 * KiB;
constexpr size_t WS_LISTW = WS_LISTT + 2 * MiB;
constexpr size_t WS_KCMP = WS_LISTW + 2 * MiB;
constexpr size_t WS_VCMPT = WS_KCMP + 256 * KiB;
constexpr size_t WS_HID = WS_VCMPT + 256 * KiB;
constexpr size_t WS_SSP = WS_HID + 2 * MiB;
constexpr size_t WS_WIN = WS_SSP + 2 * MiB;
constexpr size_t WS_WM = WS_WIN + (size_t)NL * 2304 * 1024 * 2;
constexpr size_t WS_WB = WS_WM + (size_t)NL * 3072 * 1024 * 2;
constexpr size_t WS_WO = WS_WB + (size_t)NL * 1024 * 1024 * 2;
constexpr size_t WS_W1 = WS_WO + (size_t)NL * 1024 * 1024 * 2;
constexpr size_t WS_W2 = WS_W1 + (size_t)NL * 2 * 256 * 2048 * 2;
constexpr size_t WS_WGU = WS_W2 + (size_t)NL * 2 * 64 * 256 * 2;
constexpr size_t WS_WD = WS_WGU + (size_t)NL * 16 * 1024 * 1024 * 2;
constexpr size_t WS_H = WS_WD + (size_t)NL * 16 * 1024 * 512 * 2;
constexpr size_t WS_Z = WS_H + (size_t)NTOK * 1024 * 2;
constexpr size_t Z_BYTES = (size_t)(NTOK + 64) * ZLD * 2;
constexpr size_t WS_Y = WS_Z;
constexpr size_t WS_SB = WS_Z + 64 * MiB;
constexpr size_t WS_AB = WS_Z + 64 * MiB;
constexpr size_t WS_R3 = WS_Z + Z_BYTES;
constexpr size_t WS_YB = WS_R3;
constexpr size_t WS_VT = WS_R3;
constexpr size_t WS_O = WS_R3 + 32 * MiB;
constexpr size_t WS_XB = WS_R3 + 136 * MiB;
constexpr size_t WS_TINFO = WS_XB + 64 * MiB;
constexpr size_t WS_YS = WS_R3;
constexpr size_t WS_H8 = WS_TINFO + 1 * MiB;
constexpr size_t WS_WM8 = WS_H8 + 32 * MiB;
constexpr size_t WS_END = WS_WM8 + 12 * MiB;
static_assert(64 * MiB + (size_t)AROWS * 512 * 2 <= Z_BYTES, "alias map");

constexpr int CW_Q = 4096;
constexpr int CW_GCNT = 6144;

__device__ __forceinline__ unsigned cvt_pk_bf16(float lo, float hi) { unsigned r; asm("v_cvt_pk_bf16_f32 %0, %1, %2" : "=v"(r) : "v"(lo), "v"(hi)); return r; }
__device__ __forceinline__ bf16_t f2bf(float f) { return (bf16_t)(cvt_pk_bf16(f, 0.f) & 0xffffu); }
__device__ __forceinline__ float bf_lo(unsigned u) { return __uint_as_float(u << 16); }
__device__ __forceinline__ float bf_hi(unsigned u) { return __uint_as_float(u & 0xffff0000u); }
__device__ __forceinline__ float bf2f(bf16_t b) { return __uint_as_float(((unsigned)b) << 16); }
__device__ __forceinline__ float fexp2(float x) { return __builtin_amdgcn_exp2f(x); }
__device__ __forceinline__ float flog2(float x) { return __builtin_amdgcn_logf(x); }
__device__ __forceinline__ float frcp(float x) { return __builtin_amdgcn_rcpf(x); }
__device__ __forceinline__ float sigmoidf_(float x) { return frcp(1.f + fexp2(-x * LOG2E)); }
template <int M> __device__ __forceinline__ int shxi(int v, int lane) {
    if constexpr (M < 32) return __builtin_amdgcn_ds_swizzle(v, (M << 10) | 0x1f);
    else return __builtin_amdgcn_ds_bpermute((lane ^ 32) << 2, v);
}
template <int M> __device__ __forceinline__ float shx(float v, int lane) { return __int_as_float(shxi<M>(__float_as_int(v), lane)); }
__device__ __forceinline__ float sum8_dpp(float v) {
    v += __int_as_float(__builtin_amdgcn_update_dpp(__float_as_int(v), __float_as_int(v), 0xB1, 0xf, 0xf, true));
    v += __int_as_float(__builtin_amdgcn_update_dpp(__float_as_int(v), __float_as_int(v), 0x4E, 0xf, 0xf, true));
    v += __int_as_float(__builtin_amdgcn_update_dpp(__float_as_int(v), __float_as_int(v), 0x141, 0xf, 0xf, true));
    return v;
}
__device__ __forceinline__ unsigned wave_umax(unsigned k, int lane) {
    unsigned o;
    o = (unsigned)__builtin_amdgcn_update_dpp((int)k, (int)k, 0xB1, 0xf, 0xf, true); k = k > o ? k : o;
    o = (unsigned)__builtin_amdgcn_update_dpp((int)k, (int)k, 0x4E, 0xf, 0xf, true); k = k > o ? k : o;
    o = (unsigned)__builtin_amdgcn_update_dpp((int)k, (int)k, 0x141, 0xf, 0xf, true); k = k > o ? k : o;
    o = (unsigned)__builtin_amdgcn_update_dpp((int)k, (int)k, 0x140, 0xf, 0xf, true); k = k > o ? k : o;
    o = (unsigned)shxi<16>((int)k, lane); k = k > o ? k : o;
    o = (unsigned)shxi<32>((int)k, lane); k = k > o ? k : o;
    return k;
}
__device__ __forceinline__ float wave_sum(float v, int lane) {
    v += shx<32>(v, lane); v += shx<16>(v, lane); v += shx<8>(v, lane); v += shx<4>(v, lane); v += shx<2>(v, lane); v += shx<1>(v, lane);
    return v;
}
__device__ __forceinline__ bf16x8 ldg8(const bf16_t* p) { return *(const GAS bf16x8*)p; }
__device__ __forceinline__ u32x4 ldg4u(const void* p) { return *(const GAS u32x4*)p; }
__device__ __forceinline__ u32x2 ldg2u(const void* p) { return *(const GAS u32x2*)p; }
__device__ __forceinline__ f32x4 ldg4f(const float* p) { return *(const GAS f32x4*)p; }
__device__ __forceinline__ void stg4u(void* p, u32x4 v) { *(GAS u32x4*)p = v; }
__device__ __forceinline__ void stg2u(void* p, u32x2 v) { *(GAS u32x2*)p = v; }
__device__ __forceinline__ void stg4f(float* p, f32x4 v) { *(GAS f32x4*)p = v; }

#define XB_TMO      128
#define XB_XCNT(j)  (256  + 64 * (j))
#define XB_XSUB(j)  (1280 + 64 * (j))
#define XB_XGEN(j)  (2304 + 64 * (j))
#define XB_TOP      3328
#define XB_TOPGEN   3392
#define XCD_BAR_WORDS 3456
#define XB_SPIN_CAP (1u << 18)
__device__ __forceinline__ unsigned xb_ld(unsigned* p)              { return __hip_atomic_load(p, __ATOMIC_RELAXED, __HIP_MEMORY_SCOPE_AGENT); }
__device__ __forceinline__ unsigned xb_add(unsigned* p, unsigned v) { return __hip_atomic_fetch_add(p, v, __ATOMIC_RELAXED, __HIP_MEMORY_SCOPE_AGENT); }
__device__ __forceinline__ unsigned xb_xcc_id() { return (unsigned)__builtin_amdgcn_s_getreg((3 << 11) | 20) & 0xFu; }
#define XB_SPIN(cond, bar) do { unsigned _sp = 0; while (cond) { __builtin_amdgcn_s_sleep(1); \
    if ((++_sp & 255u) == 0u) { if (xb_ld(&(bar)[XB_TMO])) break; if (_sp > XB_SPIN_CAP) { atomicAdd(&(bar)[XB_TMO], 1u); break; } } } } while (0)
constexpr int LDS_WTAB = 131072 + 12288;
__device__ __forceinline__ int tid_rebuild(const LAS unsigned char* lds) {
    const unsigned hw = (unsigned)__builtin_amdgcn_s_getreg((5 << 11) | 4) & 63u;
    const int wv = __builtin_amdgcn_readfirstlane(*(const LAS int*)(lds + LDS_WTAB + 4 * hw));
    int ln; asm volatile("v_mbcnt_lo_u32_b32 %0, -1, 0\n\tv_mbcnt_hi_u32_b32 %0, -1, %0" : "=v"(ln));
    return wv * 64 + ln;
}
struct XcdBarrier { unsigned* bar; unsigned x; volatile LAS unsigned* st; };
__device__ __forceinline__ XcdBarrier xcd_barrier_post(unsigned* bar, volatile LAS unsigned* st) {
    XcdBarrier b; b.bar = bar; b.x = xb_xcc_id(); b.st = st;
    if (tid_rebuild((const LAS unsigned char*)st - 131072) == 0) (void)xb_add(&bar[XB_XCNT(b.x)], 1u);
    return b;
}
__device__ __forceinline__ void xcd_barrier_complete(unsigned* bar, unsigned x, unsigned& nloc, unsigned& nx) {
    const unsigned G = gridDim.x * gridDim.y * gridDim.z;
    unsigned sum, cnt, mine, sp = 0u;
    for (;;) {
        sum = 0u; cnt = 0u; mine = 0u;
#pragma unroll
        for (unsigned j = 0; j < 16; ++j) { const unsigned c = xb_ld(&bar[XB_XCNT(j)]); sum += c; cnt += (c > 0u) ? 1u : 0u; mine = (j == x) ? c : mine; }
        if (sum == G) break;
        __builtin_amdgcn_s_sleep(1);
        if ((++sp & 255u) == 0u) { if (xb_ld(&bar[XB_TMO])) break; if (sp > XB_SPIN_CAP) { atomicAdd(&bar[XB_TMO], 1u); break; } }
    }
    nloc = mine > 0u ? mine : 1u; nx = cnt > 0u ? cnt : 1u;
}
__device__ __forceinline__ void xcd_barrier(const XcdBarrier& b) {
    asm volatile("s_waitcnt vmcnt(0)" ::: "memory");
    __syncthreads();
    if (tid_rebuild((const LAS unsigned char*)b.st - 131072) == 0) {
        unsigned* bar = b.bar;
        __builtin_amdgcn_s_waitcnt(0);
        unsigned nloc = b.st[0], nx = b.st[1];
        if (nloc == 0u) { xcd_barrier_complete(bar, b.x, nloc, nx); b.st[0] = nloc; b.st[1] = nx; }
        const unsigned old = xb_add(&bar[XB_XSUB(b.x)], 1u);
        const unsigned gen = old / nloc;
        if (old + 1u == (gen + 1u) * nloc) {
            __builtin_amdgcn_fence(__ATOMIC_RELEASE, "agent");
            asm volatile("s_waitcnt vmcnt(0)" ::: "memory");
            const unsigned og = xb_add(&bar[XB_TOP], 1u);
            const unsigned tg = og / nx;
            if (og + 1u == (tg + 1u) * nx) xb_add(&bar[XB_TOPGEN], 1u);
            else XB_SPIN(xb_ld(&bar[XB_TOPGEN]) == tg, bar);
            __builtin_amdgcn_fence(__ATOMIC_ACQUIRE, "agent");
            xb_add(&bar[XB_XGEN(b.x)], 1u);
            asm volatile("s_waitcnt vmcnt(0)" ::: "memory");
        } else {
            XB_SPIN(xb_ld(&bar[XB_XGEN(b.x)]) == gen, bar);
            __builtin_amdgcn_fence(__ATOMIC_ACQUIRE, "agent");
            asm volatile("s_waitcnt vmcnt(0)" ::: "memory");
        }
    }
    __syncthreads();
}

struct Params { const float* in[27]; float* out; unsigned char* ws; int step_lo, step_hi; };
struct Ctx { unsigned char* ws; float* out; LAS unsigned char* lds; int tid, bid, G; };
constexpr int LDS_PTAB = 131072 + 2048;
__device__ __forceinline__ unsigned long long uni64(unsigned long long v) {
    const unsigned lo = __builtin_amdgcn_readfirstlane((unsigned)v), hi = __builtin_amdgcn_readfirstlane((unsigned)(v >> 32)); return ((unsigned long long)hi << 32) | lo; }
__device__ __forceinline__ Ctx uni(Ctx X) { Ctx Y = X; int t = tid_rebuild(X.lds); asm volatile("" : "+v"(t)); Y.tid = t;
    unsigned long long w = (unsigned long long)X.ws; asm volatile("" : "+s"(w)); Y.ws = (unsigned char*)w;
    unsigned long long o = (unsigned long long)X.out; asm volatile("" : "+s"(o)); Y.out = (float*)o;
    int bb = blockIdx.x; asm volatile("" : "+s"(bb)); Y.bid = bb; int gg = gridDim.x; asm volatile("" : "+s"(gg)); Y.G = gg; return Y; }
__device__ __forceinline__ const float* ctx_in(const Ctx& X, int i) { return (const float*)uni64(*(const LAS unsigned long long*)(X.lds + LDS_PTAB + 8 * i)); }
#define INP(i) ctx_in(X, (i))
enum { I_X = 0, I_C, I_WADA, I_BADA, I_GMIX, I_GMOE, I_WIN, I_PEK, I_W1K, I_W2K, I_PEV, I_W1V, I_W2V, I_NQG, I_NKG, I_SQG, I_SKG, I_SINK,
       I_WBA, I_WBB, I_WBC, I_WOUT, I_WR, I_RB, I_WEG, I_WEU, I_WED };

#ifndef PRB_SEL
#define PRB_SEL 0
#endif
constexpr int CW_PRB = 7168;
#if PRB_SEL
#define PRB_DECL() unsigned long long prb_acc = 0ull, prb_t0 = 0ull; const unsigned long long prb_start = __builtin_readcyclecounter()
#define PRB_BEGIN(n) do { if ((n) == PRB_SEL) prb_t0 = __builtin_readcyclecounter(); } while (0)
#define PRB_END(n) do { if ((n) == PRB_SEL) prb_acc += __builtin_readcyclecounter() - prb_t0; } while (0)
#define PRB_FLUSH(X) do { if (((X).tid & 63) == 0) { unsigned* c_ = (unsigned*)((X).ws + WS_CTL); atomicAdd(c_ + CW_PRB, (unsigned)(prb_acc >> 8)); \
        atomicAdd(c_ + CW_PRB + 16, (unsigned)((__builtin_readcyclecounter() - prb_start) >> 8)); } } while (0)
#else
#define PRB_DECL() do {} while (0)
#define PRB_BEGIN(n) do {} while (0)
#define PRB_END(n) do {} while (0)
#define PRB_FLUSH(X) do {} while (0)
#endif

constexpr int CONV_PER_L = 576 + 768 + 256 + 256 + 256 + 8 + 4096 + 2048;
constexpr int CW_CVQ = 7680;
__device__ __forceinline__ void conv_tiles(const Ctx& X, LAS unsigned char* lds, int u0, int ustep, int uend) {
    unsigned char* ws = X.ws;
    const int tid = X.tid;
    LAS float* t32 = (LAS float*)lds;
    constexpr int PER_L = CONV_PER_L;
    const int lk = tid >> 3, lc8 = (tid & 7) * 8;
    const float* src = nullptr; const float* srcn = nullptr; bf16_t* dst = nullptr; bf16_t* dstn = nullptr; unsigned char* d8 = nullptr; unsigned char* d8n = nullptr;
    int src_ld = 0, dst_ld = 0, nvalid = 0, src_ldn = 0, dst_ldn = 0, nvalidn = 0;
    f32x4 va = (f32x4){0.f, 0.f, 0.f, 0.f}, vb = va, vna = va, vnb = va;
#define TDECODE(u, SRC, DST, SLD, DLD, NV, D8) do { \
            const int l = (u) / PER_L; int r = (u) % PER_L; NV = 64; D8 = nullptr; \
            if (r < 576) { const int n0 = (r / 16) * 64, k0 = (r % 16) * 64; int c0; \
                if (n0 < 896) c0 = n0; else if (n0 < 2176) c0 = n0 + 24; else if (n0 == 2176) { c0 = 896; NV = 24; } else { c0 = 0; NV = 0; } \
                SRC = INP(I_WIN) + ((size_t)l * 1024 + k0) * NIN + c0; SLD = NIN; DST = (bf16_t*)(ws + WS_WIN) + ((size_t)l * 2304 + n0) * 1024 + k0; DLD = 1024; } \
            else if ((r -= 576) < 768) { const int n0 = (r / 16) * 64, k0 = (r % 16) * 64; \
                SRC = INP(I_WIN) + ((size_t)l * 1024 + k0) * NIN + 2200 + n0; SLD = NIN; DST = (bf16_t*)(ws + WS_WM) + ((size_t)l * 3072 + n0) * 1024 + k0; DLD = 1024; \
                D8 = ws + WS_WM8 + ((size_t)l * 3072 + n0) * 1024 + k0; } \
            else if ((r -= 768) < 256) { const int n0 = (r / 16) * 64, k0 = (r % 16) * 64; \
                if (k0 < 512) SRC = INP(I_WBA) + ((size_t)l * 512 + k0) * 1024 + n0; \
                else if (k0 < 768) SRC = INP(I_WBB) + ((size_t)l * 256 + (k0 - 512)) * 1024 + n0; \
                else SRC = INP(I_WBC) + ((size_t)l * 256 + (k0 - 768)) * 1024 + n0; \
                SLD = 1024; DST = (bf16_t*)(ws + WS_WB) + ((size_t)l * 1024 + n0) * 1024 + k0; DLD = 1024; } \
            else if ((r -= 256) < 256) { const int n0 = (r / 16) * 64, k0 = (r % 16) * 64; \
                SRC = INP(I_WOUT) + ((size_t)l * 1024 + k0) * 1024 + n0; SLD = 1024; DST = (bf16_t*)(ws + WS_WO) + ((size_t)l * 1024 + n0) * 1024 + k0; DLD = 1024; } \
            else if ((r -= 256) < 256) { const int mat = r / 128, rr = r % 128, n0 = (rr / 32) * 64, k0 = (rr % 32) * 64; \
                SRC = INP(mat ? I_W1V : I_W1K) + ((size_t)l * 2048 + k0) * 256 + n0; SLD = 256; DST = (bf16_t*)(ws + WS_W1) + (((size_t)l * 2 + mat) * 256 + n0) * 2048 + k0; DLD = 2048; } \
            else if ((r -= 256) < 8) { const int mat = r / 4, k0 = (r % 4) * 64; \
                SRC = INP(mat ? I_W2V : I_W2K) + ((size_t)l * 256 + k0) * 64; SLD = 64; DST = (bf16_t*)(ws + WS_W2) + (((size_t)l * 2 + mat) * 64) * 256 + k0; DLD = 256; } \
            else if ((r -= 8) < 4096) { const int e = r / 256, rr = r % 256, n0 = (rr / 16) * 64, k0 = (rr % 16) * 64; \
                const int blk = n0 / 256, half = (n0 % 256) / 128, c0 = blk * 128 + (n0 % 128); \
                SRC = INP(half ? I_WEU : I_WEG) + (((size_t)l * 16 + e) * 1024 + k0) * 512 + c0; SLD = 512; DST = (bf16_t*)(ws + WS_WGU) + (((size_t)l * 16 + e) * 1024 + n0) * 1024 + k0; DLD = 1024; } \
            else { r -= 4096; const int e = r / 128, rr = r % 128, n0 = (rr / 8) * 64, k0 = (rr % 8) * 64; \
                SRC = INP(I_WED) + (((size_t)l * 16 + e) * 512 + k0) * 1024 + n0; SLD = 1024; DST = (bf16_t*)(ws + WS_WD) + (((size_t)l * 16 + e) * 1024 + n0) * 512 + k0; DLD = 512; } \
    } while (0)
#define TLOAD(SRC, SLD, NV, A, B) do { if (lc8 + 8 <= (NV)) { A = ldg4f((SRC) + (size_t)lk * (SLD) + lc8); B = ldg4f((SRC) + (size_t)lk * (SLD) + lc8 + 4); } \
            else { A = (f32x4){0.f, 0.f, 0.f, 0.f}; B = A; } } while (0)
    int u = u0;
    if (u < uend) { TDECODE(u, src, dst, src_ld, dst_ld, nvalid, d8); TLOAD(src, src_ld, nvalid, va, vb); }
    while (u < uend) {
        const int un = u + ustep;
        if (un < uend) { TDECODE(un, srcn, dstn, src_ldn, dst_ldn, nvalidn, d8n); TLOAD(srcn, src_ldn, nvalidn, vna, vnb); }
        {
            LAS float* w = t32 + lk * 65 + lc8;
            w[0] = va[0]; w[1] = va[1]; w[2] = va[2]; w[3] = va[3]; w[4] = vb[0]; w[5] = vb[1]; w[6] = vb[2]; w[7] = vb[3];
        }
        __syncthreads();
        {
            const int n = tid >> 3, k8 = (tid & 7) * 8;
            const LAS float* r_ = t32 + k8 * 65 + n;
            u32x4 o;
            o[0] = cvt_pk_bf16(r_[0 * 65], r_[1 * 65]); o[1] = cvt_pk_bf16(r_[2 * 65], r_[3 * 65]);
            o[2] = cvt_pk_bf16(r_[4 * 65], r_[5 * 65]); o[3] = cvt_pk_bf16(r_[6 * 65], r_[7 * 65]);
            stg4u(dst + (size_t)n * dst_ld + k8, o);
            if (d8 != nullptr) { u32x2 o8; int w8 = 0;
                w8 = __builtin_amdgcn_cvt_pk_fp8_f32(64.f * r_[0 * 65], 64.f * r_[1 * 65], w8, false); w8 = __builtin_amdgcn_cvt_pk_fp8_f32(64.f * r_[2 * 65], 64.f * r_[3 * 65], w8, true); o8[0] = (unsigned)w8; w8 = 0;
                w8 = __builtin_amdgcn_cvt_pk_fp8_f32(64.f * r_[4 * 65], 64.f * r_[5 * 65], w8, false); w8 = __builtin_amdgcn_cvt_pk_fp8_f32(64.f * r_[6 * 65], 64.f * r_[7 * 65], w8, true); o8[1] = (unsigned)w8;
                stg2u(d8 + (size_t)n * 1024 + k8, o8); }
        }
        __syncthreads();
        u = un; src = srcn; dst = dstn; src_ld = src_ldn; dst_ld = dst_ldn; nvalid = nvalidn; va = vna; vb = vnb; d8 = d8n;
    }
#undef TDECODE
#undef TLOAD
}
__device__ __forceinline__ void conv_fill(const Ctx& X, LAS unsigned char* lds, int l, int max_batches, bool drain) {
    if (l >= NL) return;
    unsigned* q = (unsigned*)(X.ws + WS_CTL) + CW_CVQ + 16 * l;
    LAS int* bc = (LAS int*)(lds + LDS_MISC + 32);
    for (int b = 0; drain || b < max_batches; ++b) {
        if (X.tid == 0) bc[0] = (int)atomicAdd(q, 4u);
        __syncthreads();
        const int idx0 = bc[0];
        __syncthreads();
        if (idx0 >= CONV_PER_L) break;
        const int iend = (idx0 + 4 < CONV_PER_L) ? idx0 + 4 : CONV_PER_L;
        conv_tiles(X, lds, l * CONV_PER_L + idx0, 1, l * CONV_PER_L + iend);
    }
}

__device__ __forceinline__ void p0_prologue(const Ctx& X, LAS unsigned char* lds) {
    unsigned char* ws = X.ws;
    const int tid = X.tid, G = X.G, bid = X.bid;
    {
        const int lane = tid & 63, wave = tid >> 6;
        LAS float* sc = (LAS float*)lds;
        LAS float* red = (LAS float*)(lds + 8192);
        for (int i = tid; i < 2048; i += 512) { const float cv = INP(I_C)[i]; sc[i] = cv * sigmoidf_(cv); }
        __syncthreads();
        for (int u = bid; u < 256; u += G) {
            const int l = u >> 6, j0 = (u & 63) * 96;
            f32x4 a0 = (f32x4){0.f, 0.f, 0.f, 0.f}, a1 = a0;
            if (lane < 24) {
                const float* w = INP(I_WADA) + (size_t)l * 1024 * 6144 + j0 + 4 * lane;
#pragma unroll 8
                for (int k = wave * 128; k < wave * 128 + 128; ++k) { const f32x4 wv = ldg4f(w + (size_t)k * 6144); a0 += wv * sc[k]; a1 += wv * sc[1024 + k]; }
#pragma unroll
                for (int j = 0; j < 4; ++j) { red[(wave * 2 + 0) * 96 + 4 * lane + j] = a0[j]; red[(wave * 2 + 1) * 96 + 4 * lane + j] = a1[j]; }
            }
            __syncthreads();
            if (tid < 192) {
                const int b = tid / 96, j = tid % 96; float sm = 0.f;
#pragma unroll
                for (int w = 0; w < 8; ++w) sm += red[(w * 2 + b) * 96 + j];
                ((float*)(ws + WS_MOD))[((size_t)l * 2 + b) * 6144 + j0 + j] = sm + INP(I_BADA)[l * 6144 + j0 + j];
            }
            __syncthreads();
        }
        for (int u = bid; u < 256; u += G) {
            const int l = u >> 6, mat = (u >> 5) & 1, cc = u & 31;
            const float* pe = INP(mat ? I_PEV : I_PEK) + (size_t)l * 2048;
            const float* w = INP(mat ? I_W1V : I_W1K) + (size_t)l * 2048 * 256 + cc * 8 + (lane & 1) * 4;
            f32x4 a = (f32x4){0.f, 0.f, 0.f, 0.f};
#pragma unroll
            for (int it = 0; it < 8; ++it) { const int row = wave * 256 + it * 32 + (lane >> 1); a += ldg4f(w + (size_t)row * 256) * pe[row]; }
#pragma unroll
            for (int j = 0; j < 4; ++j) { float v = a[j]; v += shx<2>(v, lane); v += shx<4>(v, lane); v += shx<8>(v, lane); v += shx<16>(v, lane); v += shx<32>(v, lane); a[j] = v; }
            if (lane < 2) {
#pragma unroll
                for (int j = 0; j < 4; ++j) red[wave * 8 + lane * 4 + j] = a[j];
            }
            __syncthreads();
            if (tid < 8) { float sm = 0.f;
#pragma unroll
                for (int w2 = 0; w2 < 8; ++w2) sm += red[w2 * 8 + tid];
                ((float*)(ws + WS_CB))[(l * 2 + mat) * 256 + cc * 8 + tid] = sm; }
            __syncthreads();
        }
    }
    __syncthreads();
    conv_tiles(X, lds, bid, G, CONV_PER_L);
}

template <int N> struct IC { static constexpr int value = N; };
template <int MODE>
__device__ __forceinline__ void norm_phase(const Ctx& X, LAS unsigned char* lds, int layer) {
    unsigned char* ws = X.ws;
    const int tid = X.tid, lane = tid & 63, wave = tid >> 6, G = X.G;
    const float* xsrc = INP(I_X);
    float* xdst = X.out;
    bf16_t* xb = (bf16_t*)(ws + WS_XB);
    const float* modl = (const float*)(ws + WS_MOD) + (size_t)layer * 2 * 6144;
    const float* modp = (const float*)(ws + WS_MOD) + (size_t)(layer - 1) * 2 * 6144;
    const bf16_t* yb = (const bf16_t*)(ws + WS_YS);
    const u32x4* tinfo = (const u32x4*)(ws + WS_TINFO);
    LAS int* tpad = (LAS int*)(lds + LDS_MISC + 1024);
    LAS int* ttmp = (LAS int*)(lds + LDS_MISC + 1088);
    bf16_t* h = (bf16_t*)(ws + WS_H);
    const float* gn = INP(MODE == 2 ? I_GMOE : I_GMIX) + (size_t)layer * 1024;
    const int sh_off = (MODE == 2) ? 3072 : 0, sc_off = (MODE == 2) ? 4096 : 1024;
    LAS float* wrT = (LAS float*)lds;
    LAS int* lcnt = (LAS int*)(lds + LDS_MISC + 64);
    LAS int* lbase = (LAS int*)(lds + LDS_MISC + 128);
    LAS float* lgl = (LAS float*)(lds + 65536);
    if (MODE == 2) {
        for (int i = tid; i < 16384; i += 512) { const int k = i >> 4, e = i & 15; wrT[e * 1024 + k] = INP(I_WR)[i]; }
        if (tid < 16) lcnt[tid] = 0;
        __syncthreads();
    }
    if (MODE == 1 || MODE == 3) {
        const unsigned* gcnt = (const unsigned*)(ws + WS_CTL) + CW_GCNT + 16 * ((layer - 1) * 16);
        if (tid < 16) ttmp[tid] = (((int)__hip_atomic_load(gcnt + 16 * tid, __ATOMIC_RELAXED, __HIP_MEMORY_SCOPE_AGENT) + 255) >> 8) * 256;
        __syncthreads();
        if (tid < 16) { int p = 0; for (int k = 0; k < tid; ++k) p += ttmp[k]; tpad[tid] = p; }
        __syncthreads();
    }
    int it = 0; (void)it;
    const int stride = G * 8, r0 = X.bid * 8 + wave;
    f32x4 vn[2][4]; u32x2 xbn[2][4], y0n[2][4], y1n[2][4]; float w0n[2] = {0.f, 0.f}, w1n[2] = {0.f, 0.f}; u32x4 tin[2] = {(u32x4){0u, 0u, 0u, 0u}, (u32x4){0u, 0u, 0u, 0u}};
#define NORM_LOAD(S, r) do { size_t yr0_ = 0, yr1_ = 0; \
        if (MODE == 1 || MODE == 3) { const unsigned a0_ = __builtin_amdgcn_readfirstlane(tin[S][0]), a1_ = __builtin_amdgcn_readfirstlane(tin[S][2]); \
            w0n[S] = __uint_as_float(__builtin_amdgcn_readfirstlane(tin[S][1])); w1n[S] = __uint_as_float(__builtin_amdgcn_readfirstlane(tin[S][3])); \
            yr0_ = (size_t)(__builtin_amdgcn_readfirstlane(tpad[a0_ & 15u]) + (int)(a0_ >> 4)) * 1024; yr1_ = (size_t)(__builtin_amdgcn_readfirstlane(tpad[a1_ & 15u]) + (int)(a1_ >> 4)) * 1024; } \
        _Pragma("unroll") for (int i = 0; i < 4; ++i) { const int col_ = 4 * (lane + 64 * i); \
        if (MODE == 0 || MODE == 2) vn[S][i] = ldg4f(xsrc + (size_t)(r) * 1024 + col_); \
        if (MODE == 1 || MODE == 3) { xbn[S][i] = ldg2u(xb + (size_t)(r) * 1024 + col_); y0n[S][i] = ldg2u(yb + yr0_ + col_); y1n[S][i] = ldg2u(yb + yr1_ + col_); } } } while (0)
    if (MODE == 1 || MODE == 3) { if (r0 < NTOK) tin[0] = ldg4u(tinfo + (r0)); if (r0 + stride < NTOK) tin[1] = ldg4u(tinfo + (r0 + stride)); }
    if (r0 < NTOK) { NORM_LOAD(0, r0); if ((MODE == 1 || MODE == 3) && r0 + 2 * stride < NTOK) tin[0] = ldg4u(tinfo + (r0 + 2 * stride)); }
    if (r0 + stride < NTOK) { NORM_LOAD(1, r0 + stride); if ((MODE == 1 || MODE == 3) && r0 + 3 * stride < NTOK) tin[1] = ldg4u(tinfo + (r0 + 3 * stride)); }
    int bcur = -1; f32x4 gmv[4], gscv[4], shv4[4];
    auto body = [&](auto SC, const int row) __attribute__((always_inline)) {
        constexpr int S = decltype(SC)::value;
        const int b = row >> 14;
        if (b != bcur) {
            bcur = b;
#pragma unroll
            for (int i = 0; i < 4; ++i) { const int col = 4 * (lane + 64 * i);
                if (MODE == 1 || MODE == 3) gmv[i] = ldg4f(modp + b * 6144 + 5120 + col);
                if (MODE != 3) { const f32x4 g = ldg4f(gn + col), sc = ldg4f(modl + b * 6144 + sc_off + col); gscv[i] = g * (1.f + sc); shv4[i] = ldg4f(modl + b * 6144 + sh_off + col); } }
        }
        f32x4 v[4];
#pragma unroll
        for (int i = 0; i < 4; ++i) {
            if (MODE == 1 || MODE == 3) {
                const u32x2 xq = xbn[S][i], y0 = y0n[S][i], y1 = y1n[S][i]; const f32x4 g = gmv[i]; const float w0c = w0n[S], w1c = w1n[S];
                v[i][0] = bf_lo(xq[0]) + g[0] * (w0c * bf_lo(y0[0]) + w1c * bf_lo(y1[0])); v[i][1] = bf_hi(xq[0]) + g[1] * (w0c * bf_hi(y0[0]) + w1c * bf_hi(y1[0]));
                v[i][2] = bf_lo(xq[1]) + g[2] * (w0c * bf_lo(y0[1]) + w1c * bf_lo(y1[1])); v[i][3] = bf_hi(xq[1]) + g[3] * (w0c * bf_hi(y0[1]) + w1c * bf_hi(y1[1]));
            } else v[i] = vn[S][i];
        }
        asm volatile("" ::: "memory");
        if (row + 2 * stride < NTOK) { NORM_LOAD(S, row + 2 * stride); if ((MODE == 1 || MODE == 3) && row + 4 * stride < NTOK) tin[S] = ldg4u(tinfo + (row + 4 * stride)); }
        asm volatile("" ::: "memory");
#pragma unroll
        for (int i = 0; i < 4; ++i) {
            const int col = 4 * (lane + 64 * i);
#if PRB_SEL
            if (MODE == 3) { const unsigned* c_ = (const unsigned*)(ws + WS_CTL); const float fr_ = (float)c_[CW_PRB] / fmaxf((float)c_[CW_PRB + 16], 1.f);
                v[i] *= 1.f + sqrtf(0.02f + 0.5f * fr_); }
#endif
            if (MODE == 3) stg4f(xdst + (size_t)row * 1024 + col, v[i]);
            else { u32x2 o; o[0] = cvt_pk_bf16(v[i][0], v[i][1]); o[1] = cvt_pk_bf16(v[i][2], v[i][3]); stg2u(xb + (size_t)row * 1024 + col, o); }
        }
        if (MODE == 3) return;
        float ss = 0.f;
#pragma unroll
        for (int i = 0; i < 4; ++i) ss += v[i][0] * v[i][0] + v[i][1] * v[i][1] + v[i][2] * v[i][2] + v[i][3] * v[i][3];
        ss = wave_sum(ss, lane);
        const float rinv = rsqrtf(ss * (1.f / 1024.f) + 1e-6f);
#pragma unroll
        for (int i = 0; i < 4; ++i) {
            const int col = 4 * (lane + 64 * i);
            f32x4 hv;
#pragma unroll
            for (int j = 0; j < 4; ++j) hv[j] = v[i][j] * rinv * gscv[i][j] + shv4[i][j];
            u32x2 o; o[0] = cvt_pk_bf16(hv[0], hv[1]); o[1] = cvt_pk_bf16(hv[2], hv[3]);
            stg2u(h + (size_t)row * 1024 + col, o);
            { int w8 = 0; w8 = __builtin_amdgcn_cvt_pk_fp8_f32(hv[0], hv[1], w8, false); w8 = __builtin_amdgcn_cvt_pk_fp8_f32(hv[2], hv[3], w8, true);
              *(GAS int*)(ws + WS_H8 + (size_t)row * 1024 + col) = w8; }
        }
    };
    for (int rowp = r0; rowp < NTOK; rowp += 2 * stride) { body(IC<0>{}, rowp); if (rowp + stride < NTOK) body(IC<1>{}, rowp + stride); }
#undef NORM_LOAD
    if (MODE == 2) {
        __syncthreads();
        const int slot = tid, srow = X.bid * 8 + (slot & 7) + (slot >> 3) * G * 8;
        const bool have = (slot < 512) && (srow < NTOK) && ((slot >> 3) < 64);
        int e0 = 0, e1 = 0, r0 = 0, r1i = 0; float w0 = 0.f, w1 = 0.f;
        if (have) {
            float sco[16], sel[16];
            f32x4 rb4[4];
#pragma unroll
            for (int q = 0; q < 4; ++q) rb4[q] = ldg4f(INP(I_RB) + 4 * q);
#pragma unroll
            for (int q = 0; q < 4; ++q) { const f32x4 lg4 = *(const LAS f32x4*)(lgl + slot * 16 + 4 * q);
#pragma unroll
                for (int j = 0; j < 4; ++j) { const int e = 4 * q + j; sco[e] = 1.f / (1.f + __expf(-lg4[j])); sel[e] = sco[e] + rb4[q][j]; } }
            float gs[4];
#pragma unroll
            for (int g = 0; g < 4; ++g) {
                const float a = sel[4 * g], bq = sel[4 * g + 1], c = sel[4 * g + 2], d = sel[4 * g + 3];
                const float m1 = fmaxf(fmaxf(a, bq), fmaxf(c, d));
                int i1 = (a == m1) ? 0 : (bq == m1) ? 1 : (c == m1) ? 2 : 3;
                float m2 = -3.0e38f;
                m2 = (i1 != 0) ? fmaxf(m2, a) : m2; m2 = (i1 != 1) ? fmaxf(m2, bq) : m2; m2 = (i1 != 2) ? fmaxf(m2, c) : m2; m2 = (i1 != 3) ? fmaxf(m2, d) : m2;
                gs[g] = m1 + m2;
            }
            int gi = 0; float gb = gs[0];
#pragma unroll
            for (int g = 1; g < 4; ++g) if (gs[g] > gb) { gb = gs[g]; gi = g; }
            float s0 = (gi == 0) ? sel[0] : (gi == 1) ? sel[4] : (gi == 2) ? sel[8] : sel[12];
            float s1 = (gi == 0) ? sel[1] : (gi == 1) ? sel[5] : (gi == 2) ? sel[9] : sel[13];
            float s2 = (gi == 0) ? sel[2] : (gi == 1) ? sel[6] : (gi == 2) ? sel[10] : sel[14];
            float s3 = (gi == 0) ? sel[3] : (gi == 1) ? sel[7] : (gi == 2) ? sel[11] : sel[15];
            float c0 = (gi == 0) ? sco[0] : (gi == 1) ? sco[4] : (gi == 2) ? sco[8] : sco[12];
            float c1 = (gi == 0) ? sco[1] : (gi == 1) ? sco[5] : (gi == 2) ? sco[9] : sco[13];
            float c2 = (gi == 0) ? sco[2] : (gi == 1) ? sco[6] : (gi == 2) ? sco[10] : sco[14];
            float c3 = (gi == 0) ? sco[3] : (gi == 1) ? sco[7] : (gi == 2) ? sco[11] : sco[15];
            const float m1 = fmaxf(fmaxf(s0, s1), fmaxf(s2, s3));
            const int i1 = (s0 == m1) ? 0 : (s1 == m1) ? 1 : (s2 == m1) ? 2 : 3;
            float m2 = -3.0e38f;
            m2 = (i1 != 0) ? fmaxf(m2, s0) : m2; m2 = (i1 != 1) ? fmaxf(m2, s1) : m2; m2 = (i1 != 2) ? fmaxf(m2, s2) : m2; m2 = (i1 != 3) ? fmaxf(m2, s3) : m2;
            const int i2 = (i1 != 0 && s0 == m2) ? 0 : (i1 != 1 && s1 == m2) ? 1 : (i1 != 2 && s2 == m2) ? 2 : 3;
            const float w1v = (i1 == 0) ? c0 : (i1 == 1) ? c1 : (i1 == 2) ? c2 : c3;
            const float w2v = (i2 == 0) ? c0 : (i2 == 1) ? c1 : (i2 == 2) ? c2 : c3;
            const float wn = 1.f / (w1v + w2v);
            e0 = gi * 4 + i1; e1 = gi * 4 + i2; w0 = w1v * wn; w1 = w2v * wn;
            r0 = __hip_atomic_fetch_add(lcnt + e0, 1, __ATOMIC_RELAXED, __HIP_MEMORY_SCOPE_WORKGROUP); r1i = __hip_atomic_fetch_add(lcnt + e1, 1, __ATOMIC_RELAXED, __HIP_MEMORY_SCOPE_WORKGROUP);
        }
        __syncthreads();
        unsigned* gcnt = (unsigned*)(ws + WS_CTL) + CW_GCNT + 16 * (layer * 16);
        if (tid < 16) lbase[tid] = (int)atomicAdd(gcnt + 16 * tid, (unsigned)lcnt[tid]);
        __syncthreads();
        if (have) {
            int* lt = (int*)(ws + WS_LISTT); float* lw = (float*)(ws + WS_LISTW);
            const int p0 = lbase[e0] + r0, p1 = lbase[e1] + r1i;
            lt[e0 * LCAP + p0] = srow * 2; lw[e0 * LCAP + p0] = w0;
            lt[e1 * LCAP + p1] = srow * 2 + 1; lw[e1 * LCAP + p1] = w1;
        }
    }
    __syncthreads();
}

constexpr int BM = 256, BK = 64, HALF = 128, HTB = HALF * BK * 2, STAGE_BYTES = 8 * HTB;
__host__ __device__ __forceinline__ int lds_byte(int r, int c) { const int st = (r >> 4) * 2 + (c >> 5), rr = r & 15, cc = c & 31, ob = rr * 64 + cc * 2; return st * 1024 + (ob ^ (((ob >> 9) & 1) << 5)); }
__host__ __device__ __forceinline__ void stage_rc(int b, int& R, int& C) { const int st = b / 1024, sb = b % 1024, swz = sb ^ (((sb >> 9) & 1) << 5); R = (st >> 1) * 16 + swz / 64; C = (st & 1) * 32 + (swz % 64) / 2; }
__host__ __device__ __forceinline__ int perm32(int rho) { const int n = rho >> 4, i = rho & 15; return 8 * (i >> 2) + 4 * n + (i & 3); }

struct GU { const char* A; const char* B; int nt, kind, pm, pn, e, aux; };
typedef int i32x8 __attribute__((ext_vector_type(8)));
typedef int i32x4_ __attribute__((ext_vector_type(4)));

__device__ __forceinline__ bool tile_map(long L, int nM, int nN, int& pm, int& pn) {
    const int nwg = nM * nN; if (L >= nwg) return false;
    int wgid = (int)L; { const int q = nwg / 8, r = nwg % 8, xcd = wgid % 8, off = wgid / 8; wgid = (xcd < r ? xcd * (q + 1) : r * (q + 1) + (xcd - r) * q) + off; }
    const int nig = 8 * nN, gid = wgid / nig, fm = gid * 8, gsz = (nM - fm) < 8 ? (nM - fm) : 8;
    pm = fm + ((wgid % nig) % gsz); pn = (wgid % nig) / gsz; return true;
}

template <class Epi, class Sched>
__device__ __forceinline__ void gemm_run(LAS unsigned char* lds, const Sched& S, const Epi& E, const int tid) {
    const int wid = __builtin_amdgcn_readfirstlane(tid >> 6), lane = tid & 63, wr = wid >> 2, wc = wid & 3, fr = lane & 15, fq = lane >> 4;
    unsigned vA[2][2], vAn[2][2], voffB[2];
#pragma unroll
    for (int i = 0; i < 2; ++i) { int R, C; stage_rc(tid * 16 + i * 8192, R, C); const int Rb = Epi::HEADMAP ? ((R >> 5) * 64 + perm32(R & 31)) : (Epi::PERM ? ((R & ~31) + perm32(R & 31)) : R);
        voffB[i] = (unsigned)Rb * (unsigned)S.ldb2 + (unsigned)C * 2u;
        vA[0][i] = (unsigned)R * (unsigned)S.lda2 + (unsigned)C * 2u; vA[1][i] = (unsigned)(R + HALF) * (unsigned)S.lda2 + (unsigned)C * 2u;
        vAn[0][i] = vA[0][i]; vAn[1][i] = vA[1][i]; }
    const size_t akstep = (size_t)S.akstep, bkstep = (size_t)(BK * 2), hstepB = (size_t)(Epi::HEADMAP ? 32 : HALF) * S.ldb2;
    const unsigned ldsw = (unsigned)wid * 1024u;
    const int aoff = lds_byte(wr * 64 + fr, fq * 8), boff = lds_byte(wc * 32 + fr, fq * 8);
    unsigned voffB8[2] = {0u, 0u}; size_t hstepB8 = 0;
    int aoff8a = 0, aoff8b = 0, boff8a = 0, boff8b = 0;
    if (Sched::FP8) {
#pragma unroll
        for (int i = 0; i < 2; ++i) { int R, C; stage_rc(tid * 16 + i * 8192, R, C); const int Rb = Epi::PERM ? ((R & ~31) + perm32(R & 31)) : R; voffB8[i] = (unsigned)Rb * (unsigned)(S.ldb2 / 2) + (unsigned)C * 2u; }
        hstepB8 = (size_t)HALF * (S.ldb2 / 2);
        aoff8a = aoff; aoff8b = aoff + 1024; boff8a = boff; boff8b = boff + 1024;
    }
#define G_SA(b, h) (((b) * 2 + (h)) * HTB)
#define G_SB(b, h) ((4 + (b) * 2 + (h)) * HTB)
#define G_STAGE2(bufoff, gbase, o0, o1) do { \
        __builtin_amdgcn_global_load_lds((const unsigned*)((const char*)(gbase) + (o0)), (LAS unsigned*)(lds + (bufoff) + ldsw), 16, 0, 0); \
        __builtin_amdgcn_global_load_lds((const unsigned*)((const char*)(gbase) + (o1)), (LAS unsigned*)(lds + (bufoff) + ldsw + 8192), 16, 0, 0); } while (0)
#define G_STAGE_B(bufoff, gbase) G_STAGE2(bufoff, gbase, voffB[0], voffB[1])
#define G_LDA(dst, b, h) do { _Pragma("unroll") for (int m = 0; m < 4; ++m) _Pragma("unroll") for (int k = 0; k < 2; ++k) dst[m][k] = *(const LAS bf16x8*)(lds + G_SA(b, h) + aoff + m * 2048 + k * 1024); } while (0)
#define G_LDB(dst, b, h) do { _Pragma("unroll") for (int n = 0; n < 2; ++n) _Pragma("unroll") for (int k = 0; k < 2; ++k) dst[n][k] = *(const LAS bf16x8*)(lds + G_SB(b, h) + boff + n * 2048 + k * 1024); } while (0)
#define G_MMA(ai, bj, At, Bt) do { __builtin_amdgcn_s_setprio(1); _Pragma("unroll") for (int m = 0; m < 4; ++m) _Pragma("unroll") for (int n = 0; n < 2; ++n) _Pragma("unroll") for (int k = 0; k < 2; ++k) \
        acc[ai][bj][m][n] = __builtin_amdgcn_mfma_f32_16x16x32_bf16(Bt[n][k], At[m][k], acc[ai][bj][m][n], 0, 0, 0); __builtin_amdgcn_s_setprio(0); } while (0)
#define G_RD8(dst, base, oa, ob) do { const u32x4 lo_ = *(const LAS u32x4*)(lds + (base) + (oa)), hi_ = *(const LAS u32x4*)(lds + (base) + (ob)); \
        dst[0] = (int)lo_[0]; dst[1] = (int)lo_[1]; dst[2] = (int)lo_[2]; dst[3] = (int)lo_[3]; dst[4] = (int)hi_[0]; dst[5] = (int)hi_[1]; dst[6] = (int)hi_[2]; dst[7] = (int)hi_[3]; } while (0)
#define G_LDA8(dst, b, h) do { _Pragma("unroll") for (int m = 0; m < 4; ++m) G_RD8(dst[m], G_SA(b, h) + m * 2048, aoff8a, aoff8b); } while (0)
#define G_LDB8(dst, b, h) do { _Pragma("unroll") for (int n = 0; n < 2; ++n) G_RD8(dst[n], G_SB(b, h) + n * 2048, boff8a, boff8b); } while (0)
#define G_MMA8(ai, bj, At, Bt) do { __builtin_amdgcn_s_setprio(1); _Pragma("unroll") for (int m = 0; m < 4; ++m) _Pragma("unroll") for (int n = 0; n < 2; ++n) \
        asm volatile("v_mfma_scale_f32_16x16x128_f8f6f4 %0, %1, %2, %0, %3, %3 op_sel_hi:[0,0,0]" : "+v"(acc[ai][bj][m][n]) : "v"(Bt[n]), "v"(At[m]), "v"(sc1_)); __builtin_amdgcn_s_setprio(0); } while (0)
#define G_WAIT_V(n) asm volatile("s_waitcnt vmcnt(" #n ")" ::: "memory")
#define G_WAIT_L(n) asm volatile("s_waitcnt lgkmcnt(" #n ")" ::: "memory")
#define G_BAR __builtin_amdgcn_s_barrier()
#define G_SCHED __builtin_amdgcn_sched_barrier(0)
    GU cur, nxt; int ui = 0;
    if (!S.next(0, cur)) return;
    if (Sched::GATHER) S.rowoff(cur, tid, vA);
    f32x4 acc[2][2][4][2];
#pragma unroll
    for (int a = 0; a < 2; ++a)
#pragma unroll
        for (int b = 0; b < 2; ++b)
#pragma unroll
            for (int m = 0; m < 4; ++m)
#pragma unroll
                for (int n = 0; n < 2; ++n) acc[a][b][m][n] = (f32x4){0.f, 0.f, 0.f, 0.f};
    bf16x8 At[4][2], B0[2][2], B1[2][2];
    i32x8 At8[4], B08[2], B18[2]; int sc1_ = 0x7f7f7f7f; asm volatile("" : "+v"(sc1_));
    const char* cA = cur.A; const char* cB = cur.B;
    { constexpr bool f8 = Sched::FP8; const unsigned p0 = f8 ? voffB8[0] : voffB[0], p1 = f8 ? voffB8[1] : voffB[1]; const size_t hs = f8 ? hstepB8 : hstepB;
      G_STAGE2(G_SB(0, 0), cB, p0, p1); G_STAGE2(G_SA(0, 0), cA, vA[0][0], vA[0][1]); G_STAGE2(G_SB(0, 1), cB + hs, p0, p1); G_STAGE2(G_SA(0, 1), cA, vA[1][0], vA[1][1]);
      if (wr == 1) G_BAR;
      G_WAIT_V(4); G_BAR;
      G_STAGE2(G_SB(1, 0), cB + bkstep, p0, p1); G_STAGE2(G_SA(1, 0), cA + akstep, vA[0][0], vA[0][1]); G_STAGE2(G_SB(1, 1), cB + hs + bkstep, p0, p1);
      G_WAIT_V(6); G_BAR; }
    for (;;) {
        const bool has_next = S.next(ui + 1, nxt);
        const char* nA = has_next ? nxt.A : cA; const char* nB = has_next ? nxt.B : cB;
        if (Sched::GATHER) { if (has_next) S.rowoff(nxt, tid, vAn); else {
#pragma unroll
            for (int h = 0; h < 2; ++h) { vAn[h][0] = vA[h][0]; vAn[h][1] = vA[h][1]; } } }
        const int nt = cur.nt;
        constexpr bool c8 = Sched::FP8, n8 = Sched::FP8;
        const unsigned obc0 = c8 ? voffB8[0] : voffB[0], obc1 = c8 ? voffB8[1] : voffB[1], obn0 = n8 ? voffB8[0] : voffB[0], obn1 = n8 ? voffB8[1] : voffB[1];
        const size_t hsc = c8 ? hstepB8 : hstepB, hsn = n8 ? hstepB8 : hstepB;
        for (int t = 0; t < nt; t += 2) {
            const bool last = (t == nt - 2);
            const char* a1 = cA + (size_t)(t + 1) * akstep;
            const char* a2 = last ? nA : cA + (size_t)(t + 2) * akstep; const char* b2 = last ? nB : cB + (size_t)(t + 2) * bkstep;
            const char* a3 = a2 + akstep; const char* b3 = b2 + bkstep;
            const unsigned ob0 = last ? obn0 : obc0, ob1 = last ? obn1 : obc1; const size_t hsx = last ? hsn : hsc;
            unsigned w00, w01, w10, w11;
            if (Sched::GATHER) { w00 = last ? vAn[0][0] : vA[0][0]; w01 = last ? vAn[0][1] : vA[0][1]; w10 = last ? vAn[1][0] : vA[1][0]; w11 = last ? vAn[1][1] : vA[1][1]; }
            else { w00 = vA[0][0]; w01 = vA[0][1]; w10 = vA[1][0]; w11 = vA[1][1]; }
            if constexpr (c8) {
            G_LDB8(B08, 0, 0); G_SCHED; G_LDA8(At8, 0, 0); G_STAGE2(G_SA(1, 1), a1, vA[1][0], vA[1][1]);
            G_WAIT_L(8); G_BAR; G_WAIT_L(0); G_MMA8(0, 0, At8, B08); G_BAR; G_SCHED;
            G_LDB8(B18, 0, 1); G_STAGE2(G_SB(0, 0), b2, ob0, ob1);
            G_BAR; G_WAIT_L(0); G_MMA8(0, 1, At8, B18); G_BAR;
            G_LDA8(At8, 0, 1); G_STAGE2(G_SA(0, 0), a2, w00, w01);
            G_BAR; G_WAIT_L(0); G_MMA8(1, 0, At8, B08); G_BAR; G_SCHED;
            G_STAGE2(G_SB(0, 1), b2 + hsx, ob0, ob1);
            G_WAIT_V(6); G_BAR; G_MMA8(1, 1, At8, B18); G_BAR;
            G_LDB8(B08, 1, 0); G_SCHED; G_LDA8(At8, 1, 0); G_STAGE2(G_SA(0, 1), a2, w10, w11);
            G_WAIT_L(8); G_BAR; G_WAIT_L(0); G_MMA8(0, 0, At8, B08); G_BAR; G_SCHED;
            G_LDB8(B18, 1, 1); G_STAGE2(G_SB(1, 0), b3, ob0, ob1);
            G_BAR; G_WAIT_L(0); G_MMA8(0, 1, At8, B18); G_BAR;
            G_LDA8(At8, 1, 1); G_STAGE2(G_SA(1, 0), a3, w00, w01);
            G_BAR; G_WAIT_L(0); G_MMA8(1, 0, At8, B08); G_BAR; G_SCHED;
            G_STAGE2(G_SB(1, 1), b3 + hsx, ob0, ob1);
            G_WAIT_V(6); G_BAR; G_MMA8(1, 1, At8, B18); G_BAR;
            } else {
            G_LDB(B0, 0, 0); G_SCHED; G_LDA(At, 0, 0); G_STAGE2(G_SA(1, 1), a1, vA[1][0], vA[1][1]);
            G_WAIT_L(8); G_BAR; G_WAIT_L(0); G_MMA(0, 0, At, B0); G_BAR; G_SCHED;
            G_LDB(B1, 0, 1); G_STAGE2(G_SB(0, 0), b2, ob0, ob1);
            G_BAR; G_WAIT_L(0); G_MMA(0, 1, At, B1); G_BAR;
            G_LDA(At, 0, 1); G_STAGE2(G_SA(0, 0), a2, w00, w01);
            G_BAR; G_WAIT_L(0); G_MMA(1, 0, At, B0); G_BAR; G_SCHED;
            G_STAGE2(G_SB(0, 1), b2 + hsx, ob0, ob1);
            G_WAIT_V(6); G_BAR; G_MMA(1, 1, At, B1); G_BAR;
            G_LDB(B0, 1, 0); G_SCHED; G_LDA(At, 1, 0); G_STAGE2(G_SA(0, 1), a2, w10, w11);
            G_WAIT_L(8); G_BAR; G_WAIT_L(0); G_MMA(0, 0, At, B0); G_BAR; G_SCHED;
            G_LDB(B1, 1, 1); G_STAGE2(G_SB(1, 0), b3, ob0, ob1);
            G_BAR; G_WAIT_L(0); G_MMA(0, 1, At, B1); G_BAR;
            G_LDA(At, 1, 1); G_STAGE2(G_SA(1, 0), a3, w00, w01);
            G_BAR; G_WAIT_L(0); G_MMA(1, 0, At, B0); G_BAR; G_SCHED;
            G_STAGE2(G_SB(1, 1), b3 + hsx, ob0, ob1);
            G_WAIT_V(6); G_BAR; G_MMA(1, 1, At, B1); G_BAR;
            }
        }
        { int fr2 = fr, fq2 = fq; asm volatile("" : "+v"(fr2), "+v"(fq2));
          E(acc, cur, wr, wc, fr2, fq2); }
        if (!has_next) break;
        if (!(Sched::CHAIN && cur.aux != 0)) {
#pragma unroll
            for (int a = 0; a < 2; ++a)
#pragma unroll
                for (int b = 0; b < 2; ++b)
#pragma unroll
                    for (int m = 0; m < 4; ++m)
#pragma unroll
                        for (int n = 0; n < 2; ++n) acc[a][b][m][n] = (f32x4){0.f, 0.f, 0.f, 0.f};
        }
        cur = nxt; cA = nA; cB = nB; ++ui;
        if (Sched::GATHER) {
#pragma unroll
            for (int h = 0; h < 2; ++h) { vA[h][0] = vAn[h][0]; vA[h][1] = vAn[h][1]; } }
    }
    G_WAIT_V(0);
    if (wr == 0) G_BAR;
    G_BAR;
#undef G_SA
#undef G_SB
#undef G_STAGE2
#undef G_STAGE_B
#undef G_LDA
#undef G_LDB
#undef G_MMA
#undef G_MMA8
#undef G_LDA8
#undef G_LDB8
#undef G_RD8
#undef G_WAIT_V
#undef G_WAIT_L
#undef G_BAR
#undef G_SCHED
}

struct SchedDense {
    static constexpr bool GATHER = false, FP8 = false, CHAIN = false;
    int lda2, akstep, ldb2; const char* A; const char* B; int nM, nN, nt, G, c;
    __device__ __forceinline__ bool next(int i, GU& u) const {
        int pm, pn; if (!tile_map((long)i * G + c, nM, nN, pm, pn)) return false;
        u.A = A + (size_t)pm * 256 * lda2; u.B = B + (size_t)pn * 256 * ldb2; u.nt = nt; u.kind = 0; u.pm = pm; u.pn = pn; u.e = 0; u.aux = 0; return true;
    }
    __device__ __forceinline__ void rowoff(const GU&, int, unsigned (&)[2][2]) const {}
};
struct SchedE1G {
    static constexpr bool GATHER = false, FP8 = true, CHAIN = false;
    int lda2, akstep, ldb2; const char* H8; const char* WM8; int G, c, T;
    __device__ __forceinline__ bool next(int i, GU& u) const {
        if (i >= 3) return false;
        int pm, pn; if (!tile_map((long)T * G + c, 128, 4, pm, pn)) return false;
        u.A = H8 + (size_t)pm * 256 * 1024; u.B = WM8 + (size_t)(i * 1024 + pn * 256) * 1024; u.nt = 8;
        u.kind = 0; u.pm = pm; u.pn = pn; u.e = i; u.aux = 0; return true;
    }
    __device__ __forceinline__ void rowoff(const GU&, int, unsigned (&)[2][2]) const {}
};
struct SchedE1T {
    static constexpr bool GATHER = false, FP8 = false, CHAIN = true;
    int lda2, akstep, ldb2; const char* O; const char* WB; int G, c, T;
    __device__ __forceinline__ bool next(int i, GU& u) const {
        if (i >= 3) return false;
        int pm, pn; if (!tile_map((long)T * G + c, 128, 4, pm, pn)) return false;
        const int koff = (i == 0) ? 0 : (i == 1) ? 512 : 768;
        u.A = O + (size_t)pm * 256 * 2048 + koff * 2; u.B = WB + (size_t)pn * 256 * 2048 + koff * 2; u.nt = (i == 0) ? 8 : 4;
        u.kind = 1; u.pm = pm; u.pn = pn; u.e = i; u.aux = (i < 2) ? 1 : 0; return true;
    }
    __device__ __forceinline__ void rowoff(const GU&, int, unsigned (&)[2][2]) const {}
};
struct SchedMoE {
    static constexpr bool GATHER = true, FP8 = false, CHAIN = false;
    int lda2, akstep, ldb2; const char* A; const char* B; size_t bstride; int ncol, nt, G, c, phase  ;
    const LAS int* tpre;
    const int* listT;
    __device__ __forceinline__ bool next(int i, GU& u) const {
        const int cx = (G % 8 == 0) ? (c % 8) * (G / 8) + c / 8 : c;
        const long L = (long)i * G + cx; const int ntile = tpre[16];
        if (L >= (long)ntile * ncol) return false;
        const int rt = (int)(L / ncol), pn = (int)(L % ncol);
        int e = 0;
#pragma unroll
        for (int k = 1; k < 16; ++k) e += (rt >= tpre[k]) ? 1 : 0;
        const int lt = rt - tpre[e];
        u.e = e; u.pm = lt; u.pn = pn; u.nt = nt; u.kind = 0; u.aux = tpre[34 + e] + lt * 256;
        u.B = B + (size_t)e * bstride + (size_t)pn * 256 * ldb2;
        u.A = (phase == 1) ? A : A + (size_t)u.aux * lda2;
        return true;
    }
    __device__ __forceinline__ void rowoff(const GU& u, int tid, unsigned (&vo)[2][2]) const {
        const int cnt = tpre[17 + u.e];
#pragma unroll
        for (int i = 0; i < 2; ++i) { int R, C; stage_rc(tid * 16 + i * 8192, R, C);
#pragma unroll
            for (int h = 0; h < 2; ++h) {
                const int r = u.pm * 256 + h * 128 + R;
                if (phase == 1) { const int tok = (r < cnt) ? (listT[u.e * LCAP + r] >> 1) : 0; vo[h][i] = (unsigned)tok * 2048u + (unsigned)C * 2u; }
                else vo[h][i] = (unsigned)(h * 128 + R) * (unsigned)lda2 + (unsigned)C * 2u;
            } }
    }
};

__device__ __forceinline__ u32x4 pack8(const f32x4 a, const f32x4 b) { u32x4 o; o[0] = cvt_pk_bf16(a[0], a[1]); o[1] = cvt_pk_bf16(a[2], a[3]); o[2] = cvt_pk_bf16(b[0], b[1]); o[3] = cvt_pk_bf16(b[2], b[3]); return o; }
__device__ __forceinline__ void unpack8(const u32x4 u, f32x4& a, f32x4& b) { a[0] = bf_lo(u[0]); a[1] = bf_hi(u[0]); a[2] = bf_lo(u[1]); a[3] = bf_hi(u[1]); b[0] = bf_lo(u[2]); b[1] = bf_hi(u[2]); b[2] = bf_lo(u[3]); b[3] = bf_hi(u[3]); }

struct EpiBf16 {
    static constexpr bool PERM = true, HEADMAP = false;
    bf16_t* O; int ldc;
    __device__ __forceinline__ void operator()(const f32x4 (&acc)[2][2][4][2], const GU& u, int wr, int wc, int fr, int fq) const {
#pragma unroll
        for (int ai = 0; ai < 2; ++ai)
#pragma unroll
            for (int m = 0; m < 4; ++m) { bf16_t* rowp = O + (size_t)(u.pm * 256 + ai * 128 + wr * 64 + m * 16 + fr) * ldc + u.pn * 256 + wc * 32 + 8 * fq;
#pragma unroll
                for (int bj = 0; bj < 2; ++bj) stg4u(rowp + bj * 128, pack8(acc[ai][bj][m][0], acc[ai][bj][m][1])); }
    }
};
struct EpiZ {
    static constexpr bool PERM = true, HEADMAP = true;
    bf16_t* Z; bf16_t* VT; const float* nqg; const float* nkg; const float* sqg; const float* skg;
    __device__ __forceinline__ void operator()(const f32x4 (&acc)[2][2][4][2], const GU& u, int wr, int wc, int fr, int fq) const {
        const int hidx = u.pn * 4 + wc, lane = fq * 16 + fr;
        int typ; const float* gain = nqg; float cst = 1.f; int vm = 0;
        if (hidx < 8) { typ = 1; gain = nqg; cst = 0.125f * LOG2E; }
        else if (hidx < 10) typ = 0;
        else if (hidx == 10) { typ = 1; gain = nkg + 64; }
        else if (hidx == 11) { typ = 3; vm = 0; }
        else if (hidx == 12) { typ = 1; gain = nkg + 128; }
        else if (hidx == 13) { typ = 3; vm = 1; }
        else if (hidx < 18) { typ = 2; cst = 0.125f; }
        else if (hidx < 22) typ = 0;
        else if (hidx < 26) { typ = 3; vm = 2 + (hidx - 22); }
        else if (hidx < 30) { typ = 1; gain = sqg; cst = 0.125f * LOG2E; }
        else if (hidx < 32) { typ = 1; gain = skg; }
        else if (hidx < 34) { typ = 3; vm = 6 + (hidx - 32); }
        else if (hidx == 34) typ = 4;
        else typ = 0;
        f32x4 g0 = (f32x4){1.f, 1.f, 1.f, 1.f}, g1 = g0, g2 = g0, g3 = g0;
        if (typ == 1) { g0 = ldg4f(gain + 8 * fq) * cst; g1 = ldg4f(gain + 8 * fq + 4) * cst; g2 = ldg4f(gain + 32 + 8 * fq) * cst; g3 = ldg4f(gain + 36 + 8 * fq) * cst; }
        const int b = u.pm >> 6;
#pragma unroll
        for (int ai = 0; ai < 2; ++ai)
#pragma unroll
            for (int m = 0; m < 4; ++m) {
                const int row = u.pm * 256 + ai * 128 + wr * 64 + m * 16 + fr;
                f32x4 v0 = acc[ai][0][m][0], v1 = acc[ai][0][m][1], v2 = acc[ai][1][m][0], v3 = acc[ai][1][m][1];
                if (typ == 3) {
                    bf16_t* vt = VT + (((size_t)b * 8 + vm) * 64 + 8 * fq) * SEQ + (row & (SEQ - 1));
#pragma unroll
                    for (int j = 0; j < 4; ++j) {
                        vt[(size_t)j * SEQ] = f2bf(v0[j]); vt[(size_t)(4 + j) * SEQ] = f2bf(v1[j]);
                        vt[(size_t)(32 + j) * SEQ] = f2bf(v2[j]); vt[(size_t)(36 + j) * SEQ] = f2bf(v3[j]);
                    }
                } else {
                    if (typ == 1) {
                        float ss = 0.f;
#pragma unroll
                        for (int j = 0; j < 4; ++j) ss += v0[j] * v0[j] + v1[j] * v1[j] + v2[j] * v2[j] + v3[j] * v3[j];
                        ss += shx<16>(ss, lane); ss += shx<32>(ss, lane);
                        const float rn = rsqrtf(ss * (1.f / 64.f) + 1e-6f);
                        v0 = v0 * g0 * rn; v1 = v1 * g1 * rn; v2 = v2 * g2 * rn; v3 = v3 * g3 * rn;
                    } else if (typ == 2) { v0 *= cst; v1 *= cst; v2 *= cst; v3 *= cst; }
                    else if (typ == 4) {
#pragma unroll
                        for (int j = 0; j < 4; ++j) { v0[j] = sigmoidf_(v0[j]); v1[j] = sigmoidf_(v1[j]); v2[j] = sigmoidf_(v2[j]); v3[j] = sigmoidf_(v3[j]); }
                    }
                    bf16_t* rowp = Z + (size_t)row * ZLD + hidx * 64 + 8 * fq;
                    stg4u(rowp, pack8(v0, v1)); stg4u(rowp + 32, pack8(v2, v3));
                }
            }
    }
};
struct EpiC1 {
    static constexpr bool PERM = true, HEADMAP = false;
    bf16_t* O; const float* cb;
    __device__ __forceinline__ void operator()(const f32x4 (&acc)[2][2][4][2], const GU& u, int wr, int wc, int fr, int fq) const {
        const int mat = u.e;
#pragma unroll
        for (int bj = 0; bj < 2; ++bj) {
            const int col = bj * 128 + wc * 32 + 8 * fq;
            const f32x4 b0 = ldg4f(cb + mat * 256 + col), b1 = ldg4f(cb + mat * 256 + col + 4);
#pragma unroll
            for (int ai = 0; ai < 2; ++ai)
#pragma unroll
                for (int m = 0; m < 4; ++m) {
                    f32x4 v0 = acc[ai][bj][m][0] + b0, v1 = acc[ai][bj][m][1] + b1;
#pragma unroll
                    for (int j = 0; j < 4; ++j) {
                        { const float x = v0[j], t = 0.7978845608f * (x + 0.044715f * x * x * x); v0[j] = x * frcp(1.f + fexp2(-2.f * LOG2E * t)); }
                        { const float x = v1[j], t = 0.7978845608f * (x + 0.044715f * x * x * x); v1[j] = x * frcp(1.f + fexp2(-2.f * LOG2E * t)); }
                    }
                    stg4u(O + ((size_t)mat * 2048 + u.pm * 256 + ai * 128 + wr * 64 + m * 16 + fr) * 256 + col, pack8(v0, v1));
                }
        }
    }
};
struct EpiE1G {
    static constexpr bool PERM = true, HEADMAP = false;
    unsigned char* Sg;
    __device__ __forceinline__ void operator()(const f32x4 (&acc)[2][2][4][2], const GU& u, int wr, int wc, int fr, int fq) const {
        const int t8 = (((wr * 4 + wc) * 64) + fq * 16 + fr) * 8;
        unsigned char* sg = Sg + u.e * 65536 + t8;
#pragma unroll
        for (int ai = 0; ai < 2; ++ai)
#pragma unroll
            for (int m = 0; m < 4; ++m)
#pragma unroll
                for (int bj = 0; bj < 2; ++bj) {
                    u32x2 w;
#pragma unroll
                    for (int n = 0; n < 2; ++n) { unsigned p = 0u;
#pragma unroll
                        for (int j = 0; j < 4; ++j) { const float g = fmaxf(255.f * sigmoidf_(acc[ai][bj][m][n][j] * (1.f / 64.f)) + 0.5f, 1.f); p |= ((unsigned)g) << (8 * j); }
                        w[n] = p; }
                    stg2u(sg + (ai * 8 + m * 2 + bj) * 4096, w);
                }
    }
};
struct EpiE1T {
    static constexpr bool PERM = true, HEADMAP = false;
    unsigned char* Sg; bf16_t* Y;
    __device__ __forceinline__ void operator()(f32x4 (&acc)[2][2][4][2], const GU& u, int wr, int wc, int fr, int fq) const {
        const int t8 = (((wr * 4 + wc) * 64) + fq * 16 + fr) * 8;
        __builtin_amdgcn_s_waitcnt(0x0070);
        asm volatile("" ::: "memory");
        if (u.e < 2) {
            const unsigned char* ga = Sg + u.e * 65536;
            const unsigned char* gb = ga + 65536;
#pragma unroll
            for (int idx = 0; idx < 16; ++idx) {
                const int ai = idx >> 3, m = (idx >> 1) & 3, bj = idx & 1;
                const u32x2 qa = ldg2u(ga + (unsigned)(t8 + idx * 4096)), qb = ldg2u(gb + (unsigned)(t8 + idx * 4096));
#pragma unroll
                for (int n = 0; n < 2; ++n) {
                    f32x4 r;
#pragma unroll
                    for (int j = 0; j < 4; ++j) r[j] = (float)((qa[n] >> (8 * j)) & 255u) * frcp((float)((qb[n] >> (8 * j)) & 255u));
                    acc[ai][bj][m][n] = acc[ai][bj][m][n] * r;
                }
                __builtin_amdgcn_sched_barrier(0);
            }
        } else {
            const unsigned char* ga = Sg + 2 * 65536;
            bf16_t* yp = Y + (size_t)(u.pm * 256 + wr * 64 + fr) * 1024 + u.pn * 256 + wc * 32 + 8 * fq;
#pragma unroll
            for (int idx = 0; idx < 16; ++idx) {
                const int ai = idx >> 3, m = (idx >> 1) & 3, bj = idx & 1;
                const u32x2 qa = ldg2u(ga + (unsigned)(t8 + idx * 4096));
                f32x4 v0, v1;
#pragma unroll
                for (int j = 0; j < 4; ++j) {
                    v0[j] = (float)((qa[0] >> (8 * j)) & 255u) * (acc[ai][bj][m][0][j] * (1.f / 255.f));
                    v1[j] = (float)((qa[1] >> (8 * j)) & 255u) * (acc[ai][bj][m][1][j] * (1.f / 255.f)); }
                stg4u(yp + (size_t)(ai * 128 + m * 16) * 1024 + bj * 128, pack8(v0, v1));
            }
        }
    }
};
struct EpiE2 {
    static constexpr bool PERM = true, HEADMAP = false;
    bf16_t* xb; const float* ga; float* ssp;
    __device__ __forceinline__ void operator()(const f32x4 (&acc)[2][2][4][2], const GU& u, int wr, int wc, int fr, int fq) const {
        const int b = u.pm >> 6, lane = fq * 16 + fr;
        __builtin_amdgcn_s_waitcnt(0x0070);
        asm volatile("" ::: "memory");
        float ssr[2][4];
#pragma unroll
        for (int ai = 0; ai < 2; ++ai)
#pragma unroll
            for (int m = 0; m < 4; ++m) ssr[ai][m] = 0.f;
        bf16_t* xp = xb + (size_t)(u.pm * 256 + wr * 64 + fr) * 1024 + u.pn * 256 + wc * 32 + 8 * fq;
        u32x4 xv[2][4];
#define E2_LOADB(BUF, BT) do { _Pragma("unroll") for (int m = 0; m < 4; ++m) xv[BUF][m] = ldg4u(xp + (size_t)(((BT) & 1) * 128 + m * 16) * 1024 + ((BT) >> 1) * 128); } while (0)
        E2_LOADB(0, 0);
#pragma unroll
        for (int bt = 0; bt < 4; ++bt) {
            const int bj = bt >> 1, ai = bt & 1;
            const int col = u.pn * 256 + bj * 128 + wc * 32 + 8 * fq;
            const f32x4 g0 = ldg4f(ga + b * 6144 + col), g1 = ldg4f(ga + b * 6144 + col + 4);
            if (bt + 1 < 4) E2_LOADB((bt + 1) & 1, bt + 1);
            asm volatile("" ::: "memory");
#pragma unroll
            for (int m = 0; m < 4; ++m) { f32x4 x0, x1; unpack8(xv[bt & 1][m], x0, x1);
                x0 += g0 * acc[ai][bj][m][0]; x1 += g1 * acc[ai][bj][m][1];
                ssr[ai][m] += (x0[0] * x0[0] + x0[1] * x0[1] + x0[2] * x0[2] + x0[3] * x0[3]) + (x1[0] * x1[0] + x1[1] * x1[1] + x1[2] * x1[2] + x1[3] * x1[3]);
                stg4u(xp + (size_t)(ai * 128 + m * 16) * 1024 + bj * 128, pack8(x0, x1)); }
            asm volatile("" ::: "memory");
        }
#undef E2_LOADB
#pragma unroll
        for (int ai = 0; ai < 2; ++ai)
#pragma unroll
            for (int m = 0; m < 4; ++m) { float v = ssr[ai][m]; v += shx<16>(v, lane); v += shx<32>(v, lane);
                if (fq == 0) ssp[(size_t)(u.pm * 256 + ai * 128 + wr * 64 + m * 16 + fr) * 16 + u.pn * 4 + wc] = v; }
    }
};
struct EpiG1 {
    static constexpr bool PERM = true, HEADMAP = false;
    bf16_t* Ab;
    __device__ __forceinline__ void operator()(const f32x4 (&acc)[2][2][4][2], const GU& u, int wr, int wc, int fr, int fq) const {
#pragma unroll
        for (int ai = 0; ai < 2; ++ai)
#pragma unroll
            for (int m = 0; m < 4; ++m) {
                f32x4 v0, v1;
#pragma unroll
                for (int j = 0; j < 4; ++j) { const float g0 = acc[ai][0][m][0][j], g1 = acc[ai][0][m][1][j];
                    v0[j] = g0 * sigmoidf_(g0) * acc[ai][1][m][0][j]; v1[j] = g1 * sigmoidf_(g1) * acc[ai][1][m][1][j]; }
                stg4u(Ab + (size_t)(u.aux + ai * 128 + wr * 64 + m * 16 + fr) * 512 + u.pn * 128 + wc * 32 + 8 * fq, pack8(v0, v1));
            }
    }
};
struct EpiG2 {
    static constexpr bool PERM = true, HEADMAP = false;
    bf16_t* Ys;
    __device__ __forceinline__ void operator()(const f32x4 (&acc)[2][2][4][2], const GU& u, int wr, int wc, int fr, int fq) const {
#pragma unroll
        for (int ai = 0; ai < 2; ++ai)
#pragma unroll
            for (int m = 0; m < 4; ++m) {
                bf16_t* rowp = Ys + (size_t)(u.aux + ai * 128 + wr * 64 + m * 16 + fr) * 1024 + u.pn * 256 + wc * 32 + 8 * fq;
#pragma unroll
                for (int bj = 0; bj < 2; ++bj) stg4u(rowp + bj * 128, pack8(acc[ai][bj][m][0], acc[ai][bj][m][1]));
            }
    }
};

__device__ __forceinline__ void norm2_mfma(const Ctx& X, LAS unsigned char* lds, int layer) {
    unsigned char* ws = X.ws;
    const int tid = X.tid, lane = tid & 63, wave = tid >> 6, G = X.G, r = lane & 15, kq = lane >> 4;
    const bf16_t* xsrc = (const bf16_t*)(ws + WS_XB);
    const float* modl = (const float*)(ws + WS_MOD) + (size_t)layer * 2 * 6144;
    const float* ssp = (const float*)(ws + WS_SSP);
    bf16_t* h = (bf16_t*)(ws + WS_H);
    const float* gn = INP(I_GMOE) + (size_t)layer * 1024;
    LAS float* Wl = (LAS float*)lds;
    LAS float* gsL = (LAS float*)(lds + 81920);
    LAS float* shL = (LAS float*)(lds + 90112);
    LAS float* cW = (LAS float*)(lds + LDS_MISC + 768);
    LAS float* lgl = (LAS float*)(lds + 98304);
    LAS int* lcnt = (LAS int*)(lds + LDS_MISC + 64);
    LAS int* lbase = (LAS int*)(lds + LDS_MISC + 128);
    const bool fastp = (G * 8 >= NTOK / 16);
    if (fastp) {
        const int b = (X.bid * 8 * 16) >> 14;
        LAS bf16x8* Whi = (LAS bf16x8*)lds;
        LAS bf16x8* Wlo = (LAS bf16x8*)(lds + 32768);
        const GAS float* wrg = (const GAS float*)INP(I_WR); const GAS float* gng = (const GAS float*)gn; const GAS float* mdg = (const GAS float*)modl;
        { const float g0_ = gng[tid], g1_ = gng[tid + 512], c0_ = mdg[b * 6144 + 4096 + tid], c1_ = mdg[b * 6144 + 4096 + tid + 512], h0_ = mdg[b * 6144 + 3072 + tid], h1_ = mdg[b * 6144 + 3072 + tid + 512];
          gsL[b * 1024 + tid] = g0_ * (1.f + c0_); gsL[b * 1024 + tid + 512] = g1_ * (1.f + c1_); shL[b * 1024 + tid] = h0_; shL[b * 1024 + tid + 512] = h1_; }
        if (tid < 16) lcnt[tid] = 0;
        __syncthreads();
        for (int f = tid; f < 2048; f += 512) {
            const int e = f & 15, k0 = (f >> 4) * 8;
            bf16x8 hi, lo; float wv[8];
#pragma unroll
            for (int j = 0; j < 8; ++j) wv[j] = wrg[(k0 + j) * 16 + e];
#pragma unroll
            for (int j = 0; j < 8; ++j) { const float w = gsL[b * 1024 + k0 + j] * wv[j]; const bf16_t hb = f2bf(w); hi[j] = (short)hb; lo[j] = (short)f2bf(w - bf2f(hb)); }
            Whi[f] = hi; Wlo[f] = lo;
        }
        if (tid < 256) {
            const int e = tid >> 4, part = tid & 15;
            float a = 0.f;
            for (int k0 = part * 64; k0 < part * 64 + 64; k0 += 16) { float wv[16];
#pragma unroll
                for (int j = 0; j < 16; ++j) wv[j] = wrg[(k0 + j) * 16 + e];
#pragma unroll
                for (int j = 0; j < 16; ++j) a += shL[b * 1024 + k0 + j] * wv[j]; }
            a += shx<1>(a, lane); a += shx<2>(a, lane); a += shx<4>(a, lane); a += shx<8>(a, lane);
            if (part == 0) cW[b * 16 + e] = a;
        }
        __syncthreads();
        const int batch = X.bid * 8 + wave;
        if (batch < NTOK / 16) {
            const int row = batch * 16 + r;
            float rinv;
            { const f32x4 p4 = ldg4f(ssp + (size_t)row * 16 + 4 * kq); float ssq = (p4[0] + p4[1]) + (p4[2] + p4[3]); ssq += shx<16>(ssq, lane); ssq += shx<32>(ssq, lane);
              rinv = rsqrtf(ssq * (1.f / 1024.f) + 1e-6f); }
            f32x4 acc = (f32x4){0.f, 0.f, 0.f, 0.f};
            const bf16_t* xr = xsrc + (size_t)row * 1024 + kq * 8;
            bf16_t* hr = h + (size_t)row * 1024 + kq * 8;
            for (int kg = 0; kg < 4; ++kg) {
                u32x4 xp[8];
#pragma unroll
                for (int u = 0; u < 8; ++u) { const int kk = (kg * 4 + (u >> 1)) * 64 + (u & 1) * 32; xp[u] = ldg4u(xr + kk); }
                asm volatile("" ::: "memory");
#pragma unroll
                for (int u = 0; u < 8; ++u) {
                    const int kc = kg * 4 + (u >> 1), jh = u & 1, kk = kc * 64 + jh * 32, ch = kc * 2 + jh;
                    const f32x4 g0 = *(const LAS f32x4*)(gsL + b * 1024 + kk + kq * 8), g1 = *(const LAS f32x4*)(gsL + b * 1024 + kk + kq * 8 + 4);
                    const f32x4 s0 = *(const LAS f32x4*)(shL + b * 1024 + kk + kq * 8), s1 = *(const LAS f32x4*)(shL + b * 1024 + kk + kq * 8 + 4);
                    const bf16x8 wh = Whi[(ch * 4 + kq) * 16 + r], wl = Wlo[(ch * 4 + kq) * 16 + r];
                    const bf16x8 xf = __builtin_bit_cast(bf16x8, xp[u]);
                    f32x4 xa, xc; unpack8(xp[u], xa, xc);
                    stg4u(hr + kk, pack8(xa * g0 * rinv + s0, xc * g1 * rinv + s1));
                    acc = __builtin_amdgcn_mfma_f32_16x16x32_bf16(wh, xf, acc, 0, 0, 0);
                    acc = __builtin_amdgcn_mfma_f32_16x16x32_bf16(wl, xf, acc, 0, 0, 0);
                }
                asm volatile("" ::: "memory");
            }
            f32x4 lg;
#pragma unroll
            for (int i = 0; i < 4; ++i) lg[i] = rinv * acc[i] + cW[b * 16 + 4 * kq + i];
            *(LAS f32x4*)(lgl + (wave * 16 + r) * 16 + 4 * kq) = lg;
        }
    } else {
    for (int i = tid; i < 16384; i += 512) { const int k = i >> 4, e = i & 15; Wl[(((k >> 5) * 4 + ((k >> 3) & 3)) * 16 + e) * 8 + (k & 7)] = INP(I_WR)[i]; }
    for (int i = tid; i < 2048; i += 512) { const int b = i >> 10, k = i & 1023; gsL[i] = gn[k] * (1.f + modl[b * 6144 + 4096 + k]); shL[i] = modl[b * 6144 + 3072 + k]; }
    if (tid < 16) lcnt[tid] = 0;
    __syncthreads();
    {
        const int be = tid >> 4, part = tid & 15, b = be >> 4, e = be & 15;
        float a = 0.f;
        for (int k = part * 64; k < part * 64 + 64; ++k) a += shL[b * 1024 + k] * Wl[(((k >> 5) * 4 + ((k >> 3) & 3)) * 16 + e) * 8 + (k & 7)];
        a += shx<1>(a, lane); a += shx<2>(a, lane); a += shx<4>(a, lane); a += shx<8>(a, lane);
        if (part == 0) cW[be] = a;
    }
    __syncthreads();
    int it = 0;
    for (int batch = X.bid * 8 + wave; batch < NTOK / 16; batch += G * 8, ++it) {
        const int row = batch * 16 + r, b = row >> 14;
        float rinv;
        { const f32x4 p4 = ldg4f(ssp + (size_t)row * 16 + 4 * kq); float ssq = (p4[0] + p4[1]) + (p4[2] + p4[3]); ssq += shx<16>(ssq, lane); ssq += shx<32>(ssq, lane);
          rinv = rsqrtf(ssq * (1.f / 1024.f) + 1e-6f); }
        f32x4 acc = (f32x4){0.f, 0.f, 0.f, 0.f};
        const bf16_t* xr = xsrc + (size_t)row * 1024 + kq * 8;
        bf16_t* hr = h + (size_t)row * 1024 + kq * 8;
        for (int kg = 0; kg < 4; ++kg) {
            u32x4 xp[8];
#pragma unroll
            for (int u = 0; u < 8; ++u) { const int kk = (kg * 4 + (u >> 1)) * 64 + (u & 1) * 32; xp[u] = ldg4u(xr + kk); }
            asm volatile("" ::: "memory");
#pragma unroll
            for (int u = 0; u < 8; ++u) {
                const int kc = kg * 4 + (u >> 1), jh = u & 1, kk = kc * 64 + jh * 32;
                const f32x4 g0 = *(const LAS f32x4*)(gsL + b * 1024 + kk + kq * 8), g1 = *(const LAS f32x4*)(gsL + b * 1024 + kk + kq * 8 + 4);
                const f32x4 s0 = *(const LAS f32x4*)(shL + b * 1024 + kk + kq * 8), s1 = *(const LAS f32x4*)(shL + b * 1024 + kk + kq * 8 + 4);
                const LAS float* wp = Wl + (((kc * 2 + jh) * 4 + kq) * 16 + r) * 8;
                const f32x4 w0 = *(const LAS f32x4*)wp, w1 = *(const LAS f32x4*)(wp + 4);
                f32x4 xa, xc; unpack8(xp[u], xa, xc);
                const f32x4 x0 = xa * g0, x1 = xc * g1;
                stg4u(hr + kk, pack8(x0 * rinv + s0, x1 * rinv + s1));
#pragma unroll
                for (int q = 0; q < 4; ++q) acc = __builtin_amdgcn_mfma_f32_16x16x4f32(w0[q], x0[q], acc, 0, 0, 0);
#pragma unroll
                for (int q = 0; q < 4; ++q) acc = __builtin_amdgcn_mfma_f32_16x16x4f32(w1[q], x1[q], acc, 0, 0, 0);
            }
            asm volatile("" ::: "memory");
        }
        if (it < 4) {
            f32x4 lg;
#pragma unroll
            for (int i = 0; i < 4; ++i) lg[i] = rinv * acc[i] + cW[b * 16 + 4 * kq + i];
            *(LAS f32x4*)(lgl + ((it * 8 + wave) * 16 + r) * 16 + 4 * kq) = lg;
        }
    }
    }
    __syncthreads();
    {
        const int slot = tid, sb = slot >> 4, srow = ((X.bid * 8 + (sb & 7)) + (sb >> 3) * G * 8) * 16 + (slot & 15);
        const bool have = (srow < NTOK) && ((sb >> 3) < 4);
        int e0 = 0, e1 = 0, r0 = 0, r1i = 0; float w0 = 0.f, w1 = 0.f;
        if (have) {
            float sco[16], sel[16];
            f32x4 rb4[4];
#pragma unroll
            for (int q = 0; q < 4; ++q) rb4[q] = ldg4f(INP(I_RB) + 4 * q);
#pragma unroll
            for (int q = 0; q < 4; ++q) { const f32x4 lg4 = *(const LAS f32x4*)(lgl + slot * 16 + 4 * q);
#pragma unroll
                for (int j = 0; j < 4; ++j) { const int e = 4 * q + j; sco[e] = 1.f / (1.f + __expf(-lg4[j])); sel[e] = sco[e] + rb4[q][j]; } }
            float gs[4];
#pragma unroll
            for (int g = 0; g < 4; ++g) {
                const float a = sel[4 * g], bq = sel[4 * g + 1], c = sel[4 * g + 2], d = sel[4 * g + 3];
                const float m1 = fmaxf(fmaxf(a, bq), fmaxf(c, d));
                int i1 = (a == m1) ? 0 : (bq == m1) ? 1 : (c == m1) ? 2 : 3;
                float m2 = -3.0e38f;
                m2 = (i1 != 0) ? fmaxf(m2, a) : m2; m2 = (i1 != 1) ? fmaxf(m2, bq) : m2; m2 = (i1 != 2) ? fmaxf(m2, c) : m2; m2 = (i1 != 3) ? fmaxf(m2, d) : m2;
                gs[g] = m1 + m2;
            }
            int gi = 0; float gb = gs[0];
#pragma unroll
            for (int g = 1; g < 4; ++g) if (gs[g] > gb) { gb = gs[g]; gi = g; }
            float s0 = (gi == 0) ? sel[0] : (gi == 1) ? sel[4] : (gi == 2) ? sel[8] : sel[12];
            float s1 = (gi == 0) ? sel[1] : (gi == 1) ? sel[5] : (gi == 2) ? sel[9] : sel[13];
            float s2 = (gi == 0) ? sel[2] : (gi == 1) ? sel[6] : (gi == 2) ? sel[10] : sel[14];
            float s3 = (gi == 0) ? sel[3] : (gi == 1) ? sel[7] : (gi == 2) ? sel[11] : sel[15];
            float c0 = (gi == 0) ? sco[0] : (gi == 1) ? sco[4] : (gi == 2) ? sco[8] : sco[12];
            float c1 = (gi == 0) ? sco[1] : (gi == 1) ? sco[5] : (gi == 2) ? sco[9] : sco[13];
            float c2 = (gi == 0) ? sco[2] : (gi == 1) ? sco[6] : (gi == 2) ? sco[10] : sco[14];
            float c3 = (gi == 0) ? sco[3] : (gi == 1) ? sco[7] : (gi == 2) ? sco[11] : sco[15];
            const float m1 = fmaxf(fmaxf(s0, s1), fmaxf(s2, s3));
            const int i1 = (s0 == m1) ? 0 : (s1 == m1) ? 1 : (s2 == m1) ? 2 : 3;
            float m2 = -3.0e38f;
            m2 = (i1 != 0) ? fmaxf(m2, s0) : m2; m2 = (i1 != 1) ? fmaxf(m2, s1) : m2; m2 = (i1 != 2) ? fmaxf(m2, s2) : m2; m2 = (i1 != 3) ? fmaxf(m2, s3) : m2;
            const int i2 = (i1 != 0 && s0 == m2) ? 0 : (i1 != 1 && s1 == m2) ? 1 : (i1 != 2 && s2 == m2) ? 2 : 3;
            const float w1v = (i1 == 0) ? c0 : (i1 == 1) ? c1 : (i1 == 2) ? c2 : c3;
            const float w2v = (i2 == 0) ? c0 : (i2 == 1) ? c1 : (i2 == 2) ? c2 : c3;
            const float wn = 1.f / (w1v + w2v);
            e0 = gi * 4 + i1; e1 = gi * 4 + i2; w0 = w1v * wn; w1 = w2v * wn;
            r0 = __hip_atomic_fetch_add(lcnt + e0, 1, __ATOMIC_RELAXED, __HIP_MEMORY_SCOPE_WORKGROUP); r1i = __hip_atomic_fetch_add(lcnt + e1, 1, __ATOMIC_RELAXED, __HIP_MEMORY_SCOPE_WORKGROUP);
        }
        __syncthreads();
        unsigned* gcnt = (unsigned*)(ws + WS_CTL) + CW_GCNT + 16 * (layer * 16);
        if (tid < 16) lbase[tid] = (int)atomicAdd(gcnt + 16 * tid, (unsigned)lcnt[tid]);
        __syncthreads();
        if (have) {
            int* lt = (int*)(ws + WS_LISTT); float* lw = (float*)(ws + WS_LISTW);
            const int p0 = lbase[e0] + r0, p1 = lbase[e1] + r1i;
            lt[e0 * LCAP + p0] = srow * 2; lw[e0 * LCAP + p0] = w0;
            lt[e1 * LCAP + p1] = srow * 2 + 1; lw[e1 * LCAP + p1] = w1;
            u32x4 ti; ti[0] = (unsigned)e0 | ((unsigned)p0 << 4); ti[1] = __float_as_uint(w0); ti[2] = (unsigned)e1 | ((unsigned)p1 << 4); ti[3] = __float_as_uint(w1);
            *(GAS u32x4*)((u32x4*)(ws + WS_TINFO) + srow) = ti;
        }
    }
    __syncthreads();
}

__device__ __forceinline__ void cmp2_unit(const Ctx& X, int layer, int u) {
    unsigned char* ws = X.ws;
    const int lane = X.tid & 63, c = lane & 15, g = lane >> 4;
    const int mat = u >> 7, r0 = (u & 127) * 16;
    const bf16_t* hid = (const bf16_t*)(ws + WS_HID) + ((size_t)mat * 2048 + r0) * 256;
    const bf16_t* w2 = (const bf16_t*)(ws + WS_W2) + ((size_t)layer * 2 + mat) * 64 * 256;
    f32x4 acc[4];
#pragma unroll
    for (int nt = 0; nt < 4; ++nt) acc[nt] = (f32x4){0.f, 0.f, 0.f, 0.f};
#pragma unroll
    for (int ks = 0; ks < 8; ++ks) {
        const bf16x8 a = ldg8(hid + c * 256 + ks * 32 + 8 * g);
#pragma unroll
        for (int nt = 0; nt < 4; ++nt) { const bf16x8 b = ldg8(w2 + (nt * 16 + c) * 256 + ks * 32 + 8 * g); acc[nt] = __builtin_amdgcn_mfma_f32_16x16x32_bf16(a, b, acc[nt], 0, 0, 0); }
    }
    if (mat == 0) {
        const float* kg = INP(I_NKG) + layer * 192;
        bf16_t* kc = (bf16_t*)(ws + WS_KCMP);
#pragma unroll
        for (int i = 0; i < 4; ++i) {
            float ss = acc[0][i] * acc[0][i] + acc[1][i] * acc[1][i] + acc[2][i] * acc[2][i] + acc[3][i] * acc[3][i];
            ss += shx<1>(ss, lane); ss += shx<2>(ss, lane); ss += shx<4>(ss, lane); ss += shx<8>(ss, lane);
            const float rn = rsqrtf(ss * (1.f / 64.f) + 1e-6f);
#pragma unroll
            for (int nt = 0; nt < 4; ++nt) kc[(size_t)(r0 + 4 * g + i) * 64 + nt * 16 + c] = f2bf(acc[nt][i] * rn * kg[nt * 16 + c]);
        }
    } else {
        bf16_t* vt = (bf16_t*)(ws + WS_VCMPT);
        const int b = r0 >> 10, cb0 = (r0 & 1023) + 4 * g;
#pragma unroll
        for (int nt = 0; nt < 4; ++nt) { u32x2 o; o[0] = cvt_pk_bf16(acc[nt][0], acc[nt][1]); o[1] = cvt_pk_bf16(acc[nt][2], acc[nt][3]);
            stg2u(vt + ((size_t)b * 64 + nt * 16 + c) * 1024 + cb0, o); }
    }
}

template <int NCT>
__device__ __forceinline__ void qk_tile(const bf16_t* kp, int kstride, const bf16x8 (&qf)[NCT][2], f32x4 (&s)[2][2][NCT]) {
#pragma unroll
    for (int ch = 0; ch < 2; ++ch)
#pragma unroll
        for (int T = 0; T < 2; ++T) {
            const bf16_t* p = kp + (size_t)(32 * ch + 4 * T) * kstride;
            const bf16x8 k0 = ldg8(p), k1 = ldg8(p + 32);
#pragma unroll
            for (int ct = 0; ct < NCT; ++ct) {
                f32x4 a = (f32x4){0.f, 0.f, 0.f, 0.f};
                a = __builtin_amdgcn_mfma_f32_16x16x32_bf16(k0, qf[ct][0], a, 0, 0, 0);
                a = __builtin_amdgcn_mfma_f32_16x16x32_bf16(k1, qf[ct][1], a, 0, 0, 0);
                s[ch][T][ct] = a;
            }
        }
}
template <int NCT>
__device__ __forceinline__ void pv_tile(const bf16_t* vp, size_t vstride, const bf16x8 (&pb)[2][NCT], f32x4 (&o)[4][NCT]) {
#pragma unroll
    for (int ch = 0; ch < 2; ++ch)
#pragma unroll
        for (int dt = 0; dt < 4; ++dt) {
            const bf16x8 v = ldg8(vp + (size_t)(16 * dt) * vstride + 32 * ch);
#pragma unroll
            for (int ct = 0; ct < NCT; ++ct) o[dt][ct] = __builtin_amdgcn_mfma_f32_16x16x32_bf16(v, pb[ch][ct], o[dt][ct], 0, 0, 0);
        }
}
struct KFrag { bf16x8 k[2][2][2]; };
struct VFrag { bf16x8 v[2][4]; };
__device__ __forceinline__ void ld_ktile(const bf16_t* kp, int kstride, KFrag& f) {
#pragma unroll
    for (int ch = 0; ch < 2; ++ch)
#pragma unroll
        for (int T = 0; T < 2; ++T) { const bf16_t* p = kp + (size_t)(32 * ch + 4 * T) * kstride; f.k[ch][T][0] = ldg8(p); f.k[ch][T][1] = ldg8(p + 32); }
}
__device__ __forceinline__ void ld_vtile(const bf16_t* vp, size_t vstride, VFrag& f) {
#pragma unroll
    for (int ch = 0; ch < 2; ++ch)
#pragma unroll
        for (int dt = 0; dt < 4; ++dt) f.v[ch][dt] = ldg8(vp + (size_t)(16 * dt) * vstride + 32 * ch);
}
template <int NCT>
__device__ __forceinline__ void qk_from(const KFrag& f, const bf16x8 (&qf)[NCT][2], f32x4 (&s)[2][2][NCT]) {
#pragma unroll
    for (int ch = 0; ch < 2; ++ch)
#pragma unroll
        for (int T = 0; T < 2; ++T)
#pragma unroll
            for (int ct = 0; ct < NCT; ++ct) {
                f32x4 a = (f32x4){0.f, 0.f, 0.f, 0.f};
                a = __builtin_amdgcn_mfma_f32_16x16x32_bf16(f.k[ch][T][0], qf[ct][0], a, 0, 0, 0);
                a = __builtin_amdgcn_mfma_f32_16x16x32_bf16(f.k[ch][T][1], qf[ct][1], a, 0, 0, 0);
                s[ch][T][ct] = a;
            }
}
template <int NCT>
__device__ __forceinline__ void pv_from(const VFrag& f, const bf16x8 (&pb)[2][NCT], f32x4 (&o)[4][NCT]) {
#pragma unroll
    for (int ch = 0; ch < 2; ++ch)
#pragma unroll
        for (int dt = 0; dt < 4; ++dt)
#pragma unroll
            for (int ct = 0; ct < NCT; ++ct) o[dt][ct] = __builtin_amdgcn_mfma_f32_16x16x32_bf16(f.v[ch][dt], pb[ch][ct], o[dt][ct], 0, 0, 0);
}
__device__ __forceinline__ bf16x8 pack_p(const f32x4 a, const f32x4 b) {
    union { u32x4 u; bf16x8 h; } x; x.u = pack8(a, b); return x.h;
}
template <int NCT> struct SmState { f32x4 o[4][NCT]; float m[NCT], l[NCT]; };

template <int NCT> __device__ __forceinline__ void sm_init(SmState<NCT>& st) {
#pragma unroll
    for (int ct = 0; ct < NCT; ++ct) { st.m[ct] = -1e30f; st.l[ct] = 0.f;
#pragma unroll
        for (int dt = 0; dt < 4; ++dt) st.o[dt][ct] = (f32x4){0.f, 0.f, 0.f, 0.f}; }
}
template <int NCT> __device__ __forceinline__ void sm_finish(SmState<NCT>& st, const int lane) {
#pragma unroll
    for (int ct = 0; ct < NCT; ++ct) {
        float l = st.l[ct]; l += shx<16>(l, lane); l += shx<32>(l, lane);
        const float inv = (l > 0.f) ? 1.f / l : 0.f;
#pragma unroll
        for (int dt = 0; dt < 4; ++dt) st.o[dt][ct] *= inv;
    }
}

constexpr int TROW = 72, TILE_E = 64 * TROW;
template <int NCT>
__device__ __forceinline__ void qk_tile_l(const LAS bf16_t* Kb, int c, int g, const bf16x8 (&qf)[NCT][2], f32x4 (&s)[2][2][NCT]) {
#pragma unroll
    for (int ch = 0; ch < 2; ++ch)
#pragma unroll
        for (int T = 0; T < 2; ++T) {
            const LAS bf16_t* p = Kb + (32 * ch + 8 * (c >> 2) + 4 * T + (c & 3)) * TROW + 8 * g;
            const bf16x8 k0 = *(const LAS bf16x8*)p, k1 = *(const LAS bf16x8*)(p + 32);
#pragma unroll
            for (int ct = 0; ct < NCT; ++ct) {
                f32x4 a = (f32x4){0.f, 0.f, 0.f, 0.f};
                a = __builtin_amdgcn_mfma_f32_16x16x32_bf16(k0, qf[ct][0], a, 0, 0, 0);
                a = __builtin_amdgcn_mfma_f32_16x16x32_bf16(k1, qf[ct][1], a, 0, 0, 0);
                s[ch][T][ct] = a;
            }
        }
}
template <int NCT>
__device__ __forceinline__ void pv_tile_l(const LAS bf16_t* Vb, int c, int g, const bf16x8 (&pb)[2][NCT], f32x4 (&o)[4][NCT]) {
#pragma unroll
    for (int ch = 0; ch < 2; ++ch)
#pragma unroll
        for (int dt = 0; dt < 4; ++dt) {
            const bf16x8 v = *(const LAS bf16x8*)(Vb + (16 * dt + c) * TROW + 32 * ch + 8 * g);
#pragma unroll
            for (int ct = 0; ct < NCT; ++ct) o[dt][ct] = __builtin_amdgcn_mfma_f32_16x16x32_bf16(v, pb[ch][ct], o[dt][ct], 0, 0, 0);
        }
}
template <int NCT, int STEP>
__device__ __forceinline__ void sm_soft(SmState<NCT>& st, f32x4 (&s)[2][2][NCT], bf16x8 (&pb)[2][NCT], const int (&d0)[NCT], const float (&slope)[NCT], const unsigned (&W)[NCT], const int lane) {
#pragma unroll
    for (int ct = 0; ct < NCT; ++ct) {
        float mx = -1e30f;
#pragma unroll
        for (int ch = 0; ch < 2; ++ch)
#pragma unroll
            for (int T = 0; T < 2; ++T)
#pragma unroll
                for (int i = 0; i < 4; ++i) {
                    const int dist = d0[ct] - STEP * (32 * ch + 4 * T + i);
                    const float v = ((unsigned)dist < W[ct]) ? (s[ch][T][ct][i] - slope[ct] * (float)dist) : -1e30f;
                    s[ch][T][ct][i] = v; mx = fmaxf(mx, v);
                }
        mx = fmaxf(mx, shx<16>(mx, lane)); mx = fmaxf(mx, shx<32>(mx, lane));
        const float mn = fmaxf(st.m[ct], mx), alpha = fexp2(st.m[ct] - mn);
        float sum = 0.f;
#pragma unroll
        for (int ch = 0; ch < 2; ++ch) {
#pragma unroll
            for (int T = 0; T < 2; ++T)
#pragma unroll
                for (int i = 0; i < 4; ++i) { const float v = s[ch][T][ct][i]; const float p = (v > -1e29f) ? fexp2(v - mn) : 0.f; s[ch][T][ct][i] = p; sum += p; }
            pb[ch][ct] = pack_p(s[ch][0][ct], s[ch][1][ct]);
        }
        st.m[ct] = mn; st.l[ct] = st.l[ct] * alpha + sum;
#pragma unroll
        for (int dt = 0; dt < 4; ++dt) st.o[dt][ct] *= alpha;
    }
}

template <int NCT, int STEP>
__device__ __forceinline__ void sm_tile(SmState<NCT>& st, f32x4 (&s)[2][2][NCT], const int (&d0)[NCT], const float (&slope)[NCT], unsigned W, const bf16_t* vp, size_t vstride, const int lane) {
    bf16x8 pb[2][NCT]; unsigned Wv[NCT];
#pragma unroll
    for (int ct = 0; ct < NCT; ++ct) Wv[ct] = W;
    sm_soft<NCT, STEP>(st, s, pb, d0, slope, Wv, lane);
    pv_tile<NCT>(vp, vstride, pb, st.o);
}

__device__ __forceinline__ f32x4 add_sle(const f32x4 v, const float sl, const int e0, const int step) {
    f32x4 r; r[0] = fmaf(sl, (float)(step * e0), v[0]); r[1] = fmaf(sl, (float)(step * (e0 + 1)), v[1]); r[2] = fmaf(sl, (float)(step * (e0 + 2)), v[2]); r[3] = fmaf(sl, (float)(step * (e0 + 3)), v[3]); return r; }
template <int NCT>
__device__ __forceinline__ void sm_fast(SmState<NCT>& st, f32x4 (&s)[2][2][NCT], bf16x8 (&pb)[2][NCT], const float sl, const float (&base)[NCT], const bool (&en)[NCT], const int lane) {
#pragma unroll
    for (int ct = 0; ct < NCT; ++ct) {
        const f32x4 u00 = add_sle(s[0][0][ct], sl, 0, 1), u01 = add_sle(s[0][1][ct], sl, 4, 1), u10 = add_sle(s[1][0][ct], sl, 32, 1), u11 = add_sle(s[1][1][ct], sl, 36, 1);
        const f32x4 m4 = __builtin_elementwise_max(__builtin_elementwise_max(u00, u01), __builtin_elementwise_max(u10, u11));
        float mx = fmaxf(fmaxf(m4[0], m4[1]), fmaxf(m4[2], m4[3])) + base[ct];
        mx = fmaxf(mx, shx<16>(mx, lane)); mx = fmaxf(mx, shx<32>(mx, lane));
        const float mn = en[ct] ? fmaxf(st.m[ct], mx) : st.m[ct], alpha = fexp2(st.m[ct] - mn);
        const float off = en[ct] ? (base[ct] - mn) : -1e30f;
        f32x4 p00 = u00 + off, p01 = u01 + off, p10 = u10 + off, p11 = u11 + off;
#pragma unroll
        for (int i = 0; i < 4; ++i) { p00[i] = fexp2(p00[i]); p01[i] = fexp2(p01[i]); p10[i] = fexp2(p10[i]); p11[i] = fexp2(p11[i]); }
        const f32x4 s4 = (p00 + p01) + (p10 + p11);
        const float sum = (s4[0] + s4[1]) + (s4[2] + s4[3]);
        pb[0][ct] = pack_p(p00, p01); pb[1][ct] = pack_p(p10, p11);
        st.m[ct] = mn; st.l[ct] = st.l[ct] * alpha + sum;
#pragma unroll
        for (int dt = 0; dt < 4; ++dt) st.o[dt][ct] *= alpha;
    }
}

__device__ __forceinline__ void nsa_block(const Ctx& X, LAS unsigned char* lds, int unit, int layer, unsigned long long& prb_acc, unsigned* qhead, int& nxt_idx, const float mref_in) {
    unsigned long long prb_t0 = 0ull; (void)prb_t0; (void)prb_acc;
    unsigned char* ws = X.ws;
    const int tid = X.tid, lane = tid & 63, wave = tid >> 6, c = lane & 15, g = lane >> 4, h = c & 7, qq = c >> 3;
    const int b = unit >> 9, t0 = (unit & 511) * 32;
    const bf16_t* z = (const bf16_t*)(ws + WS_Z) + (size_t)b * SEQ * ZLD;
    const bf16_t* vT = (const bf16_t*)(ws + WS_VT) + (size_t)b * 8 * 64 * SEQ;
    const bf16_t* kcmp = (const bf16_t*)(ws + WS_KCMP) + (size_t)b * 1024 * 64;
    const bf16_t* vcT = (const bf16_t*)(ws + WS_VCMPT) + (size_t)b * 64 * 1024;
    LAS float* impA = (LAS float*)(lds + wave * 8192);
    LAS float* impB = impA + 1024;
    LAS bf16_t* KV = (LAS bf16_t*)(lds + 65536);
    LAS int* sell = (LAS int*)(lds + 114688);
    LAS unsigned* qmask = (LAS unsigned*)(lds + 115712);
    LAS unsigned* ubits = (LAS unsigned*)(lds + 116736);
    LAS int* ulist = (LAS int*)(lds + 116800);
    const int prho = tid >> 3, pcp = tid & 7;
    const int krow = (prho & ~9) | ((prho >> 3) & 1) | ((prho & 1) << 3), kchk = pcp ^ (2 * (krow & 3));
    const int vrow = (prho & ~5) | ((prho >> 2) & 1) | ((prho & 1) << 2), vchk = pcp ^ (2 * (vrow & 3));
    const int wv512 = __builtin_amdgcn_readfirstlane(wave) * 512;
    const int fp = c & 3, fcl = g ^ (2 * (fp & 1)), fph = fp >> 1;
    const int krow0 = 8 * (c >> 2) + fp, krho0 = (krow0 & ~9) | ((krow0 >> 3) & 1) | ((krow0 & 1) << 3);
    const int kofA = krho0 * 64 + (fcl + 4 * (0 ^ fph)) * 8, kofB = krho0 * 64 + (fcl + 4 * (1 ^ fph)) * 8;
    const int vrho0 = (c & ~5) | ((c >> 2) & 1) | ((c & 1) << 2);
    const int vofA = vrho0 * 64 + (fcl + 4 * (0 ^ fph)) * 8, vofB = vrho0 * 64 + (fcl + 4 * (1 ^ fph)) * 8;
#define T_DMAK(kbase, kstride, k0, buf) __builtin_amdgcn_global_load_lds((const unsigned*)((kbase) + (size_t)((k0) + krow) * (kstride) + kchk * 8), (LAS unsigned*)(KV + (buf) * 8192 + wv512), 16, 0, 0)
#define T_DMAV(vbase, vstride, k0, buf) __builtin_amdgcn_global_load_lds((const unsigned*)((vbase) + (size_t)vrow * (vstride) + (k0) + vchk * 8), (LAS unsigned*)(KV + (buf) * 8192 + 4096 + wv512), 16, 0, 0)
#define T_KB(buf) (KV + (buf) * 8192)
#define T_DMAKP(kbase, kstride, k0, dst) __builtin_amdgcn_global_load_lds((const unsigned*)((kbase) + (size_t)((k0) + krow) * (kstride) + kchk * 8), (LAS unsigned*)((dst) + wv512), 16, 0, 0)
#define T_VB(buf) (KV + (buf) * 8192 + 4096)
#define T_WAIT(n) asm volatile("s_waitcnt vmcnt(" #n ")" ::: "memory")
#define T_BAR() do { asm volatile("" ::: "memory"); __builtin_amdgcn_s_barrier(); asm volatile("" ::: "memory"); } while (0)
#define QK2I(buf, S, OFF, STEP) QK2IP(T_KB(buf), S, OFF, STEP)
#define QK2IP(kptr, S, OFF, STEP) do { _Pragma("unroll") for (int ch = 0; ch < 2; ++ch) _Pragma("unroll") for (int T = 0; T < 2; ++T) { \
        const LAS bf16_t* p_ = (kptr) + (4 * T + 32 * ch) * 64; const bf16x8 k0_ = *(const LAS bf16x8*)(p_ + kofA), k1_ = *(const LAS bf16x8*)(p_ + kofB); \
        _Pragma("unroll") for (int ct = 0; ct < 2; ++ct) { f32x4 a_; \
            _Pragma("unroll") for (int i = 0; i < 4; ++i) a_[i] = fmaf(sl, (float)((STEP) * (32 * ch + 4 * T + i)), OFF[ct]); \
            a_ = __builtin_amdgcn_mfma_f32_16x16x32_bf16(k0_, qf[ct][0], a_, 0, 0, 0); a_ = __builtin_amdgcn_mfma_f32_16x16x32_bf16(k1_, qf[ct][1], a_, 0, 0, 0); S[ch][T][ct] = a_; } } } while (0)
#define PV2(buf, PB, O) do { _Pragma("unroll") for (int dt = 0; dt < 4; ++dt) { const LAS bf16_t* p_ = T_VB(buf) + 16 * dt * 64; \
        const bf16x8 v0_ = *(const LAS bf16x8*)(p_ + vofA), v1_ = *(const LAS bf16x8*)(p_ + vofB); \
        _Pragma("unroll") for (int ct = 0; ct < 2; ++ct) { O[dt][ct] = __builtin_amdgcn_mfma_f32_16x16x32_bf16(v0_, PB[0][ct], O[dt][ct], 0, 0, 0); \
            O[dt][ct] = __builtin_amdgcn_mfma_f32_16x16x32_bf16(v1_, PB[1][ct], O[dt][ct], 0, 0, 0); } } } while (0)
#define LSUM(PB, L) do { _Pragma("unroll") for (int ct = 0; ct < 2; ++ct) { L[ct] = __builtin_amdgcn_mfma_f32_16x16x32_bf16(ones, PB[0][ct], L[ct], 0, 0, 0); \
        L[ct] = __builtin_amdgcn_mfma_f32_16x16x32_bf16(ones, PB[1][ct], L[ct], 0, 0, 0); } } while (0)
#define PEXP(S, PB, FULL, D0, W, STEP) do { _Pragma("unroll") for (int ct = 0; ct < 2; ++ct) { _Pragma("unroll") for (int ch = 0; ch < 2; ++ch) { \
        _Pragma("unroll") for (int T = 0; T < 2; ++T) _Pragma("unroll") for (int i = 0; i < 4; ++i) { const float e_ = fexp2(S[ch][T][ct][i]); \
            S[ch][T][ct][i] = (FULL) ? e_ : (((unsigned)(D0[ct] - (STEP) * (32 * ch + 4 * T + i)) < W[ct]) ? e_ : 0.f); } \
        PB[ch][ct] = pack_p(S[ch][0][ct], S[ch][1][ct]); } } } while (0)
    PRB_BEGIN(2);
    if (tid < 256) qmask[tid] = 0u;
    if (tid < 8) ubits[tid] = 0u;
    int tq[2]; bf16x8 qf[2][2]; bf16_t gate3[2][3]; u32x2 osum[2][4];
    const float sl = exp2f(-8.f * (float)(h + 5) / 12.f) * LOG2E;
#pragma unroll
    for (int ct = 0; ct < 2; ++ct) {
        tq[ct] = t0 + 4 * wave + 2 * ct + qq;
        const bf16_t* qp = z + (size_t)tq[ct] * ZLD + ZC_QA + h * 64 + 8 * g;
        qf[ct][0] = ldg8(qp); qf[ct][1] = ldg8(qp + 32);
#pragma unroll
        for (int k = 0; k < 3; ++k) gate3[ct][k] = *(const GAS bf16_t*)(z + (size_t)tq[ct] * ZLD + ZC_GA + h * 3 + k);
    }
    const float mref = mref_in;
    bf16x8 ones;
#pragma unroll
    for (int j = 0; j < 8; ++j) ones[j] = (c == 0) ? (short)0x3F80 : (short)0;
    const int t_lo = t0 + 4 * wave, t_hi = t_lo + 3;
    bf16_t* const og = (bf16_t*)(ws + WS_O) + (size_t)b * SEQ * 1024 + h * 64 + 4 * g;
    const int ncb = (t0 >> 4) + 1;
    const int ntile = (ncb + 63) >> 6;
    const unsigned WALL[2] = {0x7fffffffu, 0x7fffffffu};
    float l2inv[2];
    PRB_END(2); PRB_BEGIN(3);
    {
        f32x4 lacc[2] = {(f32x4){0.f, 0.f, 0.f, 0.f}, (f32x4){0.f, 0.f, 0.f, 0.f}};
        if (tid == 0) nxt_idx = (int)__hip_atomic_fetch_add((GAS unsigned*)qhead, 1u, __ATOMIC_RELAXED, __HIP_MEMORY_SCOPE_AGENT);
        T_BAR();
#pragma unroll
        for (int p = 0; p < 5; ++p) if (p < ntile) T_DMAKP(kcmp, 64, p * 64, KV + p * 4096);
        for (int kt = 0; kt < ntile; ++kt) {
            f32x4 s[2][2][2]; bf16x8 pb[2][2];
            const int k0 = kt * 64, s6 = kt % 6, rem = (ntile - 1 - kt < 4) ? ntile - 1 - kt : 4;
            if (rem == 4) T_WAIT(4); else if (rem == 3) T_WAIT(3); else if (rem == 2) T_WAIT(2); else if (rem == 1) T_WAIT(1); else T_WAIT(0);
            T_BAR();
            if (kt + 5 < ntile) T_DMAKP(kcmp, 64, k0 + 320, KV + ((kt + 5) % 6) * 4096);
            const int d0[2] = {tq[0] - 31 - 16 * (k0 + 8 * g), tq[1] - 31 - 16 * (k0 + 8 * g)};
            const float off[2] = {-sl * (float)d0[0] - mref, -sl * (float)d0[1] - mref};
            QK2IP(KV + s6 * 4096, s, off, 16);
            const bool full = (16 * (k0 + 63) + 31 <= t_lo);
            if (full) PEXP(s, pb, true, d0, WALL, 16); else PEXP(s, pb, false, d0, WALL, 16);
            LSUM(pb, lacc);
        }
#pragma unroll
        for (int ct = 0; ct < 2; ++ct) { float lt = lacc[ct][0]; lt += shx<16>(lt, lane); lt += shx<32>(lt, lane); l2inv[ct] = (lt > 0.f) ? -flog2(lt) : -1e30f; }
    }
    PRB_END(3); PRB_BEGIN(4);
    {
        f32x4 o[4][2];
#pragma unroll
        for (int dt = 0; dt < 4; ++dt) { o[dt][0] = (f32x4){0.f, 0.f, 0.f, 0.f}; o[dt][1] = (f32x4){0.f, 0.f, 0.f, 0.f}; }
        T_BAR();
        T_DMAK(kcmp, 64, 0, 0); T_DMAV(vcT, 1024, 0, 0); if (ntile > 1) { T_DMAK(kcmp, 64, 64, 1); T_DMAV(vcT, 1024, 64, 1); }
        for (int kt = 0; kt < ntile; ++kt) {
            f32x4 s[2][2][2]; bf16x8 pb[2][2];
            const int k0 = kt * 64, bi = kt % 3;
            if (kt + 1 < ntile) T_WAIT(2); else T_WAIT(0);
            T_BAR();
            if (kt + 2 < ntile) { T_DMAK(kcmp, 64, k0 + 128, (kt + 2) % 3); T_DMAV(vcT, 1024, k0 + 128, (kt + 2) % 3); }
            const int d0[2] = {tq[0] - 31 - 16 * (k0 + 8 * g), tq[1] - 31 - 16 * (k0 + 8 * g)};
            const float off[2] = {-sl * (float)d0[0] - mref + l2inv[0], -sl * (float)d0[1] - mref + l2inv[1]};
            QK2I(bi, s, off, 16);
            const bool full = (16 * (k0 + 63) + 31 <= t_lo);
            if (full) PEXP(s, pb, true, d0, WALL, 16); else PEXP(s, pb, false, d0, WALL, 16);
#pragma unroll
            for (int ct = 0; ct < 2; ++ct)
#pragma unroll
                for (int ch = 0; ch < 2; ++ch) {
                    float a0 = s[ch][0][ct][0] + s[ch][0][ct][1] + s[ch][0][ct][2] + 0.5f * s[ch][0][ct][3], b0 = 0.5f * s[ch][0][ct][3];
                    float a1 = s[ch][1][ct][0] + s[ch][1][ct][1] + s[ch][1][ct][2] + 0.5f * s[ch][1][ct][3], b1 = 0.5f * s[ch][1][ct][3];
                    a0 = sum8_dpp(a0); b0 = sum8_dpp(b0); a1 = sum8_dpp(a1); b1 = sum8_dpp(b1);
                    if (h == 0) {
                        const int js = (k0 + 32 * ch) / 4 + 2 * g, ql = 2 * ct + qq;
                        impA[ql * 256 + js] = a0; impB[ql * 256 + js] = b0; impA[ql * 256 + js + 1] = a1; impB[ql * 256 + js + 1] = b1;
                    }
                }
            PV2(bi, pb, o);
        }
#pragma unroll
        for (int ct = 0; ct < 2; ++ct) {
            const float g0 = bf2f(gate3[ct][0]);
#pragma unroll
            for (int dt = 0; dt < 4; ++dt) { const f32x4 v = o[dt][ct] * g0; osum[ct][dt][0] = cvt_pk_bf16(v[0], v[1]); osum[ct][dt][1] = cvt_pk_bf16(v[2], v[3]); }
        }
    }
    PRB_END(4); PRB_BEGIN(5);
    {
        f32x4 o[4][2]; f32x4 lacc[2] = {(f32x4){0.f, 0.f, 0.f, 0.f}, (f32x4){0.f, 0.f, 0.f, 0.f}};
#pragma unroll
        for (int dt = 0; dt < 4; ++dt) { o[dt][0] = (f32x4){0.f, 0.f, 0.f, 0.f}; o[dt][1] = (f32x4){0.f, 0.f, 0.f, 0.f}; }
        int kt0 = (t0 - 511) >> 6; if (kt0 < 0) kt0 = 0;
        const int kt1 = (t0 + 31) >> 6;
        const bf16_t* kb = z + ZC_KWN; const bf16_t* vb = vT + (size_t)(1 * 64) * SEQ;
        const unsigned W2[2] = {512u, 512u};
        T_BAR();
        T_DMAK(kb, ZLD, kt0 * 64, 0); T_DMAV(vb, SEQ, kt0 * 64, 0); if (kt0 < kt1) { T_DMAK(kb, ZLD, kt0 * 64 + 64, 1); T_DMAV(vb, SEQ, kt0 * 64 + 64, 1); }
        for (int kt = kt0; kt <= kt1; ++kt) {
            const int k0 = kt * 64, bi = (kt - kt0) % 3;
            f32x4 s[2][2][2]; bf16x8 pb[2][2];
            if (kt < kt1) T_WAIT(2); else T_WAIT(0);
            T_BAR();
            if (kt + 2 <= kt1) { T_DMAK(kb, ZLD, k0 + 128, (kt - kt0 + 2) % 3); T_DMAV(vb, SEQ, k0 + 128, (kt - kt0 + 2) % 3); }
            const int d0[2] = {tq[0] - (k0 + 8 * g), tq[1] - (k0 + 8 * g)};
            const float off[2] = {-sl * (float)d0[0] - mref, -sl * (float)d0[1] - mref};
            QK2I(bi, s, off, 1);
            const bool full = (k0 + 63 <= t_lo && k0 >= t_hi - 511);
            if (full) PEXP(s, pb, true, d0, W2, 1); else PEXP(s, pb, false, d0, W2, 1);
            PV2(bi, pb, o); LSUM(pb, lacc);
        }
        asm volatile("s_waitcnt vmcnt(0)" ::: "memory");
#pragma unroll
        for (int ct = 0; ct < 2; ++ct) {
            float lt = lacc[ct][0]; lt += shx<16>(lt, lane); lt += shx<32>(lt, lane);
            const float g2 = bf2f(gate3[ct][2]) * ((lt > 0.f) ? 1.f / lt : 0.f);
#pragma unroll
            for (int dt = 0; dt < 4; ++dt) { const f32x4 v = o[dt][ct] * g2; const u32x2 t = osum[ct][dt];
                osum[ct][dt][0] = cvt_pk_bf16(bf_lo(t[0]) + v[0], bf_hi(t[0]) + v[1]); osum[ct][dt][1] = cvt_pk_bf16(bf_lo(t[1]) + v[2], bf_hi(t[1]) + v[3]); }
        }
    }
    PRB_END(5); PRB_BEGIN(6);
#pragma unroll
    for (int ql = 0; ql < 4; ++ql) {
        const int qi = 4 * wave + ql, t = t0 + qi, cur = t >> 6;
        if (cur <= 7) {
            if (lane < 8) sell[qi * 8 + lane] = (lane <= cur) ? lane : -1;
        } else {
            unsigned kk[4];
#pragma unroll
            for (int i = 0; i < 4; ++i) { const int j = lane + 64 * i;
                kk[i] = (j >= 1 && j <= cur - 2) ? ((__float_as_uint(impA[ql * 256 + j] + impB[ql * 256 + j - 1]) & 0xFFFFFF00u) | (unsigned)(255 - j)) : 0u; }
            if (lane == 0) { sell[qi * 8 + 0] = 0; sell[qi * 8 + 1] = cur - 1; sell[qi * 8 + 2] = cur; }
#pragma unroll
            for (int r = 0; r < 5; ++r) {
                unsigned m = kk[0] > kk[1] ? kk[0] : kk[1]; const unsigned m2 = kk[2] > kk[3] ? kk[2] : kk[3]; m = m > m2 ? m : m2;
                m = wave_umax(m, lane);
#pragma unroll
                for (int i = 0; i < 4; ++i) kk[i] = (kk[i] == m) ? 0u : kk[i];
                if (lane == 0) sell[qi * 8 + 3 + r] = 255 - (int)(m & 255u);
            }
        }
        if (lane < 8) {
            const int blk = sell[qi * 8 + lane];
            if (blk >= 0) { __hip_atomic_fetch_or(qmask + qi * 8 + (blk >> 5), 1u << (blk & 31), __ATOMIC_RELAXED, __HIP_MEMORY_SCOPE_WORKGROUP);
                            __hip_atomic_fetch_or(ubits + (blk >> 5), 1u << (blk & 31), __ATOMIC_RELAXED, __HIP_MEMORY_SCOPE_WORKGROUP); }
        }
    }
    __syncthreads();
    int nU = 0;
    {
        unsigned wbits[8]; int below = 0;
#pragma unroll
        for (int w = 0; w < 8; ++w) { wbits[w] = ubits[w]; nU += __builtin_popcount(wbits[w]); }
        if (tid < 256) {
            unsigned mine = 0u;
#pragma unroll
            for (int w = 0; w < 8; ++w) { if (w < (tid >> 5)) below += __builtin_popcount(wbits[w]); if (w == (tid >> 5)) mine = wbits[w]; }
            if ((mine >> (tid & 31)) & 1u) { below += __builtin_popcount(mine & ((1u << (tid & 31)) - 1u)); ulist[below] = tid; }
        }
    }
    __syncthreads();
    PRB_END(6); PRB_BEGIN(7);
    {
        f32x4 o[4][2]; f32x4 lacc[2] = {(f32x4){0.f, 0.f, 0.f, 0.f}, (f32x4){0.f, 0.f, 0.f, 0.f}};
#pragma unroll
        for (int dt = 0; dt < 4; ++dt) { o[dt][0] = (f32x4){0.f, 0.f, 0.f, 0.f}; o[dt][1] = (f32x4){0.f, 0.f, 0.f, 0.f}; }
        const bf16_t* kb = z + ZC_KSL; const bf16_t* vb = vT;
        const int q0i = 4 * wave + qq;
        T_BAR();
        { const int k0 = ulist[0] * 64; T_DMAK(kb, ZLD, k0, 0); T_DMAV(vb, SEQ, k0, 0); }
        if (nU > 1) { const int k1 = ulist[1] * 64; T_DMAK(kb, ZLD, k1, 1); T_DMAV(vb, SEQ, k1, 1); }
        for (int it = 0; it < nU; ++it) {
            const int blk = ulist[it], k0 = blk * 64, bi = it % 3;
            f32x4 s[2][2][2]; bf16x8 pb[2][2];
            if (it + 1 < nU) T_WAIT(2); else T_WAIT(0);
            T_BAR();
            if (it + 2 < nU) { const int k2 = ulist[it + 2] * 64; T_DMAK(kb, ZLD, k2, (it + 2) % 3); T_DMAV(vb, SEQ, k2, (it + 2) % 3); }
            unsigned W2[2]; float off[2];
            const int d0[2] = {tq[0] - (k0 + 8 * g), tq[1] - (k0 + 8 * g)};
#pragma unroll
            for (int ct = 0; ct < 2; ++ct) {
                const bool member = ((qmask[(q0i + 2 * ct) * 8 + (blk >> 5)] >> (blk & 31)) & 1u) != 0u;
                W2[ct] = member ? 0x7fffffffu : 0u;
                off[ct] = member ? (-sl * (float)d0[ct] - mref) : -1e30f;
            }
            QK2I(bi, s, off, 1);
            const bool full = (k0 + 63 <= t_lo);
            if (full) PEXP(s, pb, true, d0, W2, 1); else PEXP(s, pb, false, d0, W2, 1);
            PV2(bi, pb, o); LSUM(pb, lacc);
        }
        asm volatile("s_waitcnt vmcnt(0)" ::: "memory");
#pragma unroll
        for (int ct = 0; ct < 2; ++ct) {
            float lt = lacc[ct][0]; lt += shx<16>(lt, lane); lt += shx<32>(lt, lane);
            const float g1 = bf2f(gate3[ct][1]) * ((lt > 0.f) ? 1.f / lt : 0.f);
#pragma unroll
            for (int dt = 0; dt < 4; ++dt) { const f32x4 v = o[dt][ct] * g1; bf16_t* op = og + (size_t)tq[ct] * 1024 + 16 * dt; const u32x2 t = osum[ct][dt]; u32x2 w;
                w[0] = cvt_pk_bf16(bf_lo(t[0]) + v[0], bf_hi(t[0]) + v[1]); w[1] = cvt_pk_bf16(bf_lo(t[1]) + v[2], bf_hi(t[1]) + v[3]); stg2u(op, w); }
        }
    }
    PRB_END(7);
#undef T_DMAK
#undef T_DMAV
#undef T_KB
#undef T_VB
#undef T_WAIT
#undef T_BAR
#undef QK2I
#undef QK2IP
#undef T_DMAKP
#undef PV2
#undef LSUM
#undef PEXP
}

__device__ __forceinline__ void sb_unit(const Ctx& X, int unit) {
    unsigned char* ws = X.ws;
    const int lane = X.tid & 63, c = lane & 15, g = lane >> 4;
    const int b = unit >> 11, hd = (unit >> 9) & 3, t0 = (unit & 511) * 32;
    const bf16_t* z = (const bf16_t*)(ws + WS_Z) + (size_t)b * SEQ * ZLD;
    const bf16_t* vT = (const bf16_t*)(ws + WS_VT) + ((size_t)b * 8 + 2 + hd) * 64 * SEQ;
    int tq[2]; bf16x8 qf[2][2]; float R[2] = {1.f, 1.f};
    f32x4 o[4][2];
#pragma unroll
    for (int ct = 0; ct < 2; ++ct) {
        tq[ct] = t0 + 16 * ct + c;
        const bf16_t* qp = z + (size_t)tq[ct] * ZLD + ZC_QB + hd * 64 + 8 * g;
        qf[ct][0] = ldg8(qp); qf[ct][1] = ldg8(qp + 32);
#pragma unroll
        for (int dt = 0; dt < 4; ++dt) o[dt][ct] = (f32x4){0.f, 0.f, 0.f, 0.f};
    }
    const bf16_t* kbase = z + (size_t)(8 * (c >> 2) + (c & 3)) * ZLD + ZC_KB + hd * 64 + 8 * g;
    KFrag kf; VFrag vf;
    ld_ktile(kbase + (size_t)(((t0 + 31) >> 6) * 64) * ZLD, ZLD, kf);
    for (int kt = (t0 + 31) >> 6; kt >= 0; --kt) {
        const int k0 = kt * 64;
        f32x4 s[2][2][2]; bf16x8 pb[2][2];
        ld_vtile(vT + (size_t)c * SEQ + k0 + 8 * g, SEQ, vf);
        qk_from<2>(kf, qf, s);
        if (kt > 0) ld_ktile(kbase + (size_t)(k0 - 64) * ZLD, ZLD, kf);
#pragma unroll
        for (int ct = 0; ct < 2; ++ct) {
            const int d0 = tq[ct] - (k0 + 8 * g);
            float pex[2][8], tot[2], above[2];
#pragma unroll
            for (int ch = 1; ch >= 0; --ch) {
                float run = 1.f;
#pragma unroll
                for (int jj = 7; jj >= 0; --jj) {
                    const int T = jj >> 2, i = jj & 3;
                    const float zc = __builtin_amdgcn_fmed3f(s[ch][T][ct][i], -80.f, 80.f);
                    const bool ok = (d0 - (32 * ch + jj)) > 0;
                    const float t = fexp2(-zc * LOG2E), r = frcp(1.f + t);
                    s[ch][T][ct][i] = ok ? r : 0.f;
                    pex[ch][jj] = run;
                    run *= ok ? t * r : 1.f;
                }
                const float x16 = shx<16>(run, lane), a2 = run * x16, x32 = shx<32>(a2, lane);
                above[ch] = (g == 3) ? 1.f : (g == 2) ? x16 : (g == 1) ? x32 : x16 * x32;
                tot[ch] = a2 * x32;
            }
#pragma unroll
            for (int ch = 0; ch < 2; ++ch) {
                const float base = R[ct] * above[ch] * ((ch == 0) ? tot[1] : 1.f);
#pragma unroll
                for (int jj = 0; jj < 8; ++jj) { const int T = jj >> 2, i = jj & 3; s[ch][T][ct][i] *= base * pex[ch][jj]; }
                pb[ch][ct] = pack_p(s[ch][0][ct], s[ch][1][ct]);
            }
            R[ct] *= tot[0] * tot[1];
        }
        pv_from<2>(vf, pb, o);
        if (__all((R[0] == 0.f) && (R[1] == 0.f))) break;
    }
    bf16_t* ob = (bf16_t*)(ws + WS_O) + (size_t)b * SEQ * 1024 + 512 + hd * 64;
#pragma unroll
    for (int ct = 0; ct < 2; ++ct)
#pragma unroll
        for (int dt = 0; dt < 4; ++dt) {
            u32x2 w; w[0] = cvt_pk_bf16(o[dt][ct][0], o[dt][ct][1]); w[1] = cvt_pk_bf16(o[dt][ct][2], o[dt][ct][3]);
            stg2u(ob + (size_t)tq[ct] * 1024 + 16 * dt + 4 * g, w);
        }
}

__device__ __forceinline__ void swa_unit(const Ctx& X, int layer, int unit) {
    unsigned char* ws = X.ws;
    const int lane = X.tid & 63, c = lane & 15, g = lane >> 4, hg = c & 1;
    const int b = unit >> 11, gk = (unit >> 10) & 1, t0 = (unit & 1023) * 16;
    const int hd = gk * 2 + hg;
    const bf16_t* z = (const bf16_t*)(ws + WS_Z) + (size_t)b * SEQ * ZLD;
    const bf16_t* vT = (const bf16_t*)(ws + WS_VT) + ((size_t)b * 8 + 6 + gk) * 64 * SEQ;
    int tq[2]; float slope[2]; bf16x8 qf[2][2];
    const float sl = exp2f(-8.f * (float)(hd + 1) / 12.f) * LOG2E;
    const float sink = INP(I_SINK)[layer * 4 + hd] * LOG2E;
    SmState<2> st; sm_init<2>(st);
#pragma unroll
    for (int ct = 0; ct < 2; ++ct) {
        tq[ct] = t0 + 8 * ct + (c >> 1); slope[ct] = sl;
        const bf16_t* qp = z + (size_t)tq[ct] * ZLD + ZC_QC + hd * 64 + 8 * g;
        qf[ct][0] = ldg8(qp); qf[ct][1] = ldg8(qp + 32);
        st.m[ct] = sink; st.l[ct] = (g == 0) ? 1.f : 0.f;
    }
    int kt0 = (t0 - 127) >> 6; if (kt0 < 0) kt0 = 0;
    const int kt1 = (t0 + 15) >> 6;
    const bf16_t* kbase = z + (size_t)(8 * (c >> 2) + (c & 3)) * ZLD + ZC_KC + gk * 64 + 8 * g;
    KFrag kf; VFrag vf;
    ld_ktile(kbase + (size_t)(kt0 * 64) * ZLD, ZLD, kf);
    for (int kt = kt0; kt <= kt1; ++kt) {
        const int k0 = kt * 64;
        f32x4 s[2][2][2]; bf16x8 pb[2][2];
        ld_vtile(vT + (size_t)c * SEQ + k0 + 8 * g, SEQ, vf);
        qk_from<2>(kf, qf, s);
        if (kt < kt1) ld_ktile(kbase + (size_t)(k0 + 64) * ZLD, ZLD, kf);
        const int d0[2] = {tq[0] - (k0 + 8 * g), tq[1] - (k0 + 8 * g)};
        const unsigned Wv[2] = {128u, 128u};
        sm_soft<2, 1>(st, s, pb, d0, slope, Wv, lane);
        pv_from<2>(vf, pb, st.o);
    }
    sm_finish<2>(st, lane);
    bf16_t* oc = (bf16_t*)(ws + WS_O) + (size_t)b * SEQ * 1024 + 768 + hd * 64;
#pragma unroll
    for (int ct = 0; ct < 2; ++ct)
#pragma unroll
        for (int dt = 0; dt < 4; ++dt) {
            u32x2 w; w[0] = cvt_pk_bf16(st.o[dt][ct][0], st.o[dt][ct][1]); w[1] = cvt_pk_bf16(st.o[dt][ct][2], st.o[dt][ct][3]);
            stg2u(oc + (size_t)tq[ct] * 1024 + 16 * dt + 4 * g, w);
        }
}

#define STG_CONSTS() \
    const int prho = tid >> 3, pcp = tid & 7; \
    const int krow = (prho & ~9) | ((prho >> 3) & 1) | ((prho & 1) << 3), kchk = pcp ^ (2 * (krow & 3)); \
    const int vrow = (prho & ~5) | ((prho >> 2) & 1) | ((prho & 1) << 2), vchk = pcp ^ (2 * (vrow & 3)); \
    const int wv512 = __builtin_amdgcn_readfirstlane(wave) * 512; \
    const int fp = c & 3, fcl = g ^ (2 * (fp & 1)), fph = fp >> 1; \
    const int krow0 = 8 * (c >> 2) + fp, krho0 = (krow0 & ~9) | ((krow0 >> 3) & 1) | ((krow0 & 1) << 3); \
    const int kofA = krho0 * 64 + (fcl + 4 * (0 ^ fph)) * 8, kofB = krho0 * 64 + (fcl + 4 * (1 ^ fph)) * 8; \
    const int vrho0 = (c & ~5) | ((c >> 2) & 1) | ((c & 1) << 2); \
    const int vofA = vrho0 * 64 + (fcl + 4 * (0 ^ fph)) * 8, vofB = vrho0 * 64 + (fcl + 4 * (1 ^ fph)) * 8
#define T_DMAK(kbase, kstride, k0, buf) __builtin_amdgcn_global_load_lds((const unsigned*)((kbase) + (size_t)((k0) + krow) * (kstride) + kchk * 8), (LAS unsigned*)(KV + (buf) * 8192 + wv512), 16, 0, 0)
#define T_DMAV(vbase, vstride, k0, buf) __builtin_amdgcn_global_load_lds((const unsigned*)((vbase) + (size_t)vrow * (vstride) + (k0) + vchk * 8), (LAS unsigned*)(KV + (buf) * 8192 + 4096 + wv512), 16, 0, 0)
#define T_KB(buf) (KV + (buf) * 8192)
#define T_VB(buf) (KV + (buf) * 8192 + 4096)
#define T_WAIT(n) asm volatile("s_waitcnt vmcnt(" #n ")" ::: "memory")
#define T_BAR() do { asm volatile("" ::: "memory"); __builtin_amdgcn_s_barrier(); asm volatile("" ::: "memory"); } while (0)
#define QK2Z(buf, S) do { _Pragma("unroll") for (int ch = 0; ch < 2; ++ch) _Pragma("unroll") for (int T = 0; T < 2; ++T) { \
        const LAS bf16_t* p_ = T_KB(buf) + (4 * T + 32 * ch) * 64; const bf16x8 k0_ = *(const LAS bf16x8*)(p_ + kofA), k1_ = *(const LAS bf16x8*)(p_ + kofB); \
        _Pragma("unroll") for (int ct = 0; ct < 2; ++ct) { f32x4 a_ = (f32x4){0.f, 0.f, 0.f, 0.f}; \
            a_ = __builtin_amdgcn_mfma_f32_16x16x32_bf16(k0_, qf[ct][0], a_, 0, 0, 0); a_ = __builtin_amdgcn_mfma_f32_16x16x32_bf16(k1_, qf[ct][1], a_, 0, 0, 0); S[ch][T][ct] = a_; } } } while (0)
#define PV2(buf, PB, O) do { _Pragma("unroll") for (int dt = 0; dt < 4; ++dt) { const LAS bf16_t* p_ = T_VB(buf) + 16 * dt * 64; \
        const bf16x8 v0_ = *(const LAS bf16x8*)(p_ + vofA), v1_ = *(const LAS bf16x8*)(p_ + vofB); \
        _Pragma("unroll") for (int ct = 0; ct < 2; ++ct) { O[dt][ct] = __builtin_amdgcn_mfma_f32_16x16x32_bf16(v0_, PB[0][ct], O[dt][ct], 0, 0, 0); \
            O[dt][ct] = __builtin_amdgcn_mfma_f32_16x16x32_bf16(v1_, PB[1][ct], O[dt][ct], 0, 0, 0); } } } while (0)

__device__ __forceinline__ void sb_block(const Ctx& X, LAS unsigned char* lds, int unit) {
    unsigned char* ws = X.ws;
    const int tid = X.tid, lane = tid & 63, wave = tid >> 6, c = lane & 15, g = lane >> 4;
    const int b = unit >> 8, hd = (unit >> 6) & 3, t0 = (unit & 63) * 256;
    const bf16_t* z = (const bf16_t*)(ws + WS_Z) + (size_t)b * SEQ * ZLD;
    const bf16_t* vb = (const bf16_t*)(ws + WS_VT) + ((size_t)b * 8 + 2 + hd) * 64 * SEQ;
    const bf16_t* kb = z + ZC_KB + hd * 64;
    LAS bf16_t* KV = (LAS bf16_t*)lds;
    LAS int* flg = (LAS int*)(lds + LDS_MISC + 4096);
    STG_CONSTS();
    int tq[2]; bf16x8 qf[2][2]; float R[2] = {1.f, 1.f};
    f32x4 o[4][2];
#pragma unroll
    for (int ct = 0; ct < 2; ++ct) {
        tq[ct] = t0 + 32 * wave + 16 * ct + c;
        const bf16_t* qp = z + (size_t)tq[ct] * ZLD + ZC_QB + hd * 64 + 8 * g;
        qf[ct][0] = ldg8(qp); qf[ct][1] = ldg8(qp + 32);
#pragma unroll
        for (int dt = 0; dt < 4; ++dt) o[dt][ct] = (f32x4){0.f, 0.f, 0.f, 0.f};
    }
    const int kt_hi = (t0 + 255) >> 6, ktw = (t0 + 32 * wave + 31) >> 6;
    bool mydone = false;
    T_BAR();
    T_DMAK(kb, ZLD, kt_hi * 64, 0); T_DMAV(vb, SEQ, kt_hi * 64, 0);
    if (kt_hi >= 1) { T_DMAK(kb, ZLD, (kt_hi - 1) * 64, 1); T_DMAV(vb, SEQ, (kt_hi - 1) * 64, 1); }
    int stp = 0;
    for (int kt = kt_hi; kt >= 0; --kt, ++stp) {
        const int k0 = kt * 64, bi = stp % 3;
        if (kt >= 1) T_WAIT(2); else T_WAIT(0);
        T_BAR();
        if (stp > 0) {
            const LAS int* f = flg + ((stp - 1) & 1) * 8;
            if ((f[0] | f[1] | f[2] | f[3] | f[4] | f[5] | f[6] | f[7]) == 0) break;
        }
        if (kt >= 2) { T_DMAK(kb, ZLD, k0 - 128, (stp + 2) % 3); T_DMAV(vb, SEQ, k0 - 128, (stp + 2) % 3); }
        if (kt <= ktw && !mydone) {
            f32x4 s[2][2][2]; bf16x8 pb[2][2];
            QK2Z(bi, s);
#pragma unroll
            for (int ct = 0; ct < 2; ++ct) {
                const int d0 = tq[ct] - (k0 + 8 * g);
                float pex[2][8], tot[2], above[2];
#pragma unroll
                for (int ch = 1; ch >= 0; --ch) {
                    float run = 1.f;
#pragma unroll
                    for (int jj = 7; jj >= 0; --jj) {
                        const int T = jj >> 2, i = jj & 3;
                        const float zc = __builtin_amdgcn_fmed3f(s[ch][T][ct][i], -80.f, 80.f);
                        const bool ok = (d0 - (32 * ch + jj)) > 0;
                        const float t = fexp2(-zc * LOG2E), r = frcp(1.f + t);
                        s[ch][T][ct][i] = ok ? r : 0.f;
                        pex[ch][jj] = run;
                        run *= ok ? t * r : 1.f;
                    }
                    const float x16 = shx<16>(run, lane), a2 = run * x16, x32 = shx<32>(a2, lane);
                    above[ch] = (g == 3) ? 1.f : (g == 2) ? x16 : (g == 1) ? x32 : x16 * x32;
                    tot[ch] = a2 * x32;
                }
#pragma unroll
                for (int ch = 0; ch < 2; ++ch) {
                    const float base = R[ct] * above[ch] * ((ch == 0) ? tot[1] : 1.f);
#pragma unroll
                    for (int jj = 0; jj < 8; ++jj) { const int T = jj >> 2, i = jj & 3; s[ch][T][ct][i] *= base * pex[ch][jj]; }
                    pb[ch][ct] = pack_p(s[ch][0][ct], s[ch][1][ct]);
                }
                R[ct] *= tot[0] * tot[1];
            }
            PV2(bi, pb, o);
            mydone = __all((R[0] == 0.f) && (R[1] == 0.f)) != 0;
        }
        if (lane == 0) flg[(stp & 1) * 8 + wave] = (!mydone && kt > 0) ? 1 : 0;
        asm volatile("s_waitcnt lgkmcnt(0)" ::: "memory");
    }
    T_WAIT(0);
    bf16_t* ob = (bf16_t*)(ws + WS_O) + (size_t)b * SEQ * 1024 + 512 + hd * 64;
#pragma unroll
    for (int ct = 0; ct < 2; ++ct)
#pragma unroll
        for (int dt = 0; dt < 4; ++dt) {
            u32x2 w; w[0] = cvt_pk_bf16(o[dt][ct][0], o[dt][ct][1]); w[1] = cvt_pk_bf16(o[dt][ct][2], o[dt][ct][3]);
            stg2u(ob + (size_t)tq[ct] * 1024 + 16 * dt + 4 * g, w);
        }
}

__device__ __forceinline__ void swa_block(const Ctx& X, LAS unsigned char* lds, int layer, int unit) {
    unsigned char* ws = X.ws;
    const int tid = X.tid, lane = tid & 63, wave = tid >> 6, c = lane & 15, g = lane >> 4, hg = c & 1;
    const int b = unit >> 8, gk = (unit >> 7) & 1, t0 = (unit & 127) * 128;
    const int hd = gk * 2 + hg;
    const bf16_t* z = (const bf16_t*)(ws + WS_Z) + (size_t)b * SEQ * ZLD;
    const bf16_t* vb = (const bf16_t*)(ws + WS_VT) + ((size_t)b * 8 + 6 + gk) * 64 * SEQ;
    const bf16_t* kb = z + ZC_KC + gk * 64;
    LAS bf16_t* KV = (LAS bf16_t*)lds;
    STG_CONSTS();
    int tq[2]; float slope[2]; bf16x8 qf[2][2];
    const float sl = exp2f(-8.f * (float)(hd + 1) / 12.f) * LOG2E;
    const float sink = INP(I_SINK)[layer * 4 + hd] * LOG2E;
    SmState<2> st; sm_init<2>(st);
#pragma unroll
    for (int ct = 0; ct < 2; ++ct) {
        tq[ct] = t0 + 16 * wave + 8 * ct + (c >> 1); slope[ct] = sl;
        const bf16_t* qp = z + (size_t)tq[ct] * ZLD + ZC_QC + hd * 64 + 8 * g;
        qf[ct][0] = ldg8(qp); qf[ct][1] = ldg8(qp + 32);
        st.m[ct] = sink; st.l[ct] = (g == 0) ? 1.f : 0.f;
    }
    const int t_lo = t0 + 16 * wave, t_hi = t_lo + 15;
    int kt0 = (t0 - 127) >> 6; if (kt0 < 0) kt0 = 0;
    const int kt1 = (t0 + 127) >> 6;
    const unsigned Wv[2] = {128u, 128u};
    T_BAR();
    T_DMAK(kb, ZLD, kt0 * 64, 0); T_DMAV(vb, SEQ, kt0 * 64, 0); if (kt0 < kt1) { T_DMAK(kb, ZLD, kt0 * 64 + 64, 1); T_DMAV(vb, SEQ, kt0 * 64 + 64, 1); }
    for (int kt = kt0; kt <= kt1; ++kt) {
        const int k0 = kt * 64, bi = (kt - kt0) % 3;
        if (kt < kt1) T_WAIT(2); else T_WAIT(0);
        T_BAR();
        if (kt + 2 <= kt1) { T_DMAK(kb, ZLD, k0 + 128, (kt - kt0 + 2) % 3); T_DMAV(vb, SEQ, k0 + 128, (kt - kt0 + 2) % 3); }
        if (k0 <= t_hi && k0 + 63 >= t_lo - 127) {
            f32x4 s[2][2][2]; bf16x8 pb[2][2];
            QK2Z(bi, s);
            const int d0[2] = {tq[0] - (k0 + 8 * g), tq[1] - (k0 + 8 * g)};
            sm_soft<2, 1>(st, s, pb, d0, slope, Wv, lane);
            PV2(bi, pb, st.o);
        }
    }
    sm_finish<2>(st, lane);
    bf16_t* oc = (bf16_t*)(ws + WS_O) + (size_t)b * SEQ * 1024 + 768 + hd * 64;
#pragma unroll
    for (int ct = 0; ct < 2; ++ct)
#pragma unroll
        for (int dt = 0; dt < 4; ++dt) {
            u32x2 w; w[0] = cvt_pk_bf16(st.o[dt][ct][0], st.o[dt][ct][1]); w[1] = cvt_pk_bf16(st.o[dt][ct][2], st.o[dt][ct][3]);
            stg2u(oc + (size_t)tq[ct] * 1024 + 16 * dt + 4 * g, w);
        }
}
#undef STG_CONSTS
#undef T_DMAK
#undef T_DMAV
#undef T_KB
#undef T_VB
#undef T_WAIT
#undef T_BAR
#undef QK2Z
#undef PV2

struct SchedC1 {
    static constexpr bool GATHER = false, FP8 = false, CHAIN = false;
    int lda2, akstep, ldb2; const char* Z; const char* W1; int G, c;
    __device__ __forceinline__ bool next(int i, GU& u) const {
        const int L = i * G + c; if (L >= 16) return false;
        const int mat = L >> 3, pm = L & 7;
        u.A = Z + (size_t)pm * 256 * lda2 + (mat ? ZC_VCS : ZC_KCS) * 2; u.B = W1 + (size_t)mat * 256 * 2048 * 2; u.nt = 32; u.kind = 0; u.pm = pm; u.pn = 0; u.e = mat; u.aux = 0; return true;
    }
    __device__ __forceinline__ void rowoff(const GU&, int, unsigned (&)[2][2]) const {}
};

#ifndef MK_PER_STEP
#define MK_PER_STEP 0
#endif
constexpr int NSTEP = 2 + 10 * NL;
#define PHASE_FN __device__ __forceinline__

PHASE_FN void f_prologue(Ctx Xa) { const Ctx X = uni(Xa); p0_prologue(X, X.lds); }
PHASE_FN void f_norm0(Ctx Xa, int l) { const Ctx X = uni(Xa); norm_phase<0>(X, X.lds, l); }
PHASE_FN void f_norm1(Ctx Xa, int l) { const Ctx X = uni(Xa); norm_phase<1>(X, X.lds, l); }
PHASE_FN void f_norm2(Ctx Xa, int l) { const Ctx X = uni(Xa); norm2_mfma(X, X.lds, l); }
PHASE_FN void f_norm3(Ctx Xa, int l) { const Ctx X = uni(Xa); norm_phase<3>(X, X.lds, l); }
PHASE_FN void f_inproj(Ctx Xa, int la) {
    const Ctx X = uni(Xa); const int l = la; unsigned char* ws = X.ws;
    SchedDense S{2048, 128, 2048, (const char*)(ws + WS_H), (const char*)(ws + WS_WIN) + (size_t)l * 2304 * 2048, 128, 9, 16, X.G, X.bid};
    EpiZ E{(bf16_t*)(ws + WS_Z), (bf16_t*)(ws + WS_VT), INP(I_NQG) + l * 64, INP(I_NKG) + l * 192, INP(I_SQG) + l * 64, INP(I_SKG) + l * 64};
    gemm_run(X.lds, S, E, X.tid);
    { const int nunits = 128 * 9, rounds = (nunits + X.G - 1) / X.G;
      if (nunits % X.G != 0 && X.bid >= nunits - (rounds - 1) * X.G) conv_fill(X, X.lds, l + 1, 4, false); }
}
PHASE_FN void f_cmp1(Ctx Xa, int la) {
    const Ctx X = uni(Xa); const int l = la; unsigned char* ws = X.ws;
    SchedC1 S{16 * ZLD * 2, ZLD * 2, 4096, (const char*)(ws + WS_Z), (const char*)(ws + WS_W1) + (size_t)l * 2 * 256 * 2048 * 2, X.G, X.bid};
    EpiC1 E{(bf16_t*)(ws + WS_HID), (const float*)(ws + WS_CB) + l * 512};
    gemm_run(X.lds, S, E, X.tid);
    if (X.bid < 16) {
        __builtin_amdgcn_fence(__ATOMIC_RELEASE, "workgroup"); __syncthreads(); __builtin_amdgcn_fence(__ATOMIC_ACQUIRE, "workgroup");
        for (int L = X.bid; L < 16; L += X.G)
            for (int j = X.tid >> 6; j < 16; j += 8) cmp2_unit(X, l, (L >> 3) * 128 + (L & 7) * 16 + j);
    }
}
PHASE_FN void f_cmp2(Ctx Xa, int la) {
    const Ctx X = uni(Xa); const int l = la;
    for (int u = X.bid * 8 + (X.tid >> 6); u < 256; u += X.G * 8) cmp2_unit(X, l, u);
}
PHASE_FN void f_nsa(Ctx Xa, int la, int qk) {
    const Ctx X = uni(Xa); const int l = la;
    unsigned* ctl = (unsigned*)(X.ws + WS_CTL);
    LAS int* bc = (LAS int*)(X.lds + LDS_MISC + 32);
    PRB_DECL();
#if !PRB_SEL
    unsigned long long prb_acc = 0ull;
#endif
    unsigned* qhead = ctl + CW_Q + 64 * (l * 4 + qk);
    float mref;
    { const int lane = X.tid & 63, layer = l;
        float gq = fabsf(INP(I_NQG)[layer * 64 + lane]);
        const float* kg = INP(I_NKG) + layer * 192;
        float gk = fmaxf(fmaxf(fabsf(kg[lane]), fabsf(kg[64 + lane])), fabsf(kg[128 + lane]));
        gq = fmaxf(gq, shx<32>(gq, lane)); gq = fmaxf(gq, shx<16>(gq, lane)); gq = fmaxf(gq, shx<8>(gq, lane)); gq = fmaxf(gq, shx<4>(gq, lane)); gq = fmaxf(gq, shx<2>(gq, lane)); gq = fmaxf(gq, shx<1>(gq, lane));
        gk = fmaxf(gk, shx<32>(gk, lane)); gk = fmaxf(gk, shx<16>(gk, lane)); gk = fmaxf(gk, shx<8>(gk, lane)); gk = fmaxf(gk, shx<4>(gk, lane)); gk = fmaxf(gk, shx<2>(gk, lane)); gk = fmaxf(gk, shx<1>(gk, lane));
        mref = 8.f * LOG2E * 1.01f * gq * gk;
    }
    int nxt = 0;
    if (X.tid == 0) nxt = (int)atomicAdd(qhead, 1u);
    for (;;) {
        PRB_BEGIN(1);
        if (X.tid == 0) bc[0] = nxt;
        __syncthreads();
        const int idx = bc[0];
        __syncthreads();
        PRB_END(1);
        if (idx >= 1024) break;
        nsa_block(X, X.lds, (idx & 1) * 512 + (511 - (idx >> 1)), l, prb_acc, qhead, nxt, mref);
    }
    PRB_FLUSH(X);
}
PHASE_FN void f_sbswa(Ctx Xa, int la, int qk) {
    const Ctx X = uni(Xa); const int l = la;
    unsigned* ctl = (unsigned*)(X.ws + WS_CTL);
    LAS int* bc = (LAS int*)(X.lds + LDS_MISC + 32);
    for (;;) {
        if (X.tid == 0) bc[0] = (int)atomicAdd(ctl + CW_Q + 64 * (l * 4 + qk) + 16, 1u);
        __syncthreads();
        const int idx = bc[0];
        __syncthreads();
        if (idx >= 1024) break;
        if (idx < 512) sb_block(X, X.lds, idx);
        else swa_block(X, X.lds, l, idx - 512);
    }
}
PHASE_FN void f_e1(Ctx Xa, int la) {
    const Ctx X = uni(Xa); const int l = la; unsigned char* ws = X.ws;
    EpiE1G EG{(unsigned char*)(ws + WS_SB) + (size_t)X.bid * 262144};
    EpiE1T ET{(unsigned char*)(ws + WS_SB) + (size_t)X.bid * 262144, (bf16_t*)(ws + WS_Y)};
    for (int T = 0; T * X.G < 512; ++T) {
        SchedE1G SG{1024, 128, 2048, (const char*)(ws + WS_H8), (const char*)(ws + WS_WM8) + (size_t)l * 3072 * 1024, X.G, X.bid, T};
        gemm_run(X.lds, SG, EG, X.tid);
        SchedE1T ST{2048, 128, 2048, (const char*)(ws + WS_O), (const char*)(ws + WS_WB) + (size_t)l * 1024 * 2048, X.G, X.bid, T};
        gemm_run(X.lds, ST, ET, X.tid);
    }
}
PHASE_FN void f_e2(Ctx Xa, int la) {
    const Ctx X = uni(Xa); const int l = la; unsigned char* ws = X.ws;
    const float* modl = (const float*)(ws + WS_MOD) + (size_t)l * 2 * 6144;
    SchedDense S{2048, 128, 2048, (const char*)(ws + WS_Y), (const char*)(ws + WS_WO) + (size_t)l * 1024 * 2048, 128, 4, 16, X.G, X.bid};
    EpiE2 E{(bf16_t*)(ws + WS_XB), modl + 2048, (float*)(ws + WS_SSP)};
    gemm_run(X.lds, S, E, X.tid);
}
__device__ __forceinline__ void moe_table(const Ctx& X, int l) {
    LAS int* tpre = (LAS int*)(X.lds + LDS_MISC + 256);
    if (X.tid < 16) {
        const unsigned* gcnt = (const unsigned*)(X.ws + WS_CTL) + CW_GCNT + 16 * (l * 16);
        tpre[17 + X.tid] = (int)__hip_atomic_load((GAS unsigned*)(gcnt + 16 * X.tid), __ATOMIC_RELAXED, __HIP_MEMORY_SCOPE_AGENT);
    }
    __syncthreads();
    if (X.tid < 17) {
        int run = 0;
        for (int e = 0; e < X.tid; ++e) run += (tpre[17 + e] + 255) >> 8;
        tpre[X.tid] = run;
        if (X.tid < 16) tpre[34 + X.tid] = run * 256;
    }
    __syncthreads();
}
PHASE_FN void f_g1(Ctx Xa, int la) {
    const Ctx X = uni(Xa); const int l = la; unsigned char* ws = X.ws;
    moe_table(X, l);
    const LAS int* tpre = (const LAS int*)(X.lds + LDS_MISC + 256);
    SchedMoE S{2048, 128, 2048, (const char*)(ws + WS_H), (const char*)(ws + WS_WGU) + (size_t)l * 16 * 1024 * 2048, (size_t)1024 * 2048, 4, 16, X.G, X.bid, 1, tpre, (const int*)(ws + WS_LISTT)};
    EpiG1 E{(bf16_t*)(ws + WS_AB)};
    gemm_run(X.lds, S, E, X.tid);
    { const int nunits = tpre[16] * 4, rounds = (nunits + X.G - 1) / X.G, cx = (X.G % 8 == 0) ? (X.bid % 8) * (X.G / 8) + X.bid / 8 : X.bid;
      if (nunits % X.G != 0 && cx >= nunits - (rounds - 1) * X.G) conv_fill(X, X.lds, l + 1, 4, false); }
}
PHASE_FN void f_g2(Ctx Xa, int la) {
    const Ctx X = uni(Xa); const int l = la; unsigned char* ws = X.ws;
    moe_table(X, l);
    const LAS int* tpre = (const LAS int*)(X.lds + LDS_MISC + 256);
    SchedMoE S{1024, 128, 1024, (const char*)(ws + WS_AB), (const char*)(ws + WS_WD) + (size_t)l * 16 * 1024 * 1024, (size_t)1024 * 1024, 4, 8, X.G, X.bid, 2, tpre, (const int*)(ws + WS_LISTT)};
    EpiG2 E{(bf16_t*)(ws + WS_YS)};
    gemm_run(X.lds, S, E, X.tid);
    conv_fill(X, X.lds, l + 1, 0, true);
}

__global__ void __launch_bounds__(512, 2) mega_fwd(Params P) {
    extern __shared__ __attribute__((aligned(16))) unsigned char lds_raw[];
    LAS unsigned char* lds = (LAS unsigned char*)lds_raw;
    const int tid = threadIdx.x;
    unsigned* ctl = (unsigned*)(P.ws + WS_CTL);
    if (tid < 64) ((LAS unsigned*)(lds + LDS_MISC))[tid] = 0u;
    if (tid < 27) *(LAS unsigned long long*)(lds + LDS_PTAB + 8 * tid) = (unsigned long long)P.in[tid];
    if ((tid & 63) == 0) *(LAS int*)(lds + LDS_WTAB + 4 * ((unsigned)__builtin_amdgcn_s_getreg((5 << 11) | 4) & 63u)) = tid >> 6;
    __syncthreads();
    XcdBarrier bar = xcd_barrier_post(ctl, (volatile LAS unsigned*)(lds + LDS_MISC));
    Ctx X; X.ws = P.ws; X.out = P.out; X.lds = lds; X.tid = 0; X.bid = 0; X.G = 0;
    const int lo = P.step_lo, hi = P.step_hi;
#define IN(s) (lo <= (s) && (s) < hi)
#define SEAM(s) do { if ((s) + 1 < hi) xcd_barrier(bar); } while (0)
#ifndef DBL
#define DBL 0
#endif
    if (IN(0)) { f_prologue(X); if (DBL & 1) f_prologue(X); SEAM(0); }
    for (int l = 0; l < NL; ++l) {
        const int s0 = 1 + 10 * l;
        if (IN(s0 + 0)) { if (l == 0) f_norm0(X, l); else f_norm1(X, l); SEAM(s0 + 0); }
        if (IN(s0 + 1)) { f_inproj(X, l); if (DBL & 2) f_inproj(X, l); SEAM(s0 + 1); }
        if (IN(s0 + 2)) { f_cmp1(X, l); __syncthreads(); f_sbswa(X, l, 1); if (DBL & 64) f_sbswa(X, l, 2); SEAM(s0 + 2); }
        if (IN(s0 + 4)) { f_nsa(X, l, 1); if (DBL & 4) f_nsa(X, l, 2); SEAM(s0 + 4); }
        if (IN(s0 + 5)) { f_e1(X, l); if (DBL & 8) f_e1(X, l); SEAM(s0 + 5); }
        if (IN(s0 + 6)) { f_e2(X, l); SEAM(s0 + 6); }
        if (IN(s0 + 7)) { f_norm2(X, l); SEAM(s0 + 7); }
        if (IN(s0 + 8)) { f_g1(X, l); if (DBL & 16) f_g1(X, l); SEAM(s0 + 8); }
        if (IN(s0 + 9)) { f_g2(X, l); if (DBL & 32) f_g2(X, l); SEAM(s0 + 9); }
    }
    if (IN(NSTEP - 1)) f_norm3(X, NL);
#undef IN
#undef SEAM
}

extern "C" void kernel_launch(void* const* d_in, const int* in_sizes, int n_in, void* d_out, int out_size, void* d_ws, size_t ws_size, hipStream_t stream) {
    static int grid = 0;
    if (grid == 0) {
        if (n_in != 27 || out_size != NTOK * DM || ws_size < WS_END) { fprintf(stderr, "kernel_launch: unexpected shapes/workspace (n_in %d out %d ws %zu need %zu)\n", n_in, out_size, ws_size, (size_t)WS_END); grid = -1; return; }
        int dev = 0, cus = 0, per_cu = 0;
        if (hipGetDevice(&dev) != hipSuccess || hipDeviceGetAttribute(&cus, hipDeviceAttributeMultiprocessorCount, dev) != hipSuccess) { grid = -1; return; }
        if (hipFuncSetAttribute((const void*)mega_fwd, hipFuncAttributeMaxDynamicSharedMemorySize, LDS_BYTES) != hipSuccess) { fprintf(stderr, "kernel_launch: hipFuncSetAttribute failed\n"); grid = -1; return; }
        if (hipOccupancyMaxActiveBlocksPerMultiprocessor(&per_cu, (const void*)mega_fwd, 512, LDS_BYTES) != hipSuccess || per_cu < 1) { fprintf(stderr, "kernel_launch: occupancy query says %d\n", per_cu); }
        (void)hipGetLastError();
        grid = cus;
        if (grid > 256) grid = 256;
        if (grid < 64) { grid = -1; return; }
    }
    if (grid < 0) return;
    if (hipMemsetAsync((char*)d_ws + WS_CTL, 0, 64 * 1024, stream) != hipSuccess) return;
    Params p{};
    for (int i = 0; i < 27; ++i) p.in[i] = (const float*)d_in[i];
    p.out = (float*)d_out; p.ws = (unsigned char*)d_ws;
#if MK_PER_STEP
    for (int s = 0; s < NSTEP; ++s) { p.step_lo = s; p.step_hi = s + 1; hipLaunchKernelGGL(mega_fwd, dim3(grid), dim3(512), LDS_BYTES, stream, p); }
#else
    p.step_lo = 0; p.step_hi = NSTEP;
    hipLaunchKernelGGL(mega_fwd, dim3(grid), dim3(512), LDS_BYTES, stream, p);
#endif
}
```

```cpp
#include <hip/hip_runtime.h>
#include <stdio.h>
#include <stdint.h>

#define LAS __attribute__((address_space(3)))
#define GAS __attribute__((address_space(1)))
typedef unsigned short bf16_t;
typedef short bf16x8 __attribute__((ext_vector_type(8)));
typedef float f32x4 __attribute__((ext_vector_type(4)));
typedef unsigned u32x4 __attribute__((ext_vector_type(4)));
typedef unsigned u32x2 __attribute__((ext_vector_type(2)));

constexpr int NTOK = 32768, SEQ = 16384, DM = 1024, NL = 4, NB = 2;
constexpr int NIN = 5272;
constexpr int ZLD = 2304;
constexpr int ZC_QA = 0, ZC_KCS = 512, ZC_VCS = 576, ZC_KSL = 640, ZC_VSL = 704, ZC_KWN = 768, ZC_VWN = 832,
              ZC_QB = 896, ZC_KB = 1152, ZC_VB = 1408, ZC_QC = 1664, ZC_KC = 1920, ZC_VC = 2048, ZC_GA = 2176;
constexpr int LCAP = 32768;
constexpr int AROWS = 65536 + 16 * 256;
constexpr float LOG2E = 1.4426950408889634f;
constexpr float LN2 = 0.6931471805599453f;
constexpr int LDS_BYTES = 147456;
constexpr int LDS_MISC = 131072;

constexpr size_t KiB = 1024, MiB = 1024 * 1024;
constexpr size_t WS_CTL = 0;
constexpr size_t WS_MOD = WS_CTL + 64 * KiB;
constexpr size_t WS_CB = WS_MOD + 192 * KiB;
constexpr size_t WS_LISTT = WS_CB + 8 * KiB;
constexpr size_t WS_LISTW = WS_LISTT + 2 * MiB;
constexpr size_t WS_KCMP = WS_LISTW + 2 * MiB;
constexpr size_t WS_VCMPT = WS_KCMP + 256 * KiB;
constexpr size_t WS_HID = WS_VCMPT + 256 * KiB;
constexpr size_t WS_SSP = WS_HID + 2 * MiB;
constexpr size_t WS_WIN = WS_SSP + 2 * MiB;
constexpr size_t WS_WM = WS_WIN + (size_t)NL * 2304 * 1024 * 2;
constexpr size_t WS_WB = WS_WM + (size_t)NL * 3072 * 1024 * 2;
constexpr size_t WS_WO = WS_WB + (size_t)NL * 1024 * 1024 * 2;
constexpr size_t WS_W1 = WS_WO + (size_t)NL * 1024 * 1024 * 2;
constexpr size_t WS_W2 = WS_W1 + (size_t)NL * 2 * 256 * 2048 * 2;
constexpr size_t WS_WGU = WS_W2 + (size_t)NL * 2 * 64 * 256 * 2;
constexpr size_t WS_WD = WS_WGU + (size_t)NL * 16 * 1024 * 1024 * 2;
constexpr size_t WS_H = WS_WD + (size_t)NL * 16 * 1024 * 512 * 2;
constexpr size_t WS_Z = WS_H + (size_t)NTOK * 1024 * 2;
constexpr size_t Z_BYTES = (size_t)(NTOK + 64) * ZLD * 2;
constexpr size_t WS_Y = WS_Z;
constexpr size_t WS_SB = WS_Z + 64 * MiB;
constexpr size_t WS_AB = WS_Z + 64 * MiB;
constexpr size_t WS_R3 = WS_Z + Z_BYTES;
constexpr size_t WS_YB = WS_R3;
constexpr size_t WS_VT = WS_R3;
constexpr size_t WS_O = WS_R3 + 32 * MiB;
constexpr size_t WS_XB = WS_R3 + 136 * MiB;
constexpr size_t WS_TINFO = WS_XB + 64 * MiB;
constexpr size_t WS_YS = WS_R3;
constexpr size_t WS_H8 = WS_TINFO + 1 * MiB;
constexpr size_t WS_WM8 = WS_H8 + 32 * MiB;
constexpr size_t WS_END = WS_WM8 + 12 * MiB;
static_assert(64 * MiB + (size_t)AROWS * 512 * 2 <= Z_BYTES, "alias map");

constexpr int CW_Q = 4096;
constexpr int CW_GCNT = 6144;

__device__ __forceinline__ unsigned cvt_pk_bf16(float lo, float hi) { unsigned r; asm("v_cvt_pk_bf16_f32 %0, %1, %2" : "=v"(r) : "v"(lo), "v"(hi)); return r; }
__device__ __forceinline__ bf16_t f2bf(float f) { return (bf16_t)(cvt_pk_bf16(f, 0.f) & 0xffffu); }
__device__ __forceinline__ float bf_lo(unsigned u) { return __uint_as_float(u << 16); }
__device__ __forceinline__ float bf_hi(unsigned u) { return __uint_as_float(u & 0xffff0000u); }
__device__ __forceinline__ float bf2f(bf16_t b) { return __uint_as_float(((unsigned)b) << 16); }
__device__ __forceinline__ float fexp2(float x) { return __builtin_amdgcn_exp2f(x); }
__device__ __forceinline__ float flog2(float x) { return __builtin_amdgcn_logf(x); }
__device__ __forceinline__ float frcp(float x) { return __builtin_amdgcn_rcpf(x); }
__device__ __forceinline__ float sigmoidf_(float x) { return frcp(1.f + fexp2(-x * LOG2E)); }
template <int M> __device__ __forceinline__ int shxi(int v, int lane) {
    if constexpr (M < 32) return __builtin_amdgcn_ds_swizzle(v, (M << 10) | 0x1f);
    else return __builtin_amdgcn_ds_bpermute((lane ^ 32) << 2, v);
}
template <int M> __device__ __forceinline__ float shx(float v, int lane) { return __int_as_float(shxi<M>(__float_as_int(v), lane)); }
__device__ __forceinline__ float sum8_dpp(float v) {
    v += __int_as_float(__builtin_amdgcn_update_dpp(__float_as_int(v), __float_as_int(v), 0xB1, 0xf, 0xf, true));
    v += __int_as_float(__builtin_amdgcn_update_dpp(__float_as_int(v), __float_as_int(v), 0x4E, 0xf, 0xf, true));
    v += __int_as_float(__builtin_amdgcn_update_dpp(__float_as_int(v), __float_as_int(v), 0x141, 0xf, 0xf, true));
    return v;
}
__device__ __forceinline__ unsigned wave_umax(unsigned k, int lane) {
    unsigned o;
    o = (unsigned)__builtin_amdgcn_update_dpp((int)k, (int)k, 0xB1, 0xf, 0xf, true); k = k > o ? k : o;
    o = (unsigned)__builtin_amdgcn_update_dpp((int)k, (int)k, 0x4E, 0xf, 0xf, true); k = k > o ? k : o;
    o = (unsigned)__builtin_amdgcn_update_dpp((int)k, (int)k, 0x141, 0xf, 0xf, true); k = k > o ? k : o;
    o = (unsigned)__builtin_amdgcn_update_dpp((int)k, (int)k, 0x140, 0xf, 0xf, true); k = k > o ? k : o;
    o = (unsigned)shxi<16>((int)k, lane); k = k > o ? k : o;
    o = (unsigned)shxi<32>((int)k, lane); k = k > o ? k : o;
    return k;
}
__device__ __forceinline__ float wave_sum(float v, int lane) {
    v += shx<32>(v, lane); v += shx<16>(v, lane); v += shx<8>(v, lane); v += shx<4>(v, lane); v += shx<2>(v, lane); v += shx<1>(v, lane);
    return v;
}
__device__ __forceinline__ bf16x8 ldg8(const bf16_t* p) { return *(const GAS bf16x8*)p; }
__device__ __forceinline__ u32x4 ldg4u(const void* p) { return *(const GAS u32x4*)p; }
__device__ __forceinline__ u32x2 ldg2u(const void* p) { return *(const GAS u32x2*)p; }
__device__ __forceinline__ f32x4 ldg4f(const float* p) { return *(const GAS f32x4*)p; }
__device__ __forceinline__ void stg4u(void* p, u32x4 v) { *(GAS u32x4*)p = v; }
__device__ __forceinline__ void stg2u(void* p, u32x2 v) { *(GAS u32x2*)p = v; }
__device__ __forceinline__ void stg4f(float* p, f32x4 v) { *(GAS f32x4*)p = v; }

#define XB_TMO      128
#define XB_XCNT(j)  (256  + 64 * (j))
#define XB_XSUB(j)  (1280 + 64 * (j))
#define XB_XGEN(j)  (2304 + 64 * (j))
#define XB_TOP      3328
#define XB_TOPGEN   3392
#define XCD_BAR_WORDS 3456
#define XB_SPIN_CAP (1u << 18)
__device__ __forceinline__ unsigned xb_ld(unsigned* p)              { return __hip_atomic_load(p, __ATOMIC_RELAXED, __HIP_MEMORY_SCOPE_AGENT); }
__device__ __forceinline__ unsigned xb_add(unsigned* p, unsigned v) { return __hip_atomic_fetch_add(p, v, __ATOMIC_RELAXED, __HIP_MEMORY_SCOPE_AGENT); }
__device__ __forceinline__ unsigned xb_xcc_id() { return (unsigned)__builtin_amdgcn_s_getreg((3 << 11) | 20) & 0xFu; }
#define XB_SPIN(cond, bar) do { unsigned _sp = 0; while (cond) { __builtin_amdgcn_s_sleep(1); \
    if ((++_sp & 255u) == 0u) { if (xb_ld(&(bar)[XB_TMO])) break; if (_sp > XB_SPIN_CAP) { atomicAdd(&(bar)[XB_TMO], 1u); break; } } } } while (0)
constexpr int LDS_WTAB = 131072 + 12288;
__device__ __forceinline__ int tid_rebuild(const LAS unsigned char* lds) {
    const unsigned hw = (unsigned)__builtin_amdgcn_s_getreg((5 << 11) | 4) & 63u;
    const int wv = __builtin_amdgcn_readfirstlane(*(const LAS int*)(lds + LDS_WTAB + 4 * hw));
    int ln; asm volatile("v_mbcnt_lo_u32_b32 %0, -1, 0\n\tv_mbcnt_hi_u32_b32 %0, -1, %0" : "=v"(ln));
    return wv * 64 + ln;
}
struct XcdBarrier { unsigned* bar; unsigned x; volatile LAS unsigned* st; };
__device__ __forceinline__ XcdBarrier xcd_barrier_post(unsigned* bar, volatile LAS unsigned* st) {
    XcdBarrier b; b.bar = bar; b.x = xb_xcc_id(); b.st = st;
    if (tid_rebuild((const LAS unsigned char*)st - 131072) == 0) (void)xb_add(&bar[XB_XCNT(b.x)], 1u);
    return b;
}
__device__ __forceinline__ void xcd_barrier_complete(unsigned* bar, unsigned x, unsigned& nloc, unsigned& nx) {
    const unsigned G = gridDim.x * gridDim.y * gridDim.z;
    unsigned sum, cnt, mine, sp = 0u;
    for (;;) {
        sum = 0u; cnt = 0u; mine = 0u;
#pragma unroll
        for (unsigned j = 0; j < 16; ++j) { const unsigned c = xb_ld(&bar[XB_XCNT(j)]); sum += c; cnt += (c > 0u) ? 1u : 0u; mine = (j == x) ? c : mine; }
        if (sum == G) break;
        __builtin_amdgcn_s_sleep(1);
        if ((++sp & 255u) == 0u) { if (xb_ld(&bar[XB_TMO])) break; if (sp > XB_SPIN_CAP) { atomicAdd(&bar[XB_TMO], 1u); break; } }
    }
    nloc = mine > 0u ? mine : 1u; nx = cnt > 0u ? cnt : 1u;
}
__device__ __forceinline__ void xcd_barrier(const XcdBarrier& b) {
    asm volatile("s_waitcnt vmcnt(0)" ::: "memory");
    __syncthreads();
    if (tid_rebuild((const LAS unsigned char*)b.st - 131072) == 0) {
        unsigned* bar = b.bar;
        __builtin_amdgcn_s_waitcnt(0);
        unsigned nloc = b.st[0], nx = b.st[1];
        if (nloc == 0u) { xcd_barrier_complete(bar, b.x, nloc, nx); b.st[0] = nloc; b.st[1] = nx; }
        const unsigned old = xb_add(&bar[XB_XSUB(b.x)], 1u);
        const unsigned gen = old / nloc;
        if (old + 1u == (gen + 1u) * nloc) {
            __builtin_amdgcn_fence(__ATOMIC_RELEASE, "agent");
            asm volatile("s_waitcnt vmcnt(0)" ::: "memory");
            const unsigned og = xb_add(&bar[XB_TOP], 1u);
            const unsigned tg = og / nx;
            if (og + 1u == (tg + 1u) * nx) xb_add(&bar[XB_TOPGEN], 1u);
            else XB_SPIN(xb_ld(&bar[XB_TOPGEN]) == tg, bar);
            __builtin_amdgcn_fence(__ATOMIC_ACQUIRE, "agent");
            xb_add(&bar[XB_XGEN(b.x)], 1u);
            asm volatile("s_waitcnt vmcnt(0)" ::: "memory");
        } else {
            XB_SPIN(xb_ld(&bar[XB_XGEN(b.x)]) == gen, bar);
            __builtin_amdgcn_fence(__ATOMIC_ACQUIRE, "agent");
            asm volatile("s_waitcnt vmcnt(0)" ::: "memory");
        }
    }
    __syncthreads();
}

struct Params { const float* in[27]; float* out; unsigned char* ws; int step_lo, step_hi; };
struct Ctx { unsigned char* ws; float* out; LAS unsigned char* lds; int tid, bid, G; };
constexpr int LDS_PTAB = 131072 + 2048;
__device__ __forceinline__ unsigned long long uni64(unsigned long long v) {
    const unsigned lo = __builtin_amdgcn_readfirstlane((unsigned)v), hi = __builtin_amdgcn_readfirstlane((unsigned)(v >> 32)); return ((unsigned long long)hi << 32) | lo; }
__device__ __forceinline__ Ctx uni(Ctx X) { Ctx Y = X; int t = tid_rebuild(X.lds); asm volatile("" : "+v"(t)); Y.tid = t;
    unsigned long long w = (unsigned long long)X.ws; asm volatile("" : "+s"(w)); Y.ws = (unsigned char*)w;
    unsigned long long o = (unsigned long long)X.out; asm volatile("" : "+s"(o)); Y.out = (float*)o;
    int bb = blockIdx.x; asm volatile("" : "+s"(bb)); Y.bid = bb; int gg = gridDim.x; asm volatile("" : "+s"(gg)); Y.G = gg; return Y; }
__device__ __forceinline__ const float* ctx_in(const Ctx& X, int i) { return (const float*)uni64(*(const LAS unsigned long long*)(X.lds + LDS_PTAB + 8 * i)); }
#define INP(i) ctx_in(X, (i))
enum { I_X = 0, I_C, I_WADA, I_BADA, I_GMIX, I_GMOE, I_WIN, I_PEK, I_W1K, I_W2K, I_PEV, I_W1V, I_W2V, I_NQG, I_NKG, I_SQG, I_SKG, I_SINK,
       I_WBA, I_WBB, I_WBC, I_WOUT, I_WR, I_RB, I_WEG, I_WEU, I_WED };

#ifndef PRB_SEL
#define PRB_SEL 0
#endif
constexpr int CW_PRB = 7168;
#if PRB_SEL
#define PRB_DECL() unsigned long long prb_acc = 0ull, prb_t0 = 0ull; const unsigned long long prb_start = __builtin_readcyclecounter()
#define PRB_BEGIN(n) do { if ((n) == PRB_SEL) prb_t0 = __builtin_readcyclecounter(); } while (0)
#define PRB_END(n) do { if ((n) == PRB_SEL) prb_acc += __builtin_readcyclecounter() - prb_t0; } while (0)
#define PRB_FLUSH(X) do { if (((X).tid & 63) == 0) { unsigned* c_ = (unsigned*)((X).ws + WS_CTL); atomicAdd(c_ + CW_PRB, (unsigned)(prb_acc >> 8)); \
        atomicAdd(c_ + CW_PRB + 16, (unsigned)((__builtin_readcyclecounter() - prb_start) >> 8)); } } while (0)
#else
#define PRB_DECL() do {} while (0)
#define PRB_BEGIN(n) do {} while (0)
#define PRB_END(n) do {} while (0)
#define PRB_FLUSH(X) do {} while (0)
#endif

constexpr int CONV_PER_L = 576 + 768 + 256 + 256 + 256 + 8 + 4096 + 2048;
constexpr int CW_CVQ = 7680;
__device__ __forceinline__ void conv_tiles(const Ctx& X, LAS unsigned char* lds, int u0, int ustep, int uend) {
    unsigned char* ws = X.ws;
    const int tid = X.tid;
    LAS float* t32 = (LAS float*)lds;
    constexpr int PER_L = CONV_PER_L;
    const int lk = tid >> 3, lc8 = (tid & 7) * 8;
    const float* src = nullptr; const float* srcn = nullptr; bf16_t* dst = nullptr; bf16_t* dstn = nullptr; unsigned char* d8 = nullptr; unsigned char* d8n = nullptr;
    int src_ld = 0, dst_ld = 0, nvalid = 0, src_ldn = 0, dst_ldn = 0, nvalidn = 0;
    f32x4 va = (f32x4){0.f, 0.f, 0.f, 0.f}, vb = va, vna = va, vnb = va;
#define TDECODE(u, SRC, DST, SLD, DLD, NV, D8) do { \
            const int l = (u) / PER_L; int r = (u) % PER_L; NV = 64; D8 = nullptr; \
            if (r < 576) { const int n0 = (r / 16) * 64, k0 = (r % 16) * 64; int c0; \
                if (n0 < 896) c0 = n0; else if (n0 < 2176) c0 = n0 + 24; else if (n0 == 2176) { c0 = 896; NV = 24; } else { c0 = 0; NV = 0; } \
                SRC = INP(I_WIN) + ((size_t)l * 1024 + k0) * NIN + c0; SLD = NIN; DST = (bf16_t*)(ws + WS_WIN) + ((size_t)l * 2304 + n0) * 1024 + k0; DLD = 1024; } \
            else if ((r -= 576) < 768) { const int n0 = (r / 16) * 64, k0 = (r % 16) * 64; \
                SRC = INP(I_WIN) + ((size_t)l * 1024 + k0) * NIN + 2200 + n0; SLD = NIN; DST = (bf16_t*)(ws + WS_WM) + ((size_t)l * 3072 + n0) * 1024 + k0; DLD = 1024; \
                D8 = ws + WS_WM8 + ((size_t)l * 3072 + n0) * 1024 + k0; } \
            else if ((r -= 768) < 256) { const int n0 = (r / 16) * 64, k0 = (r % 16) * 64; \
                if (k0 < 512) SRC = INP(I_WBA) + ((size_t)l * 512 + k0) * 1024 + n0; \
                else if (k0 < 768) SRC = INP(I_WBB) + ((size_t)l * 256 + (k0 - 512)) * 1024 + n0; \
                else SRC = INP(I_WBC) + ((size_t)l * 256 + (k0 - 768)) * 1024 + n0; \
                SLD = 1024; DST = (bf16_t*)(ws + WS_WB) + ((size_t)l * 1024 + n0) * 1024 + k0; DLD = 1024; } \
            else if ((r -= 256) < 256) { const int n0 = (r / 16) * 64, k0 = (r % 16) * 64; \
                SRC = INP(I_WOUT) + ((size_t)l * 1024 + k0) * 1024 + n0; SLD = 1024; DST = (bf16_t*)(ws + WS_WO) + ((size_t)l * 1024 + n0) * 1024 + k0; DLD = 1024; } \
            else if ((r -= 256) < 256) { const int mat = r / 128, rr = r % 128, n0 = (rr / 32) * 64, k0 = (rr % 32) * 64; \
                SRC = INP(mat ? I_W1V : I_W1K) + ((size_t)l * 2048 + k0) * 256 + n0; SLD = 256; DST = (bf16_t*)(ws + WS_W1) + (((size_t)l * 2 + mat) * 256 + n0) * 2048 + k0; DLD = 2048; } \
            else if ((r -= 256) < 8) { const int mat = r / 4, k0 = (r % 4) * 64; \
                SRC = INP(mat ? I_W2V : I_W2K) + ((size_t)l * 256 + k0) * 64; SLD = 64; DST = (bf16_t*)(ws + WS_W2) + (((size_t)l * 2 + mat) * 64) * 256 + k0; DLD = 256; } \
            else if ((r -= 8) < 4096) { const int e = r / 256, rr = r % 256, n0 = (rr / 16) * 64, k0 = (rr % 16) * 64; \
                const int blk = n0 / 256, half = (n0 % 256) / 128, c0 = blk * 128 + (n0 % 128); \
                SRC = INP(half ? I_WEU : I_WEG) + (((size_t)l * 16 + e) * 1024 + k0) * 512 + c0; SLD = 512; DST = (bf16_t*)(ws + WS_WGU) + (((size_t)l * 16 + e) * 1024 + n0) * 1024 + k0; DLD = 1024; } \
            else { r -= 4096; const int e = r / 128, rr = r % 128, n0 = (rr / 8) * 64, k0 = (rr % 8) * 64; \
                SRC = INP(I_WED) + (((size_t)l * 16 + e) * 512 + k0) * 1024 + n0; SLD = 1024; DST = (bf16_t*)(ws + WS_WD) + (((size_t)l * 16 + e) * 1024 + n0) * 512 + k0; DLD = 512; } \
    } while (0)
#define TLOAD(SRC, SLD, NV, A, B) do { if (lc8 + 8 <= (NV)) { A = ldg4f((SRC) + (size_t)lk * (SLD) + lc8); B = ldg4f((SRC) + (size_t)lk * (SLD) + lc8 + 4); } \
            else { A = (f32x4){0.f, 0.f, 0.f, 0.f}; B = A; } } while (0)
    int u = u0;
    if (u < uend) { TDECODE(u, src, dst, src_ld, dst_ld, nvalid, d8); TLOAD(src, src_ld, nvalid, va, vb); }
    while (u < uend) {
        const int un = u + ustep;
        if (un < uend) { TDECODE(un, srcn, dstn, src_ldn, dst_ldn, nvalidn, d8n); TLOAD(srcn, src_ldn, nvalidn, vna, vnb); }
        {
            LAS float* w = t32 + lk * 65 + lc8;
            w[0] = va[0]; w[1] = va[1]; w[2] = va[2]; w[3] = va[3]; w[4] = vb[0]; w[5] = vb[1]; w[6] = vb[2]; w[7] = vb[3];
        }
        __syncthreads();
        {
            const int n = tid >> 3, k8 = (tid & 7) * 8;
            const LAS float* r_ = t32 + k8 * 65 + n;
            u32x4 o;
            o[0] = cvt_pk_bf16(r_[0 * 65], r_[1 * 65]); o[1] = cvt_pk_bf16(r_[2 * 65], r_[3 * 65]);
            o[2] = cvt_pk_bf16(r_[4 * 65], r_[5 * 65]); o[3] = cvt_pk_bf16(r_[6 * 65], r_[7 * 65]);
            stg4u(dst + (size_t)n * dst_ld + k8, o);
            if (d8 != nullptr) { u32x2 o8; int w8 = 0;
                w8 = __builtin_amdgcn_cvt_pk_fp8_f32(64.f * r_[0 * 65], 64.f * r_[1 * 65], w8, false); w8 = __builtin_amdgcn_cvt_pk_fp8_f32(64.f * r_[2 * 65], 64.f * r_[3 * 65], w8, true); o8[0] = (unsigned)w8; w8 = 0;
                w8 = __builtin_amdgcn_cvt_pk_fp8_f32(64.f * r_[4 * 65], 64.f * r_[5 * 65], w8, false); w8 = __builtin_amdgcn_cvt_pk_fp8_f32(64.f * r_[6 * 65], 64.f * r_[7 * 65], w8, true); o8[1] = (unsigned)w8;
                stg2u(d8 + (size_t)n * 1024 + k8, o8); }
        }
        __syncthreads();
        u = un; src = srcn; dst = dstn; src_ld = src_ldn; dst_ld = dst_ldn; nvalid = nvalidn; va = vna; vb = vnb; d8 = d8n;
    }
#undef TDECODE
#undef TLOAD
}
__device__ __forceinline__ void conv_fill(const Ctx& X, LAS unsigned char* lds, int l, int max_batches, bool drain) {
    if (l >= NL) return;
    unsigned* q = (unsigned*)(X.ws + WS_CTL) + CW_CVQ + 16 * l;
    LAS int* bc = (LAS int*)(lds + LDS_MISC + 32);
    for (int b = 0; drain || b < max_batches; ++b) {
        if (X.tid == 0) bc[0] = (int)atomicAdd(q, 4u);
        __syncthreads();
        const int idx0 = bc[0];
        __syncthreads();
        if (idx0 >= CONV_PER_L) break;
        const int iend = (idx0 + 4 < CONV_PER_L) ? idx0 + 4 : CONV_PER_L;
        conv_tiles(X, lds, l * CONV_PER_L + idx0, 1, l * CONV_PER_L + iend);
    }
}

__device__ __forceinline__ void p0_prologue(const Ctx& X, LAS unsigned char* lds) {
    unsigned char* ws = X.ws;
    const int tid = X.tid, G = X.G, bid = X.bid;
    {
        const int lane = tid & 63, wave = tid >> 6;
        LAS float* sc = (LAS float*)lds;
        LAS float* red = (LAS float*)(lds + 8192);
        for (int i = tid; i < 2048; i += 512) { const float cv = INP(I_C)[i]; sc[i] = cv * sigmoidf_(cv); }
        __syncthreads();
        for (int u = bid; u < 256; u += G) {
            const int l = u >> 6, j0 = (u & 63) * 96;
            f32x4 a0 = (f32x4){0.f, 0.f, 0.f, 0.f}, a1 = a0;
            if (lane < 24) {
                const float* w = INP(I_WADA) + (size_t)l * 1024 * 6144 + j0 + 4 * lane;
#pragma unroll 8
                for (int k = wave * 128; k < wave * 128 + 128; ++k) { const f32x4 wv = ldg4f(w + (size_t)k * 6144); a0 += wv * sc[k]; a1 += wv * sc[1024 + k]; }
#pragma unroll
                for (int j = 0; j < 4; ++j) { red[(wave * 2 + 0) * 96 + 4 * lane + j] = a0[j]; red[(wave * 2 + 1) * 96 + 4 * lane + j] = a1[j]; }
            }
            __syncthreads();
            if (tid < 192) {
                const int b = tid / 96, j = tid % 96; float sm = 0.f;
#pragma unroll
                for (int w = 0; w < 8; ++w) sm += red[(w * 2 + b) * 96 + j];
                ((float*)(ws + WS_MOD))[((size_t)l * 2 + b) * 6144 + j0 + j] = sm + INP(I_BADA)[l * 6144 + j0 + j];
            }
            __syncthreads();
        }
        for (int u = bid; u < 256; u += G) {
            const int l = u >> 6, mat = (u >> 5) & 1, cc = u & 31;
            const float* pe = INP(mat ? I_PEV : I_PEK) + (size_t)l * 2048;
            const float* w = INP(mat ? I_W1V : I_W1K) + (size_t)l * 2048 * 256 + cc * 8 + (lane & 1) * 4;
            f32x4 a = (f32x4){0.f, 0.f, 0.f, 0.f};
#pragma unroll
            for (int it = 0; it < 8; ++it) { const int row = wave * 256 + it * 32 + (lane >> 1); a += ldg4f(w + (size_t)row * 256) * pe[row]; }
#pragma unroll
            for (int j = 0; j < 4; ++j) { float v = a[j]; v += shx<2>(v, lane); v += shx<4>(v, lane); v += shx<8>(v, lane); v += shx<16>(v, lane); v += shx<32>(v, lane); a[j] = v; }
            if (lane < 2) {
#pragma unroll
                for (int j = 0; j < 4; ++j) red[wave * 8 + lane * 4 + j] = a[j];
            }
            __syncthreads();
            if (tid < 8) { float sm = 0.f;
#pragma unroll
                for (int w2 = 0; w2 < 8; ++w2) sm += red[w2 * 8 + tid];
                ((float*)(ws + WS_CB))[(l * 2 + mat) * 256 + cc * 8 + tid] = sm; }
            __syncthreads();
        }
    }
    __syncthreads();
    conv_tiles(X, lds, bid, G, CONV_PER_L);
}

template <int N> struct IC { static constexpr int value = N; };
template <int MODE>
__device__ __forceinline__ void norm_phase(const Ctx& X, LAS unsigned char* lds, int layer) {
    unsigned char* ws = X.ws;
    const int tid = X.tid, lane = tid & 63, wave = tid >> 6, G = X.G;
    const float* xsrc = INP(I_X);
    float* xdst = X.out;
    bf16_t* xb = (bf16_t*)(ws + WS_XB);
    const float* modl = (const float*)(ws + WS_MOD) + (size_t)layer * 2 * 6144;
    const float* modp = (const float*)(ws + WS_MOD) + (size_t)(layer - 1) * 2 * 6144;
    const bf16_t* yb = (const bf16_t*)(ws + WS_YS);
    const u32x4* tinfo = (const u32x4*)(ws + WS_TINFO);
    LAS int* tpad = (LAS int*)(lds + LDS_MISC + 1024);
    LAS int* ttmp = (LAS int*)(lds + LDS_MISC + 1088);
    bf16_t* h = (bf16_t*)(ws + WS_H);
    const float* gn = INP(MODE == 2 ? I_GMOE : I_GMIX) + (size_t)layer * 1024;
    const int sh_off = (MODE == 2) ? 3072 : 0, sc_off = (MODE == 2) ? 4096 : 1024;
    LAS float* wrT = (LAS float*)lds;
    LAS int* lcnt = (LAS int*)(lds + LDS_MISC + 64);
    LAS int* lbase = (LAS int*)(lds + LDS_MISC + 128);
    LAS float* lgl = (LAS float*)(lds + 65536);
    if (MODE == 2) {
        for (int i = tid; i < 16384; i += 512) { const int k = i >> 4, e = i & 15; wrT[e * 1024 + k] = INP(I_WR)[i]; }
        if (tid < 16) lcnt[tid] = 0;
        __syncthreads();
    }
    if (MODE == 1 || MODE == 3) {
        const unsigned* gcnt = (const unsigned*)(ws + WS_CTL) + CW_GCNT + 16 * ((layer - 1) * 16);
        if (tid < 16) ttmp[tid] = (((int)__hip_atomic_load(gcnt + 16 * tid, __ATOMIC_RELAXED, __HIP_MEMORY_SCOPE_AGENT) + 255) >> 8) * 256;
        __syncthreads();
        if (tid < 16) { int p = 0; for (int k = 0; k < tid; ++k) p += ttmp[k]; tpad[tid] = p; }
        __syncthreads();
    }
    int it = 0; (void)it;
    const int stride = G * 8, r0 = X.bid * 8 + wave;
    f32x4 vn[2][4]; u32x2 xbn[2][4], y0n[2][4], y1n[2][4]; float w0n[2] = {0.f, 0.f}, w1n[2] = {0.f, 0.f}; u32x4 tin[2] = {(u32x4){0u, 0u, 0u, 0u}, (u32x4){0u, 0u, 0u, 0u}};
#define NORM_LOAD(S, r) do { size_t yr0_ = 0, yr1_ = 0; \
        if (MODE == 1 || MODE == 3) { const unsigned a0_ = __builtin_amdgcn_readfirstlane(tin[S][0]), a1_ = __builtin_amdgcn_readfirstlane(tin[S][2]); \
            w0n[S] = __uint_as_float(__builtin_amdgcn_readfirstlane(tin[S][1])); w1n[S] = __uint_as_float(__builtin_amdgcn_readfirstlane(tin[S][3])); \
            yr0_ = (size_t)(__builtin_amdgcn_readfirstlane(tpad[a0_ & 15u]) + (int)(a0_ >> 4)) * 1024; yr1_ = (size_t)(__builtin_amdgcn_readfirstlane(tpad[a1_ & 15u]) + (int)(a1_ >> 4)) * 1024; } \
        _Pragma("unroll") for (int i = 0; i < 4; ++i) { const int col_ = 4 * (lane + 64 * i); \
        if (MODE == 0 || MODE == 2) vn[S][i] = ldg4f(xsrc + (size_t)(r) * 1024 + col_); \
        if (MODE == 1 || MODE == 3) { xbn[S][i] = ldg2u(xb + (size_t)(r) * 1024 + col_); y0n[S][i] = ldg2u(yb + yr0_ + col_); y1n[S][i] = ldg2u(yb + yr1_ + col_); } } } while (0)
    if (MODE == 1 || MODE == 3) { if (r0 < NTOK) tin[0] = ldg4u(tinfo + (r0)); if (r0 + stride < NTOK) tin[1] = ldg4u(tinfo + (r0 + stride)); }
    if (r0 < NTOK) { NORM_LOAD(0, r0); if ((MODE == 1 || MODE == 3) && r0 + 2 * stride < NTOK) tin[0] = ldg4u(tinfo + (r0 + 2 * stride)); }
    if (r0 + stride < NTOK) { NORM_LOAD(1, r0 + stride); if ((MODE == 1 || MODE == 3) && r0 + 3 * stride < NTOK) tin[1] = ldg4u(tinfo + (r0 + 3 * stride)); }
    int bcur = -1; f32x4 gmv[4], gscv[4], shv4[4];
    auto body = [&](auto SC, const int row) __attribute__((always_inline)) {
        constexpr int S = decltype(SC)::value;
        const int b = row >> 14;
        if (b != bcur) {
            bcur = b;
#pragma unroll
            for (int i = 0; i < 4; ++i) { const int col = 4 * (lane + 64 * i);
                if (MODE == 1 || MODE == 3) gmv[i] = ldg4f(modp + b * 6144 + 5120 + col);
                if (MODE != 3) { const f32x4 g = ldg4f(gn + col), sc = ldg4f(modl + b * 6144 + sc_off + col); gscv[i] = g * (1.f + sc); shv4[i] = ldg4f(modl + b * 6144 + sh_off + col); } }
        }
        f32x4 v[4];
#pragma unroll
        for (int i = 0; i < 4; ++i) {
            if (MODE == 1 || MODE == 3) {
                const u32x2 xq = xbn[S][i], y0 = y0n[S][i], y1 = y1n[S][i]; const f32x4 g = gmv[i]; const float w0c = w0n[S], w1c = w1n[S];
                v[i][0] = bf_lo(xq[0]) + g[0] * (w0c * bf_lo(y0[0]) + w1c * bf_lo(y1[0])); v[i][1] = bf_hi(xq[0]) + g[1] * (w0c * bf_hi(y0[0]) + w1c * bf_hi(y1[0]));
                v[i][2] = bf_lo(xq[1]) + g[2] * (w0c * bf_lo(y0[1]) + w1c * bf_lo(y1[1])); v[i][3] = bf_hi(xq[1]) + g[3] * (w0c * bf_hi(y0[1]) + w1c * bf_hi(y1[1]));
            } else v[i] = vn[S][i];
        }
        asm volatile("" ::: "memory");
        if (row + 2 * stride < NTOK) { NORM_LOAD(S, row + 2 * stride); if ((MODE == 1 || MODE == 3) && row + 4 * stride < NTOK) tin[S] = ldg4u(tinfo + (row + 4 * stride)); }
        asm volatile("" ::: "memory");
#pragma unroll
        for (int i = 0; i < 4; ++i) {
            const int col = 4 * (lane + 64 * i);
#if PRB_SEL
            if (MODE == 3) { const unsigned* c_ = (const unsigned*)(ws + WS_CTL); const float fr_ = (float)c_[CW_PRB] / fmaxf((float)c_[CW_PRB + 16], 1.f);
                v[i] *= 1.f + sqrtf(0.02f + 0.5f * fr_); }
#endif
            if (MODE == 3) stg4f(xdst + (size_t)row * 1024 + col, v[i]);
            else { u32x2 o; o[0] = cvt_pk_bf16(v[i][0], v[i][1]); o[1] = cvt_pk_bf16(v[i][2], v[i][3]); stg2u(xb + (size_t)row * 1024 + col, o); }
        }
        if (MODE == 3) return;
        float ss = 0.f;
#pragma unroll
        for (int i = 0; i < 4; ++i) ss += v[i][0] * v[i][0] + v[i][1] * v[i][1] + v[i][2] * v[i][2] + v[i][3] * v[i][3];
        ss = wave_sum(ss, lane);
        const float rinv = rsqrtf(ss * (1.f / 1024.f) + 1e-6f);
#pragma unroll
        for (int i = 0; i < 4; ++i) {
            const int col = 4 * (lane + 64 * i);
            f32x4 hv;
#pragma unroll
            for (int j = 0; j < 4; ++j) hv[j] = v[i][j] * rinv * gscv[i][j] + shv4[i][j];
            u32x2 o; o[0] = cvt_pk_bf16(hv[0], hv[1]); o[1] = cvt_pk_bf16(hv[2], hv[3]);
            stg2u(h + (size_t)row * 1024 + col, o);
            { int w8 = 0; w8 = __builtin_amdgcn_cvt_pk_fp8_f32(hv[0], hv[1], w8, false); w8 = __builtin_amdgcn_cvt_pk_fp8_f32(hv[2], hv[3], w8, true);
              *(GAS int*)(ws + WS_H8 + (size_t)row * 1024 + col) = w8; }
        }
    };
    for (int rowp = r0; rowp < NTOK; rowp += 2 * stride) { body(IC<0>{}, rowp); if (rowp + stride < NTOK) body(IC<1>{}, rowp + stride); }
#undef NORM_LOAD
    if (MODE == 2) {
        __syncthreads();
        const int slot = tid, srow = X.bid * 8 + (slot & 7) + (slot >> 3) * G * 8;
        const bool have = (slot < 512) && (srow < NTOK) && ((slot >> 3) < 64);
        int e0 = 0, e1 = 0, r0 = 0, r1i = 0; float w0 = 0.f, w1 = 0.f;
        if (have) {
            float sco[16], sel[16];
            f32x4 rb4[4];
#pragma unroll
            for (int q = 0; q < 4; ++q) rb4[q] = ldg4f(INP(I_RB) + 4 * q);
#pragma unroll
            for (int q = 0; q < 4; ++q) { const f32x4 lg4 = *(const LAS f32x4*)(lgl + slot * 16 + 4 * q);
#pragma unroll
                for (int j = 0; j < 4; ++j) { const int e = 4 * q + j; sco[e] = 1.f / (1.f + __expf(-lg4[j])); sel[e] = sco[e] + rb4[q][j]; } }
            float gs[4];
#pragma unroll
            for (int g = 0; g < 4; ++g) {
                const float a = sel[4 * g], bq = sel[4 * g + 1], c = sel[4 * g + 2], d = sel[4 * g + 3];
                const float m1 = fmaxf(fmaxf(a, bq), fmaxf(c, d));
                int i1 = (a == m1) ? 0 : (bq == m1) ? 1 : (c == m1) ? 2 : 3;
                float m2 = -3.0e38f;
                m2 = (i1 != 0) ? fmaxf(m2, a) : m2; m2 = (i1 != 1) ? fmaxf(m2, bq) : m2; m2 = (i1 != 2) ? fmaxf(m2, c) : m2; m2 = (i1 != 3) ? fmaxf(m2, d) : m2;
                gs[g] = m1 + m2;
            }
            int gi = 0; float gb = gs[0];
#pragma unroll
            for (int g = 1; g < 4; ++g) if (gs[g] > gb) { gb = gs[g]; gi = g; }
            float s0 = (gi == 0) ? sel[0] : (gi == 1) ? sel[4] : (gi == 2) ? sel[8] : sel[12];
            float s1 = (gi == 0) ? sel[1] : (gi == 1) ? sel[5] : (gi == 2) ? sel[9] : sel[13];
            float s2 = (gi == 0) ? sel[2] : (gi == 1) ? sel[6] : (gi == 2) ? sel[10] : sel[14];
            float s3 = (gi == 0) ? sel[3] : (gi == 1) ? sel[7] : (gi == 2) ? sel[11] : sel[15];
            float c0 = (gi == 0) ? sco[0] : (gi == 1) ? sco[4] : (gi == 2) ? sco[8] : sco[12];
            float c1 = (gi == 0) ? sco[1] : (gi == 1) ? sco[5] : (gi == 2) ? sco[9] : sco[13];
            float c2 = (gi == 0) ? sco[2] : (gi == 1) ? sco[6] : (gi == 2) ? sco[10] : sco[14];
            float c3 = (gi == 0) ? sco[3] : (gi == 1) ? sco[7] : (gi == 2) ? sco[11] : sco[15];
            const float m1 = fmaxf(fmaxf(s0, s1), fmaxf(s2, s3));
            const int i1 = (s0 == m1) ? 0 : (s1 == m1) ? 1 : (s2 == m1) ? 2 : 3;
            float m2 = -3.0e38f;
            m2 = (i1 != 0) ? fmaxf(m2, s0) : m2; m2 = (i1 != 1) ? fmaxf(m2, s1) : m2; m2 = (i1 != 2) ? fmaxf(m2, s2) : m2; m2 = (i1 != 3) ? fmaxf(m2, s3) : m2;
            const int i2 = (i1 != 0 && s0 == m2) ? 0 : (i1 != 1 && s1 == m2) ? 1 : (i1 != 2 && s2 == m2) ? 2 : 3;
            const float w1v = (i1 == 0) ? c0 : (i1 == 1) ? c1 : (i1 == 2) ? c2 : c3;
            const float w2v = (i2 == 0) ? c0 : (i2 == 1) ? c1 : (i2 == 2) ? c2 : c3;
            const float wn = 1.f / (w1v + w2v);
            e0 = gi * 4 + i1; e1 = gi * 4 + i2; w0 = w1v * wn; w1 = w2v * wn;
            r0 = __hip_atomic_fetch_add(lcnt + e0, 1, __ATOMIC_RELAXED, __HIP_MEMORY_SCOPE_WORKGROUP); r1i = __hip_atomic_fetch_add(lcnt + e1, 1, __ATOMIC_RELAXED, __HIP_MEMORY_SCOPE_WORKGROUP);
        }
        __syncthreads();
        unsigned* gcnt = (unsigned*)(ws + WS_CTL) + CW_GCNT + 16 * (layer * 16);
        if (tid < 16) lbase[tid] = (int)atomicAdd(gcnt + 16 * tid, (unsigned)lcnt[tid]);
        __syncthreads();
        if (have) {
            int* lt = (int*)(ws + WS_LISTT); float* lw = (float*)(ws + WS_LISTW);
            const int p0 = lbase[e0] + r0, p1 = lbase[e1] + r1i;
            lt[e0 * LCAP + p0] = srow * 2; lw[e0 * LCAP + p0] = w0;
            lt[e1 * LCAP + p1] = srow * 2 + 1; lw[e1 * LCAP + p1] = w1;
        }
    }
    __syncthreads();
}

constexpr int BM = 256, BK = 64, HALF = 128, HTB = HALF * BK * 2, STAGE_BYTES = 8 * HTB;
__host__ __device__ __forceinline__ int lds_byte(int r, int c) { const int st = (r >> 4) * 2 + (c >> 5), rr = r & 15, cc = c & 31, ob = rr * 64 + cc * 2; return st * 1024 + (ob ^ (((ob >> 9) & 1) << 5)); }
__host__ __device__ __forceinline__ void stage_rc(int b, int& R, int& C) { const int st = b / 1024, sb = b % 1024, swz = sb ^ (((sb >> 9) & 1) << 5); R = (st >> 1) * 16 + swz / 64; C = (st & 1) * 32 + (swz % 64) / 2; }
__host__ __device__ __forceinline__ int perm32(int rho) { const int n = rho >> 4, i = rho & 15; return 8 * (i >> 2) + 4 * n + (i & 3); }

struct GU { const char* A; const char* B; int nt, kind, pm, pn, e, aux; };
typedef int i32x8 __attribute__((ext_vector_type(8)));
typedef int i32x4_ __attribute__((ext_vector_type(4)));

__device__ __forceinline__ bool tile_map(long L, int nM, int nN, int& pm, int& pn) {
    const int nwg = nM * nN; if (L >= nwg) return false;
    int wgid = (int)L; { const int q = nwg / 8, r = nwg % 8, xcd = wgid % 8, off = wgid / 8; wgid = (xcd < r ? xcd * (q + 1) : r * (q + 1) + (xcd - r) * q) + off; }
    const int nig = 8 * nN, gid = wgid / nig, fm = gid * 8, gsz = (nM - fm) < 8 ? (nM - fm) : 8;
    pm = fm + ((wgid % nig) % gsz); pn = (wgid % nig) / gsz; return true;
}

template <class Epi, class Sched>
__device__ __forceinline__ void gemm_run(LAS unsigned char* lds, const Sched& S, const Epi& E, const int tid) {
    const int wid = __builtin_amdgcn_readfirstlane(tid >> 6), lane = tid & 63, wr = wid >> 2, wc = wid & 3, fr = lane & 15, fq = lane >> 4;
    unsigned vA[2][2], vAn[2][2], voffB[2];
#pragma unroll
    for (int i = 0; i < 2; ++i) { int R, C; stage_rc(tid * 16 + i * 8192, R, C); const int Rb = Epi::HEADMAP ? ((R >> 5) * 64 + perm32(R & 31)) : (Epi::PERM ? ((R & ~31) + perm32(R & 31)) : R);
        voffB[i] = (unsigned)Rb * (unsigned)S.ldb2 + (unsigned)C * 2u;
        vA[0][i] = (unsigned)R * (unsigned)S.lda2 + (unsigned)C * 2u; vA[1][i] = (unsigned)(R + HALF) * (unsigned)S.lda2 + (unsigned)C * 2u;
        vAn[0][i] = vA[0][i]; vAn[1][i] = vA[1][i]; }
    const size_t akstep = (size_t)S.akstep, bkstep = (size_t)(BK * 2), hstepB = (size_t)(Epi::HEADMAP ? 32 : HALF) * S.ldb2;
    const unsigned ldsw = (unsigned)wid * 1024u;
    const int aoff = lds_byte(wr * 64 + fr, fq * 8), boff = lds_byte(wc * 32 + fr, fq * 8);
    unsigned voffB8[2] = {0u, 0u}; size_t hstepB8 = 0;
    int aoff8a = 0, aoff8b = 0, boff8a = 0, boff8b = 0;
    if (Sched::FP8) {
#pragma unroll
        for (int i = 0; i < 2; ++i) { int R, C; stage_rc(tid * 16 + i * 8192, R, C); const int Rb = Epi::PERM ? ((R & ~31) + perm32(R & 31)) : R; voffB8[i] = (unsigned)Rb * (unsigned)(S.ldb2 / 2) + (unsigned)C * 2u; }
        hstepB8 = (size_t)HALF * (S.ldb2 / 2);
        aoff8a = aoff; aoff8b = aoff + 1024; boff8a = boff; boff8b = boff + 1024;
    }
#define G_SA(b, h) (((b) * 2 + (h)) * HTB)
#define G_SB(b, h) ((4 + (b) * 2 + (h)) * HTB)
#define G_STAGE2(bufoff, gbase, o0, o1) do { \
        __builtin_amdgcn_global_load_lds((const unsigned*)((const char*)(gbase) + (o0)), (LAS unsigned*)(lds + (bufoff) + ldsw), 16, 0, 0); \
        __builtin_amdgcn_global_load_lds((const unsigned*)((const char*)(gbase) + (o1)), (LAS unsigned*)(lds + (bufoff) + ldsw + 8192), 16, 0, 0); } while (0)
#define G_STAGE_B(bufoff, gbase) G_STAGE2(bufoff, gbase, voffB[0], voffB[1])
#define G_LDA(dst, b, h) do { _Pragma("unroll") for (int m = 0; m < 4; ++m) _Pragma("unroll") for (int k = 0; k < 2; ++k) dst[m][k] = *(const LAS bf16x8*)(lds + G_SA(b, h) + aoff + m * 2048 + k * 1024); } while (0)
#define G_LDB(dst, b, h) do { _Pragma("unroll") for (int n = 0; n < 2; ++n) _Pragma("unroll") for (int k = 0; k < 2; ++k) dst[n][k] = *(const LAS bf16x8*)(lds + G_SB(b, h) + boff + n * 2048 + k * 1024); } while (0)
#define G_MMA(ai, bj, At, Bt) do { __builtin_amdgcn_s_setprio(1); _Pragma("unroll") for (int m = 0; m < 4; ++m) _Pragma("unroll") for (int n = 0; n < 2; ++n) _Pragma("unroll") for (int k = 0; k < 2; ++k) \
        acc[ai][bj][m][n] = __builtin_amdgcn_mfma_f32_16x16x32_bf16(Bt[n][k], At[m][k], acc[ai][bj][m][n], 0, 0, 0); __builtin_amdgcn_s_setprio(0); } while (0)
#define G_RD8(dst, base, oa, ob) do { const u32x4 lo_ = *(const LAS u32x4*)(lds + (base) + (oa)), hi_ = *(const LAS u32x4*)(lds + (base) + (ob)); \
        dst[0] = (int)lo_[0]; dst[1] = (int)lo_[1]; dst[2] = (int)lo_[2]; dst[3] = (int)lo_[3]; dst[4] = (int)hi_[0]; dst[5] = (int)hi_[1]; dst[6] = (int)hi_[2]; dst[7] = (int)hi_[3]; } while (0)
#define G_LDA8(dst, b, h) do { _Pragma("unroll") for (int m = 0; m < 4; ++m) G_RD8(dst[m], G_SA(b, h) + m * 2048, aoff8a, aoff8b); } while (0)
#define G_LDB8(dst, b, h) do { _Pragma("unroll") for (int n = 0; n < 2; ++n) G_RD8(dst[n], G_SB(b, h) + n * 2048, boff8a, boff8b); } while (0)
#define G_MMA8(ai, bj, At, Bt) do { __builtin_amdgcn_s_setprio(1); _Pragma("unroll") for (int m = 0; m < 4; ++m) _Pragma("unroll") for (int n = 0; n < 2; ++n) \
        asm volatile("v_mfma_scale_f32_16x16x128_f8f6f4 %0, %1, %2, %0, %3, %3 op_sel_hi:[0,0,0]" : "+v"(acc[ai][bj][m][n]) : "v"(Bt[n]), "v"(At[m]), "v"(sc1_)); __builtin_amdgcn_s_setprio(0); } while (0)
#define G_WAIT_V(n) asm volatile("s_waitcnt vmcnt(" #n ")" ::: "memory")
#define G_WAIT_L(n) asm volatile("s_waitcnt lgkmcnt(" #n ")" ::: "memory")
#define G_BAR __builtin_amdgcn_s_barrier()
#define G_SCHED __builtin_amdgcn_sched_barrier(0)
    GU cur, nxt; int ui = 0;
    if (!S.next(0, cur)) return;
    if (Sched::GATHER) S.rowoff(cur, tid, vA);
    f32x4 acc[2][2][4][2];
#pragma unroll
    for (int a = 0; a < 2; ++a)
#pragma unroll
        for (int b = 0; b < 2; ++b)
#pragma unroll
            for (int m = 0; m < 4; ++m)
#pragma unroll
                for (int n = 0; n < 2; ++n) acc[a][b][m][n] = (f32x4){0.f, 0.f, 0.f, 0.f};
    bf16x8 At[4][2], B0[2][2], B1[2][2];
    i32x8 At8[4], B08[2], B18[2]; int sc1_ = 0x7f7f7f7f; asm volatile("" : "+v"(sc1_));
    const char* cA = cur.A; const char* cB = cur.B;
    { constexpr bool f8 = Sched::FP8; const unsigned p0 = f8 ? voffB8[0] : voffB[0], p1 = f8 ? voffB8[1] : voffB[1]; const size_t hs = f8 ? hstepB8 : hstepB;
      G_STAGE2(G_SB(0, 0), cB, p0, p1); G_STAGE2(G_SA(0, 0), cA, vA[0][0], vA[0][1]); G_STAGE2(G_SB(0, 1), cB + hs, p0, p1); G_STAGE2(G_SA(0, 1), cA, vA[1][0], vA[1][1]);
      if (wr == 1) G_BAR;
      G_WAIT_V(4); G_BAR;
      G_STAGE2(G_SB(1, 0), cB + bkstep, p0, p1); G_STAGE2(G_SA(1, 0), cA + akstep, vA[0][0], vA[0][1]); G_STAGE2(G_SB(1, 1), cB + hs + bkstep, p0, p1);
      G_WAIT_V(6); G_BAR; }
    for (;;) {
        const bool has_next = S.next(ui + 1, nxt);
        const char* nA = has_next ? nxt.A : cA; const char* nB = has_next ? nxt.B : cB;
        if (Sched::GATHER) { if (has_next) S.rowoff(nxt, tid, vAn); else {
#pragma unroll
            for (int h = 0; h < 2; ++h) { vAn[h][0] = vA[h][0]; vAn[h][1] = vA[h][1]; } } }
        const int nt = cur.nt;
        constexpr bool c8 = Sched::FP8, n8 = Sched::FP8;
        const unsigned obc0 = c8 ? voffB8[0] : voffB[0], obc1 = c8 ? voffB8[1] : voffB[1], obn0 = n8 ? voffB8[0] : voffB[0], obn1 = n8 ? voffB8[1] : voffB[1];
        const size_t hsc = c8 ? hstepB8 : hstepB, hsn = n8 ? hstepB8 : hstepB;
        for (int t = 0; t < nt; t += 2) {
            const bool last = (t == nt - 2);
            const char* a1 = cA + (size_t)(t + 1) * akstep;
            const char* a2 = last ? nA : cA + (size_t)(t + 2) * akstep; const char* b2 = last ? nB : cB + (size_t)(t + 2) * bkstep;
            const char* a3 = a2 + akstep; const char* b3 = b2 + bkstep;
            const unsigned ob0 = last ? obn0 : obc0, ob1 = last ? obn1 : obc1; const size_t hsx = last ? hsn : hsc;
            unsigned w00, w01, w10, w11;
            if (Sched::GATHER) { w00 = last ? vAn[0][0] : vA[0][0]; w01 = last ? vAn[0][1] : vA[0][1]; w10 = last ? vAn[1][0] : vA[1][0]; w11 = last ? vAn[1][1] : vA[1][1]; }
            else { w00 = vA[0][0]; w01 = vA[0][1]; w10 = vA[1][0]; w11 = vA[1][1]; }
            if constexpr (c8) {
            G_LDB8(B08, 0, 0); G_SCHED; G_LDA8(At8, 0, 0); G_STAGE2(G_SA(1, 1), a1, vA[1][0], vA[1][1]);
            G_WAIT_L(8); G_BAR; G_WAIT_L(0); G_MMA8(0, 0, At8, B08); G_BAR; G_SCHED;
            G_LDB8(B18, 0, 1); G_STAGE2(G_SB(0, 0), b2, ob0, ob1);
            G_BAR; G_WAIT_L(0); G_MMA8(0, 1, At8, B18); G_BAR;
            G_LDA8(At8, 0, 1); G_STAGE2(G_SA(0, 0), a2, w00, w01);
            G_BAR; G_WAIT_L(0); G_MMA8(1, 0, At8, B08); G_BAR; G_SCHED;
            G_STAGE2(G_SB(0, 1), b2 + hsx, ob0, ob1);
            G_WAIT_V(6); G_BAR; G_MMA8(1, 1, At8, B18); G_BAR;
            G_LDB8(B08, 1, 0); G_SCHED; G_LDA8(At8, 1, 0); G_STAGE2(G_SA(0, 1), a2, w10, w11);
            G_WAIT_L(8); G_BAR; G_WAIT_L(0); G_MMA8(0, 0, At8, B08); G_BAR; G_SCHED;
            G_LDB8(B18, 1, 1); G_STAGE2(G_SB(1, 0), b3, ob0, ob1);
            G_BAR; G_WAIT_L(0); G_MMA8(0, 1, At8, B18); G_BAR;
            G_LDA8(At8, 1, 1); G_STAGE2(G_SA(1, 0), a3, w00, w01);
            G_BAR; G_WAIT_L(0); G_MMA8(1, 0, At8, B08); G_BAR; G_SCHED;
            G_STAGE2(G_SB(1, 1), b3 + hsx, ob0, ob1);
            G_WAIT_V(6); G_BAR; G_MMA8(1, 1, At8, B18); G_BAR;
            } else {
            G_LDB(B0, 0, 0); G_SCHED; G_LDA(At, 0, 0); G_STAGE2(G_SA(1, 1), a1, vA[1][0], vA[1][1]);
            G_WAIT_L(8); G_BAR; G_WAIT_L(0); G_MMA(0, 0, At, B0); G_BAR; G_SCHED;
            G_LDB(B1, 0, 1); G_STAGE2(G_SB(0, 0), b2, ob0, ob1);
            G_BAR; G_WAIT_L(0); G_MMA(0, 1, At, B1); G_BAR;
            G_LDA(At, 0, 1); G_STAGE2(G_SA(0, 0), a2, w00, w01);
            G_BAR; G_WAIT_L(0); G_MMA(1, 0, At, B0); G_BAR; G_SCHED;
            G_STAGE2(G_SB(0, 1), b2 + hsx, ob0, ob1);
            G_WAIT_V(6); G_BAR; G_MMA(1, 1, At, B1); G_BAR;
            G_LDB(B0, 1, 0); G_SCHED; G_LDA(At, 1, 0); G_STAGE2(G_SA(0, 1), a2, w10, w11);
            G_WAIT_L(8); G_BAR; G_WAIT_L(0); G_MMA(0, 0, At, B0); G_BAR; G_SCHED;
            G_LDB(B1, 1, 1); G_STAGE2(G_SB(1, 0), b3, ob0, ob1);
            G_BAR; G_WAIT_L(0); G_MMA(0, 1, At, B1); G_BAR;
            G_LDA(At, 1, 1); G_STAGE2(G_SA(1, 0), a3, w00, w01);
            G_BAR; G_WAIT_L(0); G_MMA(1, 0, At, B0); G_BAR; G_SCHED;
            G_STAGE2(G_SB(1, 1), b3 + hsx, ob0, ob1);
            G_WAIT_V(6); G_BAR; G_MMA(1, 1, At, B1); G_BAR;
            }
        }
        { int fr2 = fr, fq2 = fq; asm volatile("" : "+v"(fr2), "+v"(fq2));
          E(acc, cur, wr, wc, fr2, fq2); }
        if (!has_next) break;
        if (!(Sched::CHAIN && cur.aux != 0)) {
#pragma unroll
            for (int a = 0; a < 2; ++a)
#pragma unroll
                for (int b = 0; b < 2; ++b)
#pragma unroll
                    for (int m = 0; m < 4; ++m)
#pragma unroll
                        for (int n = 0; n < 2; ++n) acc[a][b][m][n] = (f32x4){0.f, 0.f, 0.f, 0.f};
        }
        cur = nxt; cA = nA; cB = nB; ++ui;
        if (Sched::GATHER) {
#pragma unroll
            for (int h = 0; h < 2; ++h) { vA[h][0] = vAn[h][0]; vA[h][1] = vAn[h][1]; } }
    }
    G_WAIT_V(0);
    if (wr == 0) G_BAR;
    G_BAR;
#undef G_SA
#undef G_SB
#undef G_STAGE2
#undef G_STAGE_B
#undef G_LDA
#undef G_LDB
#undef G_MMA
#undef G_MMA8
#undef G_LDA8
#undef G_LDB8
#undef G_RD8
#undef G_WAIT_V
#undef G_WAIT_L
#undef G_BAR
#undef G_SCHED
}

struct SchedDense {
    static constexpr bool GATHER = false, FP8 = false, CHAIN = false;
    int lda2, akstep, ldb2; const char* A; const char* B; int nM, nN, nt, G, c;
    __device__ __forceinline__ bool next(int i, GU& u) const {
        int pm, pn; if (!tile_map((long)i * G + c, nM, nN, pm, pn)) return false;
        u.A = A + (size_t)pm * 256 * lda2; u.B = B + (size_t)pn * 256 * ldb2; u.nt = nt; u.kind = 0; u.pm = pm; u.pn = pn; u.e = 0; u.aux = 0; return true;
    }
    __device__ __forceinline__ void rowoff(const GU&, int, unsigned (&)[2][2]) const {}
};
struct SchedE1G {
    static constexpr bool GATHER = false, FP8 = true, CHAIN = false;
    int lda2, akstep, ldb2; const char* H8; const char* WM8; int G, c, T;
    __device__ __forceinline__ bool next(int i, GU& u) const {
        if (i >= 3) return false;
        int pm, pn; if (!tile_map((long)T * G + c, 128, 4, pm, pn)) return false;
        u.A = H8 + (size_t)pm * 256 * 1024; u.B = WM8 + (size_t)(i * 1024 + pn * 256) * 1024; u.nt = 8;
        u.kind = 0; u.pm = pm; u.pn = pn; u.e = i; u.aux = 0; return true;
    }
    __device__ __forceinline__ void rowoff(const GU&, int, unsigned (&)[2][2]) const {}
};
struct SchedE1T {
    static constexpr bool GATHER = false, FP8 = false, CHAIN = true;
    int lda2, akstep, ldb2; const char* O; const char* WB; int G, c, T;
    __device__ __forceinline__ bool next(int i, GU& u) const {
        if (i >= 3) return false;
        int pm, pn; if (!tile_map((long)T * G + c, 128, 4, pm, pn)) return false;
        const int koff = (i == 0) ? 0 : (i == 1) ? 512 : 768;
        u.A = O + (size_t)pm * 256 * 2048 + koff * 2; u.B = WB + (size_t)pn * 256 * 2048 + koff * 2; u.nt = (i == 0) ? 8 : 4;
        u.kind = 1; u.pm = pm; u.pn = pn; u.e = i; u.aux = (i < 2) ? 1 : 0; return true;
    }
    __device__ __forceinline__ void rowoff(const GU&, int, unsigned (&)[2][2]) const {}
};
struct SchedMoE {
    static constexpr bool GATHER = true, FP8 = false, CHAIN = false;
    int lda2, akstep, ldb2; const char* A; const char* B; size_t bstride; int ncol, nt, G, c, phase  ;
    const LAS int* tpre;
    const int* listT;
    __device__ __forceinline__ bool next(int i, GU& u) const {
        const int cx = (G % 8 == 0) ? (c % 8) * (G / 8) + c / 8 : c;
        const long L = (long)i * G + cx; const int ntile = tpre[16];
        if (L >= (long)ntile * ncol) return false;
        const int rt = (int)(L / ncol), pn = (int)(L % ncol);
        int e = 0;
#pragma unroll
        for (int k = 1; k < 16; ++k) e += (rt >= tpre[k]) ? 1 : 0;
        const int lt = rt - tpre[e];
        u.e = e; u.pm = lt; u.pn = pn; u.nt = nt; u.kind = 0; u.aux = tpre[34 + e] + lt * 256;
        u.B = B + (size_t)e * bstride + (size_t)pn * 256 * ldb2;
        u.A = (phase == 1) ? A : A + (size_t)u.aux * lda2;
        return true;
    }
    __device__ __forceinline__ void rowoff(const GU& u, int tid, unsigned (&vo)[2][2]) const {
        const int cnt = tpre[17 + u.e];
#pragma unroll
        for (int i = 0; i < 2; ++i) { int R, C; stage_rc(tid * 16 + i * 8192, R, C);
#pragma unroll
            for (int h = 0; h < 2; ++h) {
                const int r = u.pm * 256 + h * 128 + R;
                if (phase == 1) { const int tok = (r < cnt) ? (listT[u.e * LCAP + r] >> 1) : 0; vo[h][i] = (unsigned)tok * 2048u + (unsigned)C * 2u; }
                else vo[h][i] = (unsigned)(h * 128 + R) * (unsigned)lda2 + (unsigned)C * 2u;
            } }
    }
};

__device__ __forceinline__ u32x4 pack8(const f32x4 a, const f32x4 b) { u32x4 o; o[0] = cvt_pk_bf16(a[0], a[1]); o[1] = cvt_pk_bf16(a[2], a[3]); o[2] = cvt_pk_bf16(b[0], b[1]); o[3] = cvt_pk_bf16(b[2], b[3]); return o; }
__device__ __forceinline__ void unpack8(const u32x4 u, f32x4& a, f32x4& b) { a[0] = bf_lo(u[0]); a[1] = bf_hi(u[0]); a[2] = bf_lo(u[1]); a[3] = bf_hi(u[1]); b[0] = bf_lo(u[2]); b[1] = bf_hi(u[2]); b[2] = bf_lo(u[3]); b[3] = bf_hi(u[3]); }

struct EpiBf16 {
    static constexpr bool PERM = true, HEADMAP = false;
    bf16_t* O; int ldc;
    __device__ __forceinline__ void operator()(const f32x4 (&acc)[2][2][4][2], const GU& u, int wr, int wc, int fr, int fq) const {
#pragma unroll
        for (int ai = 0; ai < 2; ++ai)
#pragma unroll
            for (int m = 0; m < 4; ++m) { bf16_t* rowp = O + (size_t)(u.pm * 256 + ai * 128 + wr * 64 + m * 16 + fr) * ldc + u.pn * 256 + wc * 32 + 8 * fq;
#pragma unroll
                for (int bj = 0; bj < 2; ++bj) stg4u(rowp + bj * 128, pack8(acc[ai][bj][m][0], acc[ai][bj][m][1])); }
    }
};
struct EpiZ {
    static constexpr bool PERM = true, HEADMAP = true;
    bf16_t* Z; bf16_t* VT; const float* nqg; const float* nkg; const float* sqg; const float* skg;
    __device__ __forceinline__ void operator()(const f32x4 (&acc)[2][2][4][2], const GU& u, int wr, int wc, int fr, int fq) const {
        const int hidx = u.pn * 4 + wc, lane = fq * 16 + fr;
        int typ; const float* gain = nqg; float cst = 1.f; int vm = 0;
        if (hidx < 8) { typ = 1; gain = nqg; cst = 0.125f * LOG2E; }
        else if (hidx < 10) typ = 0;
        else if (hidx == 10) { typ = 1; gain = nkg + 64; }
        else if (hidx == 11) { typ = 3; vm = 0; }
        else if (hidx == 12) { typ = 1; gain = nkg + 128; }
        else if (hidx == 13) { typ = 3; vm = 1; }
        else if (hidx < 18) { typ = 2; cst = 0.125f; }
        else if (hidx < 22) typ = 0;
        else if (hidx < 26) { typ = 3; vm = 2 + (hidx - 22); }
        else if (hidx < 30) { typ = 1; gain = sqg; cst = 0.125f * LOG2E; }
        else if (hidx < 32) { typ = 1; gain = skg; }
        else if (hidx < 34) { typ = 3; vm = 6 + (hidx - 32); }
        else if (hidx == 34) typ = 4;
        else typ = 0;
        f32x4 g0 = (f32x4){1.f, 1.f, 1.f, 1.f}, g1 = g0, g2 = g0, g3 = g0;
        if (typ == 1) { g0 = ldg4f(gain + 8 * fq) * cst; g1 = ldg4f(gain + 8 * fq + 4) * cst; g2 = ldg4f(gain + 32 + 8 * fq) * cst; g3 = ldg4f(gain + 36 + 8 * fq) * cst; }
        const int b = u.pm >> 6;
#pragma unroll
        for (int ai = 0; ai < 2; ++ai)
#pragma unroll
            for (int m = 0; m < 4; ++m) {
                const int row = u.pm * 256 + ai * 128 + wr * 64 + m * 16 + fr;
                f32x4 v0 = acc[ai][0][m][0], v1 = acc[ai][0][m][1], v2 = acc[ai][1][m][0], v3 = acc[ai][1][m][1];
                if (typ == 3) {
                    bf16_t* vt = VT + (((size_t)b * 8 + vm) * 64 + 8 * fq) * SEQ + (row & (SEQ - 1));
#pragma unroll
                    for (int j = 0; j < 4; ++j) {
                        vt[(size_t)j * SEQ] = f2bf(v0[j]); vt[(size_t)(4 + j) * SEQ] = f2bf(v1[j]);
                        vt[(size_t)(32 + j) * SEQ] = f2bf(v2[j]); vt[(size_t)(36 + j) * SEQ] = f2bf(v3[j]);
                    }
                } else {
                    if (typ == 1) {
                        float ss = 0.f;
#pragma unroll
                        for (int j = 0; j < 4; ++j) ss += v0[j] * v0[j] + v1[j] * v1[j] + v2[j] * v2[j] + v3[j] * v3[j];
                        ss += shx<16>(ss, lane); ss += shx<32>(ss, lane);
                        const float rn = rsqrtf(ss * (1.f / 64.f) + 1e-6f);
                        v0 = v0 * g0 * rn; v1 = v1 * g1 * rn; v2 = v2 * g2 * rn; v3 = v3 * g3 * rn;
                    } else if (typ == 2) { v0 *= cst; v1 *= cst; v2 *= cst; v3 *= cst; }
                    else if (typ == 4) {
#pragma unroll
                        for (int j = 0; j < 4; ++j) { v0[j] = sigmoidf_(v0[j]); v1[j] = sigmoidf_(v1[j]); v2[j] = sigmoidf_(v2[j]); v3[j] = sigmoidf_(v3[j]); }
                    }
                    bf16_t* rowp = Z + (size_t)row * ZLD + hidx * 64 + 8 * fq;
                    stg4u(rowp, pack8(v0, v1)); stg4u(rowp + 32, pack8(v2, v3));
                }
            }
    }
};
struct EpiC1 {
    static constexpr bool PERM = true, HEADMAP = false;
    bf16_t* O; const float* cb;
    __device__ __forceinline__ void operator()(const f32x4 (&acc)[2][2][4][2], const GU& u, int wr, int wc, int fr, int fq) const {
        const int mat = u.e;
#pragma unroll
        for (int bj = 0; bj < 2; ++bj) {
            const int col = bj * 128 + wc * 32 + 8 * fq;
            const f32x4 b0 = ldg4f(cb + mat * 256 + col), b1 = ldg4f(cb + mat * 256 + col + 4);
#pragma unroll
            for (int ai = 0; ai < 2; ++ai)
#pragma unroll
                for (int m = 0; m < 4; ++m) {
                    f32x4 v0 = acc[ai][bj][m][0] + b0, v1 = acc[ai][bj][m][1] + b1;
#pragma unroll
                    for (int j = 0; j < 4; ++j) {
                        { const float x = v0[j], t = 0.7978845608f * (x + 0.044715f * x * x * x); v0[j] = x * frcp(1.f + fexp2(-2.f * LOG2E * t)); }
                        { const float x = v1[j], t = 0.7978845608f * (x + 0.044715f * x * x * x); v1[j] = x * frcp(1.f + fexp2(-2.f * LOG2E * t)); }
                    }
                    stg4u(O + ((size_t)mat * 2048 + u.pm * 256 + ai * 128 + wr * 64 + m * 16 + fr) * 256 + col, pack8(v0, v1));
                }
        }
    }
};
struct EpiE1G {
    static constexpr bool PERM = true, HEADMAP = false;
    unsigned char* Sg;
    __device__ __forceinline__ void operator()(const f32x4 (&acc)[2][2][4][2], const GU& u, int wr, int wc, int fr, int fq) const {
        const int t8 = (((wr * 4 + wc) * 64) + fq * 16 + fr) * 8;
        unsigned char* sg = Sg + u.e * 65536 + t8;
#pragma unroll
        for (int ai = 0; ai < 2; ++ai)
#pragma unroll
            for (int m = 0; m < 4; ++m)
#pragma unroll
                for (int bj = 0; bj < 2; ++bj) {
                    u32x2 w;
#pragma unroll
                    for (int n = 0; n < 2; ++n) { unsigned p = 0u;
#pragma unroll
                        for (int j = 0; j < 4; ++j) { const float g = fmaxf(255.f * sigmoidf_(acc[ai][bj][m][n][j] * (1.f / 64.f)) + 0.5f, 1.f); p |= ((unsigned)g) << (8 * j); }
                        w[n] = p; }
                    stg2u(sg + (ai * 8 + m * 2 + bj) * 4096, w);
                }
    }
};
struct EpiE1T {
    static constexpr bool PERM = true, HEADMAP = false;
    unsigned char* Sg; bf16_t* Y;
    __device__ __forceinline__ void operator()(f32x4 (&acc)[2][2][4][2], const GU& u, int wr, int wc, int fr, int fq) const {
        const int t8 = (((wr * 4 + wc) * 64) + fq * 16 + fr) * 8;
        __builtin_amdgcn_s_waitcnt(0x0070);
        asm volatile("" ::: "memory");
        if (u.e < 2) {
            const unsigned char* ga = Sg + u.e * 65536;
            const unsigned char* gb = ga + 65536;
#pragma unroll
            for (int idx = 0; idx < 16; ++idx) {
                const int ai = idx >> 3, m = (idx >> 1) & 3, bj = idx & 1;
                const u32x2 qa = ldg2u(ga + (unsigned)(t8 + idx * 4096)), qb = ldg2u(gb + (unsigned)(t8 + idx * 4096));
#pragma unroll
                for (int n = 0; n < 2; ++n) {
                    f32x4 r;
#pragma unroll
                    for (int j = 0; j < 4; ++j) r[j] = (float)((qa[n] >> (8 * j)) & 255u) * frcp((float)((qb[n] >> (8 * j)) & 255u));
                    acc[ai][bj][m][n] = acc[ai][bj][m][n] * r;
                }
                __builtin_amdgcn_sched_barrier(0);
            }
        } else {
            const unsigned char* ga = Sg + 2 * 65536;
            bf16_t* yp = Y + (size_t)(u.pm * 256 + wr * 64 + fr) * 1024 + u.pn * 256 + wc * 32 + 8 * fq;
#pragma unroll
            for (int idx = 0; idx < 16; ++idx) {
                const int ai = idx >> 3, m = (idx >> 1) & 3, bj = idx & 1;
                const u32x2 qa = ldg2u(ga + (unsigned)(t8 + idx * 4096));
                f32x4 v0, v1;
#pragma unroll
                for (int j = 0; j < 4; ++j) {
                    v0[j] = (float)((qa[0] >> (8 * j)) & 255u) * (acc[ai][bj][m][0][j] * (1.f / 255.f));
                    v1[j] = (float)((qa[1] >> (8 * j)) & 255u) * (acc[ai][bj][m][1][j] * (1.f / 255.f)); }
                stg4u(yp + (size_t)(ai * 128 + m * 16) * 1024 + bj * 128, pack8(v0, v1));
            }
        }
    }
};
struct EpiE2 {
    static constexpr bool PERM = true, HEADMAP = false;
    bf16_t* xb; const float* ga; float* ssp;
    __device__ __forceinline__ void operator()(const f32x4 (&acc)[2][2][4][2], const GU& u, int wr, int wc, int fr, int fq) const {
        const int b = u.pm >> 6, lane = fq * 16 + fr;
        __builtin_amdgcn_s_waitcnt(0x0070);
        asm volatile("" ::: "memory");
        float ssr[2][4];
#pragma unroll
        for (int ai = 0; ai < 2; ++ai)
#pragma unroll
            for (int m = 0; m < 4; ++m) ssr[ai][m] = 0.f;
        bf16_t* xp = xb + (size_t)(u.pm * 256 + wr * 64 + fr) * 1024 + u.pn * 256 + wc * 32 + 8 * fq;
        u32x4 xv[2][4];
#define E2_LOADB(BUF, BT) do { _Pragma("unroll") for (int m = 0; m < 4; ++m) xv[BUF][m] = ldg4u(xp + (size_t)(((BT) & 1) * 128 + m * 16) * 1024 + ((BT) >> 1) * 128); } while (0)
        E2_LOADB(0, 0);
#pragma unroll
        for (int bt = 0; bt < 4; ++bt) {
            const int bj = bt >> 1, ai = bt & 1;
            const int col = u.pn * 256 + bj * 128 + wc * 32 + 8 * fq;
            const f32x4 g0 = ldg4f(ga + b * 6144 + col), g1 = ldg4f(ga + b * 6144 + col + 4);
            if (bt + 1 < 4) E2_LOADB((bt + 1) & 1, bt + 1);
            asm volatile("" ::: "memory");
#pragma unroll
            for (int m = 0; m < 4; ++m) { f32x4 x0, x1; unpack8(xv[bt & 1][m], x0, x1);
                x0 += g0 * acc[ai][bj][m][0]; x1 += g1 * acc[ai][bj][m][1];
                ssr[ai][m] += (x0[0] * x0[0] + x0[1] * x0[1] + x0[2] * x0[2] + x0[3] * x0[3]) + (x1[0] * x1[0] + x1[1] * x1[1] + x1[2] * x1[2] + x1[3] * x1[3]);
                stg4u(xp + (size_t)(ai * 128 + m * 16) * 1024 + bj * 128, pack8(x0, x1)); }
            asm volatile("" ::: "memory");
        }
#undef E2_LOADB
#pragma unroll
        for (int ai = 0; ai < 2; ++ai)
#pragma unroll
            for (int m = 0; m < 4; ++m) { float v = ssr[ai][m]; v += shx<16>(v, lane); v += shx<32>(v, lane);
                if (fq == 0) ssp[(size_t)(u.pm * 256 + ai * 128 + wr * 64 + m * 16 + fr) * 16 + u.pn * 4 + wc] = v; }
    }
};
struct EpiG1 {
    static constexpr bool PERM = true, HEADMAP = false;
    bf16_t* Ab;
    __device__ __forceinline__ void operator()(const f32x4 (&acc)[2][2][4][2], const GU& u, int wr, int wc, int fr, int fq) const {
#pragma unroll
        for (int ai = 0; ai < 2; ++ai)
#pragma unroll
            for (int m = 0; m < 4; ++m) {
                f32x4 v0, v1;
#pragma unroll
                for (int j = 0; j < 4; ++j) { const float g0 = acc[ai][0][m][0][j], g1 = acc[ai][0][m][1][j];
                    v0[j] = g0 * sigmoidf_(g0) * acc[ai][1][m][0][j]; v1[j] = g1 * sigmoidf_(g1) * acc[ai][1][m][1][j]; }
                stg4u(Ab + (size_t)(u.aux + ai * 128 + wr * 64 + m * 16 + fr) * 512 + u.pn * 128 + wc * 32 + 8 * fq, pack8(v0, v1));
            }
    }
};
struct EpiG2 {
    static constexpr bool PERM = true, HEADMAP = false;
    bf16_t* Ys;
    __device__ __forceinline__ void operator()(const f32x4 (&acc)[2][2][4][2], const GU& u, int wr, int wc, int fr, int fq) const {
#pragma unroll
        for (int ai = 0; ai < 2; ++ai)
#pragma unroll
            for (int m = 0; m < 4; ++m) {
                bf16_t* rowp = Ys + (size_t)(u.aux + ai * 128 + wr * 64 + m * 16 + fr) * 1024 + u.pn * 256 + wc * 32 + 8 * fq;
#pragma unroll
                for (int bj = 0; bj < 2; ++bj) stg4u(rowp + bj * 128, pack8(acc[ai][bj][m][0], acc[ai][bj][m][1]));
            }
    }
};

__device__ __forceinline__ void norm2_mfma(const Ctx& X, LAS unsigned char* lds, int layer) {
    unsigned char* ws = X.ws;
    const int tid = X.tid, lane = tid & 63, wave = tid >> 6, G = X.G, r = lane & 15, kq = lane >> 4;
    const bf16_t* xsrc = (const bf16_t*)(ws + WS_XB);
    const float* modl = (const float*)(ws + WS_MOD) + (size_t)layer * 2 * 6144;
    const float* ssp = (const float*)(ws + WS_SSP);
    bf16_t* h = (bf16_t*)(ws + WS_H);
    const float* gn = INP(I_GMOE) + (size_t)layer * 1024;
    LAS float* Wl = (LAS float*)lds;
    LAS float* gsL = (LAS float*)(lds + 81920);
    LAS float* shL = (LAS float*)(lds + 90112);
    LAS float* cW = (LAS float*)(lds + LDS_MISC + 768);
    LAS float* lgl = (LAS float*)(lds + 98304);
    LAS int* lcnt = (LAS int*)(lds + LDS_MISC + 64);
    LAS int* lbase = (LAS int*)(lds + LDS_MISC + 128);
    const bool fastp = (G * 8 >= NTOK / 16);
    if (fastp) {
        const int b = (X.bid * 8 * 16) >> 14;
        LAS bf16x8* Whi = (LAS bf16x8*)lds;
        LAS bf16x8* Wlo = (LAS bf16x8*)(lds + 32768);
        const GAS float* wrg = (const GAS float*)INP(I_WR); const GAS float* gng = (const GAS float*)gn; const GAS float* mdg = (const GAS float*)modl;
        { const float g0_ = gng[tid], g1_ = gng[tid + 512], c0_ = mdg[b * 6144 + 4096 + tid], c1_ = mdg[b * 6144 + 4096 + tid + 512], h0_ = mdg[b * 6144 + 3072 + tid], h1_ = mdg[b * 6144 + 3072 + tid + 512];
          gsL[b * 1024 + tid] = g0_ * (1.f + c0_); gsL[b * 1024 + tid + 512] = g1_ * (1.f + c1_); shL[b * 1024 + tid] = h0_; shL[b * 1024 + tid + 512] = h1_; }
        if (tid < 16) lcnt[tid] = 0;
        __syncthreads();
        for (int f = tid; f < 2048; f += 512) {
            const int e = f & 15, k0 = (f >> 4) * 8;
            bf16x8 hi, lo; float wv[8];
#pragma unroll
            for (int j = 0; j < 8; ++j) wv[j] = wrg[(k0 + j) * 16 + e];
#pragma unroll
            for (int j = 0; j < 8; ++j) { const float w = gsL[b * 1024 + k0 + j] * wv[j]; const bf16_t hb = f2bf(w); hi[j] = (short)hb; lo[j] = (short)f2bf(w - bf2f(hb)); }
            Whi[f] = hi; Wlo[f] = lo;
        }
        if (tid < 256) {
            const int e = tid >> 4, part = tid & 15;
            float a = 0.f;
            for (int k0 = part * 64; k0 < part * 64 + 64; k0 += 16) { float wv[16];
#pragma unroll
                for (int j = 0; j < 16; ++j) wv[j] = wrg[(k0 + j) * 16 + e];
#pragma unroll
                for (int j = 0; j < 16; ++j) a += shL[b * 1024 + k0 + j] * wv[j]; }
            a += shx<1>(a, lane); a += shx<2>(a, lane); a += shx<4>(a, lane); a += shx<8>(a, lane);
            if (part == 0) cW[b * 16 + e] = a;
        }
        __syncthreads();
        const int batch = X.bid * 8 + wave;
        if (batch < NTOK / 16) {
            const int row = batch * 16 + r;
            float rinv;
            { const f32x4 p4 = ldg4f(ssp + (size_t)row * 16 + 4 * kq); float ssq = (p4[0] + p4[1]) + (p4[2] + p4[3]); ssq += shx<16>(ssq, lane); ssq += shx<32>(ssq, lane);
              rinv = rsqrtf(ssq * (1.f / 1024.f) + 1e-6f); }
            f32x4 acc = (f32x4){0.f, 0.f, 0.f, 0.f};
            const bf16_t* xr = xsrc + (size_t)row * 1024 + kq * 8;
            bf16_t* hr = h + (size_t)row * 1024 + kq * 8;
            for (int kg = 0; kg < 4; ++kg) {
                u32x4 xp[8];
#pragma unroll
                for (int u = 0; u < 8; ++u) { const int kk = (kg * 4 + (u >> 1)) * 64 + (u & 1) * 32; xp[u] = ldg4u(xr + kk); }
                asm volatile("" ::: "memory");
#pragma unroll
                for (int u = 0; u < 8; ++u) {
                    const int kc = kg * 4 + (u >> 1), jh = u & 1, kk = kc * 64 + jh * 32, ch = kc * 2 + jh;
                    const f32x4 g0 = *(const LAS f32x4*)(gsL + b * 1024 + kk + kq * 8), g1 = *(const LAS f32x4*)(gsL + b * 1024 + kk + kq * 8 + 4);
                    const f32x4 s0 = *(const LAS f32x4*)(shL + b * 1024 + kk + kq * 8), s1 = *(const LAS f32x4*)(shL + b * 1024 + kk + kq * 8 + 4);
                    const bf16x8 wh = Whi[(ch * 4 + kq) * 16 + r], wl = Wlo[(ch * 4 + kq) * 16 + r];
                    const bf16x8 xf = __builtin_bit_cast(bf16x8, xp[u]);
                    f32x4 xa, xc; unpack8(xp[u], xa, xc);
                    stg4u(hr + kk, pack8(xa * g0 * rinv + s0, xc * g1 * rinv + s1));
                    acc = __builtin_amdgcn_mfma_f32_16x16x32_bf16(wh, xf, acc, 0, 0, 0);
                    acc = __builtin_amdgcn_mfma_f32_16x16x32_bf16(wl, xf, acc, 0, 0, 0);
                }
                asm volatile("" ::: "memory");
            }
            f32x4 lg;
#pragma unroll
            for (int i = 0; i < 4; ++i) lg[i] = rinv * acc[i] + cW[b * 16 + 4 * kq + i];
            *(LAS f32x4*)(lgl + (wave * 16 + r) * 16 + 4 * kq) = lg;
        }
    } else {
    for (int i = tid; i < 16384; i += 512) { const int k = i >> 4, e = i & 15; Wl[(((k >> 5) * 4 + ((k >> 3) & 3)) * 16 + e) * 8 + (k & 7)] = INP(I_WR)[i]; }
    for (int i = tid; i < 2048; i += 512) { const int b = i >> 10, k = i & 1023; gsL[i] = gn[k] * (1.f + modl[b * 6144 + 4096 + k]); shL[i] = modl[b * 6144 + 3072 + k]; }
    if (tid < 16) lcnt[tid] = 0;
    __syncthreads();
    {
        const int be = tid >> 4, part = tid & 15, b = be >> 4, e = be & 15;
        float a = 0.f;
        for (int k = part * 64; k < part * 64 + 64; ++k) a += shL[b * 1024 + k] * Wl[(((k >> 5) * 4 + ((k >> 3) & 3)) * 16 + e) * 8 + (k & 7)];
        a += shx<1>(a, lane); a += shx<2>(a, lane); a += shx<4>(a, lane); a += shx<8>(a, lane);
        if (part == 0) cW[be] = a;
    }
    __syncthreads();
    int it = 0;
    for (int batch = X.bid * 8 + wave; batch < NTOK / 16; batch += G * 8, ++it) {
        const int row = batch * 16 + r, b = row >> 14;
        float rinv;
        { const f32x4 p4 = ldg4f(ssp + (size_t)row * 16 + 4 * kq); float ssq = (p4[0] + p4[1]) + (p4[2] + p4[3]); ssq += shx<16>(ssq, lane); ssq += shx<32>(ssq, lane);
          rinv = rsqrtf(ssq * (1.f / 1024.f) + 1e-6f); }
        f32x4 acc = (f32x4){0.f, 0.f, 0.f, 0.f};
        const bf16_t* xr = xsrc + (size_t)row * 1024 + kq * 8;
        bf16_t* hr = h + (size_t)row * 1024 + kq * 8;
        for (int kg = 0; kg < 4; ++kg) {
            u32x4 xp[8];
#pragma unroll
            for (int u = 0; u < 8; ++u) { const int kk = (kg * 4 + (u >> 1)) * 64 + (u & 1) * 32; xp[u] = ldg4u(xr + kk); }
            asm volatile("" ::: "memory");
#pragma unroll
            for (int u = 0; u < 8; ++u) {
                const int kc = kg * 4 + (u >> 1), jh = u & 1, kk = kc * 64 + jh * 32;
                const f32x4 g0 = *(const LAS f32x4*)(gsL + b * 1024 + kk + kq * 8), g1 = *(const LAS f32x4*)(gsL + b * 1024 + kk + kq * 8 + 4);
                const f32x4 s0 = *(const LAS f32x4*)(shL + b * 1024 + kk + kq * 8), s1 = *(const LAS f32x4*)(shL + b * 1024 + kk + kq * 8 + 4);
                const LAS float* wp = Wl + (((kc * 2 + jh) * 4 + kq) * 16 + r) * 8;
                const f32x4 w0 = *(const LAS f32x4*)wp, w1 = *(const LAS f32x4*)(wp + 4);
                f32x4 xa, xc; unpack8(xp[u], xa, xc);
                const f32x4 x0 = xa * g0, x1 = xc * g1;
                stg4u(hr + kk, pack8(x0 * rinv + s0, x1 * rinv + s1));
#pragma unroll
                for (int q = 0; q < 4; ++q) acc = __builtin_amdgcn_mfma_f32_16x16x4f32(w0[q], x0[q], acc, 0, 0, 0);
#pragma unroll
                for (int q = 0; q < 4; ++q) acc = __builtin_amdgcn_mfma_f32_16x16x4f32(w1[q], x1[q], acc, 0, 0, 0);
            }
            asm volatile("" ::: "memory");
        }
        if (it < 4) {
            f32x4 lg;
#pragma unroll
            for (int i = 0; i < 4; ++i) lg[i] = rinv * acc[i] + cW[b * 16 + 4 * kq + i];
            *(LAS f32x4*)(lgl + ((it * 8 + wave) * 16 + r) * 16 + 4 * kq) = lg;
        }
    }
    }
    __syncthreads();
    {
        const int slot = tid, sb = slot >> 4, srow = ((X.bid * 8 + (sb & 7)) + (sb >> 3) * G * 8) * 16 + (slot & 15);
        const bool have = (srow < NTOK) && ((sb >> 3) < 4);
        int e0 = 0, e1 = 0, r0 = 0, r1i = 0; float w0 = 0.f, w1 = 0.f;
        if (have) {
            float sco[16], sel[16];
            f32x4 rb4[4];
#pragma unroll
            for (int q = 0; q < 4; ++q) rb4[q] = ldg4f(INP(I_RB) + 4 * q);
#pragma unroll
            for (int q = 0; q < 4; ++q) { const f32x4 lg4 = *(const LAS f32x4*)(lgl + slot * 16 + 4 * q);
#pragma unroll
                for (int j = 0; j < 4; ++j) { const int e = 4 * q + j; sco[e] = 1.f / (1.f + __expf(-lg4[j])); sel[e] = sco[e] + rb4[q][j]; } }
            float gs[4];
#pragma unroll
            for (int g = 0; g < 4; ++g) {
                const float a = sel[4 * g], bq = sel[4 * g + 1], c = sel[4 * g + 2], d = sel[4 * g + 3];
                const float m1 = fmaxf(fmaxf(a, bq), fmaxf(c, d));
                int i1 = (a == m1) ? 0 : (bq == m1) ? 1 : (c == m1) ? 2 : 3;
                float m2 = -3.0e38f;
                m2 = (i1 != 0) ? fmaxf(m2, a) : m2; m2 = (i1 != 1) ? fmaxf(m2, bq) : m2; m2 = (i1 != 2) ? fmaxf(m2, c) : m2; m2 = (i1 != 3) ? fmaxf(m2, d) : m2;
                gs[g] = m1 + m2;
            }
            int gi = 0; float gb = gs[0];
#pragma unroll
            for (int g = 1; g < 4; ++g) if (gs[g] > gb) { gb = gs[g]; gi = g; }
            float s0 = (gi == 0) ? sel[0] : (gi == 1) ? sel[4] : (gi == 2) ? sel[8] : sel[12];
            float s1 = (gi == 0) ? sel[1] : (gi == 1) ? sel[5] : (gi == 2) ? sel[9] : sel[13];
            float s2 = (gi == 0) ? sel[2] : (gi == 1) ? sel[6] : (gi == 2) ? sel[10] : sel[14];
            float s3 = (gi == 0) ? sel[3] : (gi == 1) ? sel[7] : (gi == 2) ? sel[11] : sel[15];
            float c0 = (gi == 0) ? sco[0] : (gi == 1) ? sco[4] : (gi == 2) ? sco[8] : sco[12];
            float c1 = (gi == 0) ? sco[1] : (gi == 1) ? sco[5] : (gi == 2) ? sco[9] : sco[13];
            float c2 = (gi == 0) ? sco[2] : (gi == 1) ? sco[6] : (gi == 2) ? sco[10] : sco[14];
            float c3 = (gi == 0) ? sco[3] : (gi == 1) ? sco[7] : (gi == 2) ? sco[11] : sco[15];
            const float m1 = fmaxf(fmaxf(s0, s1), fmaxf(s2, s3));
            const int i1 = (s0 == m1) ? 0 : (s1 == m1) ? 1 : (s2 == m1) ? 2 : 3;
            float m2 = -3.0e38f;
            m2 = (i1 != 0) ? fmaxf(m2, s0) : m2; m2 = (i1 != 1) ? fmaxf(m2, s1) : m2; m2 = (i1 != 2) ? fmaxf(m2, s2) : m2; m2 = (i1 != 3) ? fmaxf(m2, s3) : m2;
            const int i2 = (i1 != 0 && s0 == m2) ? 0 : (i1 != 1 && s1 == m2) ? 1 : (i1 != 2 && s2 == m2) ? 2 : 3;
            const float w1v = (i1 == 0) ? c0 : (i1 == 1) ? c1 : (i1 == 2) ? c2 : c3;
            const float w2v = (i2 == 0) ? c0 : (i2 == 1) ? c1 : (i2 == 2) ? c2 : c3;
            const float wn = 1.f / (w1v + w2v);
            e0 = gi * 4 + i1; e1 = gi * 4 + i2; w0 = w1v * wn; w1 = w2v * wn;
            r0 = __hip_atomic_fetch_add(lcnt + e0, 1, __ATOMIC_RELAXED, __HIP_MEMORY_SCOPE_WORKGROUP); r1i = __hip_atomic_fetch_add(lcnt + e1, 1, __ATOMIC_RELAXED, __HIP_MEMORY_SCOPE_WORKGROUP);
        }
        __syncthreads();
        unsigned* gcnt = (unsigned*)(ws + WS_CTL) + CW_GCNT + 16 * (layer * 16);
        if (tid < 16) lbase[tid] = (int)atomicAdd(gcnt + 16 * tid, (unsigned)lcnt[tid]);
        __syncthreads();
        if (have) {
            int* lt = (int*)(ws + WS_LISTT); float* lw = (float*)(ws + WS_LISTW);
            const int p0 = lbase[e0] + r0, p1 = lbase[e1] + r1i;
            lt[e0 * LCAP + p0] = srow * 2; lw[e0 * LCAP + p0] = w0;
            lt[e1 * LCAP + p1] = srow * 2 + 1; lw[e1 * LCAP + p1] = w1;
            u32x4 ti; ti[0] = (unsigned)e0 | ((unsigned)p0 << 4); ti[1] = __float_as_uint(w0); ti[2] = (unsigned)e1 | ((unsigned)p1 << 4); ti[3] = __float_as_uint(w1);
            *(GAS u32x4*)((u32x4*)(ws + WS_TINFO) + srow) = ti;
        }
    }
    __syncthreads();
}

__device__ __forceinline__ void cmp2_unit(const Ctx& X, int layer, int u) {
    unsigned char* ws = X.ws;
    const int lane = X.tid & 63, c = lane & 15, g = lane >> 4;
    const int mat = u >> 7, r0 = (u & 127) * 16;
    const bf16_t* hid = (const bf16_t*)(ws + WS_HID) + ((size_t)mat * 2048 + r0) * 256;
    const bf16_t* w2 = (const bf16_t*)(ws + WS_W2) + ((size_t)layer * 2 + mat) * 64 * 256;
    f32x4 acc[4];
#pragma unroll
    for (int nt = 0; nt < 4; ++nt) acc[nt] = (f32x4){0.f, 0.f, 0.f, 0.f};
#pragma unroll
    for (int ks = 0; ks < 8; ++ks) {
        const bf16x8 a = ldg8(hid + c * 256 + ks * 32 + 8 * g);
#pragma unroll
        for (int nt = 0; nt < 4; ++nt) { const bf16x8 b = ldg8(w2 + (nt * 16 + c) * 256 + ks * 32 + 8 * g); acc[nt] = __builtin_amdgcn_mfma_f32_16x16x32_bf16(a, b, acc[nt], 0, 0, 0); }
    }
    if (mat == 0) {
        const float* kg = INP(I_NKG) + layer * 192;
        bf16_t* kc = (bf16_t*)(ws + WS_KCMP);
#pragma unroll
        for (int i = 0; i < 4; ++i) {
            float ss = acc[0][i] * acc[0][i] + acc[1][i] * acc[1][i] + acc[2][i] * acc[2][i] + acc[3][i] * acc[3][i];
            ss += shx<1>(ss, lane); ss += shx<2>(ss, lane); ss += shx<4>(ss, lane); ss += shx<8>(ss, lane);
            const float rn = rsqrtf(ss * (1.f / 64.f) + 1e-6f);
#pragma unroll
            for (int nt = 0; nt < 4; ++nt) kc[(size_t)(r0 + 4 * g + i) * 64 + nt * 16 + c] = f2bf(acc[nt][i] * rn * kg[nt * 16 + c]);
        }
    } else {
        bf16_t* vt = (bf16_t*)(ws + WS_VCMPT);
        const int b = r0 >> 10, cb0 = (r0 & 1023) + 4 * g;
#pragma unroll
        for (int nt = 0; nt < 4; ++nt) { u32x2 o; o[0] = cvt_pk_bf16(acc[nt][0], acc[nt][1]); o[1] = cvt_pk_bf16(acc[nt][2], acc[nt][3]);
            stg2u(vt + ((size_t)b * 64 + nt * 16 + c) * 1024 + cb0, o); }
    }
}

template <int NCT>
__device__ __forceinline__ void qk_tile(const bf16_t* kp, int kstride, const bf16x8 (&qf)[NCT][2], f32x4 (&s)[2][2][NCT]) {
#pragma unroll
    for (int ch = 0; ch < 2; ++ch)
#pragma unroll
        for (int T = 0; T < 2; ++T) {
            const bf16_t* p = kp + (size_t)(32 * ch + 4 * T) * kstride;
            const bf16x8 k0 = ldg8(p), k1 = ldg8(p + 32);
#pragma unroll
            for (int ct = 0; ct < NCT; ++ct) {
                f32x4 a = (f32x4){0.f, 0.f, 0.f, 0.f};
                a = __builtin_amdgcn_mfma_f32_16x16x32_bf16(k0, qf[ct][0], a, 0, 0, 0);
                a = __builtin_amdgcn_mfma_f32_16x16x32_bf16(k1, qf[ct][1], a, 0, 0, 0);
                s[ch][T][ct] = a;
            }
        }
}
template <int NCT>
__device__ __forceinline__ void pv_tile(const bf16_t* vp, size_t vstride, const bf16x8 (&pb)[2][NCT], f32x4 (&o)[4][NCT]) {
#pragma unroll
    for (int ch = 0; ch < 2; ++ch)
#pragma unroll
        for (int dt = 0; dt < 4; ++dt) {
            const bf16x8 v = ldg8(vp + (size_t)(16 * dt) * vstride + 32 * ch);
#pragma unroll
            for (int ct = 0; ct < NCT; ++ct) o[dt][ct] = __builtin_amdgcn_mfma_f32_16x16x32_bf16(v, pb[ch][ct], o[dt][ct], 0, 0, 0);
        }
}
struct KFrag { bf16x8 k[2][2][2]; };
struct VFrag { bf16x8 v[2][4]; };
__device__ __forceinline__ void ld_ktile(const bf16_t* kp, int kstride, KFrag& f) {
#pragma unroll
    for (int ch = 0; ch < 2; ++ch)
#pragma unroll
        for (int T = 0; T < 2; ++T) { const bf16_t* p = kp + (size_t)(32 * ch + 4 * T) * kstride; f.k[ch][T][0] = ldg8(p); f.k[ch][T][1] = ldg8(p + 32); }
}
__device__ __forceinline__ void ld_vtile(const bf16_t* vp, size_t vstride, VFrag& f) {
#pragma unroll
    for (int ch = 0; ch < 2; ++ch)
#pragma unroll
        for (int dt = 0; dt < 4; ++dt) f.v[ch][dt] = ldg8(vp + (size_t)(16 * dt) * vstride + 32 * ch);
}
template <int NCT>
__device__ __forceinline__ void qk_from(const KFrag& f, const bf16x8 (&qf)[NCT][2], f32x4 (&s)[2][2][NCT]) {
#pragma unroll
    for (int ch = 0; ch < 2; ++ch)
#pragma unroll
        for (int T = 0; T < 2; ++T)
#pragma unroll
            for (int ct = 0; ct < NCT; ++ct) {
                f32x4 a = (f32x4){0.f, 0.f, 0.f, 0.f};
                a = __builtin_amdgcn_mfma_f32_16x16x32_bf16(f.k[ch][T][0], qf[ct][0], a, 0, 0, 0);
                a = __builtin_amdgcn_mfma_f32_16x16x32_bf16(f.k[ch][T][1], qf[ct][1], a, 0, 0, 0);
                s[ch][T][ct] = a;
            }
}
template <int NCT>
__device__ __forceinline__ void pv_from(const VFrag& f, const bf16x8 (&pb)[2][NCT], f32x4 (&o)[4][NCT]) {
#pragma unroll
    for (int ch = 0; ch < 2; ++ch)
#pragma unroll
        for (int dt = 0; dt < 4; ++dt)
#pragma unroll
            for (int ct = 0; ct < NCT; ++ct) o[dt][ct] = __builtin_amdgcn_mfma_f32_16x16x32_bf16(f.v[ch][dt], pb[ch][ct], o[dt][ct], 0, 0, 0);
}
__device__ __forceinline__ bf16x8 pack_p(const f32x4 a, const f32x4 b) {
    union { u32x4 u; bf16x8 h; } x; x.u = pack8(a, b); return x.h;
}
template <int NCT> struct SmState { f32x4 o[4][NCT]; float m[NCT], l[NCT]; };

template <int NCT> __device__ __forceinline__ void sm_init(SmState<NCT>& st) {
#pragma unroll
    for (int ct = 0; ct < NCT; ++ct) { st.m[ct] = -1e30f; st.l[ct] = 0.f;
#pragma unroll
        for (int dt = 0; dt < 4; ++dt) st.o[dt][ct] = (f32x4){0.f, 0.f, 0.f, 0.f}; }
}
template <int NCT> __device__ __forceinline__ void sm_finish(SmState<NCT>& st, const int lane) {
#pragma unroll
    for (int ct = 0; ct < NCT; ++ct) {
        float l = st.l[ct]; l += shx<16>(l, lane); l += shx<32>(l, lane);
        const float inv = (l > 0.f) ? 1.f / l : 0.f;
#pragma unroll
        for (int dt = 0; dt < 4; ++dt) st.o[dt][ct] *= inv;
    }
}

constexpr int TROW = 72, TILE_E = 64 * TROW;
template <int NCT>
__device__ __forceinline__ void qk_tile_l(const LAS bf16_t* Kb, int c, int g, const bf16x8 (&qf)[NCT][2], f32x4 (&s)[2][2][NCT]) {
#pragma unroll
    for (int ch = 0; ch < 2; ++ch)
#pragma unroll
        for (int T = 0; T < 2; ++T) {
            const LAS bf16_t* p = Kb + (32 * ch + 8 * (c >> 2) + 4 * T + (c & 3)) * TROW + 8 * g;
            const bf16x8 k0 = *(const LAS bf16x8*)p, k1 = *(const LAS bf16x8*)(p + 32);
#pragma unroll
            for (int ct = 0; ct < NCT; ++ct) {
                f32x4 a = (f32x4){0.f, 0.f, 0.f, 0.f};
                a = __builtin_amdgcn_mfma_f32_16x16x32_bf16(k0, qf[ct][0], a, 0, 0, 0);
                a = __builtin_amdgcn_mfma_f32_16x16x32_bf16(k1, qf[ct][1], a, 0, 0, 0);
                s[ch][T][ct] = a;
            }
        }
}
template <int NCT>
__device__ __forceinline__ void pv_tile_l(const LAS bf16_t* Vb, int c, int g, const bf16x8 (&pb)[2][NCT], f32x4 (&o)[4][NCT]) {
#pragma unroll
    for (int ch = 0; ch < 2; ++ch)
#pragma unroll
        for (int dt = 0; dt < 4; ++dt) {
            const bf16x8 v = *(const LAS bf16x8*)(Vb + (16 * dt + c) * TROW + 32 * ch + 8 * g);
#pragma unroll
            for (int ct = 0; ct < NCT; ++ct) o[dt][ct] = __builtin_amdgcn_mfma_f32_16x16x32_bf16(v, pb[ch][ct], o[dt][ct], 0, 0, 0);
        }
}
template <int NCT, int STEP>
__device__ __forceinline__ void sm_soft(SmState<NCT>& st, f32x4 (&s)[2][2][NCT], bf16x8 (&pb)[2][NCT], const int (&d0)[NCT], const float (&slope)[NCT], const unsigned (&W)[NCT], const int lane) {
#pragma unroll
    for (int ct = 0; ct < NCT; ++ct) {
        float mx = -1e30f;
#pragma unroll
        for (int ch = 0; ch < 2; ++ch)
#pragma unroll
            for (int T = 0; T < 2; ++T)
#pragma unroll
                for (int i = 0; i < 4; ++i) {
                    const int dist = d0[ct] - STEP * (32 * ch + 4 * T + i);
                    const float v = ((unsigned)dist < W[ct]) ? (s[ch][T][ct][i] - slope[ct] * (float)dist) : -1e30f;
                    s[ch][T][ct][i] = v; mx = fmaxf(mx, v);
                }
        mx = fmaxf(mx, shx<16>(mx, lane)); mx = fmaxf(mx, shx<32>(mx, lane));
        const float mn = fmaxf(st.m[ct], mx), alpha = fexp2(st.m[ct] - mn);
        float sum = 0.f;
#pragma unroll
        for (int ch = 0; ch < 2; ++ch) {
#pragma unroll
            for (int T = 0; T < 2; ++T)
#pragma unroll
                for (int i = 0; i < 4; ++i) { const float v = s[ch][T][ct][i]; const float p = (v > -1e29f) ? fexp2(v - mn) : 0.f; s[ch][T][ct][i] = p; sum += p; }
            pb[ch][ct] = pack_p(s[ch][0][ct], s[ch][1][ct]);
        }
        st.m[ct] = mn; st.l[ct] = st.l[ct] * alpha + sum;
#pragma unroll
        for (int dt = 0; dt < 4; ++dt) st.o[dt][ct] *= alpha;
    }
}

template <int NCT, int STEP>
__device__ __forceinline__ void sm_tile(SmState<NCT>& st, f32x4 (&s)[2][2][NCT], const int (&d0)[NCT], const float (&slope)[NCT], unsigned W, const bf16_t* vp, size_t vstride, const int lane) {
    bf16x8 pb[2][NCT]; unsigned Wv[NCT];
#pragma unroll
    for (int ct = 0; ct < NCT; ++ct) Wv[ct] = W;
    sm_soft<NCT, STEP>(st, s, pb, d0, slope, Wv, lane);
    pv_tile<NCT>(vp, vstride, pb, st.o);
}

__device__ __forceinline__ f32x4 add_sle(const f32x4 v, const float sl, const int e0, const int step) {
    f32x4 r; r[0] = fmaf(sl, (float)(step * e0), v[0]); r[1] = fmaf(sl, (float)(step * (e0 + 1)), v[1]); r[2] = fmaf(sl, (float)(step * (e0 + 2)), v[2]); r[3] = fmaf(sl, (float)(step * (e0 + 3)), v[3]); return r; }
template <int NCT>
__device__ __forceinline__ void sm_fast(SmState<NCT>& st, f32x4 (&s)[2][2][NCT], bf16x8 (&pb)[2][NCT], const float sl, const float (&base)[NCT], const bool (&en)[NCT], const int lane) {
#pragma unroll
    for (int ct = 0; ct < NCT; ++ct) {
        const f32x4 u00 = add_sle(s[0][0][ct], sl, 0, 1), u01 = add_sle(s[0][1][ct], sl, 4, 1), u10 = add_sle(s[1][0][ct], sl, 32, 1), u11 = add_sle(s[1][1][ct], sl, 36, 1);
        const f32x4 m4 = __builtin_elementwise_max(__builtin_elementwise_max(u00, u01), __builtin_elementwise_max(u10, u11));
        float mx = fmaxf(fmaxf(m4[0], m4[1]), fmaxf(m4[2], m4[3])) + base[ct];
        mx = fmaxf(mx, shx<16>(mx, lane)); mx = fmaxf(mx, shx<32>(mx, lane));
        const float mn = en[ct] ? fmaxf(st.m[ct], mx) : st.m[ct], alpha = fexp2(st.m[ct] - mn);
        const float off = en[ct] ? (base[ct] - mn) : -1e30f;
        f32x4 p00 = u00 + off, p01 = u01 + off, p10 = u10 + off, p11 = u11 + off;
#pragma unroll
        for (int i = 0; i < 4; ++i) { p00[i] = fexp2(p00[i]); p01[i] = fexp2(p01[i]); p10[i] = fexp2(p10[i]); p11[i] = fexp2(p11[i]); }
        const f32x4 s4 = (p00 + p01) + (p10 + p11);
        const float sum = (s4[0] + s4[1]) + (s4[2] + s4[3]);
        pb[0][ct] = pack_p(p00, p01); pb[1][ct] = pack_p(p10, p11);
        st.m[ct] = mn; st.l[ct] = st.l[ct] * alpha + sum;
#pragma unroll
        for (int dt = 0; dt < 4; ++dt) st.o[dt][ct] *= alpha;
    }
}

__device__ __forceinline__ void nsa_block(const Ctx& X, LAS unsigned char* lds, int unit, int layer, unsigned long long& prb_acc, unsigned* qhead, int& nxt_idx, const float mref_in) {
    unsigned long long prb_t0 = 0ull; (void)prb_t0; (void)prb_acc;
    unsigned char* ws = X.ws;
    const int tid = X.tid, lane = tid & 63, wave = tid >> 6, c = lane & 15, g = lane >> 4, h = c & 7, qq = c >> 3;
    const int b = unit >> 9, t0 = (unit & 511) * 32;
    const bf16_t* z = (const bf16_t*)(ws + WS_Z) + (size_t)b * SEQ * ZLD;
    const bf16_t* vT = (const bf16_t*)(ws + WS_VT) + (size_t)b * 8 * 64 * SEQ;
    const bf16_t* kcmp = (const bf16_t*)(ws + WS_KCMP) + (size_t)b * 1024 * 64;
    const bf16_t* vcT = (const bf16_t*)(ws + WS_VCMPT) + (size_t)b * 64 * 1024;
    LAS float* impA = (LAS float*)(lds + wave * 8192);
    LAS float* impB = impA + 1024;
    LAS bf16_t* KV = (LAS bf16_t*)(lds + 65536);
    LAS int* sell = (LAS int*)(lds + 114688);
    LAS unsigned* qmask = (LAS unsigned*)(lds + 115712);
    LAS unsigned* ubits = (LAS unsigned*)(lds + 116736);
    LAS int* ulist = (LAS int*)(lds + 116800);
    const int prho = tid >> 3, pcp = tid & 7;
    const int krow = (prho & ~9) | ((prho >> 3) & 1) | ((prho & 1) << 3), kchk = pcp ^ (2 * (krow & 3));
    const int vrow = (prho & ~5) | ((prho >> 2) & 1) | ((prho & 1) << 2), vchk = pcp ^ (2 * (vrow & 3));
    const int wv512 = __builtin_amdgcn_readfirstlane(wave) * 512;
    const int fp = c & 3, fcl = g ^ (2 * (fp & 1)), fph = fp >> 1;
    const int krow0 = 8 * (c >> 2) + fp, krho0 = (krow0 & ~9) | ((krow0 >> 3) & 1) | ((krow0 & 1) << 3);
    const int kofA = krho0 * 64 + (fcl + 4 * (0 ^ fph)) * 8, kofB = krho0 * 64 + (fcl + 4 * (1 ^ fph)) * 8;
    const int vrho0 = (c & ~5) | ((c >> 2) & 1) | ((c & 1) << 2);
    const int vofA = vrho0 * 64 + (fcl + 4 * (0 ^ fph)) * 8, vofB = vrho0 * 64 + (fcl + 4 * (1 ^ fph)) * 8;
#define T_DMAK(kbase, kstride, k0, buf) __builtin_amdgcn_global_load_lds((const unsigned*)((kbase) + (size_t)((k0) + krow) * (kstride) + kchk * 8), (LAS unsigned*)(KV + (buf) * 8192 + wv512), 16, 0, 0)
#define T_DMAV(vbase, vstride, k0, buf) __builtin_amdgcn_global_load_lds((const unsigned*)((vbase) + (size_t)vrow * (vstride) + (k0) + vchk * 8), (LAS unsigned*)(KV + (buf) * 8192 + 4096 + wv512), 16, 0, 0)
#define T_KB(buf) (KV + (buf) * 8192)
#define T_DMAKP(kbase, kstride, k0, dst) __builtin_amdgcn_global_load_lds((const unsigned*)((kbase) + (size_t)((k0) + krow) * (kstride) + kchk * 8), (LAS unsigned*)((dst) + wv512), 16, 0, 0)
#define T_VB(buf) (KV + (buf) * 8192 + 4096)
#define T_WAIT(n) asm volatile("s_waitcnt vmcnt(" #n ")" ::: "memory")
#define T_BAR() do { asm volatile("" ::: "memory"); __builtin_amdgcn_s_barrier(); asm volatile("" ::: "memory"); } while (0)
#define QK2I(buf, S, OFF, STEP) QK2IP(T_KB(buf), S, OFF, STEP)
#define QK2IP(kptr, S, OFF, STEP) do { _Pragma("unroll") for (int ch = 0; ch < 2; ++ch) _Pragma("unroll") for (int T = 0; T < 2; ++T) { \
        const LAS bf16_t* p_ = (kptr) + (4 * T + 32 * ch) * 64; const bf16x8 k0_ = *(const LAS bf16x8*)(p_ + kofA), k1_ = *(const LAS bf16x8*)(p_ + kofB); \
        _Pragma("unroll") for (int ct = 0; ct < 2; ++ct) { f32x4 a_; \
            _Pragma("unroll") for (int i = 0; i < 4; ++i) a_[i] = fmaf(sl, (float)((STEP) * (32 * ch + 4 * T + i)), OFF[ct]); \
            a_ = __builtin_amdgcn_mfma_f32_16x16x32_bf16(k0_, qf[ct][0], a_, 0, 0, 0); a_ = __builtin_amdgcn_mfma_f32_16x16x32_bf16(k1_, qf[ct][1], a_, 0, 0, 0); S[ch][T][ct] = a_; } } } while (0)
#define PV2(buf, PB, O) do { _Pragma("unroll") for (int dt = 0; dt < 4; ++dt) { const LAS bf16_t* p_ = T_VB(buf) + 16 * dt * 64; \
        const bf16x8 v0_ = *(const LAS bf16x8*)(p_ + vofA), v1_ = *(const LAS bf16x8*)(p_ + vofB); \
        _Pragma("unroll") for (int ct = 0; ct < 2; ++ct) { O[dt][ct] = __builtin_amdgcn_mfma_f32_16x16x32_bf16(v0_, PB[0][ct], O[dt][ct], 0, 0, 0); \
            O[dt][ct] = __builtin_amdgcn_mfma_f32_16x16x32_bf16(v1_, PB[1][ct], O[dt][ct], 0, 0, 0); } } } while (0)
#define LSUM(PB, L) do { _Pragma("unroll") for (int ct = 0; ct < 2; ++ct) { L[ct] = __builtin_amdgcn_mfma_f32_16x16x32_bf16(ones, PB[0][ct], L[ct], 0, 0, 0); \
        L[ct] = __builtin_amdgcn_mfma_f32_16x16x32_bf16(ones, PB[1][ct], L[ct], 0, 0, 0); } } while (0)
#define PEXP(S, PB, FULL, D0, W, STEP) do { _Pragma("unroll") for (int ct = 0; ct < 2; ++ct) { _Pragma("unroll") for (int ch = 0; ch < 2; ++ch) { \
        _Pragma("unroll") for (int T = 0; T < 2; ++T) _Pragma("unroll") for (int i = 0; i < 4; ++i) { const float e_ = fexp2(S[ch][T][ct][i]); \
            S[ch][T][ct][i] = (FULL) ? e_ : (((unsigned)(D0[ct] - (STEP) * (32 * ch + 4 * T + i)) < W[ct]) ? e_ : 0.f); } \
        PB[ch][ct] = pack_p(S[ch][0][ct], S[ch][1][ct]); } } } while (0)
    PRB_BEGIN(2);
    if (tid < 256) qmask[tid] = 0u;
    if (tid < 8) ubits[tid] = 0u;
    int tq[2]; bf16x8 qf[2][2]; bf16_t gate3[2][3]; u32x2 osum[2][4];
    const float sl = exp2f(-8.f * (float)(h + 5) / 12.f) * LOG2E;
#pragma unroll
    for (int ct = 0; ct < 2; ++ct) {
        tq[ct] = t0 + 4 * wave + 2 * ct + qq;
        const bf16_t* qp = z + (size_t)tq[ct] * ZLD + ZC_QA + h * 64 + 8 * g;
        qf[ct][0] = ldg8(qp); qf[ct][1] = ldg8(qp + 32);
#pragma unroll
        for (int k = 0; k < 3; ++k) gate3[ct][k] = *(const GAS bf16_t*)(z + (size_t)tq[ct] * ZLD + ZC_GA + h * 3 + k);
    }
    const float mref = mref_in;
    bf16x8 ones;
#pragma unroll
    for (int j = 0; j < 8; ++j) ones[j] = (c == 0) ? (short)0x3F80 : (short)0;
    const int t_lo = t0 + 4 * wave, t_hi = t_lo + 3;
    bf16_t* const og = (bf16_t*)(ws + WS_O) + (size_t)b * SEQ * 1024 + h * 64 + 4 * g;
    const int ncb = (t0 >> 4) + 1;
    const int ntile = (ncb + 63) >> 6;
    const unsigned WALL[2] = {0x7fffffffu, 0x7fffffffu};
    float l2inv[2];
    PRB_END(2); PRB_BEGIN(3);
    {
        f32x4 lacc[2] = {(f32x4){0.f, 0.f, 0.f, 0.f}, (f32x4){0.f, 0.f, 0.f, 0.f}};
        if (tid == 0) nxt_idx = (int)__hip_atomic_fetch_add((GAS unsigned*)qhead, 1u, __ATOMIC_RELAXED, __HIP_MEMORY_SCOPE_AGENT);
        T_BAR();
#pragma unroll
        for (int p = 0; p < 5; ++p) if (p < ntile) T_DMAKP(kcmp, 64, p * 64, KV + p * 4096);
        for (int kt = 0; kt < ntile; ++kt) {
            f32x4 s[2][2][2]; bf16x8 pb[2][2];
            const int k0 = kt * 64, s6 = kt % 6, rem = (ntile - 1 - kt < 4) ? ntile - 1 - kt : 4;
            if (rem == 4) T_WAIT(4); else if (rem == 3) T_WAIT(3); else if (rem == 2) T_WAIT(2); else if (rem == 1) T_WAIT(1); else T_WAIT(0);
            T_BAR();
            if (kt + 5 < ntile) T_DMAKP(kcmp, 64, k0 + 320, KV + ((kt + 5) % 6) * 4096);
            const int d0[2] = {tq[0] - 31 - 16 * (k0 + 8 * g), tq[1] - 31 - 16 * (k0 + 8 * g)};
            const float off[2] = {-sl * (float)d0[0] - mref, -sl * (float)d0[1] - mref};
            QK2IP(KV + s6 * 4096, s, off, 16);
            const bool full = (16 * (k0 + 63) + 31 <= t_lo);
            if (full) PEXP(s, pb, true, d0, WALL, 16); else PEXP(s, pb, false, d0, WALL, 16);
            LSUM(pb, lacc);
        }
#pragma unroll
        for (int ct = 0; ct < 2; ++ct) { float lt = lacc[ct][0]; lt += shx<16>(lt, lane); lt += shx<32>(lt, lane); l2inv[ct] = (lt > 0.f) ? -flog2(lt) : -1e30f; }
    }
    PRB_END(3); PRB_BEGIN(4);
    {
        f32x4 o[4][2];
#pragma unroll
        for (int dt = 0; dt < 4; ++dt) { o[dt][0] = (f32x4){0.f, 0.f, 0.f, 0.f}; o[dt][1] = (f32x4){0.f, 0.f, 0.f, 0.f}; }
        T_BAR();
        T_DMAK(kcmp, 64, 0, 0); T_DMAV(vcT, 1024, 0, 0); if (ntile > 1) { T_DMAK(kcmp, 64, 64, 1); T_DMAV(vcT, 1024, 64, 1); }
        for (int kt = 0; kt < ntile; ++kt) {
            f32x4 s[2][2][2]; bf16x8 pb[2][2];
            const int k0 = kt * 64, bi = kt % 3;
            if (kt + 1 < ntile) T_WAIT(2); else T_WAIT(0);
            T_BAR();
            if (kt + 2 < ntile) { T_DMAK(kcmp, 64, k0 + 128, (kt + 2) % 3); T_DMAV(vcT, 1024, k0 + 128, (kt + 2) % 3); }
            const int d0[2] = {tq[0] - 31 - 16 * (k0 + 8 * g), tq[1] - 31 - 16 * (k0 + 8 * g)};
            const float off[2] = {-sl * (float)d0[0] - mref + l2inv[0], -sl * (float)d0[1] - mref + l2inv[1]};
            QK2I(bi, s, off, 16);
            const bool full = (16 * (k0 + 63) + 31 <= t_lo);
            if (full) PEXP(s, pb, true, d0, WALL, 16); else PEXP(s, pb, false, d0, WALL, 16);
#pragma unroll
            for (int ct = 0; ct < 2; ++ct)
#pragma unroll
                for (int ch = 0; ch < 2; ++ch) {
                    float a0 = s[ch][0][ct][0] + s[ch][0][ct][1] + s[ch][0][ct][2] + 0.5f * s[ch][0][ct][3], b0 = 0.5f * s[ch][0][ct][3];
                    float a1 = s[ch][1][ct][0] + s[ch][1][ct][1] + s[ch][1][ct][2] + 0.5f * s[ch][1][ct][3], b1 = 0.5f * s[ch][1][ct][3];
                    a0 = sum8_dpp(a0); b0 = sum8_dpp(b0); a1 = sum8_dpp(a1); b1 = sum8_dpp(b1);
                    if (h == 0) {
                        const int js = (k0 + 32 * ch) / 4 + 2 * g, ql = 2 * ct + qq;
                        impA[ql * 256 + js] = a0; impB[ql * 256 + js] = b0; impA[ql * 256 + js + 1] = a1; impB[ql * 256 + js + 1] = b1;
                    }
                }
            PV2(bi, pb, o);
        }
#pragma unroll
        for (int ct = 0; ct < 2; ++ct) {
            const float g0 = bf2f(gate3[ct][0]);
#pragma unroll
            for (int dt = 0; dt < 4; ++dt) { const f32x4 v = o[dt][ct] * g0; osum[ct][dt][0] = cvt_pk_bf16(v[0], v[1]); osum[ct][dt][1] = cvt_pk_bf16(v[2], v[3]); }
        }
    }
    PRB_END(4); PRB_BEGIN(5);
    {
        f32x4 o[4][2]; f32x4 lacc[2] = {(f32x4){0.f, 0.f, 0.f, 0.f}, (f32x4){0.f, 0.f, 0.f, 0.f}};
#pragma unroll
        for (int dt = 0; dt < 4; ++dt) { o[dt][0] = (f32x4){0.f, 0.f, 0.f, 0.f}; o[dt][1] = (f32x4){0.f, 0.f, 0.f, 0.f}; }
        int kt0 = (t0 - 511) >> 6; if (kt0 < 0) kt0 = 0;
        const int kt1 = (t0 + 31) >> 6;
        const bf16_t* kb = z + ZC_KWN; const bf16_t* vb = vT + (size_t)(1 * 64) * SEQ;
        const unsigned W2[2] = {512u, 512u};
        T_BAR();
        T_DMAK(kb, ZLD, kt0 * 64, 0); T_DMAV(vb, SEQ, kt0 * 64, 0); if (kt0 < kt1) { T_DMAK(kb, ZLD, kt0 * 64 + 64, 1); T_DMAV(vb, SEQ, kt0 * 64 + 64, 1); }
        for (int kt = kt0; kt <= kt1; ++kt) {
            const int k0 = kt * 64, bi = (kt - kt0) % 3;
            f32x4 s[2][2][2]; bf16x8 pb[2][2];
            if (kt < kt1) T_WAIT(2); else T_WAIT(0);
            T_BAR();
            if (kt + 2 <= kt1) { T_DMAK(kb, ZLD, k0 + 128, (kt - kt0 + 2) % 3); T_DMAV(vb, SEQ, k0 + 128, (kt - kt0 + 2) % 3); }
            const int d0[2] = {tq[0] - (k0 + 8 * g), tq[1] - (k0 + 8 * g)};
            const float off[2] = {-sl * (float)d0[0] - mref, -sl * (float)d0[1] - mref};
            QK2I(bi, s, off, 1);
            const bool full = (k0 + 63 <= t_lo && k0 >= t_hi - 511);
            if (full) PEXP(s, pb, true, d0, W2, 1); else PEXP(s, pb, false, d0, W2, 1);
            PV2(bi, pb, o); LSUM(pb, lacc);
        }
        asm volatile("s_waitcnt vmcnt(0)" ::: "memory");
#pragma unroll
        for (int ct = 0; ct < 2; ++ct) {
            float lt = lacc[ct][0]; lt += shx<16>(lt, lane); lt += shx<32>(lt, lane);
            const float g2 = bf2f(gate3[ct][2]) * ((lt > 0.f) ? 1.f / lt : 0.f);
#pragma unroll
            for (int dt = 0; dt < 4; ++dt) { const f32x4 v = o[dt][ct] * g2; const u32x2 t = osum[ct][dt];
                osum[ct][dt][0] = cvt_pk_bf16(bf_lo(t[0]) + v[0], bf_hi(t[0]) + v[1]); osum[ct][dt][1] = cvt_pk_bf16(bf_lo(t[1]) + v[2], bf_hi(t[1]) + v[3]); }
        }
    }
    PRB_END(5); PRB_BEGIN(6);
    T_BAR();
    T_DMAK(z + ZC_KSL, ZLD, 0, 0); T_DMAV(vT, SEQ, 0, 0);
#pragma unroll
    for (int ql = 0; ql < 4; ++ql) {
        const int qi = 4 * wave + ql, t = t0 + qi, cur = t >> 6;
        if (cur <= 7) {
            if (lane < 8) sell[qi * 8 + lane] = (lane <= cur) ? lane : -1;
        } else {
            unsigned kk[4];
#pragma unroll
            for (int i = 0; i < 4; ++i) { const int j = lane + 64 * i;
                kk[i] = (j >= 1 && j <= cur - 2) ? ((__float_as_uint(impA[ql * 256 + j] + impB[ql * 256 + j - 1]) & 0xFFFFFF00u) | (unsigned)(255 - j)) : 0u; }
            if (lane == 0) { sell[qi * 8 + 0] = 0; sell[qi * 8 + 1] = cur - 1; sell[qi * 8 + 2] = cur; }
#pragma unroll
            for (int r = 0; r < 5; ++r) {
                unsigned m = kk[0] > kk[1] ? kk[0] : kk[1]; const unsigned m2 = kk[2] > kk[3] ? kk[2] : kk[3]; m = m > m2 ? m : m2;
                m = wave_umax(m, lane);
#pragma unroll
                for (int i = 0; i < 4; ++i) kk[i] = (kk[i] == m) ? 0u : kk[i];
                if (lane == 0) sell[qi * 8 + 3 + r] = 255 - (int)(m & 255u);
            }
        }
        if (lane < 8) {
            const int blk = sell[qi * 8 + lane];
            if (blk >= 0) { __hip_atomic_fetch_or(qmask + qi * 8 + (blk >> 5), 1u << (blk & 31), __ATOMIC_RELAXED, __HIP_MEMORY_SCOPE_WORKGROUP);
                            __hip_atomic_fetch_or(ubits + (blk >> 5), 1u << (blk & 31), __ATOMIC_RELAXED, __HIP_MEMORY_SCOPE_WORKGROUP); }
        }
    }
    __syncthreads();
    int nU = 0;
    {
        unsigned wbits[8]; int below = 0;
#pragma unroll
        for (int w = 0; w < 8; ++w) { wbits[w] = ubits[w]; nU += __builtin_popcount(wbits[w]); }
        if (tid < 256) {
            unsigned mine = 0u;
#pragma unroll
            for (int w = 0; w < 8; ++w) { if (w < (tid >> 5)) below += __builtin_popcount(wbits[w]); if (w == (tid >> 5)) mine = wbits[w]; }
            if ((mine >> (tid & 31)) & 1u) { below += __builtin_popcount(mine & ((1u << (tid & 31)) - 1u)); ulist[below] = tid; }
        }
    }
    __syncthreads();
    PRB_END(6); PRB_BEGIN(7);
    {
        f32x4 o[4][2]; f32x4 lacc[2] = {(f32x4){0.f, 0.f, 0.f, 0.f}, (f32x4){0.f, 0.f, 0.f, 0.f}};
#pragma unroll
        for (int dt = 0; dt < 4; ++dt) { o[dt][0] = (f32x4){0.f, 0.f, 0.f, 0.f}; o[dt][1] = (f32x4){0.f, 0.f, 0.f, 0.f}; }
        const bf16_t* kb = z + ZC_KSL; const bf16_t* vb = vT;
        const int q0i = 4 * wave + qq;
        if (nU > 1) { const int k1 = ulist[1] * 64; T_DMAK(kb, ZLD, k1, 1); T_DMAV(vb, SEQ, k1, 1); }
        for (int it = 0; it < nU; ++it) {
            const int blk = ulist[it], k0 = blk * 64, bi = it % 3;
            f32x4 s[2][2][2]; bf16x8 pb[2][2];
            if (it + 1 < nU) T_WAIT(2); else T_WAIT(0);
            T_BAR();
            if (it + 2 < nU) { const int k2 = ulist[it + 2] * 64; T_DMAK(kb, ZLD, k2, (it + 2) % 3); T_DMAV(vb, SEQ, k2, (it + 2) % 3); }
            unsigned W2[2]; float off[2];
            const int d0[2] = {tq[0] - (k0 + 8 * g), tq[1] - (k0 + 8 * g)};
#pragma unroll
            for (int ct = 0; ct < 2; ++ct) {
                const bool member = ((qmask[(q0i + 2 * ct) * 8 + (blk >> 5)] >> (blk & 31)) & 1u) != 0u;
                W2[ct] = member ? 0x7fffffffu : 0u;
                off[ct] = member ? (-sl * (float)d0[ct] - mref) : -1e30f;
            }
            QK2I(bi, s, off, 1);
            const bool full = (k0 + 63 <= t_lo);
            if (full) PEXP(s, pb, true, d0, W2, 1); else PEXP(s, pb, false, d0, W2, 1);
            PV2(bi, pb, o); LSUM(pb, lacc);
        }
        asm volatile("s_waitcnt vmcnt(0)" ::: "memory");
#pragma unroll
        for (int ct = 0; ct < 2; ++ct) {
            float lt = lacc[ct][0]; lt += shx<16>(lt, lane); lt += shx<32>(lt, lane);
            const float g1 = bf2f(gate3[ct][1]) * ((lt > 0.f) ? 1.f / lt : 0.f);
#pragma unroll
            for (int dt = 0; dt < 4; ++dt) { const f32x4 v = o[dt][ct] * g1; bf16_t* op = og + (size_t)tq[ct] * 1024 + 16 * dt; const u32x2 t = osum[ct][dt]; u32x2 w;
                w[0] = cvt_pk_bf16(bf_lo(t[0]) + v[0], bf_hi(t[0]) + v[1]); w[1] = cvt_pk_bf16(bf_lo(t[1]) + v[2], bf_hi(t[1]) + v[3]); stg2u(op, w); }
        }
    }
    PRB_END(7);
#undef T_DMAK
#undef T_DMAV
#undef T_KB
#undef T_VB
#undef T_WAIT
#undef T_BAR
#undef QK2I
#undef QK2IP
#undef T_DMAKP
#undef PV2
#undef LSUM
#undef PEXP
}

__device__ __forceinline__ void sb_unit(const Ctx& X, int unit) {
    unsigned char* ws = X.ws;
    const int lane = X.tid & 63, c = lane & 15, g = lane >> 4;
    const int b = unit >> 11, hd = (unit >> 9) & 3, t0 = (unit & 511) * 32;
    const bf16_t* z = (const bf16_t*)(ws + WS_Z) + (size_t)b * SEQ * ZLD;
    const bf16_t* vT = (const bf16_t*)(ws + WS_VT) + ((size_t)b * 8 + 2 + hd) * 64 * SEQ;
    int tq[2]; bf16x8 qf[2][2]; float R[2] = {1.f, 1.f};
    f32x4 o[4][2];
#pragma unroll
    for (int ct = 0; ct < 2; ++ct) {
        tq[ct] = t0 + 16 * ct + c;
        const bf16_t* qp = z + (size_t)tq[ct] * ZLD + ZC_QB + hd * 64 + 8 * g;
        qf[ct][0] = ldg8(qp); qf[ct][1] = ldg8(qp + 32);
#pragma unroll
        for (int dt = 0; dt < 4; ++dt) o[dt][ct] = (f32x4){0.f, 0.f, 0.f, 0.f};
    }
    const bf16_t* kbase = z + (size_t)(8 * (c >> 2) + (c & 3)) * ZLD + ZC_KB + hd * 64 + 8 * g;
    KFrag kf; VFrag vf;
    ld_ktile(kbase + (size_t)(((t0 + 31) >> 6) * 64) * ZLD, ZLD, kf);
    for (int kt = (t0 + 31) >> 6; kt >= 0; --kt) {
        const int k0 = kt * 64;
        f32x4 s[2][2][2]; bf16x8 pb[2][2];
        ld_vtile(vT + (size_t)c * SEQ + k0 + 8 * g, SEQ, vf);
        qk_from<2>(kf, qf, s);
        if (kt > 0) ld_ktile(kbase + (size_t)(k0 - 64) * ZLD, ZLD, kf);
#pragma unroll
        for (int ct = 0; ct < 2; ++ct) {
            const int d0 = tq[ct] - (k0 + 8 * g);
            float pex[2][8], tot[2], above[2];
#pragma unroll
            for (int ch = 1; ch >= 0; --ch) {
                float run = 1.f;
#pragma unroll
                for (int jj = 7; jj >= 0; --jj) {
                    const int T = jj >> 2, i = jj & 3;
                    const float zc = __builtin_amdgcn_fmed3f(s[ch][T][ct][i], -80.f, 80.f);
                    const bool ok = (d0 - (32 * ch + jj)) > 0;
                    const float t = fexp2(-zc * LOG2E), r = frcp(1.f + t);
                    s[ch][T][ct][i] = ok ? r : 0.f;
                    pex[ch][jj] = run;
                    run *= ok ? t * r : 1.f;
                }
                const float x16 = shx<16>(run, lane), a2 = run * x16, x32 = shx<32>(a2, lane);
                above[ch] = (g == 3) ? 1.f : (g == 2) ? x16 : (g == 1) ? x32 : x16 * x32;
                tot[ch] = a2 * x32;
            }
#pragma unroll
            for (int ch = 0; ch < 2; ++ch) {
                const float base = R[ct] * above[ch] * ((ch == 0) ? tot[1] : 1.f);
#pragma unroll
                for (int jj = 0; jj < 8; ++jj) { const int T = jj >> 2, i = jj & 3; s[ch][T][ct][i] *= base * pex[ch][jj]; }
                pb[ch][ct] = pack_p(s[ch][0][ct], s[ch][1][ct]);
            }
            R[ct] *= tot[0] * tot[1];
        }
        pv_from<2>(vf, pb, o);
        if (__all((R[0] == 0.f) && (R[1] == 0.f))) break;
    }
    bf16_t* ob = (bf16_t*)(ws + WS_O) + (size_t)b * SEQ * 1024 + 512 + hd * 64;
#pragma unroll
    for (int ct = 0; ct < 2; ++ct)
#pragma unroll
        for (int dt = 0; dt < 4; ++dt) {
            u32x2 w; w[0] = cvt_pk_bf16(o[dt][ct][0], o[dt][ct][1]); w[1] = cvt_pk_bf16(o[dt][ct][2], o[dt][ct][3]);
            stg2u(ob + (size_t)tq[ct] * 1024 + 16 * dt + 4 * g, w);
        }
}

__device__ __forceinline__ void swa_unit(const Ctx& X, int layer, int unit) {
    unsigned char* ws = X.ws;
    const int lane = X.tid & 63, c = lane & 15, g = lane >> 4, hg = c & 1;
    const int b = unit >> 11, gk = (unit >> 10) & 1, t0 = (unit & 1023) * 16;
    const int hd = gk * 2 + hg;
    const bf16_t* z = (const bf16_t*)(ws + WS_Z) + (size_t)b * SEQ * ZLD;
    const bf16_t* vT = (const bf16_t*)(ws + WS_VT) + ((size_t)b * 8 + 6 + gk) * 64 * SEQ;
    int tq[2]; float slope[2]; bf16x8 qf[2][2];
    const float sl = exp2f(-8.f * (float)(hd + 1) / 12.f) * LOG2E;
    const float sink = INP(I_SINK)[layer * 4 + hd] * LOG2E;
    SmState<2> st; sm_init<2>(st);
#pragma unroll
    for (int ct = 0; ct < 2; ++ct) {
        tq[ct] = t0 + 8 * ct + (c >> 1); slope[ct] = sl;
        const bf16_t* qp = z + (size_t)tq[ct] * ZLD + ZC_QC + hd * 64 + 8 * g;
        qf[ct][0] = ldg8(qp); qf[ct][1] = ldg8(qp + 32);
        st.m[ct] = sink; st.l[ct] = (g == 0) ? 1.f : 0.f;
    }
    int kt0 = (t0 - 127) >> 6; if (kt0 < 0) kt0 = 0;
    const int kt1 = (t0 + 15) >> 6;
    const bf16_t* kbase = z + (size_t)(8 * (c >> 2) + (c & 3)) * ZLD + ZC_KC + gk * 64 + 8 * g;
    KFrag kf; VFrag vf;
    ld_ktile(kbase + (size_t)(kt0 * 64) * ZLD, ZLD, kf);
    for (int kt = kt0; kt <= kt1; ++kt) {
        const int k0 = kt * 64;
        f32x4 s[2][2][2]; bf16x8 pb[2][2];
        ld_vtile(vT + (size_t)c * SEQ + k0 + 8 * g, SEQ, vf);
        qk_from<2>(kf, qf, s);
        if (kt < kt1) ld_ktile(kbase + (size_t)(k0 + 64) * ZLD, ZLD, kf);
        const int d0[2] = {tq[0] - (k0 + 8 * g), tq[1] - (k0 + 8 * g)};
        const unsigned Wv[2] = {128u, 128u};
        sm_soft<2, 1>(st, s, pb, d0, slope, Wv, lane);
        pv_from<2>(vf, pb, st.o);
    }
    sm_finish<2>(st, lane);
    bf16_t* oc = (bf16_t*)(ws + WS_O) + (size_t)b * SEQ * 1024 + 768 + hd * 64;
#pragma unroll
    for (int ct = 0; ct < 2; ++ct)
#pragma unroll
        for (int dt = 0; dt < 4; ++dt) {
            u32x2 w; w[0] = cvt_pk_bf16(st.o[dt][ct][0], st.o[dt][ct][1]); w[1] = cvt_pk_bf16(st.o[dt][ct][2], st.o[dt][ct][3]);
            stg2u(oc + (size_t)tq[ct] * 1024 + 16 * dt + 4 * g, w);
        }
}

#define STG_CONSTS() \
    const int prho = tid >> 3, pcp = tid & 7; \
    const int krow = (prho & ~9) | ((prho >> 3) & 1) | ((prho & 1) << 3), kchk = pcp ^ (2 * (krow & 3)); \
    const int vrow = (prho & ~5) | ((prho >> 2) & 1) | ((prho & 1) << 2), vchk = pcp ^ (2 * (vrow & 3)); \
    const int wv512 = __builtin_amdgcn_readfirstlane(wave) * 512; \
    const int fp = c & 3, fcl = g ^ (2 * (fp & 1)), fph = fp >> 1; \
    const int krow0 = 8 * (c >> 2) + fp, krho0 = (krow0 & ~9) | ((krow0 >> 3) & 1) | ((krow0 & 1) << 3); \
    const int kofA = krho0 * 64 + (fcl + 4 * (0 ^ fph)) * 8, kofB = krho0 * 64 + (fcl + 4 * (1 ^ fph)) * 8; \
    const int vrho0 = (c & ~5) | ((c >> 2) & 1) | ((c & 1) << 2); \
    const int vofA = vrho0 * 64 + (fcl + 4 * (0 ^ fph)) * 8, vofB = vrho0 * 64 + (fcl + 4 * (1 ^ fph)) * 8
#define T_DMAK(kbase, kstride, k0, buf) __builtin_amdgcn_global_load_lds((const unsigned*)((kbase) + (size_t)((k0) + krow) * (kstride) + kchk * 8), (LAS unsigned*)(KV + (buf) * 8192 + wv512), 16, 0, 0)
#define T_DMAV(vbase, vstride, k0, buf) __builtin_amdgcn_global_load_lds((const unsigned*)((vbase) + (size_t)vrow * (vstride) + (k0) + vchk * 8), (LAS unsigned*)(KV + (buf) * 8192 + 4096 + wv512), 16, 0, 0)
#define T_KB(buf) (KV + (buf) * 8192)
#define T_VB(buf) (KV + (buf) * 8192 + 4096)
#define T_WAIT(n) asm volatile("s_waitcnt vmcnt(" #n ")" ::: "memory")
#define T_BAR() do { asm volatile("" ::: "memory"); __builtin_amdgcn_s_barrier(); asm volatile("" ::: "memory"); } while (0)
#define QK2Z(buf, S) do { _Pragma("unroll") for (int ch = 0; ch < 2; ++ch) _Pragma("unroll") for (int T = 0; T < 2; ++T) { \
        const LAS bf16_t* p_ = T_KB(buf) + (4 * T + 32 * ch) * 64; const bf16x8 k0_ = *(const LAS bf16x8*)(p_ + kofA), k1_ = *(const LAS bf16x8*)(p_ + kofB); \
        _Pragma("unroll") for (int ct = 0; ct < 2; ++ct) { f32x4 a_ = (f32x4){0.f, 0.f, 0.f, 0.f}; \
            a_ = __builtin_amdgcn_mfma_f32_16x16x32_bf16(k0_, qf[ct][0], a_, 0, 0, 0); a_ = __builtin_amdgcn_mfma_f32_16x16x32_bf16(k1_, qf[ct][1], a_, 0, 0, 0); S[ch][T][ct] = a_; } } } while (0)
#define PV2(buf, PB, O) do { _Pragma("unroll") for (int dt = 0; dt < 4; ++dt) { const LAS bf16_t* p_ = T_VB(buf) + 16 * dt * 64; \
        const bf16x8 v0_ = *(const LAS bf16x8*)(p_ + vofA), v1_ = *(const LAS bf16x8*)(p_ + vofB); \
        _Pragma("unroll") for (int ct = 0; ct < 2; ++ct) { O[dt][ct] = __builtin_amdgcn_mfma_f32_16x16x32_bf16(v0_, PB[0][ct], O[dt][ct], 0, 0, 0); \
            O[dt][ct] = __builtin_amdgcn_mfma_f32_16x16x32_bf16(v1_, PB[1][ct], O[dt][ct], 0, 0, 0); } } } while (0)

__device__ __forceinline__ void sb_block(const Ctx& X, LAS unsigned char* lds, int unit) {
    unsigned char* ws = X.ws;
    const int tid = X.tid, lane = tid & 63, wave = tid >> 6, c = lane & 15, g = lane >> 4;
    const int b = unit >> 8, hd = (unit >> 6) & 3, t0 = (unit & 63) * 256;
    const bf16_t* z = (const bf16_t*)(ws + WS_Z) + (size_t)b * SEQ * ZLD;
    const bf16_t* vb = (const bf16_t*)(ws + WS_VT) + ((size_t)b * 8 + 2 + hd) * 64 * SEQ;
    const bf16_t* kb = z + ZC_KB + hd * 64;
    LAS bf16_t* KV = (LAS bf16_t*)lds;
    LAS int* flg = (LAS int*)(lds + LDS_MISC + 4096);
    STG_CONSTS();
    int tq[2]; bf16x8 qf[2][2]; float R[2] = {1.f, 1.f};
    f32x4 o[4][2];
#pragma unroll
    for (int ct = 0; ct < 2; ++ct) {
        tq[ct] = t0 + 32 * wave + 16 * ct + c;
        const bf16_t* qp = z + (size_t)tq[ct] * ZLD + ZC_QB + hd * 64 + 8 * g;
        qf[ct][0] = ldg8(qp); qf[ct][1] = ldg8(qp + 32);
#pragma unroll
        for (int dt = 0; dt < 4; ++dt) o[dt][ct] = (f32x4){0.f, 0.f, 0.f, 0.f};
    }
    const int kt_hi = (t0 + 255) >> 6, ktw = (t0 + 32 * wave + 31) >> 6;
    bool mydone = false;
    T_BAR();
    T_DMAK(kb, ZLD, kt_hi * 64, 0); T_DMAV(vb, SEQ, kt_hi * 64, 0);
    if (kt_hi >= 1) { T_DMAK(kb, ZLD, (kt_hi - 1) * 64, 1); T_DMAV(vb, SEQ, (kt_hi - 1) * 64, 1); }
    int stp = 0;
    for (int kt = kt_hi; kt >= 0; --kt, ++stp) {
        const int k0 = kt * 64, bi = stp % 3;
        if (kt >= 1) T_WAIT(2); else T_WAIT(0);
        T_BAR();
        if (stp > 0) {
            const LAS int* f = flg + ((stp - 1) & 1) * 8;
            if ((f[0] | f[1] | f[2] | f[3] | f[4] | f[5] | f[6] | f[7]) == 0) break;
        }
        if (kt >= 2) { T_DMAK(kb, ZLD, k0 - 128, (stp + 2) % 3); T_DMAV(vb, SEQ, k0 - 128, (stp + 2) % 3); }
        if (kt <= ktw && !mydone) {
            f32x4 s[2][2][2]; bf16x8 pb[2][2];
            QK2Z(bi, s);
#pragma unroll
            for (int ct = 0; ct < 2; ++ct) {
                const int d0 = tq[ct] - (k0 + 8 * g);
                float pex[2][8], tot[2], above[2];
#pragma unroll
                for (int ch = 1; ch >= 0; --ch) {
                    float run = 1.f;
#pragma unroll
                    for (int jj = 7; jj >= 0; --jj) {
                        const int T = jj >> 2, i = jj & 3;
                        const float zc = __builtin_amdgcn_fmed3f(s[ch][T][ct][i], -80.f, 80.f);
                        const bool ok = (d0 - (32 * ch + jj)) > 0;
                        const float t = fexp2(-zc * LOG2E), r = frcp(1.f + t);
                        s[ch][T][ct][i] = ok ? r : 0.f;
                        pex[ch][jj] = run;
                        run *= ok ? t * r : 1.f;
                    }
                    const float x16 = shx<16>(run, lane), a2 = run * x16, x32 = shx<32>(a2, lane);
                    above[ch] = (g == 3) ? 1.f : (g == 2) ? x16 : (g == 1) ? x32 : x16 * x32;
                    tot[ch] = a2 * x32;
                }
#pragma unroll
                for (int ch = 0; ch < 2; ++ch) {
                    const float base = R[ct] * above[ch] * ((ch == 0) ? tot[1] : 1.f);
#pragma unroll
                    for (int jj = 0; jj < 8; ++jj) { const int T = jj >> 2, i = jj & 3; s[ch][T][ct][i] *= base * pex[ch][jj]; }
                    pb[ch][ct] = pack_p(s[ch][0][ct], s[ch][1][ct]);
                }
                R[ct] *= tot[0] * tot[1];
            }
            PV2(bi, pb, o);
            mydone = __all((R[0] == 0.f) && (R[1] == 0.f)) != 0;
        }
        if (lane == 0) flg[(stp & 1) * 8 + wave] = (!mydone && kt > 0) ? 1 : 0;
        asm volatile("s_waitcnt lgkmcnt(0)" ::: "memory");
    }
    T_WAIT(0);
    bf16_t* ob = (bf16_t*)(ws + WS_O) + (size_t)b * SEQ * 1024 + 512 + hd * 64;
#pragma unroll
    for (int ct = 0; ct < 2; ++ct)
#pragma unroll
        for (int dt = 0; dt < 4; ++dt) {
            u32x2 w; w[0] = cvt_pk_bf16(o[dt][ct][0], o[dt][ct][1]); w[1] = cvt_pk_bf16(o[dt][ct][2], o[dt][ct][3]);
            stg2u(ob + (size_t)tq[ct] * 1024 + 16 * dt + 4 * g, w);
        }
}

__device__ __forceinline__ void swa_block(const Ctx& X, LAS unsigned char* lds, int layer, int unit) {
    unsigned char* ws = X.ws;
    const int tid = X.tid, lane = tid & 63, wave = tid >> 6, c = lane & 15, g = lane >> 4, hg = c & 1;
    const int b = unit >> 8, gk = (unit >> 7) & 1, t0 = (unit & 127) * 128;
    const int hd = gk * 2 + hg;
    const bf16_t* z = (const bf16_t*)(ws + WS_Z) + (size_t)b * SEQ * ZLD;
    const bf16_t* vb = (const bf16_t*)(ws + WS_VT) + ((size_t)b * 8 + 6 + gk) * 64 * SEQ;
    const bf16_t* kb = z + ZC_KC + gk * 64;
    LAS bf16_t* KV = (LAS bf16_t*)lds;
    STG_CONSTS();
    int tq[2]; float slope[2]; bf16x8 qf[2][2];
    const float sl = exp2f(-8.f * (float)(hd + 1) / 12.f) * LOG2E;
    const float sink = INP(I_SINK)[layer * 4 + hd] * LOG2E;
    SmState<2> st; sm_init<2>(st);
#pragma unroll
    for (int ct = 0; ct < 2; ++ct) {
        tq[ct] = t0 + 16 * wave + 8 * ct + (c >> 1); slope[ct] = sl;
        const bf16_t* qp = z + (size_t)tq[ct] * ZLD + ZC_QC + hd * 64 + 8 * g;
        qf[ct][0] = ldg8(qp); qf[ct][1] = ldg8(qp + 32);
        st.m[ct] = sink; st.l[ct] = (g == 0) ? 1.f : 0.f;
    }
    const int t_lo = t0 + 16 * wave, t_hi = t_lo + 15;
    int kt0 = (t0 - 127) >> 6; if (kt0 < 0) kt0 = 0;
    const int kt1 = (t0 + 127) >> 6;
    const unsigned Wv[2] = {128u, 128u};
    T_BAR();
    T_DMAK(kb, ZLD, kt0 * 64, 0); T_DMAV(vb, SEQ, kt0 * 64, 0); if (kt0 < kt1) { T_DMAK(kb, ZLD, kt0 * 64 + 64, 1); T_DMAV(vb, SEQ, kt0 * 64 + 64, 1); }
    for (int kt = kt0; kt <= kt1; ++kt) {
        const int k0 = kt * 64, bi = (kt - kt0) % 3;
        if (kt < kt1) T_WAIT(2); else T_WAIT(0);
        T_BAR();
        if (kt + 2 <= kt1) { T_DMAK(kb, ZLD, k0 + 128, (kt - kt0 + 2) % 3); T_DMAV(vb, SEQ, k0 + 128, (kt - kt0 + 2) % 3); }
        if (k0 <= t_hi && k0 + 63 >= t_lo - 127) {
            f32x4 s[2][2][2]; bf16x8 pb[2][2];
            QK2Z(bi, s);
            const int d0[2] = {tq[0] - (k0 + 8 * g), tq[1] - (k0 + 8 * g)};
            sm_soft<2, 1>(st, s, pb, d0, slope, Wv, lane);
            PV2(bi, pb, st.o);
        }
    }
    sm_finish<2>(st, lane);
    bf16_t* oc = (bf16_t*)(ws + WS_O) + (size_t)b * SEQ * 1024 + 768 + hd * 64;
#pragma unroll
    for (int ct = 0; ct < 2; ++ct)
#pragma unroll
        for (int dt = 0; dt < 4; ++dt) {
            u32x2 w; w[0] = cvt_pk_bf16(st.o[dt][ct][0], st.o[dt][ct][1]); w[1] = cvt_pk_bf16(st.o[dt][ct][2], st.o[dt][ct][3]);
            stg2u(oc + (size_t)tq[ct] * 1024 + 16 * dt + 4 * g, w);
        }
}
#undef STG_CONSTS
#undef T_DMAK
#undef T_DMAV
#undef T_KB
#undef T_VB
#undef T_WAIT
#undef T_BAR
#undef QK2Z
#undef PV2

struct SchedC1 {
    static constexpr bool GATHER = false, FP8 = false, CHAIN = false;
    int lda2, akstep, ldb2; const char* Z; const char* W1; int G, c;
    __device__ __forceinline__ bool next(int i, GU& u) const {
        const int L = i * G + c; if (L >= 16) return false;
        const int mat = L >> 3, pm = L & 7;
        u.A = Z + (size_t)pm * 256 * lda2 + (mat ? ZC_VCS : ZC_KCS) * 2; u.B = W1 + (size_t)mat * 256 * 2048 * 2; u.nt = 32; u.kind = 0; u.pm = pm; u.pn = 0; u.e = mat; u.aux = 0; return true;
    }
    __device__ __forceinline__ void rowoff(const GU&, int, unsigned (&)[2][2]) const {}
};

#ifndef MK_PER_STEP
#define MK_PER_STEP 0
#endif
constexpr int NSTEP = 2 + 10 * NL;
#define PHASE_FN __device__ __forceinline__

PHASE_FN void f_prologue(Ctx Xa) { const Ctx X = uni(Xa); p0_prologue(X, X.lds); }
PHASE_FN void f_norm0(Ctx Xa, int l) { const Ctx X = uni(Xa); norm_phase<0>(X, X.lds, l); }
PHASE_FN void f_norm1(Ctx Xa, int l) { const Ctx X = uni(Xa); norm_phase<1>(X, X.lds, l); }
PHASE_FN void f_norm2(Ctx Xa, int l) { const Ctx X = uni(Xa); norm2_mfma(X, X.lds, l); }
PHASE_FN void f_norm3(Ctx Xa, int l) { const Ctx X = uni(Xa); norm_phase<3>(X, X.lds, l); }
PHASE_FN void f_inproj(Ctx Xa, int la) {
    const Ctx X = uni(Xa); const int l = la; unsigned char* ws = X.ws;
    SchedDense S{2048, 128, 2048, (const char*)(ws + WS_H), (const char*)(ws + WS_WIN) + (size_t)l * 2304 * 2048, 128, 9, 16, X.G, X.bid};
    EpiZ E{(bf16_t*)(ws + WS_Z), (bf16_t*)(ws + WS_VT), INP(I_NQG) + l * 64, INP(I_NKG) + l * 192, INP(I_SQG) + l * 64, INP(I_SKG) + l * 64};
    gemm_run(X.lds, S, E, X.tid);
    { const int nunits = 128 * 9, rounds = (nunits + X.G - 1) / X.G;
      if (nunits % X.G != 0 && X.bid >= nunits - (rounds - 1) * X.G) conv_fill(X, X.lds, l + 1, 4, false); }
}
PHASE_FN void f_cmp1(Ctx Xa, int la) {
    const Ctx X = uni(Xa); const int l = la; unsigned char* ws = X.ws;
    SchedC1 S{16 * ZLD * 2, ZLD * 2, 4096, (const char*)(ws + WS_Z), (const char*)(ws + WS_W1) + (size_t)l * 2 * 256 * 2048 * 2, X.G, X.bid};
    EpiC1 E{(bf16_t*)(ws + WS_HID), (const float*)(ws + WS_CB) + l * 512};
    gemm_run(X.lds, S, E, X.tid);
    if (X.bid < 16) {
        __builtin_amdgcn_fence(__ATOMIC_RELEASE, "workgroup"); __syncthreads(); __builtin_amdgcn_fence(__ATOMIC_ACQUIRE, "workgroup");
        for (int L = X.bid; L < 16; L += X.G)
            for (int j = X.tid >> 6; j < 16; j += 8) cmp2_unit(X, l, (L >> 3) * 128 + (L & 7) * 16 + j);
    }
}
PHASE_FN void f_cmp2(Ctx Xa, int la) {
    const Ctx X = uni(Xa); const int l = la;
    for (int u = X.bid * 8 + (X.tid >> 6); u < 256; u += X.G * 8) cmp2_unit(X, l, u);
}
PHASE_FN void f_nsa(Ctx Xa, int la, int qk) {
    const Ctx X = uni(Xa); const int l = la;
    unsigned* ctl = (unsigned*)(X.ws + WS_CTL);
    LAS int* bc = (LAS int*)(X.lds + LDS_MISC + 32);
    PRB_DECL();
#if !PRB_SEL
    unsigned long long prb_acc = 0ull;
#endif
    unsigned* qhead = ctl + CW_Q + 64 * (l * 4 + qk);
    float mref;
    { const int lane = X.tid & 63, layer = l;
        float gq = fabsf(INP(I_NQG)[layer * 64 + lane]);
        const float* kg = INP(I_NKG) + layer * 192;
        float gk = fmaxf(fmaxf(fabsf(kg[lane]), fabsf(kg[64 + lane])), fabsf(kg[128 + lane]));
        gq = fmaxf(gq, shx<32>(gq, lane)); gq = fmaxf(gq, shx<16>(gq, lane)); gq = fmaxf(gq, shx<8>(gq, lane)); gq = fmaxf(gq, shx<4>(gq, lane)); gq = fmaxf(gq, shx<2>(gq, lane)); gq = fmaxf(gq, shx<1>(gq, lane));
        gk = fmaxf(gk, shx<32>(gk, lane)); gk = fmaxf(gk, shx<16>(gk, lane)); gk = fmaxf(gk, shx<8>(gk, lane)); gk = fmaxf(gk, shx<4>(gk, lane)); gk = fmaxf(gk, shx<2>(gk, lane)); gk = fmaxf(gk, shx<1>(gk, lane));
        mref = 8.f * LOG2E * 1.01f * gq * gk;
    }
    int nxt = 0;
    if (X.tid == 0) nxt = (int)atomicAdd(qhead, 1u);
    for (;;) {
        PRB_BEGIN(1);
        if (X.tid == 0) bc[0] = nxt;
        __syncthreads();
        const int idx = bc[0];
        __syncthreads();
        PRB_END(1);
        if (idx >= 1024) break;
        nsa_block(X, X.lds, (idx & 1) * 512 + (511 - (idx >> 1)), l, prb_acc, qhead, nxt, mref);
    }
    PRB_FLUSH(X);
}
PHASE_FN void f_sbswa(Ctx Xa, int la, int qk) {
    const Ctx X = uni(Xa); const int l = la;
    unsigned* ctl = (unsigned*)(X.ws + WS_CTL);
    LAS int* bc = (LAS int*)(X.lds + LDS_MISC + 32);
    for (;;) {
        if (X.tid == 0) bc[0] = (int)atomicAdd(ctl + CW_Q + 64 * (l * 4 + qk) + 16, 1u);
        __syncthreads();
        const int idx = bc[0];
        __syncthreads();
        if (idx >= 1024) break;
        if (idx < 512) sb_block(X, X.lds, idx);
        else swa_block(X, X.lds, l, idx - 512);
    }
}
PHASE_FN void f_e1(Ctx Xa, int la) {
    const Ctx X = uni(Xa); const int l = la; unsigned char* ws = X.ws;
    EpiE1G EG{(unsigned char*)(ws + WS_SB) + (size_t)X.bid * 262144};
    EpiE1T ET{(unsigned char*)(ws + WS_SB) + (size_t)X.bid * 262144, (bf16_t*)(ws + WS_Y)};
    for (int T = 0; T * X.G < 512; ++T) {
        SchedE1G SG{1024, 128, 2048, (const char*)(ws + WS_H8), (const char*)(ws + WS_WM8) + (size_t)l * 3072 * 1024, X.G, X.bid, T};
        gemm_run(X.lds, SG, EG, X.tid);
        SchedE1T ST{2048, 128, 2048, (const char*)(ws + WS_O), (const char*)(ws + WS_WB) + (size_t)l * 1024 * 2048, X.G, X.bid, T};
        gemm_run(X.lds, ST, ET, X.tid);
    }
}
PHASE_FN void f_e2(Ctx Xa, int la) {
    const Ctx X = uni(Xa); const int l = la; unsigned char* ws = X.ws;
    const float* modl = (const float*)(ws + WS_MOD) + (size_t)l * 2 * 6144;
    SchedDense S{2048, 128, 2048, (const char*)(ws + WS_Y), (const char*)(ws + WS_WO) + (size_t)l * 1024 * 2048, 128, 4, 16, X.G, X.bid};
    EpiE2 E{(bf16_t*)(ws + WS_XB), modl + 2048, (float*)(ws + WS_SSP)};
    gemm_run(X.lds, S, E, X.tid);
}
__device__ __forceinline__ void moe_table(const Ctx& X, int l) {
    LAS int* tpre = (LAS int*)(X.lds + LDS_MISC + 256);
    if (X.tid < 16) {
        const unsigned* gcnt = (const unsigned*)(X.ws + WS_CTL) + CW_GCNT + 16 * (l * 16);
        tpre[17 + X.tid] = (int)__hip_atomic_load((GAS unsigned*)(gcnt + 16 * X.tid), __ATOMIC_RELAXED, __HIP_MEMORY_SCOPE_AGENT);
    }
    __syncthreads();
    if (X.tid < 17) {
        int run = 0;
        for (int e = 0; e < X.tid; ++e) run += (tpre[17 + e] + 255) >> 8;
        tpre[X.tid] = run;
        if (X.tid < 16) tpre[34 + X.tid] = run * 256;
    }
    __syncthreads();
}
PHASE_FN void f_g1(Ctx Xa, int la) {
    const Ctx X = uni(Xa); const int l = la; unsigned char* ws = X.ws;
    moe_table(X, l);
    const LAS int* tpre = (const LAS int*)(X.lds + LDS_MISC + 256);
    SchedMoE S{2048, 128, 2048, (const char*)(ws + WS_H), (const char*)(ws + WS_WGU) + (size_t)l * 16 * 1024 * 2048, (size_t)1024 * 2048, 4, 16, X.G, X.bid, 1, tpre, (const int*)(ws + WS_LISTT)};
    EpiG1 E{(bf16_t*)(ws + WS_AB)};
    gemm_run(X.lds, S, E, X.tid);
    { const int nunits = tpre[16] * 4, rounds = (nunits + X.G - 1) / X.G, cx = (X.G % 8 == 0) ? (X.bid % 8) * (X.G / 8) + X.bid / 8 : X.bid;
      if (nunits % X.G != 0 && cx >= nunits - (rounds - 1) * X.G) conv_fill(X, X.lds, l + 1, 4, false); }
}
PHASE_FN void f_g2(Ctx Xa, int la) {
    const Ctx X = uni(Xa); const int l = la; unsigned char* ws = X.ws;
    moe_table(X, l);
    const LAS int* tpre = (const LAS int*)(X.lds + LDS_MISC + 256);
    SchedMoE S{1024, 128, 1024, (const char*)(ws + WS_AB), (const char*)(ws + WS_WD) + (size_t)l * 16 * 1024 * 1024, (size_t)1024 * 1024, 4, 8, X.G, X.bid, 2, tpre, (const int*)(ws + WS_LISTT)};
    EpiG2 E{(bf16_t*)(ws + WS_YS)};
    gemm_run(X.lds, S, E, X.tid);
    conv_fill(X, X.lds, l + 1, 0, true);
}

__global__ void __launch_bounds__(512, 2) mega_fwd(Params P) {
    extern __shared__ __attribute__((aligned(16))) unsigned char lds_raw[];
    LAS unsigned char* lds = (LAS unsigned char*)lds_raw;
    const int tid = threadIdx.x;
    unsigned* ctl = (unsigned*)(P.ws + WS_CTL);
    if (tid < 64) ((LAS unsigned*)(lds + LDS_MISC))[tid] = 0u;
    if (tid < 27) *(LAS unsigned long long*)(lds + LDS_PTAB + 8 * tid) = (unsigned long long)P.in[tid];
    if ((tid & 63) == 0) *(LAS int*)(lds + LDS_WTAB + 4 * ((unsigned)__builtin_amdgcn_s_getreg((5 << 11) | 4) & 63u)) = tid >> 6;
    __syncthreads();
    XcdBarrier bar = xcd_barrier_post(ctl, (volatile LAS unsigned*)(lds + LDS_MISC));
    Ctx X; X.ws = P.ws; X.out = P.out; X.lds = lds; X.tid = 0; X.bid = 0; X.G = 0;
    const int lo = P.step_lo, hi = P.step_hi;
#define IN(s) (lo <= (s) && (s) < hi)
#define SEAM(s) do { if ((s) + 1 < hi) xcd_barrier(bar); } while (0)
#ifndef DBL
#define DBL 0
#endif
    if (IN(0)) { f_prologue(X); if (DBL & 1) f_prologue(X); SEAM(0); }
    for (int l = 0; l < NL; ++l) {
        const int s0 = 1 + 10 * l;
        if (IN(s0 + 0)) { if (l == 0) f_norm0(X, l); else f_norm1(X, l); SEAM(s0 + 0); }
        if (IN(s0 + 1)) { f_inproj(X, l); if (DBL & 2) f_inproj(X, l); SEAM(s0 + 1); }
        if (IN(s0 + 2)) { f_cmp1(X, l); __syncthreads(); f_sbswa(X, l, 1); if (DBL & 64) f_sbswa(X, l, 2); SEAM(s0 + 2); }
        if (IN(s0 + 4)) { f_nsa(X, l, 1); if (DBL & 4) f_nsa(X, l, 2); SEAM(s0 + 4); }
        if (IN(s0 + 5)) { f_e1(X, l); if (DBL & 8) f_e1(X, l); SEAM(s0 + 5); }
        if (IN(s0 + 6)) { f_e2(X, l); SEAM(s0 + 6); }
        if (IN(s0 + 7)) { f_norm2(X, l); SEAM(s0 + 7); }
        if (IN(s0 + 8)) { f_g1(X, l); if (DBL & 16) f_g1(X, l); SEAM(s0 + 8); }
        if (IN(s0 + 9)) { f_g2(X, l); if (DBL & 32) f_g2(X, l); SEAM(s0 + 9); }
    }
    if (IN(NSTEP - 1)) f_norm3(X, NL);
#undef IN
#undef SEAM
}

extern "C" void kernel_launch(void* const* d_in, const int* in_sizes, int n_in, void* d_out, int out_size, void* d_ws, size_t ws_size, hipStream_t stream) {
    static int grid = 0;
    if (grid == 0) {
        if (n_in != 27 || out_size != NTOK * DM || ws_size < WS_END) { fprintf(stderr, "kernel_launch: unexpected shapes/workspace (n_in %d out %d ws %zu need %zu)\n", n_in, out_size, ws_size, (size_t)WS_END); grid = -1; return; }
        int dev = 0, cus = 0, per_cu = 0;
        if (hipGetDevice(&dev) != hipSuccess || hipDeviceGetAttribute(&cus, hipDeviceAttributeMultiprocessorCount, dev) != hipSuccess) { grid = -1; return; }
        if (hipFuncSetAttribute((const void*)mega_fwd, hipFuncAttributeMaxDynamicSharedMemorySize, LDS_BYTES) != hipSuccess) { fprintf(stderr, "kernel_launch: hipFuncSetAttribute failed\n"); grid = -1; return; }
        if (hipOccupancyMaxActiveBlocksPerMultiprocessor(&per_cu, (const void*)mega_fwd, 512, LDS_BYTES) != hipSuccess || per_cu < 1) { fprintf(stderr, "kernel_launch: occupancy query says %d\n", per_cu); }
        (void)hipGetLastError();
        grid = cus;
        if (grid > 256) grid = 256;
        if (grid < 64) { grid = -1; return; }
    }
    if (grid < 0) return;
    if (hipMemsetAsync((char*)d_ws + WS_CTL, 0, 64 * 1024, stream) != hipSuccess) return;
    Params p{};
    for (int i = 0; i < 27; ++i) p.in[i] = (const float*)d_in[i];
    p.out = (float*)d_out; p.ws = (unsigned char*)d_ws;
#if MK_PER_STEP
    for (int s = 0; s < NSTEP; ++s) { p.step_lo = s; p.step_hi = s + 1; hipLaunchKernelGGL(mega_fwd, dim3(grid), dim3(512), LDS_BYTES, stream, p); }
#else
    p.step_lo = 0; p.step_hi = NSTEP;
    hipLaunchKernelGGL(mega_fwd, dim3(grid), dim3(512), LDS_BYTES, stream, p);
#endif
}
```

```cpp
#include <hip/hip_runtime.h>
#include <stdio.h>
#include <stdint.h>

#define LAS __attribute__((address_space(3)))
#define GAS __attribute__((address_space(1)))
typedef unsigned short bf16_t;
typedef short bf16x8 __attribute__((ext_vector_type(8)));
typedef float f32x4 __attribute__((ext_vector_type(4)));
typedef unsigned u32x4 __attribute__((ext_vector_type(4)));
typedef unsigned u32x2 __attribute__((ext_vector_type(2)));

constexpr int NTOK = 32768, SEQ = 16384, DM = 1024, NL = 4, NB = 2;
constexpr int NIN = 5272;
constexpr int ZLD = 2304;
constexpr int ZC_QA = 0, ZC_KCS = 512, ZC_VCS = 576, ZC_KSL = 640, ZC_VSL = 704, ZC_KWN = 768, ZC_VWN = 832,
              ZC_QB = 896, ZC_KB = 1152, ZC_VB = 1408, ZC_QC = 1664, ZC_KC = 1920, ZC_VC = 2048, ZC_GA = 2176;
constexpr int LCAP = 32768;
constexpr int AROWS = 65536 + 16 * 256;
constexpr float LOG2E = 1.4426950408889634f;
constexpr float LN2 = 0.6931471805599453f;
constexpr int LDS_BYTES = 147456;
constexpr int LDS_MISC = 131072;

constexpr size_t KiB = 1024, MiB = 1024 * 1024;
constexpr size_t WS_CTL = 0;
constexpr size_t WS_MOD = WS_CTL + 64 * KiB;
constexpr size_t WS_CB = WS_MOD + 192 * KiB;
constexpr size_t WS_LISTT = WS_CB + 8 * KiB;
constexpr size_t WS_LISTW = WS_LISTT + 2 * MiB;
constexpr size_t WS_KCMP = WS_LISTW + 2 * MiB;
constexpr size_t WS_VCMPT = WS_KCMP + 256 * KiB;
constexpr size_t WS_HID = WS_VCMPT + 256 * KiB;
constexpr size_t WS_SSP = WS_HID + 2 * MiB;
constexpr size_t WS_WIN = WS_SSP + 2 * MiB;
constexpr size_t WS_WM = WS_WIN + (size_t)NL * 2304 * 1024 * 2;
constexpr size_t WS_WB = WS_WM + (size_t)NL * 3072 * 1024 * 2;
constexpr size_t WS_WO = WS_WB + (size_t)NL * 1024 * 1024 * 2;
constexpr size_t WS_W1 = WS_WO + (size_t)NL * 1024 * 1024 * 2;
constexpr size_t WS_W2 = WS_W1 + (size_t)NL * 2 * 256 * 2048 * 2;
constexpr size_t WS_WGU = WS_W2 + (size_t)NL * 2 * 64 * 256 * 2;
constexpr size_t WS_WD = WS_WGU + (size_t)NL * 16 * 1024 * 1024 * 2;
constexpr size_t WS_H = WS_WD + (size_t)NL * 16 * 1024 * 512 * 2;
constexpr size_t WS_Z = WS_H + (size_t)NTOK * 1024 * 2;
constexpr size_t Z_BYTES = (size_t)(NTOK + 64) * ZLD * 2;
constexpr size_t WS_Y = WS_Z;
constexpr size_t WS_SB = WS_Z + 64 * MiB;
constexpr size_t WS_AB = WS_Z + 64 * MiB;
constexpr size_t WS_R3 = WS_Z + Z_BYTES;
constexpr size_t WS_YB = WS_R3;
constexpr size_t WS_VT = WS_R3;
constexpr size_t WS_O = WS_R3 + 32 * MiB;
constexpr size_t WS_XB = WS_R3 + 136 * MiB;
constexpr size_t WS_TINFO = WS_XB + 64 * MiB;
constexpr size_t WS_YS = WS_R3;
constexpr size_t WS_H8 = WS_TINFO + 1 * MiB;
constexpr size_t WS_WM8 = WS_H8 + 32 * MiB;
constexpr size_t WS_END = WS_WM8 + 12 * MiB;
static_assert(64 * MiB + (size_t)AROWS * 512 * 2 <= Z_BYTES, "alias map");

constexpr int CW_Q = 4096;
constexpr int CW_GCNT = 6144;

__device__ __forceinline__ unsigned cvt_pk_bf16(float lo, float hi) { unsigned r; asm("v_cvt_pk_bf16_f32 %0, %1, %2" : "=v"(r) : "v"(lo), "v"(hi)); return r; }
__device__ __forceinline__ bf16_t f2bf(float f) { return (bf16_t)(cvt_pk_bf16(f, 0.f) & 0xffffu); }
__device__ __forceinline__ float bf_lo(unsigned u) { return __uint_as_float(u << 16); }
__device__ __forceinline__ float bf_hi(unsigned u) { return __uint_as_float(u & 0xffff0000u); }
__device__ __forceinline__ float bf2f(bf16_t b) { return __uint_as_float(((unsigned)b) << 16); }
__device__ __forceinline__ float fexp2(float x) { return __builtin_amdgcn_exp2f(x); }
__device__ __forceinline__ float flog2(float x) { return __builtin_amdgcn_logf(x); }
__device__ __forceinline__ float frcp(float x) { return __builtin_amdgcn_rcpf(x); }
__device__ __forceinline__ float sigmoidf_(float x) { return frcp(1.f + fexp2(-x * LOG2E)); }
template <int M> __device__ __forceinline__ int shxi(int v, int lane) {
    if constexpr (M < 32) return __builtin_amdgcn_ds_swizzle(v, (M << 10) | 0x1f);
    else return __builtin_amdgcn_ds_bpermute((lane ^ 32) << 2, v);
}
template <int M> __device__ __forceinline__ float shx(float v, int lane) { return __int_as_float(shxi<M>(__float_as_int(v), lane)); }
__device__ __forceinline__ float sum8_dpp(float v) {
    v += __int_as_float(__builtin_amdgcn_update_dpp(__float_as_int(v), __float_as_int(v), 0xB1, 0xf, 0xf, true));
    v += __int_as_float(__builtin_amdgcn_update_dpp(__float_as_int(v), __float_as_int(v), 0x4E, 0xf, 0xf, true));
    v += __int_as_float(__builtin_amdgcn_update_dpp(__float_as_int(v), __float_as_int(v), 0x141, 0xf, 0xf, true));
    return v;
}
__device__ __forceinline__ unsigned wave_umax(unsigned k, int lane) {
    unsigned o;
    o = (unsigned)__builtin_amdgcn_update_dpp((int)k, (int)k, 0xB1, 0xf, 0xf, true); k = k > o ? k : o;
    o = (unsigned)__builtin_amdgcn_update_dpp((int)k, (int)k, 0x4E, 0xf, 0xf, true); k = k > o ? k : o;
    o = (unsigned)__builtin_amdgcn_update_dpp((int)k, (int)k, 0x141, 0xf, 0xf, true); k = k > o ? k : o;
    o = (unsigned)__builtin_amdgcn_update_dpp((int)k, (int)k, 0x140, 0xf, 0xf, true); k = k > o ? k : o;
    o = (unsigned)shxi<16>((int)k, lane); k = k > o ? k : o;
    o = (unsigned)shxi<32>((int)k, lane); k = k > o ? k : o;
    return k;
}
__device__ __forceinline__ float wave_sum(float v, int lane) {
    v += shx<32>(v, lane); v += shx<16>(v, lane); v += shx<8>(v, lane); v += shx<4>(v, lane); v += shx<2>(v, lane); v += shx<1>(v, lane);
    return v;
}
__device__ __forceinline__ bf16x8 ldg8(const bf16_t* p) { return *(const GAS bf16x8*)p; }
__device__ __forceinline__ u32x4 ldg4u(const void* p) { return *(const GAS u32x4*)p; }
__device__ __forceinline__ u32x2 ldg2u(const void* p) { return *(const GAS u32x2*)p; }
__device__ __forceinline__ f32x4 ldg4f(const float* p) { return *(const GAS f32x4*)p; }
__device__ __forceinline__ void stg4u(void* p, u32x4 v) { *(GAS u32x4*)p = v; }
__device__ __forceinline__ void stg2u(void* p, u32x2 v) { *(GAS u32x2*)p = v; }
__device__ __forceinline__ void stg4f(float* p, f32x4 v) { *(GAS f32x4*)p = v; }

#define XB_TMO      128
#define XB_XCNT(j)  (256  + 64 * (j))
#define XB_XSUB(j)  (1280 + 64 * (j))
#define XB_XGEN(j)  (2304 + 64 * (j))
#define XB_TOP      3328
#define XB_TOPGEN   3392
#define XCD_BAR_WORDS 3456
#define XB_SPIN_CAP (1u << 18)
__device__ __forceinline__ unsigned xb_ld(unsigned* p)              { return __hip_atomic_load(p, __ATOMIC_RELAXED, __HIP_MEMORY_SCOPE_AGENT); }
__device__ __forceinline__ unsigned xb_add(unsigned* p, unsigned v) { return __hip_atomic_fetch_add(p, v, __ATOMIC_RELAXED, __HIP_MEMORY_SCOPE_AGENT); }
__device__ __forceinline__ unsigned xb_xcc_id() { return (unsigned)__builtin_amdgcn_s_getreg((3 << 11) | 20) & 0xFu; }
#define XB_SPIN(cond, bar) do { unsigned _sp = 0; while (cond) { __builtin_amdgcn_s_sleep(1); \
    if ((++_sp & 255u) == 0u) { if (xb_ld(&(bar)[XB_TMO])) break; if (_sp > XB_SPIN_CAP) { atomicAdd(&(bar)[XB_TMO], 1u); break; } } } } while (0)
constexpr int LDS_WTAB = 131072 + 12288;
__device__ __forceinline__ int tid_rebuild(const LAS unsigned char* lds) {
    const unsigned hw = (unsigned)__builtin_amdgcn_s_getreg((5 << 11) | 4) & 63u;
    const int wv = __builtin_amdgcn_readfirstlane(*(const LAS int*)(lds + LDS_WTAB + 4 * hw));
    int ln; asm volatile("v_mbcnt_lo_u32_b32 %0, -1, 0\n\tv_mbcnt_hi_u32_b32 %0, -1, %0" : "=v"(ln));
    return wv * 64 + ln;
}
struct XcdBarrier { unsigned* bar; unsigned x; volatile LAS unsigned* st; };
__device__ __forceinline__ XcdBarrier xcd_barrier_post(unsigned* bar, volatile LAS unsigned* st) {
    XcdBarrier b; b.bar = bar; b.x = xb_xcc_id(); b.st = st;
    if (tid_rebuild((const LAS unsigned char*)st - 131072) == 0) (void)xb_add(&bar[XB_XCNT(b.x)], 1u);
    return b;
}
__device__ __forceinline__ void xcd_barrier_complete(unsigned* bar, unsigned x, unsigned& nloc, unsigned& nx) {
    const unsigned G = gridDim.x * gridDim.y * gridDim.z;
    unsigned sum, cnt, mine, sp = 0u;
    for (;;) {
        sum = 0u; cnt = 0u; mine = 0u;
#pragma unroll
        for (unsigned j = 0; j < 16; ++j) { const unsigned c = xb_ld(&bar[XB_XCNT(j)]); sum += c; cnt += (c > 0u) ? 1u : 0u; mine = (j == x) ? c : mine; }
        if (sum == G) break;
        __builtin_amdgcn_s_sleep(1);
        if ((++sp & 255u) == 0u) { if (xb_ld(&bar[XB_TMO])) break; if (sp > XB_SPIN_CAP) { atomicAdd(&bar[XB_TMO], 1u); break; } }
    }
    nloc = mine > 0u ? mine : 1u; nx = cnt > 0u ? cnt : 1u;
}
__device__ __forceinline__ void xcd_barrier(const XcdBarrier& b) {
    asm volatile("s_waitcnt vmcnt(0)" ::: "memory");
    __syncthreads();
    if (tid_rebuild((const LAS unsigned char*)b.st - 131072) == 0) {
        unsigned* bar = b.bar;
        __builtin_amdgcn_s_waitcnt(0);
        unsigned nloc = b.st[0], nx = b.st[1];
        if (nloc == 0u) { xcd_barrier_complete(bar, b.x, nloc, nx); b.st[0] = nloc; b.st[1] = nx; }
        const unsigned old = xb_add(&bar[XB_XSUB(b.x)], 1u);
        const unsigned gen = old / nloc;
        if (old + 1u == (gen + 1u) * nloc) {
            __builtin_amdgcn_fence(__ATOMIC_RELEASE, "agent");
            asm volatile("s_waitcnt vmcnt(0)" ::: "memory");
            const unsigned og = xb_add(&bar[XB_TOP], 1u);
            const unsigned tg = og / nx;
            if (og + 1u == (tg + 1u) * nx) xb_add(&bar[XB_TOPGEN], 1u);
            else XB_SPIN(xb_ld(&bar[XB_TOPGEN]) == tg, bar);
            __builtin_amdgcn_fence(__ATOMIC_ACQUIRE, "agent");
            xb_add(&bar[XB_XGEN(b.x)], 1u);
            asm volatile("s_waitcnt vmcnt(0)" ::: "memory");
        } else {
            XB_SPIN(xb_ld(&bar[XB_XGEN(b.x)]) == gen, bar);
            __builtin_amdgcn_fence(__ATOMIC_ACQUIRE, "agent");
            asm volatile("s_waitcnt vmcnt(0)" ::: "memory");
        }
    }
    __syncthreads();
}

struct Params { const float* in[27]; float* out; unsigned char* ws; int step_lo, step_hi; };
struct Ctx { unsigned char* ws; float* out; LAS unsigned char* lds; int tid, bid, G; };
constexpr int LDS_PTAB = 131072 + 2048;
__device__ __forceinline__ unsigned long long uni64(unsigned long long v) {
    const unsigned lo = __builtin_amdgcn_readfirstlane((unsigned)v), hi = __builtin_amdgcn_readfirstlane((unsigned)(v >> 32)); return ((unsigned long long)hi << 32) | lo; }
__device__ __forceinline__ Ctx uni(Ctx X) { Ctx Y = X; int t = tid_rebuild(X.lds); asm volatile("" : "+v"(t)); Y.tid = t;
    unsigned long long w = (unsigned long long)X.ws; asm volatile("" : "+s"(w)); Y.ws = (unsigned char*)w;
    unsigned long long o = (unsigned long long)X.out; asm volatile("" : "+s"(o)); Y.out = (float*)o;
    int bb = blockIdx.x; asm volatile("" : "+s"(bb)); Y.bid = bb; int gg = gridDim.x; asm volatile("" : "+s"(gg)); Y.G = gg; return Y; }
__device__ __forceinline__ const float* ctx_in(const Ctx& X, int i) { return (const float*)uni64(*(const LAS unsigned long long*)(X.lds + LDS_PTAB + 8 * i)); }
#define INP(i) ctx_in(X, (i))
enum { I_X = 0, I_C, I_WADA, I_BADA, I_GMIX, I_GMOE, I_WIN, I_PEK, I_W1K, I_W2K, I_PEV, I_W1V, I_W2V, I_NQG, I_NKG, I_SQG, I_SKG, I_SINK,
       I_WBA, I_WBB, I_WBC, I_WOUT, I_WR, I_RB, I_WEG, I_WEU, I_WED };

#ifndef PRB_SEL
#define PRB_SEL 0
#endif
constexpr int CW_PRB = 7168;
#if PRB_SEL
#define PRB_DECL() unsigned long long prb_acc = 0ull, prb_t0 = 0ull; const unsigned long long prb_start = __builtin_readcyclecounter()
#define PRB_BEGIN(n) do { if ((n) == PRB_SEL) prb_t0 = __builtin_readcyclecounter(); } while (0)
#define PRB_END(n) do { if ((n) == PRB_SEL) prb_acc += __builtin_readcyclecounter() - prb_t0; } while (0)
#define PRB_FLUSH(X) do { if (((X).tid & 63) == 0) { unsigned* c_ = (unsigned*)((X).ws + WS_CTL); atomicAdd(c_ + CW_PRB, (unsigned)(prb_acc >> 8)); \
        atomicAdd(c_ + CW_PRB + 16, (unsigned)((__builtin_readcyclecounter() - prb_start) >> 8)); } } while (0)
#else
#define PRB_DECL() do {} while (0)
#define PRB_BEGIN(n) do {} while (0)
#define PRB_END(n) do {} while (0)
#define PRB_FLUSH(X) do {} while (0)
#endif

constexpr int CONV_PER_L = 576 + 768 + 256 + 256 + 256 + 8 + 4096 + 2048;
constexpr int CW_CVQ = 7680;
__device__ __forceinline__ void conv_tiles(const Ctx& X, LAS unsigned char* lds, int u0, int ustep, int uend) {
    unsigned char* ws = X.ws;
    const int tid = X.tid;
    LAS float* t32 = (LAS float*)lds;
    constexpr int PER_L = CONV_PER_L;
    const int lk = tid >> 3, lc8 = (tid & 7) * 8;
    const float* src = nullptr; const float* srcn = nullptr; bf16_t* dst = nullptr; bf16_t* dstn = nullptr; unsigned char* d8 = nullptr; unsigned char* d8n = nullptr;
    int src_ld = 0, dst_ld = 0, nvalid = 0, src_ldn = 0, dst_ldn = 0, nvalidn = 0;
    f32x4 va = (f32x4){0.f, 0.f, 0.f, 0.f}, vb = va, vna = va, vnb = va;
#define TDECODE(u, SRC, DST, SLD, DLD, NV, D8) do { \
            const int l = (u) / PER_L; int r = (u) % PER_L; NV = 64; D8 = nullptr; \
            if (r < 576) { const int n0 = (r / 16) * 64, k0 = (r % 16) * 64; int c0; \
                if (n0 < 896) c0 = n0; else if (n0 < 2176) c0 = n0 + 24; else if (n0 == 2176) { c0 = 896; NV = 24; } else { c0 = 0; NV = 0; } \
                SRC = INP(I_WIN) + ((size_t)l * 1024 + k0) * NIN + c0; SLD = NIN; DST = (bf16_t*)(ws + WS_WIN) + ((size_t)l * 2304 + n0) * 1024 + k0; DLD = 1024; } \
            else if ((r -= 576) < 768) { const int n0 = (r / 16) * 64, k0 = (r % 16) * 64; \
                SRC = INP(I_WIN) + ((size_t)l * 1024 + k0) * NIN + 2200 + n0; SLD = NIN; DST = (bf16_t*)(ws + WS_WM) + ((size_t)l * 3072 + n0) * 1024 + k0; DLD = 1024; \
                D8 = ws + WS_WM8 + ((size_t)l * 3072 + n0) * 1024 + k0; } \
            else if ((r -= 768) < 256) { const int n0 = (r / 16) * 64, k0 = (r % 16) * 64; \
                if (k0 < 512) SRC = INP(I_WBA) + ((size_t)l * 512 + k0) * 1024 + n0; \
                else if (k0 < 768) SRC = INP(I_WBB) + ((size_t)l * 256 + (k0 - 512)) * 1024 + n0; \
                else SRC = INP(I_WBC) + ((size_t)l * 256 + (k0 - 768)) * 1024 + n0; \
                SLD = 1024; DST = (bf16_t*)(ws + WS_WB) + ((size_t)l * 1024 + n0) * 1024 + k0; DLD = 1024; } \
            else if ((r -= 256) < 256) { const int n0 = (r / 16) * 64, k0 = (r % 16) * 64; \
                SRC = INP(I_WOUT) + ((size_t)l * 1024 + k0) * 1024 + n0; SLD = 1024; DST = (bf16_t*)(ws + WS_WO) + ((size_t)l * 1024 + n0) * 1024 + k0; DLD = 1024; } \
            else if ((r -= 256) < 256) { const int mat = r / 128, rr = r % 128, n0 = (rr / 32) * 64, k0 = (rr % 32) * 64; \
                SRC = INP(mat ? I_W1V : I_W1K) + ((size_t)l * 2048 + k0) * 256 + n0; SLD = 256; DST = (bf16_t*)(ws + WS_W1) + (((size_t)l * 2 + mat) * 256 + n0) * 2048 + k0; DLD = 2048; } \
            else if ((r -= 256) < 8) { const int mat = r / 4, k0 = (r % 4) * 64; \
                SRC = INP(mat ? I_W2V : I_W2K) + ((size_t)l * 256 + k0) * 64; SLD = 64; DST = (bf16_t*)(ws + WS_W2) + (((size_t)l * 2 + mat) * 64) * 256 + k0; DLD = 256; } \
            else if ((r -= 8) < 4096) { const int e = r / 256, rr = r % 256, n0 = (rr / 16) * 64, k0 = (rr % 16) * 64; \
                const int blk = n0 / 256, half = (n0 % 256) / 128, c0 = blk * 128 + (n0 % 128); \
                SRC = INP(half ? I_WEU : I_WEG) + (((size_t)l * 16 + e) * 1024 + k0) * 512 + c0; SLD = 512; DST = (bf16_t*)(ws + WS_WGU) + (((size_t)l * 16 + e) * 1024 + n0) * 1024 + k0; DLD = 1024; } \
            else { r -= 4096; const int e = r / 128, rr = r % 128, n0 = (rr / 8) * 64, k0 = (rr % 8) * 64; \
                SRC = INP(I_WED) + (((size_t)l * 16 + e) * 512 + k0) * 1024 + n0; SLD = 1024; DST = (bf16_t*)(ws + WS_WD) + (((size_t)l * 16 + e) * 1024 + n0) * 512 + k0; DLD = 512; } \
    } while (0)
#define TLOAD(SRC, SLD, NV, A, B) do { if (lc8 + 8 <= (NV)) { A = ldg4f((SRC) + (size_t)lk * (SLD) + lc8); B = ldg4f((SRC) + (size_t)lk * (SLD) + lc8 + 4); } \
            else { A = (f32x4){0.f, 0.f, 0.f, 0.f}; B = A; } } while (0)
    int u = u0;
    if (u < uend) { TDECODE(u, src, dst, src_ld, dst_ld, nvalid, d8); TLOAD(src, src_ld, nvalid, va, vb); }
    while (u < uend) {
        const int un = u + ustep;
        if (un < uend) { TDECODE(un, srcn, dstn, src_ldn, dst_ldn, nvalidn, d8n); TLOAD(srcn, src_ldn, nvalidn, vna, vnb); }
        {
            LAS float* w = t32 + lk * 65 + lc8;
            w[0] = va[0]; w[1] = va[1]; w[2] = va[2]; w[3] = va[3]; w[4] = vb[0]; w[5] = vb[1]; w[6] = vb[2]; w[7] = vb[3];
        }
        __syncthreads();
        {
            const int n = tid >> 3, k8 = (tid & 7) * 8;
            const LAS float* r_ = t32 + k8 * 65 + n;
            u32x4 o;
            o[0] = cvt_pk_bf16(r_[0 * 65], r_[1 * 65]); o[1] = cvt_pk_bf16(r_[2 * 65], r_[3 * 65]);
            o[2] = cvt_pk_bf16(r_[4 * 65], r_[5 * 65]); o[3] = cvt_pk_bf16(r_[6 * 65], r_[7 * 65]);
            stg4u(dst + (size_t)n * dst_ld + k8, o);
            if (d8 != nullptr) { u32x2 o8; int w8 = 0;
                w8 = __builtin_amdgcn_cvt_pk_fp8_f32(64.f * r_[0 * 65], 64.f * r_[1 * 65], w8, false); w8 = __builtin_amdgcn_cvt_pk_fp8_f32(64.f * r_[2 * 65], 64.f * r_[3 * 65], w8, true); o8[0] = (unsigned)w8; w8 = 0;
                w8 = __builtin_amdgcn_cvt_pk_fp8_f32(64.f * r_[4 * 65], 64.f * r_[5 * 65], w8, false); w8 = __builtin_amdgcn_cvt_pk_fp8_f32(64.f * r_[6 * 65], 64.f * r_[7 * 65], w8, true); o8[1] = (unsigned)w8;
                stg2u(d8 + (size_t)n * 1024 + k8, o8); }
        }
        __syncthreads();
        u = un; src = srcn; dst = dstn; src_ld = src_ldn; dst_ld = dst_ldn; nvalid = nvalidn; va = vna; vb = vnb; d8 = d8n;
    }
#undef TDECODE
#undef TLOAD
}
__device__ __forceinline__ void conv_fill(const Ctx& X, LAS unsigned char* lds, int l, int max_batches, bool drain) {
    if (l >= NL) return;
    unsigned* q = (unsigned*)(X.ws + WS_CTL) + CW_CVQ + 16 * l;
    LAS int* bc = (LAS int*)(lds + LDS_MISC + 32);
    for (int b = 0; drain || b < max_batches; ++b) {
        if (X.tid == 0) bc[0] = (int)atomicAdd(q, 4u);
        __syncthreads();
        const int idx0 = bc[0];
        __syncthreads();
        if (idx0 >= CONV_PER_L) break;
        const int iend = (idx0 + 4 < CONV_PER_L) ? idx0 + 4 : CONV_PER_L;
        conv_tiles(X, lds, l * CONV_PER_L + idx0, 1, l * CONV_PER_L + iend);
    }
}

__device__ __forceinline__ void p0_prologue(const Ctx& X, LAS unsigned char* lds) {
    unsigned char* ws = X.ws;
    const int tid = X.tid, G = X.G, bid = X.bid;
    {
        const int lane = tid & 63, wave = tid >> 6;
        LAS float* sc = (LAS float*)lds;
        LAS float* red = (LAS float*)(lds + 8192);
        for (int i = tid; i < 2048; i += 512) { const float cv = INP(I_C)[i]; sc[i] = cv * sigmoidf_(cv); }
        __syncthreads();
        for (int u = bid; u < 256; u += G) {
            const int l = u >> 6, j0 = (u & 63) * 96;
            f32x4 a0 = (f32x4){0.f, 0.f, 0.f, 0.f}, a1 = a0;
            if (lane < 24) {
                const float* w = INP(I_WADA) + (size_t)l * 1024 * 6144 + j0 + 4 * lane;
#pragma unroll 8
                for (int k = wave * 128; k < wave * 128 + 128; ++k) { const f32x4 wv = ldg4f(w + (size_t)k * 6144); a0 += wv * sc[k]; a1 += wv * sc[1024 + k]; }
#pragma unroll
                for (int j = 0; j < 4; ++j) { red[(wave * 2 + 0) * 96 + 4 * lane + j] = a0[j]; red[(wave * 2 + 1) * 96 + 4 * lane + j] = a1[j]; }
            }
            __syncthreads();
            if (tid < 192) {
                const int b = tid / 96, j = tid % 96; float sm = 0.f;
#pragma unroll
                for (int w = 0; w < 8; ++w) sm += red[(w * 2 + b) * 96 + j];
                ((float*)(ws + WS_MOD))[((size_t)l * 2 + b) * 6144 + j0 + j] = sm + INP(I_BADA)[l * 6144 + j0 + j];
            }
            __syncthreads();
        }
        for (int u = bid; u < 256; u += G) {
            const int l = u >> 6, mat = (u >> 5) & 1, cc = u & 31;
            const float* pe = INP(mat ? I_PEV : I_PEK) + (size_t)l * 2048;
            const float* w = INP(mat ? I_W1V : I_W1K) + (size_t)l * 2048 * 256 + cc * 8 + (lane & 1) * 4;
            f32x4 a = (f32x4){0.f, 0.f, 0.f, 0.f};
#pragma unroll
            for (int it = 0; it < 8; ++it) { const int row = wave * 256 + it * 32 + (lane >> 1); a += ldg4f(w + (size_t)row * 256) * pe[row]; }
#pragma unroll
            for (int j = 0; j < 4; ++j) { float v = a[j]; v += shx<2>(v, lane); v += shx<4>(v, lane); v += shx<8>(v, lane); v += shx<16>(v, lane); v += shx<32>(v, lane); a[j] = v; }
            if (lane < 2) {
#pragma unroll
                for (int j = 0; j < 4; ++j) red[wave * 8 + lane * 4 + j] = a[j];
            }
            __syncthreads();
            if (tid < 8) { float sm = 0.f;
#pragma unroll
                for (int w2 = 0; w2 < 8; ++w2) sm += red[w2 * 8 + tid];
                ((float*)(ws + WS_CB))[(l * 2 + mat) * 256 + cc * 8 + tid] = sm; }
            __syncthreads();
        }
    }
    __syncthreads();
    conv_tiles(X, lds, bid, G, CONV_PER_L);
}

template <int N> struct IC { static constexpr int value = N; };
template <int MODE>
__device__ __forceinline__ void norm_phase(const Ctx& X, LAS unsigned char* lds, int layer) {
    unsigned char* ws = X.ws;
    const int tid = X.tid, lane = tid & 63, wave = tid >> 6, G = X.G;
    const float* xsrc = INP(I_X);
    float* xdst = X.out;
    bf16_t* xb = (bf16_t*)(ws + WS_XB);
    const float* modl = (const float*)(ws + WS_MOD) + (size_t)layer * 2 * 6144;
    const float* modp = (const float*)(ws + WS_MOD) + (size_t)(layer - 1) * 2 * 6144;
    const bf16_t* yb = (const bf16_t*)(ws + WS_YS);
    const u32x4* tinfo = (const u32x4*)(ws + WS_TINFO);
    LAS int* tpad = (LAS int*)(lds + LDS_MISC + 1024);
    LAS int* ttmp = (LAS int*)(lds + LDS_MISC + 1088);
    bf16_t* h = (bf16_t*)(ws + WS_H);
    const float* gn = INP(MODE == 2 ? I_GMOE : I_GMIX) + (size_t)layer * 1024;
    const int sh_off = (MODE == 2) ? 3072 : 0, sc_off = (MODE == 2) ? 4096 : 1024;
    LAS float* wrT = (LAS float*)lds;
    LAS int* lcnt = (LAS int*)(lds + LDS_MISC + 64);
    LAS int* lbase = (LAS int*)(lds + LDS_MISC + 128);
    LAS float* lgl = (LAS float*)(lds + 65536);
    if (MODE == 2) {
        for (int i = tid; i < 16384; i += 512) { const int k = i >> 4, e = i & 15; wrT[e * 1024 + k] = INP(I_WR)[i]; }
        if (tid < 16) lcnt[tid] = 0;
        __syncthreads();
    }
    if (MODE == 1 || MODE == 3) {
        const unsigned* gcnt = (const unsigned*)(ws + WS_CTL) + CW_GCNT + 16 * ((layer - 1) * 16);
        if (tid < 16) ttmp[tid] = (((int)__hip_atomic_load(gcnt + 16 * tid, __ATOMIC_RELAXED, __HIP_MEMORY_SCOPE_AGENT) + 255) >> 8) * 256;
        __syncthreads();
        if (tid < 16) { int p = 0; for (int k = 0; k < tid; ++k) p += ttmp[k]; tpad[tid] = p; }
        __syncthreads();
    }
    int it = 0; (void)it;
    const int stride = G * 8, r0 = X.bid * 8 + wave;
    f32x4 vn[2][4]; u32x2 xbn[2][4], y0n[2][4], y1n[2][4]; float w0n[2] = {0.f, 0.f}, w1n[2] = {0.f, 0.f}; u32x4 tin[2] = {(u32x4){0u, 0u, 0u, 0u}, (u32x4){0u, 0u, 0u, 0u}};
#define NORM_LOAD(S, r) do { size_t yr0_ = 0, yr1_ = 0; \
        if (MODE == 1 || MODE == 3) { const unsigned a0_ = __builtin_amdgcn_readfirstlane(tin[S][0]), a1_ = __builtin_amdgcn_readfirstlane(tin[S][2]); \
            w0n[S] = __uint_as_float(__builtin_amdgcn_readfirstlane(tin[S][1])); w1n[S] = __uint_as_float(__builtin_amdgcn_readfirstlane(tin[S][3])); \
            yr0_ = (size_t)(__builtin_amdgcn_readfirstlane(tpad[a0_ & 15u]) + (int)(a0_ >> 4)) * 1024; yr1_ = (size_t)(__builtin_amdgcn_readfirstlane(tpad[a1_ & 15u]) + (int)(a1_ >> 4)) * 1024; } \
        _Pragma("unroll") for (int i = 0; i < 4; ++i) { const int col_ = 4 * (lane + 64 * i); \
        if (MODE == 0 || MODE == 2) vn[S][i] = ldg4f(xsrc + (size_t)(r) * 1024 + col_); \
        if (MODE == 1 || MODE == 3) { xbn[S][i] = ldg2u(xb + (size_t)(r) * 1024 + col_); y0n[S][i] = ldg2u(yb + yr0_ + col_); y1n[S][i] = ldg2u(yb + yr1_ + col_); } } } while (0)
    if (MODE == 1 || MODE == 3) { if (r0 < NTOK) tin[0] = ldg4u(tinfo + (r0)); if (r0 + stride < NTOK) tin[1] = ldg4u(tinfo + (r0 + stride)); }
    if (r0 < NTOK) { NORM_LOAD(0, r0); if ((MODE == 1 || MODE == 3) && r0 + 2 * stride < NTOK) tin[0] = ldg4u(tinfo + (r0 + 2 * stride)); }
    if (r0 + stride < NTOK) { NORM_LOAD(1, r0 + stride); if ((MODE == 1 || MODE == 3) && r0 + 3 * stride < NTOK) tin[1] = ldg4u(tinfo + (r0 + 3 * stride)); }
    int bcur = -1; f32x4 gmv[4], gscv[4], shv4[4];
    auto body = [&](auto SC, const int row) __attribute__((always_inline)) {
        constexpr int S = decltype(SC)::value;
        const int b = row >> 14;
        if (b != bcur) {
            bcur = b;
#pragma unroll
            for (int i = 0; i < 4; ++i) { const int col = 4 * (lane + 64 * i);
                if (MODE == 1 || MODE == 3) gmv[i] = ldg4f(modp + b * 6144 + 5120 + col);
                if (MODE != 3) { const f32x4 g = ldg4f(gn + col), sc = ldg4f(modl + b * 6144 + sc_off + col); gscv[i] = g * (1.f + sc); shv4[i] = ldg4f(modl + b * 6144 + sh_off + col); } }
        }
        f32x4 v[4];
#pragma unroll
        for (int i = 0; i < 4; ++i) {
            if (MODE == 1 || MODE == 3) {
                const u32x2 xq = xbn[S][i], y0 = y0n[S][i], y1 = y1n[S][i]; const f32x4 g = gmv[i]; const float w0c = w0n[S], w1c = w1n[S];
                v[i][0] = bf_lo(xq[0]) + g[0] * (w0c * bf_lo(y0[0]) + w1c * bf_lo(y1[0])); v[i][1] = bf_hi(xq[0]) + g[1] * (w0c * bf_hi(y0[0]) + w1c * bf_hi(y1[0]));
                v[i][2] = bf_lo(xq[1]) + g[2] * (w0c * bf_lo(y0[1]) + w1c * bf_lo(y1[1])); v[i][3] = bf_hi(xq[1]) + g[3] * (w0c * bf_hi(y0[1]) + w1c * bf_hi(y1[1]));
            } else v[i] = vn[S][i];
        }
        asm volatile("" ::: "memory");
        if (row + 2 * stride < NTOK) { NORM_LOAD(S, row + 2 * stride); if ((MODE == 1 || MODE == 3) && row + 4 * stride < NTOK) tin[S] = ldg4u(tinfo + (row + 4 * stride)); }
        asm volatile("" ::: "memory");
#pragma unroll
        for (int i = 0; i < 4; ++i) {
            const int col = 4 * (lane + 64 * i);
#if PRB_SEL
            if (MODE == 3) { const unsigned* c_ = (const unsigned*)(ws + WS_CTL); const float fr_ = (float)c_[CW_PRB] / fmaxf((float)c_[CW_PRB + 16], 1.f);
                v[i] *= 1.f + sqrtf(0.02f + 0.5f * fr_); }
#endif
            if (MODE == 3) stg4f(xdst + (size_t)row * 1024 + col, v[i]);
            else { u32x2 o; o[0] = cvt_pk_bf16(v[i][0], v[i][1]); o[1] = cvt_pk_bf16(v[i][2], v[i][3]); stg2u(xb + (size_t)row * 1024 + col, o); }
        }
        if (MODE == 3) return;
        float ss = 0.f;
#pragma unroll
        for (int i = 0; i < 4; ++i) ss += v[i][0] * v[i][0] + v[i][1] * v[i][1] + v[i][2] * v[i][2] + v[i][3] * v[i][3];
        ss = wave_sum(ss, lane);
        const float rinv = rsqrtf(ss * (1.f / 1024.f) + 1e-6f);
#pragma unroll
        for (int i = 0; i < 4; ++i) {
            const int col = 4 * (lane + 64 * i);
            f32x4 hv;
#pragma unroll
            for (int j = 0; j < 4; ++j) hv[j] = v[i][j] * rinv * gscv[i][j] + shv4[i][j];
            u32x2 o; o[0] = cvt_pk_bf16(hv[0], hv[1]); o[1] = cvt_pk_bf16(hv[2], hv[3]);
            stg2u(h + (size_t)row * 1024 + col, o);
            { int w8 = 0; w8 = __builtin_amdgcn_cvt_pk_fp8_f32(hv[0], hv[1], w8, false); w8 = __builtin_amdgcn_cvt_pk_fp8_f32(hv[2], hv[3], w8, true);
              *(GAS int*)(ws + WS_H8 + (size_t)row * 1024 + col) = w8; }
        }
    };
    for (int rowp = r0; rowp < NTOK; rowp += 2 * stride) { body(IC<0>{}, rowp); if (rowp + stride < NTOK) body(IC<1>{}, rowp + stride); }
#undef NORM_LOAD
    if (MODE == 2) {
        __syncthreads();
        const int slot = tid, srow = X.bid * 8 + (slot & 7) + (slot >> 3) * G * 8;
        const bool have = (slot < 512) && (srow < NTOK) && ((slot >> 3) < 64);
        int e0 = 0, e1 = 0, r0 = 0, r1i = 0; float w0 = 0.f, w1 = 0.f;
        if (have) {
            float sco[16], sel[16];
            f32x4 rb4[4];
#pragma unroll
            for (int q = 0; q < 4; ++q) rb4[q] = ldg4f(INP(I_RB) + 4 * q);
#pragma unroll
            for (int q = 0; q < 4; ++q) { const f32x4 lg4 = *(const LAS f32x4*)(lgl + slot * 16 + 4 * q);
#pragma unroll
                for (int j = 0; j < 4; ++j) { const int e = 4 * q + j; sco[e] = 1.f / (1.f + __expf(-lg4[j])); sel[e] = sco[e] + rb4[q][j]; } }
            float gs[4];
#pragma unroll
            for (int g = 0; g < 4; ++g) {
                const float a = sel[4 * g], bq = sel[4 * g + 1], c = sel[4 * g + 2], d = sel[4 * g + 3];
                const float m1 = fmaxf(fmaxf(a, bq), fmaxf(c, d));
                int i1 = (a == m1) ? 0 : (bq == m1) ? 1 : (c == m1) ? 2 : 3;
                float m2 = -3.0e38f;
                m2 = (i1 != 0) ? fmaxf(m2, a) : m2; m2 = (i1 != 1) ? fmaxf(m2, bq) : m2; m2 = (i1 != 2) ? fmaxf(m2, c) : m2; m2 = (i1 != 3) ? fmaxf(m2, d) : m2;
                gs[g] = m1 + m2;
            }
            int gi = 0; float gb = gs[0];
#pragma unroll
            for (int g = 1; g < 4; ++g) if (gs[g] > gb) { gb = gs[g]; gi = g; }
            float s0 = (gi == 0) ? sel[0] : (gi == 1) ? sel[4] : (gi == 2) ? sel[8] : sel[12];
            float s1 = (gi == 0) ? sel[1] : (gi == 1) ? sel[5] : (gi == 2) ? sel[9] : sel[13];
            float s2 = (gi == 0) ? sel[2] : (gi == 1) ? sel[6] : (gi == 2) ? sel[10] : sel[14];
            float s3 = (gi == 0) ? sel[3] : (gi == 1) ? sel[7] : (gi == 2) ? sel[11] : sel[15];
            float c0 = (gi == 0) ? sco[0] : (gi == 1) ? sco[4] : (gi == 2) ? sco[8] : sco[12];
            float c1 = (gi == 0) ? sco[1] : (gi == 1) ? sco[5] : (gi == 2) ? sco[9] : sco[13];
            float c2 = (gi == 0) ? sco[2] : (gi == 1) ? sco[6] : (gi == 2) ? sco[10] : sco[14];
            float c3 = (gi == 0) ? sco[3] : (gi == 1) ? sco[7] : (gi == 2) ? sco[11] : sco[15];
            const float m1 = fmaxf(fmaxf(s0, s1), fmaxf(s2, s3));
            const int i1 = (s0 == m1) ? 0 : (s1 == m1) ? 1 : (s2 == m1) ? 2 : 3;
            float m2 = -3.0e38f;
            m2 = (i1 != 0) ? fmaxf(m2, s0) : m2; m2 = (i1 != 1) ? fmaxf(m2, s1) : m2; m2 = (i1 != 2) ? fmaxf(m2, s2) : m2; m2 = (i1 != 3) ? fmaxf(m2, s3) : m2;
            const int i2 = (i1 != 0 && s0 == m2) ? 0 : (i1 != 1 && s1 == m2) ? 1 : (i1 != 2 && s2 == m2) ? 2 : 3;
            const float w1v = (i1 == 0) ? c0 : (i1 == 1) ? c1 : (i1 == 2) ? c2 : c3;
            const float w2v = (i2 == 0) ? c0 : (i2 == 1) ? c1 : (i2 == 2) ? c2 : c3;
            const float wn = 1.f / (w1v + w2v);
            e0 = gi * 4 + i1; e1 = gi * 4 + i2; w0 = w1v * wn; w1 = w2v * wn;
            r0 = __hip_atomic_fetch_add(lcnt + e0, 1, __ATOMIC_RELAXED, __HIP_MEMORY_SCOPE_WORKGROUP); r1i = __hip_atomic_fetch_add(lcnt + e1, 1, __ATOMIC_RELAXED, __HIP_MEMORY_SCOPE_WORKGROUP);
        }
        __syncthreads();
        unsigned* gcnt = (unsigned*)(ws + WS_CTL) + CW_GCNT + 16 * (layer * 16);
        if (tid < 16) lbase[tid] = (int)atomicAdd(gcnt + 16 * tid, (unsigned)lcnt[tid]);
        __syncthreads();
        if (have) {
            int* lt = (int*)(ws + WS_LISTT); float* lw = (float*)(ws + WS_LISTW);
            const int p0 = lbase[e0] + r0, p1 = lbase[e1] + r1i;
            lt[e0 * LCAP + p0] = srow * 2; lw[e0 * LCAP + p0] = w0;
            lt[e1 * LCAP + p1] = srow * 2 + 1; lw[e1 * LCAP + p1] = w1;
        }
    }
    __syncthreads();
}

constexpr int BM = 256, BK = 64, HALF = 128, HTB = HALF * BK * 2, STAGE_BYTES = 8 * HTB;
__host__ __device__ __forceinline__ int lds_byte(int r, int c) { const int st = (r >> 4) * 2 + (c >> 5), rr = r & 15, cc = c & 31, ob = rr * 64 + cc * 2; return st * 1024 + (ob ^ (((ob >> 9) & 1) << 5)); }
__host__ __device__ __forceinline__ void stage_rc(int b, int& R, int& C) { const int st = b / 1024, sb = b % 1024, swz = sb ^ (((sb >> 9) & 1) << 5); R = (st >> 1) * 16 + swz / 64; C = (st & 1) * 32 + (swz % 64) / 2; }
__host__ __device__ __forceinline__ int perm32(int rho) { const int n = rho >> 4, i = rho & 15; return 8 * (i >> 2) + 4 * n + (i & 3); }

struct GU { const char* A; const char* B; int nt, kind, pm, pn, e, aux; };
typedef int i32x8 __attribute__((ext_vector_type(8)));
typedef int i32x4_ __attribute__((ext_vector_type(4)));

__device__ __forceinline__ bool tile_map(long L, int nM, int nN, int& pm, int& pn) {
    const int nwg = nM * nN; if (L >= nwg) return false;
    int wgid = (int)L; { const int q = nwg / 8, r = nwg % 8, xcd = wgid % 8, off = wgid / 8; wgid = (xcd < r ? xcd * (q + 1) : r * (q + 1) + (xcd - r) * q) + off; }
    const int nig = 8 * nN, gid = wgid / nig, fm = gid * 8, gsz = (nM - fm) < 8 ? (nM - fm) : 8;
    pm = fm + ((wgid % nig) % gsz); pn = (wgid % nig) / gsz; return true;
}

template <class Epi, class Sched>
__device__ __forceinline__ void gemm_run(LAS unsigned char* lds, const Sched& S, const Epi& E, const int tid) {
    const int wid = __builtin_amdgcn_readfirstlane(tid >> 6), lane = tid & 63, wr = wid >> 2, wc = wid & 3, fr = lane & 15, fq = lane >> 4;
    unsigned vA[2][2], vAn[2][2], voffB[2];
#pragma unroll
    for (int i = 0; i < 2; ++i) { int R, C; stage_rc(tid * 16 + i * 8192, R, C); const int Rb = Epi::HEADMAP ? ((R >> 5) * 64 + perm32(R & 31)) : (Epi::PERM ? ((R & ~31) + perm32(R & 31)) : R);
        voffB[i] = (unsigned)Rb * (unsigned)S.ldb2 + (unsigned)C * 2u;
        vA[0][i] = (unsigned)R * (unsigned)S.lda2 + (unsigned)C * 2u; vA[1][i] = (unsigned)(R + HALF) * (unsigned)S.lda2 + (unsigned)C * 2u;
        vAn[0][i] = vA[0][i]; vAn[1][i] = vA[1][i]; }
    const size_t akstep = (size_t)S.akstep, bkstep = (size_t)(BK * 2), hstepB = (size_t)(Epi::HEADMAP ? 32 : HALF) * S.ldb2;
    const unsigned ldsw = (unsigned)wid * 1024u;
    const int aoff = lds_byte(wr * 64 + fr, fq * 8), boff = lds_byte(wc * 32 + fr, fq * 8);
    unsigned voffB8[2] = {0u, 0u}; size_t hstepB8 = 0;
    int aoff8a = 0, aoff8b = 0, boff8a = 0, boff8b = 0;
    if (Sched::FP8) {
#pragma unroll
        for (int i = 0; i < 2; ++i) { int R, C; stage_rc(tid * 16 + i * 8192, R, C); const int Rb = Epi::PERM ? ((R & ~31) + perm32(R & 31)) : R; voffB8[i] = (unsigned)Rb * (unsigned)(S.ldb2 / 2) + (unsigned)C * 2u; }
        hstepB8 = (size_t)HALF * (S.ldb2 / 2);
        aoff8a = aoff; aoff8b = aoff + 1024; boff8a = boff; boff8b = boff + 1024;
    }
#define G_SA(b, h) (((b) * 2 + (h)) * HTB)
#define G_SB(b, h) ((4 + (b) * 2 + (h)) * HTB)
#define G_STAGE2(bufoff, gbase, o0, o1) do { \
        __builtin_amdgcn_global_load_lds((const unsigned*)((const char*)(gbase) + (o0)), (LAS unsigned*)(lds + (bufoff) + ldsw), 16, 0, 0); \
        __builtin_amdgcn_global_load_lds((const unsigned*)((const char*)(gbase) + (o1)), (LAS unsigned*)(lds + (bufoff) + ldsw + 8192), 16, 0, 0); } while (0)
#define G_STAGE_B(bufoff, gbase) G_STAGE2(bufoff, gbase, voffB[0], voffB[1])
#define G_LDA(dst, b, h) do { _Pragma("unroll") for (int m = 0; m < 4; ++m) _Pragma("unroll") for (int k = 0; k < 2; ++k) dst[m][k] = *(const LAS bf16x8*)(lds + G_SA(b, h) + aoff + m * 2048 + k * 1024); } while (0)
#define G_LDB(dst, b, h) do { _Pragma("unroll") for (int n = 0; n < 2; ++n) _Pragma("unroll") for (int k = 0; k < 2; ++k) dst[n][k] = *(const LAS bf16x8*)(lds + G_SB(b, h) + boff + n * 2048 + k * 1024); } while (0)
#define G_MMA(ai, bj, At, Bt) do { __builtin_amdgcn_s_setprio(1); _Pragma("unroll") for (int m = 0; m < 4; ++m) _Pragma("unroll") for (int n = 0; n < 2; ++n) _Pragma("unroll") for (int k = 0; k < 2; ++k) \
        acc[ai][bj][m][n] = __builtin_amdgcn_mfma_f32_16x16x32_bf16(Bt[n][k], At[m][k], acc[ai][bj][m][n], 0, 0, 0); __builtin_amdgcn_s_setprio(0); } while (0)
#define G_RD8(dst, base, oa, ob) do { const u32x4 lo_ = *(const LAS u32x4*)(lds + (base) + (oa)), hi_ = *(const LAS u32x4*)(lds + (base) + (ob)); \
        dst[0] = (int)lo_[0]; dst[1] = (int)lo_[1]; dst[2] = (int)lo_[2]; dst[3] = (int)lo_[3]; dst[4] = (int)hi_[0]; dst[5] = (int)hi_[1]; dst[6] = (int)hi_[2]; dst[7] = (int)hi_[3]; } while (0)
#define G_LDA8(dst, b, h) do { _Pragma("unroll") for (int m = 0; m < 4; ++m) G_RD8(dst[m], G_SA(b, h) + m * 2048, aoff8a, aoff8b); } while (0)
#define G_LDB8(dst, b, h) do { _Pragma("unroll") for (int n = 0; n < 2; ++n) G_RD8(dst[n], G_SB(b, h) + n * 2048, boff8a, boff8b); } while (0)
#define G_MMA8(ai, bj, At, Bt) do { __builtin_amdgcn_s_setprio(1); _Pragma("unroll") for (int m = 0; m < 4; ++m) _Pragma("unroll") for (int n = 0; n < 2; ++n) \
        asm volatile("v_mfma_scale_f32_16x16x128_f8f6f4 %0, %1, %2, %0, %3, %3 op_sel_hi:[0,0,0]" : "+v"(acc[ai][bj][m][n]) : "v"(Bt[n]), "v"(At[m]), "v"(sc1_)); __builtin_amdgcn_s_setprio(0); } while (0)
#define G_WAIT_V(n) asm volatile("s_waitcnt vmcnt(" #n ")" ::: "memory")
#define G_WAIT_L(n) asm volatile("s_waitcnt lgkmcnt(" #n ")" ::: "memory")
#define G_BAR __builtin_amdgcn_s_barrier()
#define G_SCHED __builtin_amdgcn_sched_barrier(0)
    GU cur, nxt; int ui = 0;
    if (!S.next(0, cur)) return;
    if (Sched::GATHER) S.rowoff(cur, tid, vA);
    f32x4 acc[2][2][4][2];
#pragma unroll
    for (int a = 0; a < 2; ++a)
#pragma unroll
        for (int b = 0; b < 2; ++b)
#pragma unroll
            for (int m = 0; m < 4; ++m)
#pragma unroll
                for (int n = 0; n < 2; ++n) acc[a][b][m][n] = (f32x4){0.f, 0.f, 0.f, 0.f};
    bf16x8 At[4][2], B0[2][2], B1[2][2];
    i32x8 At8[4], B08[2], B18[2]; int sc1_ = 0x7f7f7f7f; asm volatile("" : "+v"(sc1_));
    const char* cA = cur.A; const char* cB = cur.B;
    { constexpr bool f8 = Sched::FP8; const unsigned p0 = f8 ? voffB8[0] : voffB[0], p1 = f8 ? voffB8[1] : voffB[1]; const size_t hs = f8 ? hstepB8 : hstepB;
      G_STAGE2(G_SB(0, 0), cB, p0, p1); G_STAGE2(G_SA(0, 0), cA, vA[0][0], vA[0][1]); G_STAGE2(G_SB(0, 1), cB + hs, p0, p1); G_STAGE2(G_SA(0, 1), cA, vA[1][0], vA[1][1]);
      if (wr == 1) G_BAR;
      G_WAIT_V(4); G_BAR;
      G_STAGE2(G_SB(1, 0), cB + bkstep, p0, p1); G_STAGE2(G_SA(1, 0), cA + akstep, vA[0][0], vA[0][1]); G_STAGE2(G_SB(1, 1), cB + hs + bkstep, p0, p1);
      G_WAIT_V(6); G_BAR; }
    for (;;) {
        const bool has_next = S.next(ui + 1, nxt);
        const char* nA = has_next ? nxt.A : cA; const char* nB = has_next ? nxt.B : cB;
        if (Sched::GATHER) { if (has_next) S.rowoff(nxt, tid, vAn); else {
#pragma unroll
            for (int h = 0; h < 2; ++h) { vAn[h][0] = vA[h][0]; vAn[h][1] = vA[h][1]; } } }
        const int nt = cur.nt;
        constexpr bool c8 = Sched::FP8, n8 = Sched::FP8;
        const unsigned obc0 = c8 ? voffB8[0] : voffB[0], obc1 = c8 ? voffB8[1] : voffB[1], obn0 = n8 ? voffB8[0] : voffB[0], obn1 = n8 ? voffB8[1] : voffB[1];
        const size_t hsc = c8 ? hstepB8 : hstepB, hsn = n8 ? hstepB8 : hstepB;
        for (int t = 0; t < nt; t += 2) {
            const bool last = (t == nt - 2);
            const char* a1 = cA + (size_t)(t + 1) * akstep;
            const char* a2 = last ? nA : cA + (size_t)(t + 2) * akstep; const char* b2 = last ? nB : cB + (size_t)(t + 2) * bkstep;
            const char* a3 = a2 + akstep; const char* b3 = b2 + bkstep;
            const unsigned ob0 = last ? obn0 : obc0, ob1 = last ? obn1 : obc1; const size_t hsx = last ? hsn : hsc;
            unsigned w00, w01, w10, w11;
            if (Sched::GATHER) { w00 = last ? vAn[0][0] : vA[0][0]; w01 = last ? vAn[0][1] : vA[0][1]; w10 = last ? vAn[1][0] : vA[1][0]; w11 = last ? vAn[1][1] : vA[1][1]; }
            else { w00 = vA[0][0]; w01 = vA[0][1]; w10 = vA[1][0]; w11 = vA[1][1]; }
            if constexpr (c8) {
            G_LDB8(B08, 0, 0); G_SCHED; G_LDA8(At8, 0, 0); G_STAGE2(G_SA(1, 1), a1, vA[1][0], vA[1][1]);
            G_WAIT_L(8); G_BAR; G_WAIT_L(0); G_MMA8(0, 0, At8, B08); G_BAR; G_SCHED;
            G_LDB8(B18, 0, 1); G_STAGE2(G_SB(0, 0), b2, ob0, ob1);
            G_BAR; G_WAIT_L(0); G_MMA8(0, 1, At8, B18); G_BAR;
            G_LDA8(At8, 0, 1); G_STAGE2(G_SA(0, 0), a2, w00, w01);
            G_BAR; G_WAIT_L(0); G_MMA8(1, 0, At8, B08); G_BAR; G_SCHED;
            G_STAGE2(G_SB(0, 1), b2 + hsx, ob0, ob1);
            G_WAIT_V(6); G_BAR; G_MMA8(1, 1, At8, B18); G_BAR;
            G_LDB8(B08, 1, 0); G_SCHED; G_LDA8(At8, 1, 0); G_STAGE2(G_SA(0, 1), a2, w10, w11);
            G_WAIT_L(8); G_BAR; G_WAIT_L(0); G_MMA8(0, 0, At8, B08); G_BAR; G_SCHED;
            G_LDB8(B18, 1, 1); G_STAGE2(G_SB(1, 0), b3, ob0, ob1);
            G_BAR; G_WAIT_L(0); G_MMA8(0, 1, At8, B18); G_BAR;
            G_LDA8(At8, 1, 1); G_STAGE2(G_SA(1, 0), a3, w00, w01);
            G_BAR; G_WAIT_L(0); G_MMA8(1, 0, At8, B08); G_BAR; G_SCHED;
            G_STAGE2(G_SB(1, 1), b3 + hsx, ob0, ob1);
            G_WAIT_V(6); G_BAR; G_MMA8(1, 1, At8, B18); G_BAR;
            } else {
            G_LDB(B0, 0, 0); G_SCHED; G_LDA(At, 0, 0); G_STAGE2(G_SA(1, 1), a1, vA[1][0], vA[1][1]);
            G_WAIT_L(8); G_BAR; G_WAIT_L(0); G_MMA(0, 0, At, B0); G_BAR; G_SCHED;
            G_LDB(B1, 0, 1); G_STAGE2(G_SB(0, 0), b2, ob0, ob1);
            G_BAR; G_WAIT_L(0); G_MMA(0, 1, At, B1); G_BAR;
            G_LDA(At, 0, 1); G_STAGE2(G_SA(0, 0), a2, w00, w01);
            G_BAR; G_WAIT_L(0); G_MMA(1, 0, At, B0); G_BAR; G_SCHED;
            G_STAGE2(G_SB(0, 1), b2 + hsx, ob0, ob1);
            G_WAIT_V(6); G_BAR; G_MMA(1, 1, At, B1); G_BAR;
            G_LDB(B0, 1, 0); G_SCHED; G_LDA(At, 1, 0); G_STAGE2(G_SA(0, 1), a2, w10, w11);
            G_WAIT_L(8); G_BAR; G_WAIT_L(0); G_MMA(0, 0, At, B0); G_BAR; G_SCHED;
            G_LDB(B1, 1, 1); G_STAGE2(G_SB(1, 0), b3, ob0, ob1);
            G_BAR; G_WAIT_L(0); G_MMA(0, 1, At, B1); G_BAR;
            G_LDA(At, 1, 1); G_STAGE2(G_SA(1, 0), a3, w00, w01);
            G_BAR; G_WAIT_L(0); G_MMA(1, 0, At, B0); G_BAR; G_SCHED;
            G_STAGE2(G_SB(1, 1), b3 + hsx, ob0, ob1);
            G_WAIT_V(6); G_BAR; G_MMA(1, 1, At, B1); G_BAR;
            }
        }
        { int fr2 = fr, fq2 = fq; asm volatile("" : "+v"(fr2), "+v"(fq2));
          E(acc, cur, wr, wc, fr2, fq2); }
        if (!has_next) break;
        if (!(Sched::CHAIN && cur.aux != 0)) {
#pragma unroll
            for (int a = 0; a < 2; ++a)
#pragma unroll
                for (int b = 0; b < 2; ++b)
#pragma unroll
                    for (int m = 0; m < 4; ++m)
#pragma unroll
                        for (int n = 0; n < 2; ++n) acc[a][b][m][n] = (f32x4){0.f, 0.f, 0.f, 0.f};
        }
        cur = nxt; cA = nA; cB = nB; ++ui;
        if (Sched::GATHER) {
#pragma unroll
            for (int h = 0; h < 2; ++h) { vA[h][0] = vAn[h][0]; vA[h][1] = vAn[h][1]; } }
    }
    G_WAIT_V(0);
    if (wr == 0) G_BAR;
    G_BAR;
#undef G_SA
#undef G_SB
#undef G_STAGE2
#undef G_STAGE_B
#undef G_LDA
#undef G_LDB
#undef G_MMA
#undef G_MMA8
#undef G_LDA8
#undef G_LDB8
#undef G_RD8
#undef G_WAIT_V
#undef G_WAIT_L
#undef G_BAR
#undef G_SCHED
}

struct SchedDense {
    static constexpr bool GATHER = false, FP8 = false, CHAIN = false;
    int lda2, akstep, ldb2; const char* A; const char* B; int nM, nN, nt, G, c;
    __device__ __forceinline__ bool next(int i, GU& u) const {
        int pm, pn; if (!tile_map((long)i * G + c, nM, nN, pm, pn)) return false;
        u.A = A + (size_t)pm * 256 * lda2; u.B = B + (size_t)pn * 256 * ldb2; u.nt = nt; u.kind = 0; u.pm = pm; u.pn = pn; u.e = 0; u.aux = 0; return true;
    }
    __device__ __forceinline__ void rowoff(const GU&, int, unsigned (&)[2][2]) const {}
};
struct SchedE1G {
    static constexpr bool GATHER = false, FP8 = true, CHAIN = false;
    int lda2, akstep, ldb2; const char* H8; const char* WM8; int G, c, T;
    __device__ __forceinline__ bool next(int i, GU& u) const {
        if (i >= 3) return false;
        int pm, pn; if (!tile_map((long)T * G + c, 128, 4, pm, pn)) return false;
        u.A = H8 + (size_t)pm * 256 * 1024; u.B = WM8 + (size_t)(i * 1024 + pn * 256) * 1024; u.nt = 8;
        u.kind = 0; u.pm = pm; u.pn = pn; u.e = i; u.aux = 0; return true;
    }
    __device__ __forceinline__ void rowoff(const GU&, int, unsigned (&)[2][2]) const {}
};
struct SchedE1T {
    static constexpr bool GATHER = false, FP8 = false, CHAIN = true;
    int lda2, akstep, ldb2; const char* O; const char* WB; int G, c, T;
    __device__ __forceinline__ bool next(int i, GU& u) const {
        if (i >= 3) return false;
        int pm, pn; if (!tile_map((long)T * G + c, 128, 4, pm, pn)) return false;
        const int koff = (i == 0) ? 0 : (i == 1) ? 512 : 768;
        u.A = O + (size_t)pm * 256 * 2048 + koff * 2; u.B = WB + (size_t)pn * 256 * 2048 + koff * 2; u.nt = (i == 0) ? 8 : 4;
        u.kind = 1; u.pm = pm; u.pn = pn; u.e = i; u.aux = (i < 2) ? 1 : 0; return true;
    }
    __device__ __forceinline__ void rowoff(const GU&, int, unsigned (&)[2][2]) const {}
};
struct SchedMoE {
    static constexpr bool GATHER = true, FP8 = false, CHAIN = false;
    int lda2, akstep, ldb2; const char* A; const char* B; size_t bstride; int ncol, nt, G, c, phase  ;
    const LAS int* tpre;
    const int* listT;
    __device__ __forceinline__ bool next(int i, GU& u) const {
        const int cx = (G % 8 == 0) ? (c % 8) * (G / 8) + c / 8 : c;
        const long L = (long)i * G + cx; const int ntile = tpre[16];
        if (L >= (long)ntile * ncol) return false;
        const int rt = (int)(L / ncol), pn = (int)(L % ncol);
        int e = 0;
#pragma unroll
        for (int k = 1; k < 16; ++k) e += (rt >= tpre[k]) ? 1 : 0;
        const int lt = rt - tpre[e];
        u.e = e; u.pm = lt; u.pn = pn; u.nt = nt; u.kind = 0; u.aux = tpre[34 + e] + lt * 256;
        u.B = B + (size_t)e * bstride + (size_t)pn * 256 * ldb2;
        u.A = (phase == 1) ? A : A + (size_t)u.aux * lda2;
        return true;
    }
    __device__ __forceinline__ void rowoff(const GU& u, int tid, unsigned (&vo)[2][2]) const {
        const int cnt = tpre[17 + u.e];
#pragma unroll
        for (int i = 0; i < 2; ++i) { int R, C; stage_rc(tid * 16 + i * 8192, R, C);
#pragma unroll
            for (int h = 0; h < 2; ++h) {
                const int r = u.pm * 256 + h * 128 + R;
                if (phase == 1) { const int tok = (r < cnt) ? (*(const GAS int*)(listT + u.e * LCAP + r) >> 1) : 0; vo[h][i] = (unsigned)tok * 2048u + (unsigned)C * 2u; }
                else vo[h][i] = (unsigned)(h * 128 + R) * (unsigned)lda2 + (unsigned)C * 2u;
            } }
    }
};

__device__ __forceinline__ u32x4 pack8(const f32x4 a, const f32x4 b) { u32x4 o; o[0] = cvt_pk_bf16(a[0], a[1]); o[1] = cvt_pk_bf16(a[2], a[3]); o[2] = cvt_pk_bf16(b[0], b[1]); o[3] = cvt_pk_bf16(b[2], b[3]); return o; }
__device__ __forceinline__ void unpack8(const u32x4 u, f32x4& a, f32x4& b) { a[0] = bf_lo(u[0]); a[1] = bf_hi(u[0]); a[2] = bf_lo(u[1]); a[3] = bf_hi(u[1]); b[0] = bf_lo(u[2]); b[1] = bf_hi(u[2]); b[2] = bf_lo(u[3]); b[3] = bf_hi(u[3]); }

struct EpiBf16 {
    static constexpr bool PERM = true, HEADMAP = false;
    bf16_t* O; int ldc;
    __device__ __forceinline__ void operator()(const f32x4 (&acc)[2][2][4][2], const GU& u, int wr, int wc, int fr, int fq) const {
#pragma unroll
        for (int ai = 0; ai < 2; ++ai)
#pragma unroll
            for (int m = 0; m < 4; ++m) { bf16_t* rowp = O + (size_t)(u.pm * 256 + ai * 128 + wr * 64 + m * 16 + fr) * ldc + u.pn * 256 + wc * 32 + 8 * fq;
#pragma unroll
                for (int bj = 0; bj < 2; ++bj) stg4u(rowp + bj * 128, pack8(acc[ai][bj][m][0], acc[ai][bj][m][1])); }
    }
};
struct EpiZ {
    static constexpr bool PERM = true, HEADMAP = true;
    bf16_t* Z; bf16_t* VT; const float* nqg; const float* nkg; const float* sqg; const float* skg;
    __device__ __forceinline__ void operator()(const f32x4 (&acc)[2][2][4][2], const GU& u, int wr, int wc, int fr, int fq) const {
        const int hidx = u.pn * 4 + wc, lane = fq * 16 + fr;
        int typ; const float* gain = nqg; float cst = 1.f; int vm = 0;
        if (hidx < 8) { typ = 1; gain = nqg; cst = 0.125f * LOG2E; }
        else if (hidx < 10) typ = 0;
        else if (hidx == 10) { typ = 1; gain = nkg + 64; }
        else if (hidx == 11) { typ = 3; vm = 0; }
        else if (hidx == 12) { typ = 1; gain = nkg + 128; }
        else if (hidx == 13) { typ = 3; vm = 1; }
        else if (hidx < 18) { typ = 2; cst = 0.125f; }
        else if (hidx < 22) typ = 0;
        else if (hidx < 26) { typ = 3; vm = 2 + (hidx - 22); }
        else if (hidx < 30) { typ = 1; gain = sqg; cst = 0.125f * LOG2E; }
        else if (hidx < 32) { typ = 1; gain = skg; }
        else if (hidx < 34) { typ = 3; vm = 6 + (hidx - 32); }
        else if (hidx == 34) typ = 4;
        else typ = 0;
        f32x4 g0 = (f32x4){1.f, 1.f, 1.f, 1.f}, g1 = g0, g2 = g0, g3 = g0;
        if (typ == 1) { g0 = ldg4f(gain + 8 * fq) * cst; g1 = ldg4f(gain + 8 * fq + 4) * cst; g2 = ldg4f(gain + 32 + 8 * fq) * cst; g3 = ldg4f(gain + 36 + 8 * fq) * cst; }
        const int b = u.pm >> 6;
#pragma unroll
        for (int ai = 0; ai < 2; ++ai)
#pragma unroll
            for (int m = 0; m < 4; ++m) {
                const int row = u.pm * 256 + ai * 128 + wr * 64 + m * 16 + fr;
                f32x4 v0 = acc[ai][0][m][0], v1 = acc[ai][0][m][1], v2 = acc[ai][1][m][0], v3 = acc[ai][1][m][1];
                if (typ == 3) {
                    bf16_t* vt = VT + (((size_t)b * 8 + vm) * 64 + 8 * fq) * SEQ + (row & (SEQ - 1));
#pragma unroll
                    for (int j = 0; j < 4; ++j) {
                        vt[(size_t)j * SEQ] = f2bf(v0[j]); vt[(size_t)(4 + j) * SEQ] = f2bf(v1[j]);
                        vt[(size_t)(32 + j) * SEQ] = f2bf(v2[j]); vt[(size_t)(36 + j) * SEQ] = f2bf(v3[j]);
                    }
                } else {
                    if (typ == 1) {
                        float ss = 0.f;
#pragma unroll
                        for (int j = 0; j < 4; ++j) ss += v0[j] * v0[j] + v1[j] * v1[j] + v2[j] * v2[j] + v3[j] * v3[j];
                        ss += shx<16>(ss, lane); ss += shx<32>(ss, lane);
                        const float rn = rsqrtf(ss * (1.f / 64.f) + 1e-6f);
                        v0 = v0 * g0 * rn; v1 = v1 * g1 * rn; v2 = v2 * g2 * rn; v3 = v3 * g3 * rn;
                    } else if (typ == 2) { v0 *= cst; v1 *= cst; v2 *= cst; v3 *= cst; }
                    else if (typ == 4) {
#pragma unroll
                        for (int j = 0; j < 4; ++j) { v0[j] = sigmoidf_(v0[j]); v1[j] = sigmoidf_(v1[j]); v2[j] = sigmoidf_(v2[j]); v3[j] = sigmoidf_(v3[j]); }
                    }
                    bf16_t* rowp = Z + (size_t)row * ZLD + hidx * 64 + 8 * fq;
                    stg4u(rowp, pack8(v0, v1)); stg4u(rowp + 32, pack8(v2, v3));
                }
            }
    }
};
struct EpiC1 {
    static constexpr bool PERM = true, HEADMAP = false;
    bf16_t* O; const float* cb;
    __device__ __forceinline__ void operator()(const f32x4 (&acc)[2][2][4][2], const GU& u, int wr, int wc, int fr, int fq) const {
        const int mat = u.e;
#pragma unroll
        for (int bj = 0; bj < 2; ++bj) {
            const int col = bj * 128 + wc * 32 + 8 * fq;
            const f32x4 b0 = ldg4f(cb + mat * 256 + col), b1 = ldg4f(cb + mat * 256 + col + 4);
#pragma unroll
            for (int ai = 0; ai < 2; ++ai)
#pragma unroll
                for (int m = 0; m < 4; ++m) {
                    f32x4 v0 = acc[ai][bj][m][0] + b0, v1 = acc[ai][bj][m][1] + b1;
#pragma unroll
                    for (int j = 0; j < 4; ++j) {
                        { const float x = v0[j], t = 0.7978845608f * (x + 0.044715f * x * x * x); v0[j] = x * frcp(1.f + fexp2(-2.f * LOG2E * t)); }
                        { const float x = v1[j], t = 0.7978845608f * (x + 0.044715f * x * x * x); v1[j] = x * frcp(1.f + fexp2(-2.f * LOG2E * t)); }
                    }
                    stg4u(O + ((size_t)mat * 2048 + u.pm * 256 + ai * 128 + wr * 64 + m * 16 + fr) * 256 + col, pack8(v0, v1));
                }
        }
    }
};
struct EpiE1G {
    static constexpr bool PERM = true, HEADMAP = false;
    unsigned char* Sg;
    __device__ __forceinline__ void operator()(const f32x4 (&acc)[2][2][4][2], const GU& u, int wr, int wc, int fr, int fq) const {
        const int t8 = (((wr * 4 + wc) * 64) + fq * 16 + fr) * 8;
        unsigned char* sg = Sg + u.e * 65536 + t8;
#pragma unroll
        for (int ai = 0; ai < 2; ++ai)
#pragma unroll
            for (int m = 0; m < 4; ++m)
#pragma unroll
                for (int bj = 0; bj < 2; ++bj) {
                    u32x2 w;
#pragma unroll
                    for (int n = 0; n < 2; ++n) { unsigned p = 0u;
#pragma unroll
                        for (int j = 0; j < 4; ++j) { const float g = fmaxf(255.f * sigmoidf_(acc[ai][bj][m][n][j] * (1.f / 64.f)) + 0.5f, 1.f); p |= ((unsigned)g) << (8 * j); }
                        w[n] = p; }
                    stg2u(sg + (ai * 8 + m * 2 + bj) * 4096, w);
                }
    }
};
struct EpiE1T {
    static constexpr bool PERM = true, HEADMAP = false;
    unsigned char* Sg; bf16_t* Y;
    __device__ __forceinline__ void operator()(f32x4 (&acc)[2][2][4][2], const GU& u, int wr, int wc, int fr, int fq) const {
        const int t8 = (((wr * 4 + wc) * 64) + fq * 16 + fr) * 8;
        __builtin_amdgcn_s_waitcnt(0x0070);
        asm volatile("" ::: "memory");
        if (u.e < 2) {
            const unsigned char* ga = Sg + u.e * 65536;
            const unsigned char* gb = ga + 65536;
#pragma unroll
            for (int idx = 0; idx < 16; ++idx) {
                const int ai = idx >> 3, m = (idx >> 1) & 3, bj = idx & 1;
                const u32x2 qa = ldg2u(ga + (unsigned)(t8 + idx * 4096)), qb = ldg2u(gb + (unsigned)(t8 + idx * 4096));
#pragma unroll
                for (int n = 0; n < 2; ++n) {
                    f32x4 r;
#pragma unroll
                    for (int j = 0; j < 4; ++j) r[j] = (float)((qa[n] >> (8 * j)) & 255u) * frcp((float)((qb[n] >> (8 * j)) & 255u));
                    acc[ai][bj][m][n] = acc[ai][bj][m][n] * r;
                }
                __builtin_amdgcn_sched_barrier(0);
            }
        } else {
            const unsigned char* ga = Sg + 2 * 65536;
            bf16_t* yp = Y + (size_t)(u.pm * 256 + wr * 64 + fr) * 1024 + u.pn * 256 + wc * 32 + 8 * fq;
#pragma unroll
            for (int idx = 0; idx < 16; ++idx) {
                const int ai = idx >> 3, m = (idx >> 1) & 3, bj = idx & 1;
                const u32x2 qa = ldg2u(ga + (unsigned)(t8 + idx * 4096));
                f32x4 v0, v1;
#pragma unroll
                for (int j = 0; j < 4; ++j) {
                    v0[j] = (float)((qa[0] >> (8 * j)) & 255u) * (acc[ai][bj][m][0][j] * (1.f / 255.f));
                    v1[j] = (float)((qa[1] >> (8 * j)) & 255u) * (acc[ai][bj][m][1][j] * (1.f / 255.f)); }
                stg4u(yp + (size_t)(ai * 128 + m * 16) * 1024 + bj * 128, pack8(v0, v1));
            }
        }
    }
};
struct EpiE2 {
    static constexpr bool PERM = true, HEADMAP = false;
    bf16_t* xb; const float* ga; float* ssp;
    __device__ __forceinline__ void operator()(const f32x4 (&acc)[2][2][4][2], const GU& u, int wr, int wc, int fr, int fq) const {
        const int b = u.pm >> 6, lane = fq * 16 + fr;
        __builtin_amdgcn_s_waitcnt(0x0070);
        asm volatile("" ::: "memory");
        float ssr[2][4];
#pragma unroll
        for (int ai = 0; ai < 2; ++ai)
#pragma unroll
            for (int m = 0; m < 4; ++m) ssr[ai][m] = 0.f;
        bf16_t* xp = xb + (size_t)(u.pm * 256 + wr * 64 + fr) * 1024 + u.pn * 256 + wc * 32 + 8 * fq;
        u32x4 xv[2][4];
#define E2_LOADB(BUF, BT) do { _Pragma("unroll") for (int m = 0; m < 4; ++m) xv[BUF][m] = ldg4u(xp + (size_t)(((BT) & 1) * 128 + m * 16) * 1024 + ((BT) >> 1) * 128); } while (0)
        E2_LOADB(0, 0);
#pragma unroll
        for (int bt = 0; bt < 4; ++bt) {
            const int bj = bt >> 1, ai = bt & 1;
            const int col = u.pn * 256 + bj * 128 + wc * 32 + 8 * fq;
            const f32x4 g0 = ldg4f(ga + b * 6144 + col), g1 = ldg4f(ga + b * 6144 + col + 4);
            if (bt + 1 < 4) E2_LOADB((bt + 1) & 1, bt + 1);
            asm volatile("" ::: "memory");
#pragma unroll
            for (int m = 0; m < 4; ++m) { f32x4 x0, x1; unpack8(xv[bt & 1][m], x0, x1);
                x0 += g0 * acc[ai][bj][m][0]; x1 += g1 * acc[ai][bj][m][1];
                ssr[ai][m] += (x0[0] * x0[0] + x0[1] * x0[1] + x0[2] * x0[2] + x0[3] * x0[3]) + (x1[0] * x1[0] + x1[1] * x1[1] + x1[2] * x1[2] + x1[3] * x1[3]);
                stg4u(xp + (size_t)(ai * 128 + m * 16) * 1024 + bj * 128, pack8(x0, x1)); }
            asm volatile("" ::: "memory");
        }
#undef E2_LOADB
#pragma unroll
        for (int ai = 0; ai < 2; ++ai)
#pragma unroll
            for (int m = 0; m < 4; ++m) { float v = ssr[ai][m]; v += shx<16>(v, lane); v += shx<32>(v, lane);
                if (fq == 0) ssp[(size_t)(u.pm * 256 + ai * 128 + wr * 64 + m * 16 + fr) * 16 + u.pn * 4 + wc] = v; }
    }
};
struct EpiG1 {
    static constexpr bool PERM = true, HEADMAP = false;
    bf16_t* Ab;
    __device__ __forceinline__ void operator()(const f32x4 (&acc)[2][2][4][2], const GU& u, int wr, int wc, int fr, int fq) const {
#pragma unroll
        for (int ai = 0; ai < 2; ++ai)
#pragma unroll
            for (int m = 0; m < 4; ++m) {
                f32x4 v0, v1;
#pragma unroll
                for (int j = 0; j < 4; ++j) { const float g0 = acc[ai][0][m][0][j], g1 = acc[ai][0][m][1][j];
                    v0[j] = g0 * sigmoidf_(g0) * acc[ai][1][m][0][j]; v1[j] = g1 * sigmoidf_(g1) * acc[ai][1][m][1][j]; }
                stg4u(Ab + (size_t)(u.aux + ai * 128 + wr * 64 + m * 16 + fr) * 512 + u.pn * 128 + wc * 32 + 8 * fq, pack8(v0, v1));
            }
    }
};
struct EpiG2 {
    static constexpr bool PERM = true, HEADMAP = false;
    bf16_t* Ys;
    __device__ __forceinline__ void operator()(const f32x4 (&acc)[2][2][4][2], const GU& u, int wr, int wc, int fr, int fq) const {
#pragma unroll
        for (int ai = 0; ai < 2; ++ai)
#pragma unroll
            for (int m = 0; m < 4; ++m) {
                bf16_t* rowp = Ys + (size_t)(u.aux + ai * 128 + wr * 64 + m * 16 + fr) * 1024 + u.pn * 256 + wc * 32 + 8 * fq;
#pragma unroll
                for (int bj = 0; bj < 2; ++bj) stg4u(rowp + bj * 128, pack8(acc[ai][bj][m][0], acc[ai][bj][m][1]));
            }
    }
};

__device__ __forceinline__ void norm2_mfma(const Ctx& X, LAS unsigned char* lds, int layer) {
    unsigned char* ws = X.ws;
    const int tid = X.tid, lane = tid & 63, wave = tid >> 6, G = X.G, r = lane & 15, kq = lane >> 4;
    const bf16_t* xsrc = (const bf16_t*)(ws + WS_XB);
    const float* modl = (const float*)(ws + WS_MOD) + (size_t)layer * 2 * 6144;
    const float* ssp = (const float*)(ws + WS_SSP);
    bf16_t* h = (bf16_t*)(ws + WS_H);
    const float* gn = INP(I_GMOE) + (size_t)layer * 1024;
    LAS float* Wl = (LAS float*)lds;
    LAS float* gsL = (LAS float*)(lds + 81920);
    LAS float* shL = (LAS float*)(lds + 90112);
    LAS float* cW = (LAS float*)(lds + LDS_MISC + 768);
    LAS float* lgl = (LAS float*)(lds + 98304);
    LAS int* lcnt = (LAS int*)(lds + LDS_MISC + 64);
    LAS int* lbase = (LAS int*)(lds + LDS_MISC + 128);
    const bool fastp = (G * 8 >= NTOK / 16);
    if (fastp) {
        const int b = (X.bid * 8 * 16) >> 14;
        LAS bf16x8* Whi = (LAS bf16x8*)lds;
        LAS bf16x8* Wlo = (LAS bf16x8*)(lds + 32768);
        const GAS float* wrg = (const GAS float*)INP(I_WR); const GAS float* gng = (const GAS float*)gn; const GAS float* mdg = (const GAS float*)modl;
        { const float g0_ = gng[tid], g1_ = gng[tid + 512], c0_ = mdg[b * 6144 + 4096 + tid], c1_ = mdg[b * 6144 + 4096 + tid + 512], h0_ = mdg[b * 6144 + 3072 + tid], h1_ = mdg[b * 6144 + 3072 + tid + 512];
          gsL[b * 1024 + tid] = g0_ * (1.f + c0_); gsL[b * 1024 + tid + 512] = g1_ * (1.f + c1_); shL[b * 1024 + tid] = h0_; shL[b * 1024 + tid + 512] = h1_; }
        if (tid < 16) lcnt[tid] = 0;
        __syncthreads();
        for (int f = tid; f < 2048; f += 512) {
            const int e = f & 15, k0 = (f >> 4) * 8;
            bf16x8 hi, lo; float wv[8];
#pragma unroll
            for (int j = 0; j < 8; ++j) wv[j] = wrg[(k0 + j) * 16 + e];
#pragma unroll
            for (int j = 0; j < 8; ++j) { const float w = gsL[b * 1024 + k0 + j] * wv[j]; const bf16_t hb = f2bf(w); hi[j] = (short)hb; lo[j] = (short)f2bf(w - bf2f(hb)); }
            Whi[f] = hi; Wlo[f] = lo;
        }
        if (tid < 256) {
            const int e = tid >> 4, part = tid & 15;
            float a = 0.f;
            for (int k0 = part * 64; k0 < part * 64 + 64; k0 += 16) { float wv[16];
#pragma unroll
                for (int j = 0; j < 16; ++j) wv[j] = wrg[(k0 + j) * 16 + e];
#pragma unroll
                for (int j = 0; j < 16; ++j) a += shL[b * 1024 + k0 + j] * wv[j]; }
            a += shx<1>(a, lane); a += shx<2>(a, lane); a += shx<4>(a, lane); a += shx<8>(a, lane);
            if (part == 0) cW[b * 16 + e] = a;
        }
        __syncthreads();
        const int batch = X.bid * 8 + wave;
        if (batch < NTOK / 16) {
            const int row = batch * 16 + r;
            float rinv;
            { const f32x4 p4 = ldg4f(ssp + (size_t)row * 16 + 4 * kq); float ssq = (p4[0] + p4[1]) + (p4[2] + p4[3]); ssq += shx<16>(ssq, lane); ssq += shx<32>(ssq, lane);
              rinv = rsqrtf(ssq * (1.f / 1024.f) + 1e-6f); }
            f32x4 acc = (f32x4){0.f, 0.f, 0.f, 0.f};
            const bf16_t* xr = xsrc + (size_t)row * 1024 + kq * 8;
            bf16_t* hr = h + (size_t)row * 1024 + kq * 8;
            for (int kg = 0; kg < 4; ++kg) {
                u32x4 xp[8];
#pragma unroll
                for (int u = 0; u < 8; ++u) { const int kk = (kg * 4 + (u >> 1)) * 64 + (u & 1) * 32; xp[u] = ldg4u(xr + kk); }
                asm volatile("" ::: "memory");
#pragma unroll
                for (int u = 0; u < 8; ++u) {
                    const int kc = kg * 4 + (u >> 1), jh = u & 1, kk = kc * 64 + jh * 32, ch = kc * 2 + jh;
                    const f32x4 g0 = *(const LAS f32x4*)(gsL + b * 1024 + kk + kq * 8), g1 = *(const LAS f32x4*)(gsL + b * 1024 + kk + kq * 8 + 4);
                    const f32x4 s0 = *(const LAS f32x4*)(shL + b * 1024 + kk + kq * 8), s1 = *(const LAS f32x4*)(shL + b * 1024 + kk + kq * 8 + 4);
                    const bf16x8 wh = Whi[(ch * 4 + kq) * 16 + r], wl = Wlo[(ch * 4 + kq) * 16 + r];
                    const bf16x8 xf = __builtin_bit_cast(bf16x8, xp[u]);
                    f32x4 xa, xc; unpack8(xp[u], xa, xc);
                    stg4u(hr + kk, pack8(xa * g0 * rinv + s0, xc * g1 * rinv + s1));
                    acc = __builtin_amdgcn_mfma_f32_16x16x32_bf16(wh, xf, acc, 0, 0, 0);
                    acc = __builtin_amdgcn_mfma_f32_16x16x32_bf16(wl, xf, acc, 0, 0, 0);
                }
                asm volatile("" ::: "memory");
            }
            f32x4 lg;
#pragma unroll
            for (int i = 0; i < 4; ++i) lg[i] = rinv * acc[i] + cW[b * 16 + 4 * kq + i];
            *(LAS f32x4*)(lgl + (wave * 16 + r) * 16 + 4 * kq) = lg;
        }
    } else {
    for (int i = tid; i < 16384; i += 512) { const int k = i >> 4, e = i & 15; Wl[(((k >> 5) * 4 + ((k >> 3) & 3)) * 16 + e) * 8 + (k & 7)] = INP(I_WR)[i]; }
    for (int i = tid; i < 2048; i += 512) { const int b = i >> 10, k = i & 1023; gsL[i] = gn[k] * (1.f + modl[b * 6144 + 4096 + k]); shL[i] = modl[b * 6144 + 3072 + k]; }
    if (tid < 16) lcnt[tid] = 0;
    __syncthreads();
    {
        const int be = tid >> 4, part = tid & 15, b = be >> 4, e = be & 15;
        float a = 0.f;
        for (int k = part * 64; k < part * 64 + 64; ++k) a += shL[b * 1024 + k] * Wl[(((k >> 5) * 4 + ((k >> 3) & 3)) * 16 + e) * 8 + (k & 7)];
        a += shx<1>(a, lane); a += shx<2>(a, lane); a += shx<4>(a, lane); a += shx<8>(a, lane);
        if (part == 0) cW[be] = a;
    }
    __syncthreads();
    int it = 0;
    for (int batch = X.bid * 8 + wave; batch < NTOK / 16; batch += G * 8, ++it) {
        const int row = batch * 16 + r, b = row >> 14;
        float rinv;
        { const f32x4 p4 = ldg4f(ssp + (size_t)row * 16 + 4 * kq); float ssq = (p4[0] + p4[1]) + (p4[2] + p4[3]); ssq += shx<16>(ssq, lane); ssq += shx<32>(ssq, lane);
          rinv = rsqrtf(ssq * (1.f / 1024.f) + 1e-6f); }
        f32x4 acc = (f32x4){0.f, 0.f, 0.f, 0.f};
        const bf16_t* xr = xsrc + (size_t)row * 1024 + kq * 8;
        bf16_t* hr = h + (size_t)row * 1024 + kq * 8;
        for (int kg = 0; kg < 4; ++kg) {
            u32x4 xp[8];
#pragma unroll
            for (int u = 0; u < 8; ++u) { const int kk = (kg * 4 + (u >> 1)) * 64 + (u & 1) * 32; xp[u] = ldg4u(xr + kk); }
            asm volatile("" ::: "memory");
#pragma unroll
            for (int u = 0; u < 8; ++u) {
                const int kc = kg * 4 + (u >> 1), jh = u & 1, kk = kc * 64 + jh * 32;
                const f32x4 g0 = *(const LAS f32x4*)(gsL + b * 1024 + kk + kq * 8), g1 = *(const LAS f32x4*)(gsL + b * 1024 + kk + kq * 8 + 4);
                const f32x4 s0 = *(const LAS f32x4*)(shL + b * 1024 + kk + kq * 8), s1 = *(const LAS f32x4*)(shL + b * 1024 + kk + kq * 8 + 4);
                const LAS float* wp = Wl + (((kc * 2 + jh) * 4 + kq) * 16 + r) * 8;
                const f32x4 w0 = *(const LAS f32x4*)wp, w1 = *(const LAS f32x4*)(wp + 4);
                f32x4 xa, xc; unpack8(xp[u], xa, xc);
                const f32x4 x0 = xa * g0, x1 = xc * g1;
                stg4u(hr + kk, pack8(x0 * rinv + s0, x1 * rinv + s1));
#pragma unroll
                for (int q = 0; q < 4; ++q) acc = __builtin_amdgcn_mfma_f32_16x16x4f32(w0[q], x0[q], acc, 0, 0, 0);
#pragma unroll
                for (int q = 0; q < 4; ++q) acc = __builtin_amdgcn_mfma_f32_16x16x4f32(w1[q], x1[q], acc, 0, 0, 0);
            }
            asm volatile("" ::: "memory");
        }
        if (it < 4) {
            f32x4 lg;
#pragma unroll
            for (int i = 0; i < 4; ++i) lg[i] = rinv * acc[i] + cW[b * 16 + 4 * kq + i];
            *(LAS f32x4*)(lgl + ((it * 8 + wave) * 16 + r) * 16 + 4 * kq) = lg;
        }
    }
    }
    __syncthreads();
    {
        const int slot = tid, sb = slot >> 4, srow = ((X.bid * 8 + (sb & 7)) + (sb >> 3) * G * 8) * 16 + (slot & 15);
        const bool have = (srow < NTOK) && ((sb >> 3) < 4);
        int e0 = 0, e1 = 0, r0 = 0, r1i = 0; float w0 = 0.f, w1 = 0.f;
        if (have) {
            float sco[16], sel[16];
            f32x4 rb4[4];
#pragma unroll
            for (int q = 0; q < 4; ++q) rb4[q] = ldg4f(INP(I_RB) + 4 * q);
#pragma unroll
            for (int q = 0; q < 4; ++q) { const f32x4 lg4 = *(const LAS f32x4*)(lgl + slot * 16 + 4 * q);
#pragma unroll
                for (int j = 0; j < 4; ++j) { const int e = 4 * q + j; sco[e] = 1.f / (1.f + __expf(-lg4[j])); sel[e] = sco[e] + rb4[q][j]; } }
            float gs[4];
#pragma unroll
            for (int g = 0; g < 4; ++g) {
                const float a = sel[4 * g], bq = sel[4 * g + 1], c = sel[4 * g + 2], d = sel[4 * g + 3];
                const float m1 = fmaxf(fmaxf(a, bq), fmaxf(c, d));
                int i1 = (a == m1) ? 0 : (bq == m1) ? 1 : (c == m1) ? 2 : 3;
                float m2 = -3.0e38f;
                m2 = (i1 != 0) ? fmaxf(m2, a) : m2; m2 = (i1 != 1) ? fmaxf(m2, bq) : m2; m2 = (i1 != 2) ? fmaxf(m2, c) : m2; m2 = (i1 != 3) ? fmaxf(m2, d) : m2;
                gs[g] = m1 + m2;
            }
            int gi = 0; float gb = gs[0];
#pragma unroll
            for (int g = 1; g < 4; ++g) if (gs[g] > gb) { gb = gs[g]; gi = g; }
            float s0 = (gi == 0) ? sel[0] : (gi == 1) ? sel[4] : (gi == 2) ? sel[8] : sel[12];
            float s1 = (gi == 0) ? sel[1] : (gi == 1) ? sel[5] : (gi == 2) ? sel[9] : sel[13];
            float s2 = (gi == 0) ? sel[2] : (gi == 1) ? sel[6] : (gi == 2) ? sel[10] : sel[14];
            float s3 = (gi == 0) ? sel[3] : (gi == 1) ? sel[7] : (gi == 2) ? sel[11] : sel[15];
            float c0 = (gi == 0) ? sco[0] : (gi == 1) ? sco[4] : (gi == 2) ? sco[8] : sco[12];
            float c1 = (gi == 0) ? sco[1] : (gi == 1) ? sco[5] : (gi == 2) ? sco[9] : sco[13];
            float c2 = (gi == 0) ? sco[2] : (gi == 1) ? sco[6] : (gi == 2) ? sco[10] : sco[14];
            float c3 = (gi == 0) ? sco[3] : (gi == 1) ? sco[7] : (gi == 2) ? sco[11] : sco[15];
            const float m1 = fmaxf(fmaxf(s0, s1), fmaxf(s2, s3));
            const int i1 = (s0 == m1) ? 0 : (s1 == m1) ? 1 : (s2 == m1) ? 2 : 3;
            float m2 = -3.0e38f;
            m2 = (i1 != 0) ? fmaxf(m2, s0) : m2; m2 = (i1 != 1) ? fmaxf(m2, s1) : m2; m2 = (i1 != 2) ? fmaxf(m2, s2) : m2; m2 = (i1 != 3) ? fmaxf(m2, s3) : m2;
            const int i2 = (i1 != 0 && s0 == m2) ? 0 : (i1 != 1 && s1 == m2) ? 1 : (i1 != 2 && s2 == m2) ? 2 : 3;
            const float w1v = (i1 == 0) ? c0 : (i1 == 1) ? c1 : (i1 == 2) ? c2 : c3;
            const float w2v = (i2 == 0) ? c0 : (i2 == 1) ? c1 : (i2 == 2) ? c2 : c3;
            const float wn = 1.f / (w1v + w2v);
            e0 = gi * 4 + i1; e1 = gi * 4 + i2; w0 = w1v * wn; w1 = w2v * wn;
            r0 = __hip_atomic_fetch_add(lcnt + e0, 1, __ATOMIC_RELAXED, __HIP_MEMORY_SCOPE_WORKGROUP); r1i = __hip_atomic_fetch_add(lcnt + e1, 1, __ATOMIC_RELAXED, __HIP_MEMORY_SCOPE_WORKGROUP);
        }
        __syncthreads();
        unsigned* gcnt = (unsigned*)(ws + WS_CTL) + CW_GCNT + 16 * (layer * 16);
        if (tid < 16) lbase[tid] = (int)atomicAdd(gcnt + 16 * tid, (unsigned)lcnt[tid]);
        __syncthreads();
        if (have) {
            int* lt = (int*)(ws + WS_LISTT); float* lw = (float*)(ws + WS_LISTW);
            const int p0 = lbase[e0] + r0, p1 = lbase[e1] + r1i;
            lt[e0 * LCAP + p0] = srow * 2; lw[e0 * LCAP + p0] = w0;
            lt[e1 * LCAP + p1] = srow * 2 + 1; lw[e1 * LCAP + p1] = w1;
            u32x4 ti; ti[0] = (unsigned)e0 | ((unsigned)p0 << 4); ti[1] = __float_as_uint(w0); ti[2] = (unsigned)e1 | ((unsigned)p1 << 4); ti[3] = __float_as_uint(w1);
            *(GAS u32x4*)((u32x4*)(ws + WS_TINFO) + srow) = ti;
        }
    }
    __syncthreads();
}

__device__ __forceinline__ void cmp2_unit(const Ctx& X, int layer, int u) {
    unsigned char* ws = X.ws;
    const int lane = X.tid & 63, c = lane & 15, g = lane >> 4;
    const int mat = u >> 7, r0 = (u & 127) * 16;
    const bf16_t* hid = (const bf16_t*)(ws + WS_HID) + ((size_t)mat * 2048 + r0) * 256;
    const bf16_t* w2 = (const bf16_t*)(ws + WS_W2) + ((size_t)layer * 2 + mat) * 64 * 256;
    f32x4 acc[4];
#pragma unroll
    for (int nt = 0; nt < 4; ++nt) acc[nt] = (f32x4){0.f, 0.f, 0.f, 0.f};
#pragma unroll
    for (int ks = 0; ks < 8; ++ks) {
        const bf16x8 a = ldg8(hid + c * 256 + ks * 32 + 8 * g);
#pragma unroll
        for (int nt = 0; nt < 4; ++nt) { const bf16x8 b = ldg8(w2 + (nt * 16 + c) * 256 + ks * 32 + 8 * g); acc[nt] = __builtin_amdgcn_mfma_f32_16x16x32_bf16(a, b, acc[nt], 0, 0, 0); }
    }
    if (mat == 0) {
        const GAS float* kg = (const GAS float*)(INP(I_NKG) + layer * 192);
        GAS bf16_t* kc = (GAS bf16_t*)(ws + WS_KCMP);
        float kgv[4];
#pragma unroll
        for (int nt = 0; nt < 4; ++nt) kgv[nt] = kg[nt * 16 + c];
#pragma unroll
        for (int i = 0; i < 4; ++i) {
            float ss = acc[0][i] * acc[0][i] + acc[1][i] * acc[1][i] + acc[2][i] * acc[2][i] + acc[3][i] * acc[3][i];
            ss += shx<1>(ss, lane); ss += shx<2>(ss, lane); ss += shx<4>(ss, lane); ss += shx<8>(ss, lane);
            const float rn = rsqrtf(ss * (1.f / 64.f) + 1e-6f);
#pragma unroll
            for (int nt = 0; nt < 4; ++nt) kc[(size_t)(r0 + 4 * g + i) * 64 + nt * 16 + c] = f2bf(acc[nt][i] * rn * kgv[nt]);
        }
    } else {
        bf16_t* vt = (bf16_t*)(ws + WS_VCMPT);
        const int b = r0 >> 10, cb0 = (r0 & 1023) + 4 * g;
#pragma unroll
        for (int nt = 0; nt < 4; ++nt) { u32x2 o; o[0] = cvt_pk_bf16(acc[nt][0], acc[nt][1]); o[1] = cvt_pk_bf16(acc[nt][2], acc[nt][3]);
            stg2u(vt + ((size_t)b * 64 + nt * 16 + c) * 1024 + cb0, o); }
    }
}

template <int NCT>
__device__ __forceinline__ void qk_tile(const bf16_t* kp, int kstride, const bf16x8 (&qf)[NCT][2], f32x4 (&s)[2][2][NCT]) {
#pragma unroll
    for (int ch = 0; ch < 2; ++ch)
#pragma unroll
        for (int T = 0; T < 2; ++T) {
            const bf16_t* p = kp + (size_t)(32 * ch + 4 * T) * kstride;
            const bf16x8 k0 = ldg8(p), k1 = ldg8(p + 32);
#pragma unroll
            for (int ct = 0; ct < NCT; ++ct) {
                f32x4 a = (f32x4){0.f, 0.f, 0.f, 0.f};
                a = __builtin_amdgcn_mfma_f32_16x16x32_bf16(k0, qf[ct][0], a, 0, 0, 0);
                a = __builtin_amdgcn_mfma_f32_16x16x32_bf16(k1, qf[ct][1], a, 0, 0, 0);
                s[ch][T][ct] = a;
            }
        }
}
template <int NCT>
__device__ __forceinline__ void pv_tile(const bf16_t* vp, size_t vstride, const bf16x8 (&pb)[2][NCT], f32x4 (&o)[4][NCT]) {
#pragma unroll
    for (int ch = 0; ch < 2; ++ch)
#pragma unroll
        for (int dt = 0; dt < 4; ++dt) {
            const bf16x8 v = ldg8(vp + (size_t)(16 * dt) * vstride + 32 * ch);
#pragma unroll
            for (int ct = 0; ct < NCT; ++ct) o[dt][ct] = __builtin_amdgcn_mfma_f32_16x16x32_bf16(v, pb[ch][ct], o[dt][ct], 0, 0, 0);
        }
}
struct KFrag { bf16x8 k[2][2][2]; };
struct VFrag { bf16x8 v[2][4]; };
__device__ __forceinline__ void ld_ktile(const bf16_t* kp, int kstride, KFrag& f) {
#pragma unroll
    for (int ch = 0; ch < 2; ++ch)
#pragma unroll
        for (int T = 0; T < 2; ++T) { const bf16_t* p = kp + (size_t)(32 * ch + 4 * T) * kstride; f.k[ch][T][0] = ldg8(p); f.k[ch][T][1] = ldg8(p + 32); }
}
__device__ __forceinline__ void ld_vtile(const bf16_t* vp, size_t vstride, VFrag& f) {
#pragma unroll
    for (int ch = 0; ch < 2; ++ch)
#pragma unroll
        for (int dt = 0; dt < 4; ++dt) f.v[ch][dt] = ldg8(vp + (size_t)(16 * dt) * vstride + 32 * ch);
}
template <int NCT>
__device__ __forceinline__ void qk_from(const KFrag& f, const bf16x8 (&qf)[NCT][2], f32x4 (&s)[2][2][NCT]) {
#pragma unroll
    for (int ch = 0; ch < 2; ++ch)
#pragma unroll
        for (int T = 0; T < 2; ++T)
#pragma unroll
            for (int ct = 0; ct < NCT; ++ct) {
                f32x4 a = (f32x4){0.f, 0.f, 0.f, 0.f};
                a = __builtin_amdgcn_mfma_f32_16x16x32_bf16(f.k[ch][T][0], qf[ct][0], a, 0, 0, 0);
                a = __builtin_amdgcn_mfma_f32_16x16x32_bf16(f.k[ch][T][1], qf[ct][1], a, 0, 0, 0);
                s[ch][T][ct] = a;
            }
}
template <int NCT>
__device__ __forceinline__ void pv_from(const VFrag& f, const bf16x8 (&pb)[2][NCT], f32x4 (&o)[4][NCT]) {
#pragma unroll
    for (int ch = 0; ch < 2; ++ch)
#pragma unroll
        for (int dt = 0; dt < 4; ++dt)
#pragma unroll
            for (int ct = 0; ct < NCT; ++ct) o[dt][ct] = __builtin_amdgcn_mfma_f32_16x16x32_bf16(f.v[ch][dt], pb[ch][ct], o[dt][ct], 0, 0, 0);
}
__device__ __forceinline__ bf16x8 pack_p(const f32x4 a, const f32x4 b) {
    union { u32x4 u; bf16x8 h; } x; x.u = pack8(a, b); return x.h;
}
template <int NCT> struct SmState { f32x4 o[4][NCT]; float m[NCT], l[NCT]; };

template <int NCT> __device__ __forceinline__ void sm_init(SmState<NCT>& st) {
#pragma unroll
    for (int ct = 0; ct < NCT; ++ct) { st.m[ct] = -1e30f; st.l[ct] = 0.f;
#pragma unroll
        for (int dt = 0; dt < 4; ++dt) st.o[dt][ct] = (f32x4){0.f, 0.f, 0.f, 0.f}; }
}
template <int NCT> __device__ __forceinline__ void sm_finish(SmState<NCT>& st, const int lane) {
#pragma unroll
    for (int ct = 0; ct < NCT; ++ct) {
        float l = st.l[ct]; l += shx<16>(l, lane); l += shx<32>(l, lane);
        const float inv = (l > 0.f) ? 1.f / l : 0.f;
#pragma unroll
        for (int dt = 0; dt < 4; ++dt) st.o[dt][ct] *= inv;
    }
}

constexpr int TROW = 72, TILE_E = 64 * TROW;
template <int NCT>
__device__ __forceinline__ void qk_tile_l(const LAS bf16_t* Kb, int c, int g, const bf16x8 (&qf)[NCT][2], f32x4 (&s)[2][2][NCT]) {
#pragma unroll
    for (int ch = 0; ch < 2; ++ch)
#pragma unroll
        for (int T = 0; T < 2; ++T) {
            const LAS bf16_t* p = Kb + (32 * ch + 8 * (c >> 2) + 4 * T + (c & 3)) * TROW + 8 * g;
            const bf16x8 k0 = *(const LAS bf16x8*)p, k1 = *(const LAS bf16x8*)(p + 32);
#pragma unroll
            for (int ct = 0; ct < NCT; ++ct) {
                f32x4 a = (f32x4){0.f, 0.f, 0.f, 0.f};
                a = __builtin_amdgcn_mfma_f32_16x16x32_bf16(k0, qf[ct][0], a, 0, 0, 0);
                a = __builtin_amdgcn_mfma_f32_16x16x32_bf16(k1, qf[ct][1], a, 0, 0, 0);
                s[ch][T][ct] = a;
            }
        }
}
template <int NCT>
__device__ __forceinline__ void pv_tile_l(const LAS bf16_t* Vb, int c, int g, const bf16x8 (&pb)[2][NCT], f32x4 (&o)[4][NCT]) {
#pragma unroll
    for (int ch = 0; ch < 2; ++ch)
#pragma unroll
        for (int dt = 0; dt < 4; ++dt) {
            const bf16x8 v = *(const LAS bf16x8*)(Vb + (16 * dt + c) * TROW + 32 * ch + 8 * g);
#pragma unroll
            for (int ct = 0; ct < NCT; ++ct) o[dt][ct] = __builtin_amdgcn_mfma_f32_16x16x32_bf16(v, pb[ch][ct], o[dt][ct], 0, 0, 0);
        }
}
template <int NCT, int STEP>
__device__ __forceinline__ void sm_soft(SmState<NCT>& st, f32x4 (&s)[2][2][NCT], bf16x8 (&pb)[2][NCT], const int (&d0)[NCT], const float (&slope)[NCT], const unsigned (&W)[NCT], const int lane) {
#pragma unroll
    for (int ct = 0; ct < NCT; ++ct) {
        float mx = -1e30f;
#pragma unroll
        for (int ch = 0; ch < 2; ++ch)
#pragma unroll
            for (int T = 0; T < 2; ++T)
#pragma unroll
                for (int i = 0; i < 4; ++i) {
                    const int dist = d0[ct] - STEP * (32 * ch + 4 * T + i);
                    const float v = ((unsigned)dist < W[ct]) ? (s[ch][T][ct][i] - slope[ct] * (float)dist) : -1e30f;
                    s[ch][T][ct][i] = v; mx = fmaxf(mx, v);
                }
        mx = fmaxf(mx, shx<16>(mx, lane)); mx = fmaxf(mx, shx<32>(mx, lane));
        const float mn = fmaxf(st.m[ct], mx), alpha = fexp2(st.m[ct] - mn);
        float sum = 0.f;
#pragma unroll
        for (int ch = 0; ch < 2; ++ch) {
#pragma unroll
            for (int T = 0; T < 2; ++T)
#pragma unroll
                for (int i = 0; i < 4; ++i) { const float v = s[ch][T][ct][i]; const float p = (v > -1e29f) ? fexp2(v - mn) : 0.f; s[ch][T][ct][i] = p; sum += p; }
            pb[ch][ct] = pack_p(s[ch][0][ct], s[ch][1][ct]);
        }
        st.m[ct] = mn; st.l[ct] = st.l[ct] * alpha + sum;
#pragma unroll
        for (int dt = 0; dt < 4; ++dt) st.o[dt][ct] *= alpha;
    }
}

template <int NCT, int STEP>
__device__ __forceinline__ void sm_tile(SmState<NCT>& st, f32x4 (&s)[2][2][NCT], const int (&d0)[NCT], const float (&slope)[NCT], unsigned W, const bf16_t* vp, size_t vstride, const int lane) {
    bf16x8 pb[2][NCT]; unsigned Wv[NCT];
#pragma unroll
    for (int ct = 0; ct < NCT; ++ct) Wv[ct] = W;
    sm_soft<NCT, STEP>(st, s, pb, d0, slope, Wv, lane);
    pv_tile<NCT>(vp, vstride, pb, st.o);
}

__device__ __forceinline__ f32x4 add_sle(const f32x4 v, const float sl, const int e0, const int step) {
    f32x4 r; r[0] = fmaf(sl, (float)(step * e0), v[0]); r[1] = fmaf(sl, (float)(step * (e0 + 1)), v[1]); r[2] = fmaf(sl, (float)(step * (e0 + 2)), v[2]); r[3] = fmaf(sl, (float)(step * (e0 + 3)), v[3]); return r; }
template <int NCT>
__device__ __forceinline__ void sm_fast(SmState<NCT>& st, f32x4 (&s)[2][2][NCT], bf16x8 (&pb)[2][NCT], const float sl, const float (&base)[NCT], const bool (&en)[NCT], const int lane) {
#pragma unroll
    for (int ct = 0; ct < NCT; ++ct) {
        const f32x4 u00 = add_sle(s[0][0][ct], sl, 0, 1), u01 = add_sle(s[0][1][ct], sl, 4, 1), u10 = add_sle(s[1][0][ct], sl, 32, 1), u11 = add_sle(s[1][1][ct], sl, 36, 1);
        const f32x4 m4 = __builtin_elementwise_max(__builtin_elementwise_max(u00, u01), __builtin_elementwise_max(u10, u11));
        float mx = fmaxf(fmaxf(m4[0], m4[1]), fmaxf(m4[2], m4[3])) + base[ct];
        mx = fmaxf(mx, shx<16>(mx, lane)); mx = fmaxf(mx, shx<32>(mx, lane));
        const float mn = en[ct] ? fmaxf(st.m[ct], mx) : st.m[ct], alpha = fexp2(st.m[ct] - mn);
        const float off = en[ct] ? (base[ct] - mn) : -1e30f;
        f32x4 p00 = u00 + off, p01 = u01 + off, p10 = u10 + off, p11 = u11 + off;
#pragma unroll
        for (int i = 0; i < 4; ++i) { p00[i] = fexp2(p00[i]); p01[i] = fexp2(p01[i]); p10[i] = fexp2(p10[i]); p11[i] = fexp2(p11[i]); }
        const f32x4 s4 = (p00 + p01) + (p10 + p11);
        const float sum = (s4[0] + s4[1]) + (s4[2] + s4[3]);
        pb[0][ct] = pack_p(p00, p01); pb[1][ct] = pack_p(p10, p11);
        st.m[ct] = mn; st.l[ct] = st.l[ct] * alpha + sum;
#pragma unroll
        for (int dt = 0; dt < 4; ++dt) st.o[dt][ct] *= alpha;
    }
}

__device__ __forceinline__ void nsa_block(const Ctx& X, LAS unsigned char* lds, int unit, int layer, unsigned long long& prb_acc, unsigned* qhead, int& nxt_idx, const float mref_in) {
    unsigned long long prb_t0 = 0ull; (void)prb_t0; (void)prb_acc;
    unsigned char* ws = X.ws;
    const int tid = X.tid, lane = tid & 63, wave = tid >> 6, c = lane & 15, g = lane >> 4, h = c & 7, qq = c >> 3;
    const int b = unit >> 9, t0 = (unit & 511) * 32;
    const bf16_t* z = (const bf16_t*)(ws + WS_Z) + (size_t)b * SEQ * ZLD;
    const bf16_t* vT = (const bf16_t*)(ws + WS_VT) + (size_t)b * 8 * 64 * SEQ;
    const bf16_t* kcmp = (const bf16_t*)(ws + WS_KCMP) + (size_t)b * 1024 * 64;
    const bf16_t* vcT = (const bf16_t*)(ws + WS_VCMPT) + (size_t)b * 64 * 1024;
    LAS float* impA = (LAS float*)(lds + wave * 8192);
    LAS float* impB = impA + 1024;
    LAS bf16_t* KV = (LAS bf16_t*)(lds + 65536);
    LAS int* sell = (LAS int*)(lds + 114688);
    LAS unsigned* qmask = (LAS unsigned*)(lds + 115712);
    LAS unsigned* ubits = (LAS unsigned*)(lds + 116736);
    LAS int* ulist = (LAS int*)(lds + 116800);
    const int prho = tid >> 3, pcp = tid & 7;
    const int krow = (prho & ~9) | ((prho >> 3) & 1) | ((prho & 1) << 3), kchk = pcp ^ (2 * (krow & 3));
    const int vrow = (prho & ~5) | ((prho >> 2) & 1) | ((prho & 1) << 2), vchk = pcp ^ (2 * (vrow & 3));
    const int wv512 = __builtin_amdgcn_readfirstlane(wave) * 512;
    const int fp = c & 3, fcl = g ^ (2 * (fp & 1)), fph = fp >> 1;
    const int krow0 = 8 * (c >> 2) + fp, krho0 = (krow0 & ~9) | ((krow0 >> 3) & 1) | ((krow0 & 1) << 3);
    const int kofA = krho0 * 64 + (fcl + 4 * (0 ^ fph)) * 8, kofB = krho0 * 64 + (fcl + 4 * (1 ^ fph)) * 8;
    const int vrho0 = (c & ~5) | ((c >> 2) & 1) | ((c & 1) << 2);
    const int vofA = vrho0 * 64 + (fcl + 4 * (0 ^ fph)) * 8, vofB = vrho0 * 64 + (fcl + 4 * (1 ^ fph)) * 8;
#define T_DMAK(kbase, kstride, k0, buf) __builtin_amdgcn_global_load_lds((const unsigned*)((kbase) + (size_t)((k0) + krow) * (kstride) + kchk * 8), (LAS unsigned*)(KV + (buf) * 8192 + wv512), 16, 0, 0)
#define T_DMAV(vbase, vstride, k0, buf) __builtin_amdgcn_global_load_lds((const unsigned*)((vbase) + (size_t)vrow * (vstride) + (k0) + vchk * 8), (LAS unsigned*)(KV + (buf) * 8192 + 4096 + wv512), 16, 0, 0)
#define T_KB(buf) (KV + (buf) * 8192)
#define T_DMAKP(kbase, kstride, k0, dst) __builtin_amdgcn_global_load_lds((const unsigned*)((kbase) + (size_t)((k0) + krow) * (kstride) + kchk * 8), (LAS unsigned*)((dst) + wv512), 16, 0, 0)
#define T_VB(buf) (KV + (buf) * 8192 + 4096)
#define T_WAIT(n) asm volatile("s_waitcnt vmcnt(" #n ")" ::: "memory")
#define T_BAR() do { asm volatile("" ::: "memory"); __builtin_amdgcn_s_barrier(); asm volatile("" ::: "memory"); } while (0)
#define QK2I(buf, S, OFF, STEP) QK2IP(T_KB(buf), S, OFF, STEP)
#define QK2IP(kptr, S, OFF, STEP) do { _Pragma("unroll") for (int ch = 0; ch < 2; ++ch) _Pragma("unroll") for (int T = 0; T < 2; ++T) { \
        const LAS bf16_t* p_ = (kptr) + (4 * T + 32 * ch) * 64; const bf16x8 k0_ = *(const LAS bf16x8*)(p_ + kofA), k1_ = *(const LAS bf16x8*)(p_ + kofB); \
        _Pragma("unroll") for (int ct = 0; ct < 2; ++ct) { f32x4 a_; \
            _Pragma("unroll") for (int i = 0; i < 4; ++i) a_[i] = fmaf(sl, (float)((STEP) * (32 * ch + 4 * T + i)), OFF[ct]); \
            a_ = __builtin_amdgcn_mfma_f32_16x16x32_bf16(k0_, qf[ct][0], a_, 0, 0, 0); a_ = __builtin_amdgcn_mfma_f32_16x16x32_bf16(k1_, qf[ct][1], a_, 0, 0, 0); S[ch][T][ct] = a_; } } } while (0)
#define PV2(buf, PB, O) do { _Pragma("unroll") for (int dt = 0; dt < 4; ++dt) { const LAS bf16_t* p_ = T_VB(buf) + 16 * dt * 64; \
        const bf16x8 v0_ = *(const LAS bf16x8*)(p_ + vofA), v1_ = *(const LAS bf16x8*)(p_ + vofB); \
        _Pragma("unroll") for (int ct = 0; ct < 2; ++ct) { O[dt][ct] = __builtin_amdgcn_mfma_f32_16x16x32_bf16(v0_, PB[0][ct], O[dt][ct], 0, 0, 0); \
            O[dt][ct] = __builtin_amdgcn_mfma_f32_16x16x32_bf16(v1_, PB[1][ct], O[dt][ct], 0, 0, 0); } } } while (0)
#define LSUM(PB, L) do { _Pragma("unroll") for (int ct = 0; ct < 2; ++ct) { L[ct] = __builtin_amdgcn_mfma_f32_16x16x32_bf16(ones, PB[0][ct], L[ct], 0, 0, 0); \
        L[ct] = __builtin_amdgcn_mfma_f32_16x16x32_bf16(ones, PB[1][ct], L[ct], 0, 0, 0); } } while (0)
#define PEXP(S, PB, FULL, D0, W, STEP) do { _Pragma("unroll") for (int ct = 0; ct < 2; ++ct) { _Pragma("unroll") for (int ch = 0; ch < 2; ++ch) { \
        _Pragma("unroll") for (int T = 0; T < 2; ++T) _Pragma("unroll") for (int i = 0; i < 4; ++i) { const float e_ = fexp2(S[ch][T][ct][i]); \
            S[ch][T][ct][i] = (FULL) ? e_ : (((unsigned)(D0[ct] - (STEP) * (32 * ch + 4 * T + i)) < W[ct]) ? e_ : 0.f); } \
        PB[ch][ct] = pack_p(S[ch][0][ct], S[ch][1][ct]); } } } while (0)
    PRB_BEGIN(2);
    if (tid < 256) qmask[tid] = 0u;
    if (tid < 8) ubits[tid] = 0u;
    int tq[2]; bf16x8 qf[2][2]; bf16_t gate3[2][3]; u32x2 osum[2][4];
    const float sl = exp2f(-8.f * (float)(h + 5) / 12.f) * LOG2E;
#pragma unroll
    for (int ct = 0; ct < 2; ++ct) {
        tq[ct] = t0 + 4 * wave + 2 * ct + qq;
        const bf16_t* qp = z + (size_t)tq[ct] * ZLD + ZC_QA + h * 64 + 8 * g;
        qf[ct][0] = ldg8(qp); qf[ct][1] = ldg8(qp + 32);
#pragma unroll
        for (int k = 0; k < 3; ++k) gate3[ct][k] = *(const GAS bf16_t*)(z + (size_t)tq[ct] * ZLD + ZC_GA + h * 3 + k);
    }
    const float mref = mref_in;
    bf16x8 ones;
#pragma unroll
    for (int j = 0; j < 8; ++j) ones[j] = (c == 0) ? (short)0x3F80 : (short)0;
    const int t_lo = t0 + 4 * wave, t_hi = t_lo + 3;
    bf16_t* const og = (bf16_t*)(ws + WS_O) + (size_t)b * SEQ * 1024 + h * 64 + 4 * g;
    const int ncb = (t0 >> 4) + 1;
    const int ntile = (ncb + 63) >> 6;
    const unsigned WALL[2] = {0x7fffffffu, 0x7fffffffu};
    float l2inv[2];
    PRB_END(2); PRB_BEGIN(3);
    {
        f32x4 lacc[2] = {(f32x4){0.f, 0.f, 0.f, 0.f}, (f32x4){0.f, 0.f, 0.f, 0.f}};
        if (tid == 0) nxt_idx = (int)__hip_atomic_fetch_add((GAS unsigned*)qhead, 1u, __ATOMIC_RELAXED, __HIP_MEMORY_SCOPE_AGENT);
        T_BAR();
#pragma unroll
        for (int p = 0; p < 5; ++p) if (p < ntile) T_DMAKP(kcmp, 64, p * 64, KV + p * 4096);
        for (int kt = 0; kt < ntile; ++kt) {
            f32x4 s[2][2][2]; bf16x8 pb[2][2];
            const int k0 = kt * 64, s6 = kt % 6, rem = (ntile - 1 - kt < 4) ? ntile - 1 - kt : 4;
            if (rem == 4) T_WAIT(4); else if (rem == 3) T_WAIT(3); else if (rem == 2) T_WAIT(2); else if (rem == 1) T_WAIT(1); else T_WAIT(0);
            T_BAR();
            if (kt + 5 < ntile) T_DMAKP(kcmp, 64, k0 + 320, KV + ((kt + 5) % 6) * 4096);
            const int d0[2] = {tq[0] - 31 - 16 * (k0 + 8 * g), tq[1] - 31 - 16 * (k0 + 8 * g)};
            const float off[2] = {-sl * (float)d0[0] - mref, -sl * (float)d0[1] - mref};
            QK2IP(KV + s6 * 4096, s, off, 16);
            const bool full = (16 * (k0 + 63) + 31 <= t_lo);
            if (full) PEXP(s, pb, true, d0, WALL, 16); else PEXP(s, pb, false, d0, WALL, 16);
            LSUM(pb, lacc);
        }
#pragma unroll
        for (int ct = 0; ct < 2; ++ct) { float lt = lacc[ct][0]; lt += shx<16>(lt, lane); lt += shx<32>(lt, lane); l2inv[ct] = (lt > 0.f) ? -flog2(lt) : -1e30f; }
    }
    PRB_END(3); PRB_BEGIN(4);
    {
        f32x4 o[4][2];
#pragma unroll
        for (int dt = 0; dt < 4; ++dt) { o[dt][0] = (f32x4){0.f, 0.f, 0.f, 0.f}; o[dt][1] = (f32x4){0.f, 0.f, 0.f, 0.f}; }
        T_BAR();
        T_DMAK(kcmp, 64, 0, 0); T_DMAV(vcT, 1024, 0, 0); if (ntile > 1) { T_DMAK(kcmp, 64, 64, 1); T_DMAV(vcT, 1024, 64, 1); }
        for (int kt = 0; kt < ntile; ++kt) {
            f32x4 s[2][2][2]; bf16x8 pb[2][2];
            const int k0 = kt * 64, bi = kt % 3;
            if (kt + 1 < ntile) T_WAIT(2); else T_WAIT(0);
            T_BAR();
            if (kt + 2 < ntile) { T_DMAK(kcmp, 64, k0 + 128, (kt + 2) % 3); T_DMAV(vcT, 1024, k0 + 128, (kt + 2) % 3); }
            const int d0[2] = {tq[0] - 31 - 16 * (k0 + 8 * g), tq[1] - 31 - 16 * (k0 + 8 * g)};
            const float off[2] = {-sl * (float)d0[0] - mref + l2inv[0], -sl * (float)d0[1] - mref + l2inv[1]};
            QK2I(bi, s, off, 16);
            const bool full = (16 * (k0 + 63) + 31 <= t_lo);
            if (full) PEXP(s, pb, true, d0, WALL, 16); else PEXP(s, pb, false, d0, WALL, 16);
#pragma unroll
            for (int ct = 0; ct < 2; ++ct)
#pragma unroll
                for (int ch = 0; ch < 2; ++ch) {
                    float a0 = s[ch][0][ct][0] + s[ch][0][ct][1] + s[ch][0][ct][2] + 0.5f * s[ch][0][ct][3], b0 = 0.5f * s[ch][0][ct][3];
                    float a1 = s[ch][1][ct][0] + s[ch][1][ct][1] + s[ch][1][ct][2] + 0.5f * s[ch][1][ct][3], b1 = 0.5f * s[ch][1][ct][3];
                    a0 = sum8_dpp(a0); b0 = sum8_dpp(b0); a1 = sum8_dpp(a1); b1 = sum8_dpp(b1);
                    if (h == 0) {
                        const int js = (k0 + 32 * ch) / 4 + 2 * g, ql = 2 * ct + qq;
                        impA[ql * 256 + js] = a0; impB[ql * 256 + js] = b0; impA[ql * 256 + js + 1] = a1; impB[ql * 256 + js + 1] = b1;
                    }
                }
            PV2(bi, pb, o);
        }
#pragma unroll
        for (int ct = 0; ct < 2; ++ct) {
            const float g0 = bf2f(gate3[ct][0]);
#pragma unroll
            for (int dt = 0; dt < 4; ++dt) { const f32x4 v = o[dt][ct] * g0; osum[ct][dt][0] = cvt_pk_bf16(v[0], v[1]); osum[ct][dt][1] = cvt_pk_bf16(v[2], v[3]); }
        }
    }
    PRB_END(4); PRB_BEGIN(5);
    {
        f32x4 o[4][2]; f32x4 lacc[2] = {(f32x4){0.f, 0.f, 0.f, 0.f}, (f32x4){0.f, 0.f, 0.f, 0.f}};
#pragma unroll
        for (int dt = 0; dt < 4; ++dt) { o[dt][0] = (f32x4){0.f, 0.f, 0.f, 0.f}; o[dt][1] = (f32x4){0.f, 0.f, 0.f, 0.f}; }
        int kt0 = (t0 - 511) >> 6; if (kt0 < 0) kt0 = 0;
        const int kt1 = (t0 + 31) >> 6;
        const bf16_t* kb = z + ZC_KWN; const bf16_t* vb = vT + (size_t)(1 * 64) * SEQ;
        const unsigned W2[2] = {512u, 512u};
        T_BAR();
        T_DMAK(kb, ZLD, kt0 * 64, 0); T_DMAV(vb, SEQ, kt0 * 64, 0); if (kt0 < kt1) { T_DMAK(kb, ZLD, kt0 * 64 + 64, 1); T_DMAV(vb, SEQ, kt0 * 64 + 64, 1); }
        for (int kt = kt0; kt <= kt1; ++kt) {
            const int k0 = kt * 64, bi = (kt - kt0) % 3;
            f32x4 s[2][2][2]; bf16x8 pb[2][2];
            if (kt < kt1) T_WAIT(2); else T_WAIT(0);
            T_BAR();
            if (kt + 2 <= kt1) { T_DMAK(kb, ZLD, k0 + 128, (kt - kt0 + 2) % 3); T_DMAV(vb, SEQ, k0 + 128, (kt - kt0 + 2) % 3); }
            const int d0[2] = {tq[0] - (k0 + 8 * g), tq[1] - (k0 + 8 * g)};
            const float off[2] = {-sl * (float)d0[0] - mref, -sl * (float)d0[1] - mref};
            QK2I(bi, s, off, 1);
            const bool full = (k0 + 63 <= t_lo && k0 >= t_hi - 511);
            if (full) PEXP(s, pb, true, d0, W2, 1); else PEXP(s, pb, false, d0, W2, 1);
            PV2(bi, pb, o); LSUM(pb, lacc);
        }
        asm volatile("s_waitcnt vmcnt(0)" ::: "memory");
#pragma unroll
        for (int ct = 0; ct < 2; ++ct) {
            float lt = lacc[ct][0]; lt += shx<16>(lt, lane); lt += shx<32>(lt, lane);
            const float g2 = bf2f(gate3[ct][2]) * ((lt > 0.f) ? 1.f / lt : 0.f);
#pragma unroll
            for (int dt = 0; dt < 4; ++dt) { const f32x4 v = o[dt][ct] * g2; const u32x2 t = osum[ct][dt];
                osum[ct][dt][0] = cvt_pk_bf16(bf_lo(t[0]) + v[0], bf_hi(t[0]) + v[1]); osum[ct][dt][1] = cvt_pk_bf16(bf_lo(t[1]) + v[2], bf_hi(t[1]) + v[3]); }
        }
    }
    PRB_END(5); PRB_BEGIN(6);
    T_BAR();
    T_DMAK(z + ZC_KSL, ZLD, 0, 0); T_DMAV(vT, SEQ, 0, 0);
#pragma unroll
    for (int ql = 0; ql < 4; ++ql) {
        const int qi = 4 * wave + ql, t = t0 + qi, cur = t >> 6;
        if (cur <= 7) {
            if (lane < 8) sell[qi * 8 + lane] = (lane <= cur) ? lane : -1;
        } else {
            unsigned kk[4];
#pragma unroll
            for (int i = 0; i < 4; ++i) { const int j = lane + 64 * i;
                kk[i] = (j >= 1 && j <= cur - 2) ? ((__float_as_uint(impA[ql * 256 + j] + impB[ql * 256 + j - 1]) & 0xFFFFFF00u) | (unsigned)(255 - j)) : 0u; }
            if (lane == 0) { sell[qi * 8 + 0] = 0; sell[qi * 8 + 1] = cur - 1; sell[qi * 8 + 2] = cur; }
#pragma unroll
            for (int r = 0; r < 5; ++r) {
                unsigned m = kk[0] > kk[1] ? kk[0] : kk[1]; const unsigned m2 = kk[2] > kk[3] ? kk[2] : kk[3]; m = m > m2 ? m : m2;
                m = wave_umax(m, lane);
#pragma unroll
                for (int i = 0; i < 4; ++i) kk[i] = (kk[i] == m) ? 0u : kk[i];
                if (lane == 0) sell[qi * 8 + 3 + r] = 255 - (int)(m & 255u);
            }
        }
        if (lane < 8) {
            const int blk = sell[qi * 8 + lane];
            if (blk >= 0) { __hip_atomic_fetch_or(qmask + qi * 8 + (blk >> 5), 1u << (blk & 31), __ATOMIC_RELAXED, __HIP_MEMORY_SCOPE_WORKGROUP);
                            __hip_atomic_fetch_or(ubits + (blk >> 5), 1u << (blk & 31), __ATOMIC_RELAXED, __HIP_MEMORY_SCOPE_WORKGROUP); }
        }
    }
    __syncthreads();
    int nU = 0;
    {
        unsigned wbits[8]; int below = 0;
#pragma unroll
        for (int w = 0; w < 8; ++w) { wbits[w] = ubits[w]; nU += __builtin_popcount(wbits[w]); }
        if (tid < 256) {
            unsigned mine = 0u;
#pragma unroll
            for (int w = 0; w < 8; ++w) { if (w < (tid >> 5)) below += __builtin_popcount(wbits[w]); if (w == (tid >> 5)) mine = wbits[w]; }
            if ((mine >> (tid & 31)) & 1u) { below += __builtin_popcount(mine & ((1u << (tid & 31)) - 1u)); ulist[below] = tid; }
        }
    }
    __syncthreads();
    PRB_END(6); PRB_BEGIN(7);
    {
        f32x4 o[4][2]; f32x4 lacc[2] = {(f32x4){0.f, 0.f, 0.f, 0.f}, (f32x4){0.f, 0.f, 0.f, 0.f}};
#pragma unroll
        for (int dt = 0; dt < 4; ++dt) { o[dt][0] = (f32x4){0.f, 0.f, 0.f, 0.f}; o[dt][1] = (f32x4){0.f, 0.f, 0.f, 0.f}; }
        const bf16_t* kb = z + ZC_KSL; const bf16_t* vb = vT;
        const int q0i = 4 * wave + qq;
        if (nU > 1) { const int k1 = ulist[1] * 64; T_DMAK(kb, ZLD, k1, 1); T_DMAV(vb, SEQ, k1, 1); }
        for (int it = 0; it < nU; ++it) {
            const int blk = ulist[it], k0 = blk * 64, bi = it % 3;
            f32x4 s[2][2][2]; bf16x8 pb[2][2];
            if (it + 1 < nU) T_WAIT(2); else T_WAIT(0);
            T_BAR();
            if (it + 2 < nU) { const int k2 = ulist[it + 2] * 64; T_DMAK(kb, ZLD, k2, (it + 2) % 3); T_DMAV(vb, SEQ, k2, (it + 2) % 3); }
            unsigned W2[2]; float off[2];
            const int d0[2] = {tq[0] - (k0 + 8 * g), tq[1] - (k0 + 8 * g)};
#pragma unroll
            for (int ct = 0; ct < 2; ++ct) {
                const bool member = ((qmask[(q0i + 2 * ct) * 8 + (blk >> 5)] >> (blk & 31)) & 1u) != 0u;
                W2[ct] = member ? 0x7fffffffu : 0u;
                off[ct] = member ? (-sl * (float)d0[ct] - mref) : -1e30f;
            }
            QK2I(bi, s, off, 1);
            const bool full = (k0 + 63 <= t_lo);
            if (full) PEXP(s, pb, true, d0, W2, 1); else PEXP(s, pb, false, d0, W2, 1);
            PV2(bi, pb, o); LSUM(pb, lacc);
        }
        asm volatile("s_waitcnt vmcnt(0)" ::: "memory");
#pragma unroll
        for (int ct = 0; ct < 2; ++ct) {
            float lt = lacc[ct][0]; lt += shx<16>(lt, lane); lt += shx<32>(lt, lane);
            const float g1 = bf2f(gate3[ct][1]) * ((lt > 0.f) ? 1.f / lt : 0.f);
#pragma unroll
            for (int dt = 0; dt < 4; ++dt) { const f32x4 v = o[dt][ct] * g1; bf16_t* op = og + (size_t)tq[ct] * 1024 + 16 * dt; const u32x2 t = osum[ct][dt]; u32x2 w;
                w[0] = cvt_pk_bf16(bf_lo(t[0]) + v[0], bf_hi(t[0]) + v[1]); w[1] = cvt_pk_bf16(bf_lo(t[1]) + v[2], bf_hi(t[1]) + v[3]); stg2u(op, w); }
        }
    }
    PRB_END(7);
#undef T_DMAK
#undef T_DMAV
#undef T_KB
#undef T_VB
#undef T_WAIT
#undef T_BAR
#undef QK2I
#undef QK2IP
#undef T_DMAKP
#undef PV2
#undef LSUM
#undef PEXP
}

__device__ __forceinline__ void sb_unit(const Ctx& X, int unit) {
    unsigned char* ws = X.ws;
    const int lane = X.tid & 63, c = lane & 15, g = lane >> 4;
    const int b = unit >> 11, hd = (unit >> 9) & 3, t0 = (unit & 511) * 32;
    const bf16_t* z = (const bf16_t*)(ws + WS_Z) + (size_t)b * SEQ * ZLD;
    const bf16_t* vT = (const bf16_t*)(ws + WS_VT) + ((size_t)b * 8 + 2 + hd) * 64 * SEQ;
    int tq[2]; bf16x8 qf[2][2]; float R[2] = {1.f, 1.f};
    f32x4 o[4][2];
#pragma unroll
    for (int ct = 0; ct < 2; ++ct) {
        tq[ct] = t0 + 16 * ct + c;
        const bf16_t* qp = z + (size_t)tq[ct] * ZLD + ZC_QB + hd * 64 + 8 * g;
        qf[ct][0] = ldg8(qp); qf[ct][1] = ldg8(qp + 32);
#pragma unroll
        for (int dt = 0; dt < 4; ++dt) o[dt][ct] = (f32x4){0.f, 0.f, 0.f, 0.f};
    }
    const bf16_t* kbase = z + (size_t)(8 * (c >> 2) + (c & 3)) * ZLD + ZC_KB + hd * 64 + 8 * g;
    KFrag kf; VFrag vf;
    ld_ktile(kbase + (size_t)(((t0 + 31) >> 6) * 64) * ZLD, ZLD, kf);
    for (int kt = (t0 + 31) >> 6; kt >= 0; --kt) {
        const int k0 = kt * 64;
        f32x4 s[2][2][2]; bf16x8 pb[2][2];
        ld_vtile(vT + (size_t)c * SEQ + k0 + 8 * g, SEQ, vf);
        qk_from<2>(kf, qf, s);
        if (kt > 0) ld_ktile(kbase + (size_t)(k0 - 64) * ZLD, ZLD, kf);
#pragma unroll
        for (int ct = 0; ct < 2; ++ct) {
            const int d0 = tq[ct] - (k0 + 8 * g);
            float pex[2][8], tot[2], above[2];
#pragma unroll
            for (int ch = 1; ch >= 0; --ch) {
                float run = 1.f;
#pragma unroll
                for (int jj = 7; jj >= 0; --jj) {
                    const int T = jj >> 2, i = jj & 3;
                    const float zc = __builtin_amdgcn_fmed3f(s[ch][T][ct][i], -80.f, 80.f);
                    const bool ok = (d0 - (32 * ch + jj)) > 0;
                    const float t = fexp2(-zc * LOG2E), r = frcp(1.f + t);
                    s[ch][T][ct][i] = ok ? r : 0.f;
                    pex[ch][jj] = run;
                    run *= ok ? t * r : 1.f;
                }
                const float x16 = shx<16>(run, lane), a2 = run * x16, x32 = shx<32>(a2, lane);
                above[ch] = (g == 3) ? 1.f : (g == 2) ? x16 : (g == 1) ? x32 : x16 * x32;
                tot[ch] = a2 * x32;
            }
#pragma unroll
            for (int ch = 0; ch < 2; ++ch) {
                const float base = R[ct] * above[ch] * ((ch == 0) ? tot[1] : 1.f);
#pragma unroll
                for (int jj = 0; jj < 8; ++jj) { const int T = jj >> 2, i = jj & 3; s[ch][T][ct][i] *= base * pex[ch][jj]; }
                pb[ch][ct] = pack_p(s[ch][0][ct], s[ch][1][ct]);
            }
            R[ct] *= tot[0] * tot[1];
        }
        pv_from<2>(vf, pb, o);
        if (__all((R[0] == 0.f) && (R[1] == 0.f))) break;
    }
    bf16_t* ob = (bf16_t*)(ws + WS_O) + (size_t)b * SEQ * 1024 + 512 + hd * 64;
#pragma unroll
    for (int ct = 0; ct < 2; ++ct)
#pragma unroll
        for (int dt = 0; dt < 4; ++dt) {
            u32x2 w; w[0] = cvt_pk_bf16(o[dt][ct][0], o[dt][ct][1]); w[1] = cvt_pk_bf16(o[dt][ct][2], o[dt][ct][3]);
            stg2u(ob + (size_t)tq[ct] * 1024 + 16 * dt + 4 * g, w);
        }
}

__device__ __forceinline__ void swa_unit(const Ctx& X, int layer, int unit) {
    unsigned char* ws = X.ws;
    const int lane = X.tid & 63, c = lane & 15, g = lane >> 4, hg = c & 1;
    const int b = unit >> 11, gk = (unit >> 10) & 1, t0 = (unit & 1023) * 16;
    const int hd = gk * 2 + hg;
    const bf16_t* z = (const bf16_t*)(ws + WS_Z) + (size_t)b * SEQ * ZLD;
    const bf16_t* vT = (const bf16_t*)(ws + WS_VT) + ((size_t)b * 8 + 6 + gk) * 64 * SEQ;
    int tq[2]; float slope[2]; bf16x8 qf[2][2];
    const float sl = exp2f(-8.f * (float)(hd + 1) / 12.f) * LOG2E;
    const float sink = INP(I_SINK)[layer * 4 + hd] * LOG2E;
    SmState<2> st; sm_init<2>(st);
#pragma unroll
    for (int ct = 0; ct < 2; ++ct) {
        tq[ct] = t0 + 8 * ct + (c >> 1); slope[ct] = sl;
        const bf16_t* qp = z + (size_t)tq[ct] * ZLD + ZC_QC + hd * 64 + 8 * g;
        qf[ct][0] = ldg8(qp); qf[ct][1] = ldg8(qp + 32);
        st.m[ct] = sink; st.l[ct] = (g == 0) ? 1.f : 0.f;
    }
    int kt0 = (t0 - 127) >> 6; if (kt0 < 0) kt0 = 0;
    const int kt1 = (t0 + 15) >> 6;
    const bf16_t* kbase = z + (size_t)(8 * (c >> 2) + (c & 3)) * ZLD + ZC_KC + gk * 64 + 8 * g;
    KFrag kf; VFrag vf;
    ld_ktile(kbase + (size_t)(kt0 * 64) * ZLD, ZLD, kf);
    for (int kt = kt0; kt <= kt1; ++kt) {
        const int k0 = kt * 64;
        f32x4 s[2][2][2]; bf16x8 pb[2][2];
        ld_vtile(vT + (size_t)c * SEQ + k0 + 8 * g, SEQ, vf);
        qk_from<2>(kf, qf, s);
        if (kt < kt1) ld_ktile(kbase + (size_t)(k0 + 64) * ZLD, ZLD, kf);
        const int d0[2] = {tq[0] - (k0 + 8 * g), tq[1] - (k0 + 8 * g)};
        const unsigned Wv[2] = {128u, 128u};
        sm_soft<2, 1>(st, s, pb, d0, slope, Wv, lane);
        pv_from<2>(vf, pb, st.o);
    }
    sm_finish<2>(st, lane);
    bf16_t* oc = (bf16_t*)(ws + WS_O) + (size_t)b * SEQ * 1024 + 768 + hd * 64;
#pragma unroll
    for (int ct = 0; ct < 2; ++ct)
#pragma unroll
        for (int dt = 0; dt < 4; ++dt) {
            u32x2 w; w[0] = cvt_pk_bf16(st.o[dt][ct][0], st.o[dt][ct][1]); w[1] = cvt_pk_bf16(st.o[dt][ct][2], st.o[dt][ct][3]);
            stg2u(oc + (size_t)tq[ct] * 1024 + 16 * dt + 4 * g, w);
        }
}

#define STG_CONSTS() \
    const int prho = tid >> 3, pcp = tid & 7; \
    const int krow = (prho & ~9) | ((prho >> 3) & 1) | ((prho & 1) << 3), kchk = pcp ^ (2 * (krow & 3)); \
    const int vrow = (prho & ~5) | ((prho >> 2) & 1) | ((prho & 1) << 2), vchk = pcp ^ (2 * (vrow & 3)); \
    const int wv512 = __builtin_amdgcn_readfirstlane(wave) * 512; \
    const int fp = c & 3, fcl = g ^ (2 * (fp & 1)), fph = fp >> 1; \
    const int krow0 = 8 * (c >> 2) + fp, krho0 = (krow0 & ~9) | ((krow0 >> 3) & 1) | ((krow0 & 1) << 3); \
    const int kofA = krho0 * 64 + (fcl + 4 * (0 ^ fph)) * 8, kofB = krho0 * 64 + (fcl + 4 * (1 ^ fph)) * 8; \
    const int vrho0 = (c & ~5) | ((c >> 2) & 1) | ((c & 1) << 2); \
    const int vofA = vrho0 * 64 + (fcl + 4 * (0 ^ fph)) * 8, vofB = vrho0 * 64 + (fcl + 4 * (1 ^ fph)) * 8
#define T_DMAK(kbase, kstride, k0, buf) __builtin_amdgcn_global_load_lds((const unsigned*)((kbase) + (size_t)((k0) + krow) * (kstride) + kchk * 8), (LAS unsigned*)(KV + (buf) * 8192 + wv512), 16, 0, 0)
#define T_DMAV(vbase, vstride, k0, buf) __builtin_amdgcn_global_load_lds((const unsigned*)((vbase) + (size_t)vrow * (vstride) + (k0) + vchk * 8), (LAS unsigned*)(KV + (buf) * 8192 + 4096 + wv512), 16, 0, 0)
#define T_KB(buf) (KV + (buf) * 8192)
#define T_VB(buf) (KV + (buf) * 8192 + 4096)
#define T_WAIT(n) asm volatile("s_waitcnt vmcnt(" #n ")" ::: "memory")
#define T_BAR() do { asm volatile("" ::: "memory"); __builtin_amdgcn_s_barrier(); asm volatile("" ::: "memory"); } while (0)
#define QK2Z(buf, S) do { _Pragma("unroll") for (int ch = 0; ch < 2; ++ch) _Pragma("unroll") for (int T = 0; T < 2; ++T) { \
        const LAS bf16_t* p_ = T_KB(buf) + (4 * T + 32 * ch) * 64; const bf16x8 k0_ = *(const LAS bf16x8*)(p_ + kofA), k1_ = *(const LAS bf16x8*)(p_ + kofB); \
        _Pragma("unroll") for (int ct = 0; ct < 2; ++ct) { f32x4 a_ = (f32x4){0.f, 0.f, 0.f, 0.f}; \
            a_ = __builtin_amdgcn_mfma_f32_16x16x32_bf16(k0_, qf[ct][0], a_, 0, 0, 0); a_ = __builtin_amdgcn_mfma_f32_16x16x32_bf16(k1_, qf[ct][1], a_, 0, 0, 0); S[ch][T][ct] = a_; } } } while (0)
#define PV2(buf, PB, O) do { _Pragma("unroll") for (int dt = 0; dt < 4; ++dt) { const LAS bf16_t* p_ = T_VB(buf) + 16 * dt * 64; \
        const bf16x8 v0_ = *(const LAS bf16x8*)(p_ + vofA), v1_ = *(const LAS bf16x8*)(p_ + vofB); \
        _Pragma("unroll") for (int ct = 0; ct < 2; ++ct) { O[dt][ct] = __builtin_amdgcn_mfma_f32_16x16x32_bf16(v0_, PB[0][ct], O[dt][ct], 0, 0, 0); \
            O[dt][ct] = __builtin_amdgcn_mfma_f32_16x16x32_bf16(v1_, PB[1][ct], O[dt][ct], 0, 0, 0); } } } while (0)

__device__ __forceinline__ void sb_block(const Ctx& X, LAS unsigned char* lds, int unit) {
    unsigned char* ws = X.ws;
    const int tid = X.tid, lane = tid & 63, wave = tid >> 6, c = lane & 15, g = lane >> 4;
    const int b = unit >> 8, hd = (unit >> 6) & 3, t0 = (unit & 63) * 256;
    const bf16_t* z = (const bf16_t*)(ws + WS_Z) + (size_t)b * SEQ * ZLD;
    const bf16_t* vb = (const bf16_t*)(ws + WS_VT) + ((size_t)b * 8 + 2 + hd) * 64 * SEQ;
    const bf16_t* kb = z + ZC_KB + hd * 64;
    LAS bf16_t* KV = (LAS bf16_t*)lds;
    LAS int* flg = (LAS int*)(lds + LDS_MISC + 4096);
    STG_CONSTS();
    int tq[2]; bf16x8 qf[2][2]; float R[2] = {1.f, 1.f};
    f32x4 o[4][2];
#pragma unroll
    for (int ct = 0; ct < 2; ++ct) {
        tq[ct] = t0 + 32 * wave + 16 * ct + c;
        const bf16_t* qp = z + (size_t)tq[ct] * ZLD + ZC_QB + hd * 64 + 8 * g;
        qf[ct][0] = ldg8(qp); qf[ct][1] = ldg8(qp + 32);
#pragma unroll
        for (int dt = 0; dt < 4; ++dt) o[dt][ct] = (f32x4){0.f, 0.f, 0.f, 0.f};
    }
    const int kt_hi = (t0 + 255) >> 6, ktw = (t0 + 32 * wave + 31) >> 6;
    bool mydone = false;
    T_BAR();
    T_DMAK(kb, ZLD, kt_hi * 64, 0); T_DMAV(vb, SEQ, kt_hi * 64, 0);
    if (kt_hi >= 1) { T_DMAK(kb, ZLD, (kt_hi - 1) * 64, 1); T_DMAV(vb, SEQ, (kt_hi - 1) * 64, 1); }
    int stp = 0;
    for (int kt = kt_hi; kt >= 0; --kt, ++stp) {
        const int k0 = kt * 64, bi = stp % 3;
        if (kt >= 1) T_WAIT(2); else T_WAIT(0);
        T_BAR();
        if (stp > 0) {
            const LAS int* f = flg + ((stp - 1) & 1) * 8;
            if ((f[0] | f[1] | f[2] | f[3] | f[4] | f[5] | f[6] | f[7]) == 0) break;
        }
        if (kt >= 2) { T_DMAK(kb, ZLD, k0 - 128, (stp + 2) % 3); T_DMAV(vb, SEQ, k0 - 128, (stp + 2) % 3); }
        if (kt <= ktw && !mydone) {
            f32x4 s[2][2][2]; bf16x8 pb[2][2];
            QK2Z(bi, s);
#pragma unroll
            for (int ct = 0; ct < 2; ++ct) {
                const int d0 = tq[ct] - (k0 + 8 * g);
                float pex[2][8], tot[2], above[2];
#pragma unroll
                for (int ch = 1; ch >= 0; --ch) {
                    float run = 1.f;
#pragma unroll
                    for (int jj = 7; jj >= 0; --jj) {
                        const int T = jj >> 2, i = jj & 3;
                        const float zc = __builtin_amdgcn_fmed3f(s[ch][T][ct][i], -80.f, 80.f);
                        const bool ok = (d0 - (32 * ch + jj)) > 0;
                        const float t = fexp2(-zc * LOG2E), r = frcp(1.f + t);
                        s[ch][T][ct][i] = ok ? r : 0.f;
                        pex[ch][jj] = run;
                        run *= ok ? t * r : 1.f;
                    }
                    const float x16 = shx<16>(run, lane), a2 = run * x16, x32 = shx<32>(a2, lane);
                    above[ch] = (g == 3) ? 1.f : (g == 2) ? x16 : (g == 1) ? x32 : x16 * x32;
                    tot[ch] = a2 * x32;
                }
#pragma unroll
                for (int ch = 0; ch < 2; ++ch) {
                    const float base = R[ct] * above[ch] * ((ch == 0) ? tot[1] : 1.f);
#pragma unroll
                    for (int jj = 0; jj < 8; ++jj) { const int T = jj >> 2, i = jj & 3; s[ch][T][ct][i] *= base * pex[ch][jj]; }
                    pb[ch][ct] = pack_p(s[ch][0][ct], s[ch][1][ct]);
                }
                R[ct] *= tot[0] * tot[1];
            }
            PV2(bi, pb, o);
            mydone = __all((R[0] == 0.f) && (R[1] == 0.f)) != 0;
        }
        if (lane == 0) flg[(stp & 1) * 8 + wave] = (!mydone && kt > 0) ? 1 : 0;
        asm volatile("s_waitcnt lgkmcnt(0)" ::: "memory");
    }
    T_WAIT(0);
    bf16_t* ob = (bf16_t*)(ws + WS_O) + (size_t)b * SEQ * 1024 + 512 + hd * 64;
#pragma unroll
    for (int ct = 0; ct < 2; ++ct)
#pragma unroll
        for (int dt = 0; dt < 4; ++dt) {
            u32x2 w; w[0] = cvt_pk_bf16(o[dt][ct][0], o[dt][ct][1]); w[1] = cvt_pk_bf16(o[dt][ct][2], o[dt][ct][3]);
            stg2u(ob + (size_t)tq[ct] * 1024 + 16 * dt + 4 * g, w);
        }
}

__device__ __forceinline__ void swa_block(const Ctx& X, LAS unsigned char* lds, int layer, int unit) {
    unsigned char* ws = X.ws;
    const int tid = X.tid, lane = tid & 63, wave = tid >> 6, c = lane & 15, g = lane >> 4, hg = c & 1;
    const int b = unit >> 8, gk = (unit >> 7) & 1, t0 = (unit & 127) * 128;
    const int hd = gk * 2 + hg;
    const bf16_t* z = (const bf16_t*)(ws + WS_Z) + (size_t)b * SEQ * ZLD;
    const bf16_t* vb = (const bf16_t*)(ws + WS_VT) + ((size_t)b * 8 + 6 + gk) * 64 * SEQ;
    const bf16_t* kb = z + ZC_KC + gk * 64;
    LAS bf16_t* KV = (LAS bf16_t*)lds;
    STG_CONSTS();
    int tq[2]; float slope[2]; bf16x8 qf[2][2];
    const float sl = exp2f(-8.f * (float)(hd + 1) / 12.f) * LOG2E;
    const float sink = INP(I_SINK)[layer * 4 + hd] * LOG2E;
    SmState<2> st; sm_init<2>(st);
#pragma unroll
    for (int ct = 0; ct < 2; ++ct) {
        tq[ct] = t0 + 16 * wave + 8 * ct + (c >> 1); slope[ct] = sl;
        const bf16_t* qp = z + (size_t)tq[ct] * ZLD + ZC_QC + hd * 64 + 8 * g;
        qf[ct][0] = ldg8(qp); qf[ct][1] = ldg8(qp + 32);
        st.m[ct] = sink; st.l[ct] = (g == 0) ? 1.f : 0.f;
    }
    const int t_lo = t0 + 16 * wave, t_hi = t_lo + 15;
    int kt0 = (t0 - 127) >> 6; if (kt0 < 0) kt0 = 0;
    const int kt1 = (t0 + 127) >> 6;
    const unsigned Wv[2] = {128u, 128u};
    T_BAR();
    T_DMAK(kb, ZLD, kt0 * 64, 0); T_DMAV(vb, SEQ, kt0 * 64, 0); if (kt0 < kt1) { T_DMAK(kb, ZLD, kt0 * 64 + 64, 1); T_DMAV(vb, SEQ, kt0 * 64 + 64, 1); }
    for (int kt = kt0; kt <= kt1; ++kt) {
        const int k0 = kt * 64, bi = (kt - kt0) % 3;
        if (kt < kt1) T_WAIT(2); else T_WAIT(0);
        T_BAR();
        if (kt + 2 <= kt1) { T_DMAK(kb, ZLD, k0 + 128, (kt - kt0 + 2) % 3); T_DMAV(vb, SEQ, k0 + 128, (kt - kt0 + 2) % 3); }
        if (k0 <= t_hi && k0 + 63 >= t_lo - 127) {
            f32x4 s[2][2][2]; bf16x8 pb[2][2];
            QK2Z(bi, s);
            const int d0[2] = {tq[0] - (k0 + 8 * g), tq[1] - (k0 + 8 * g)};
            sm_soft<2, 1>(st, s, pb, d0, slope, Wv, lane);
            PV2(bi, pb, st.o);
        }
    }
    sm_finish<2>(st, lane);
    bf16_t* oc = (bf16_t*)(ws + WS_O) + (size_t)b * SEQ * 1024 + 768 + hd * 64;
#pragma unroll
    for (int ct = 0; ct < 2; ++ct)
#pragma unroll
        for (int dt = 0; dt < 4; ++dt) {
            u32x2 w; w[0] = cvt_pk_bf16(st.o[dt][ct][0], st.o[dt][ct][1]); w[1] = cvt_pk_bf16(st.o[dt][ct][2], st.o[dt][ct][3]);
            stg2u(oc + (size_t)tq[ct] * 1024 + 16 * dt + 4 * g, w);
        }
}
#undef STG_CONSTS
#undef T_DMAK
#undef T_DMAV
#undef T_KB
#undef T_VB
#undef T_WAIT
#undef T_BAR
#undef QK2Z
#undef PV2

struct SchedC1 {
    static constexpr bool GATHER = false, FP8 = false, CHAIN = false;
    int lda2, akstep, ldb2; const char* Z; const char* W1; int G, c;
    __device__ __forceinline__ bool next(int i, GU& u) const {
        const int L = i * G + c; if (L >= 16) return false;
        const int mat = L >> 3, pm = L & 7;
        u.A = Z + (size_t)pm * 256 * lda2 + (mat ? ZC_VCS : ZC_KCS) * 2; u.B = W1 + (size_t)mat * 256 * 2048 * 2; u.nt = 32; u.kind = 0; u.pm = pm; u.pn = 0; u.e = mat; u.aux = 0; return true;
    }
    __device__ __forceinline__ void rowoff(const GU&, int, unsigned (&)[2][2]) const {}
};

#ifndef MK_PER_STEP
#define MK_PER_STEP 0
#endif
constexpr int NSTEP = 2 + 10 * NL;
#define PHASE_FN __device__ __forceinline__

PHASE_FN void f_prologue(Ctx Xa) { const Ctx X = uni(Xa); p0_prologue(X, X.lds); }
PHASE_FN void f_norm0(Ctx Xa, int l) { const Ctx X = uni(Xa); norm_phase<0>(X, X.lds, l); }
PHASE_FN void f_norm1(Ctx Xa, int l) { const Ctx X = uni(Xa); norm_phase<1>(X, X.lds, l); }
PHASE_FN void f_norm2(Ctx Xa, int l) { const Ctx X = uni(Xa); norm2_mfma(X, X.lds, l); }
PHASE_FN void f_norm3(Ctx Xa, int l) { const Ctx X = uni(Xa); norm_phase<3>(X, X.lds, l); }
PHASE_FN void f_inproj(Ctx Xa, int la) {
    const Ctx X = uni(Xa); const int l = la; unsigned char* ws = X.ws;
    SchedDense S{2048, 128, 2048, (const char*)(ws + WS_H), (const char*)(ws + WS_WIN) + (size_t)l * 2304 * 2048, 128, 9, 16, X.G, X.bid};
    EpiZ E{(bf16_t*)(ws + WS_Z), (bf16_t*)(ws + WS_VT), INP(I_NQG) + l * 64, INP(I_NKG) + l * 192, INP(I_SQG) + l * 64, INP(I_SKG) + l * 64};
    gemm_run(X.lds, S, E, X.tid);
    { const int nunits = 128 * 9, rounds = (nunits + X.G - 1) / X.G;
      if (nunits % X.G != 0 && X.bid >= nunits - (rounds - 1) * X.G) conv_fill(X, X.lds, l + 1, 4, false); }
}
PHASE_FN void f_cmp1(Ctx Xa, int la) {
    const Ctx X = uni(Xa); const int l = la; unsigned char* ws = X.ws;
    SchedC1 S{16 * ZLD * 2, ZLD * 2, 4096, (const char*)(ws + WS_Z), (const char*)(ws + WS_W1) + (size_t)l * 2 * 256 * 2048 * 2, X.G, X.bid};
    EpiC1 E{(bf16_t*)(ws + WS_HID), (const float*)(ws + WS_CB) + l * 512};
    gemm_run(X.lds, S, E, X.tid);
    if (X.bid < 16) {
        __builtin_amdgcn_fence(__ATOMIC_RELEASE, "workgroup"); __syncthreads(); __builtin_amdgcn_fence(__ATOMIC_ACQUIRE, "workgroup");
        for (int L = X.bid; L < 16; L += X.G)
            for (int j = X.tid >> 6; j < 16; j += 8) cmp2_unit(X, l, (L >> 3) * 128 + (L & 7) * 16 + j);
    }
}
PHASE_FN void f_cmp2(Ctx Xa, int la) {
    const Ctx X = uni(Xa); const int l = la;
    for (int u = X.bid * 8 + (X.tid >> 6); u < 256; u += X.G * 8) cmp2_unit(X, l, u);
}
PHASE_FN void f_nsa(Ctx Xa, int la, int qk) {
    const Ctx X = uni(Xa); const int l = la;
    unsigned* ctl = (unsigned*)(X.ws + WS_CTL);
    LAS int* bc = (LAS int*)(X.lds + LDS_MISC + 32);
    PRB_DECL();
#if !PRB_SEL
    unsigned long long prb_acc = 0ull;
#endif
    unsigned* qhead = ctl + CW_Q + 64 * (l * 4 + qk);
    float mref;
    { const int lane = X.tid & 63, layer = l;
        float gq = fabsf(INP(I_NQG)[layer * 64 + lane]);
        const float* kg = INP(I_NKG) + layer * 192;
        float gk = fmaxf(fmaxf(fabsf(kg[lane]), fabsf(kg[64 + lane])), fabsf(kg[128 + lane]));
        gq = fmaxf(gq, shx<32>(gq, lane)); gq = fmaxf(gq, shx<16>(gq, lane)); gq = fmaxf(gq, shx<8>(gq, lane)); gq = fmaxf(gq, shx<4>(gq, lane)); gq = fmaxf(gq, shx<2>(gq, lane)); gq = fmaxf(gq, shx<1>(gq, lane));
        gk = fmaxf(gk, shx<32>(gk, lane)); gk = fmaxf(gk, shx<16>(gk, lane)); gk = fmaxf(gk, shx<8>(gk, lane)); gk = fmaxf(gk, shx<4>(gk, lane)); gk = fmaxf(gk, shx<2>(gk, lane)); gk = fmaxf(gk, shx<1>(gk, lane));
        mref = 8.f * LOG2E * 1.01f * gq * gk;
    }
    int nxt = 0;
    if (X.tid == 0) nxt = (int)atomicAdd(qhead, 1u);
    for (;;) {
        PRB_BEGIN(1);
        if (X.tid == 0) bc[0] = nxt;
        __syncthreads();
        const int idx = bc[0];
        __syncthreads();
        PRB_END(1);
        if (idx >= 1024) break;
        nsa_block(X, X.lds, (idx & 1) * 512 + (511 - (idx >> 1)), l, prb_acc, qhead, nxt, mref);
    }
    PRB_FLUSH(X);
}
PHASE_FN void f_sbswa(Ctx Xa, int la, int qk) {
    const Ctx X = uni(Xa); const int l = la;
    unsigned* ctl = (unsigned*)(X.ws + WS_CTL);
    LAS int* bc = (LAS int*)(X.lds + LDS_MISC + 32);
    for (;;) {
        if (X.tid == 0) bc[0] = (int)atomicAdd(ctl + CW_Q + 64 * (l * 4 + qk) + 16, 1u);
        __syncthreads();
        const int idx = bc[0];
        __syncthreads();
        if (idx >= 1024) break;
        if (idx < 512) sb_block(X, X.lds, idx);
        else swa_block(X, X.lds, l, idx - 512);
    }
}
PHASE_FN void f_e1(Ctx Xa, int la) {
    const Ctx X = uni(Xa); const int l = la; unsigned char* ws = X.ws;
    EpiE1G EG{(unsigned char*)(ws + WS_SB) + (size_t)X.bid * 262144};
    EpiE1T ET{(unsigned char*)(ws + WS_SB) + (size_t)X.bid * 262144, (bf16_t*)(ws + WS_Y)};
    for (int T = 0; T * X.G < 512; ++T) {
        SchedE1G SG{1024, 128, 2048, (const char*)(ws + WS_H8), (const char*)(ws + WS_WM8) + (size_t)l * 3072 * 1024, X.G, X.bid, T};
        gemm_run(X.lds, SG, EG, X.tid);
        SchedE1T ST{2048, 128, 2048, (const char*)(ws + WS_O), (const char*)(ws + WS_WB) + (size_t)l * 1024 * 2048, X.G, X.bid, T};
        gemm_run(X.lds, ST, ET, X.tid);
    }
}
PHASE_FN void f_e2(Ctx Xa, int la) {
    const Ctx X = uni(Xa); const int l = la; unsigned char* ws = X.ws;
    const float* modl = (const float*)(ws + WS_MOD) + (size_t)l * 2 * 6144;
    SchedDense S{2048, 128, 2048, (const char*)(ws + WS_Y), (const char*)(ws + WS_WO) + (size_t)l * 1024 * 2048, 128, 4, 16, X.G, X.bid};
    EpiE2 E{(bf16_t*)(ws + WS_XB), modl + 2048, (float*)(ws + WS_SSP)};
    gemm_run(X.lds, S, E, X.tid);
}
__device__ __forceinline__ void moe_table(const Ctx& X, int l) {
    LAS int* tpre = (LAS int*)(X.lds + LDS_MISC + 256);
    if (X.tid < 16) {
        const unsigned* gcnt = (const unsigned*)(X.ws + WS_CTL) + CW_GCNT + 16 * (l * 16);
        tpre[17 + X.tid] = (int)__hip_atomic_load((GAS unsigned*)(gcnt + 16 * X.tid), __ATOMIC_RELAXED, __HIP_MEMORY_SCOPE_AGENT);
    }
    __syncthreads();
    if (X.tid < 17) {
        int run = 0;
        for (int e = 0; e < X.tid; ++e) run += (tpre[17 + e] + 255) >> 8;
        tpre[X.tid] = run;
        if (X.tid < 16) tpre[34 + X.tid] = run * 256;
    }
    __syncthreads();
}
PHASE_FN void f_g1(Ctx Xa, int la) {
    const Ctx X = uni(Xa); const int l = la; unsigned char* ws = X.ws;
    moe_table(X, l);
    const LAS int* tpre = (const LAS int*)(X.lds + LDS_MISC + 256);
    SchedMoE S{2048, 128, 2048, (const char*)(ws + WS_H), (const char*)(ws + WS_WGU) + (size_t)l * 16 * 1024 * 2048, (size_t)1024 * 2048, 4, 16, X.G, X.bid, 1, tpre, (const int*)(ws + WS_LISTT)};
    EpiG1 E{(bf16_t*)(ws + WS_AB)};
    gemm_run(X.lds, S, E, X.tid);
    { const int nunits = tpre[16] * 4, rounds = (nunits + X.G - 1) / X.G, cx = (X.G % 8 == 0) ? (X.bid % 8) * (X.G / 8) + X.bid / 8 : X.bid;
      if (nunits % X.G != 0 && cx >= nunits - (rounds - 1) * X.G) conv_fill(X, X.lds, l + 1, 4, false); }
}
PHASE_FN void f_g2(Ctx Xa, int la) {
    const Ctx X = uni(Xa); const int l = la; unsigned char* ws = X.ws;
    moe_table(X, l);
    const LAS int* tpre = (const LAS int*)(X.lds + LDS_MISC + 256);
    SchedMoE S{1024, 128, 1024, (const char*)(ws + WS_AB), (const char*)(ws + WS_WD) + (size_t)l * 16 * 1024 * 1024, (size_t)1024 * 1024, 4, 8, X.G, X.bid, 2, tpre, (const int*)(ws + WS_LISTT)};
    EpiG2 E{(bf16_t*)(ws + WS_YS)};
    gemm_run(X.lds, S, E, X.tid);
    conv_fill(X, X.lds, l + 1, 0, true);
}

__global__ void __launch_bounds__(512, 2) mega_fwd(Params P) {
    extern __shared__ __attribute__((aligned(16))) unsigned char lds_raw[];
    LAS unsigned char* lds = (LAS unsigned char*)lds_raw;
    const int tid = threadIdx.x;
    unsigned* ctl = (unsigned*)(P.ws + WS_CTL);
    if (tid < 64) ((LAS unsigned*)(lds + LDS_MISC))[tid] = 0u;
    if (tid < 27) *(LAS unsigned long long*)(lds + LDS_PTAB + 8 * tid) = (unsigned long long)P.in[tid];
    if ((tid & 63) == 0) *(LAS int*)(lds + LDS_WTAB + 4 * ((unsigned)__builtin_amdgcn_s_getreg((5 << 11) | 4) & 63u)) = tid >> 6;
    __syncthreads();
    XcdBarrier bar = xcd_barrier_post(ctl, (volatile LAS unsigned*)(lds + LDS_MISC));
    Ctx X; X.ws = P.ws; X.out = P.out; X.lds = lds; X.tid = 0; X.bid = 0; X.G = 0;
    const int lo = P.step_lo, hi = P.step_hi;
#define IN(s) (lo <= (s) && (s) < hi)
#define SEAM(s) do { if ((s) + 1 < hi) xcd_barrier(bar); } while (0)
#ifndef DBL
#define DBL 0
#endif
    if (IN(0)) { f_prologue(X); if (DBL & 1) f_prologue(X); SEAM(0); }
    for (int l = 0; l < NL; ++l) {
        const int s0 = 1 + 10 * l;
        if (IN(s0 + 0)) { if (l == 0) f_norm0(X, l); else f_norm1(X, l); SEAM(s0 + 0); }
        if (IN(s0 + 1)) { f_inproj(X, l); if (DBL & 2) f_inproj(X, l); SEAM(s0 + 1); }
        if (IN(s0 + 2)) { f_cmp1(X, l); __syncthreads(); f_sbswa(X, l, 1); if (DBL & 64) f_sbswa(X, l, 2); SEAM(s0 + 2); }
        if (IN(s0 + 4)) { f_nsa(X, l, 1); if (DBL & 4) f_nsa(X, l, 2); SEAM(s0 + 4); }
        if (IN(s0 + 5)) { f_e1(X, l); if (DBL & 8) f_e1(X, l); SEAM(s0 + 5); }
        if (IN(s0 + 6)) { f_e2(X, l); SEAM(s0 + 6); }
        if (IN(s0 + 7)) { f_norm2(X, l); SEAM(s0 + 7); }
        if (IN(s0 + 8)) { f_g1(X, l); if (DBL & 16) f_g1(X, l); SEAM(s0 + 8); }
        if (IN(s0 + 9)) { f_g2(X, l); if (DBL & 32) f_g2(X, l); SEAM(s0 + 9); }
    }
    if (IN(NSTEP - 1)) f_norm3(X, NL);
#undef IN
#undef SEAM
}

extern "C" void kernel_launch(void* const* d_in, const int* in_sizes, int n_in, void* d_out, int out_size, void* d_ws, size_t ws_size, hipStream_t stream) {
    static int grid = 0;
    if (grid == 0) {
        if (n_in != 27 || out_size != NTOK * DM || ws_size < WS_END) { fprintf(stderr, "kernel_launch: unexpected shapes/workspace (n_in %d out %d ws %zu need %zu)\n", n_in, out_size, ws_size, (size_t)WS_END); grid = -1; return; }
        int dev = 0, cus = 0, per_cu = 0;
        if (hipGetDevice(&dev) != hipSuccess || hipDeviceGetAttribute(&cus, hipDeviceAttributeMultiprocessorCount, dev) != hipSuccess) { grid = -1; return; }
        if (hipFuncSetAttribute((const void*)mega_fwd, hipFuncAttributeMaxDynamicSharedMemorySize, LDS_BYTES) != hipSuccess) { fprintf(stderr, "kernel_launch: hipFuncSetAttribute failed\n"); grid = -1; return; }
        if (hipOccupancyMaxActiveBlocksPerMultiprocessor(&per_cu, (const void*)mega_fwd, 512, LDS_BYTES) != hipSuccess || per_cu < 1) { fprintf(stderr, "kernel_launch: occupancy query says %d\n", per_cu); }
        (void)hipGetLastError();
        grid = cus;
        if (grid > 256) grid = 256;
        if (grid < 64) { grid = -1; return; }
    }
    if (grid < 0) return;
    if (hipMemsetAsync((char*)d_ws + WS_CTL, 0, 64 * 1024, stream) != hipSuccess) return;
    Params p{};
    for (int i = 0; i < 27; ++i) p.in[i] = (const float*)d_in[i];
    p.out = (float*)d_out; p.ws = (unsigned char*)d_ws;
#if MK_PER_STEP
    for (int s = 0; s < NSTEP; ++s) { p.step_lo = s; p.step_hi = s + 1; hipLaunchKernelGGL(mega_fwd, dim3(grid), dim3(512), LDS_BYTES, stream, p); }
#else
    p.step_lo = 0; p.step_hi = NSTEP;
    hipLaunchKernelGGL(mega_fwd, dim3(grid), dim3(512), LDS_BYTES, stream, p);
#endif
}
```

```cpp
#include <hip/hip_runtime.h>
#include <stdio.h>
#include <stdint.h>

#define LAS __attribute__((address_space(3)))
#define GAS __attribute__((address_space(1)))
typedef unsigned short bf16_t;
typedef short bf16x8 __attribute__((ext_vector_type(8)));
typedef float f32x4 __attribute__((ext_vector_type(4)));
typedef unsigned u32x4 __attribute__((ext_vector_type(4)));
typedef unsigned u32x2 __attribute__((ext_vector_type(2)));

constexpr int NTOK = 32768, SEQ = 16384, DM = 1024, NL = 4, NB = 2;
constexpr int NIN = 5272;
constexpr int ZLD = 2304;
constexpr int ZC_QA = 0, ZC_KCS = 512, ZC_VCS = 576, ZC_KSL = 640, ZC_VSL = 704, ZC_KWN = 768, ZC_VWN = 832,
              ZC_QB = 896, ZC_KB = 1152, ZC_VB = 1408, ZC_QC = 1664, ZC_KC = 1920, ZC_VC = 2048, ZC_GA = 2176;
constexpr int LCAP = 32768;
constexpr int AROWS = 65536 + 16 * 256;
constexpr float LOG2E = 1.4426950408889634f;
constexpr float LN2 = 0.6931471805599453f;
constexpr int LDS_BYTES = 147456;
constexpr int LDS_MISC = 131072;

constexpr size_t KiB = 1024, MiB = 1024 * 1024;
constexpr size_t WS_CTL = 0;
constexpr size_t WS_MOD = WS_CTL + 64 * KiB;
constexpr size_t WS_CB = WS_MOD + 192 * KiB;
constexpr size_t WS_LISTT = WS_CB + 8 * KiB;
constexpr size_t WS_LISTW = WS_LISTT + 2 * MiB;
constexpr size_t WS_KCMP = WS_LISTW + 2 * MiB;
constexpr size_t WS_VCMPT = WS_KCMP + 256 * KiB;
constexpr size_t WS_HID = WS_VCMPT + 256 * KiB;
constexpr size_t WS_SSP = WS_HID + 2 * MiB;
constexpr size_t WS_WIN = WS_SSP + 2 * MiB;
constexpr size_t WS_WM = WS_WIN + (size_t)NL * 2304 * 1024 * 2;
constexpr size_t WS_WB = WS_WM + (size_t)NL * 3072 * 1024 * 2;
constexpr size_t WS_WO = WS_WB + (size_t)NL * 1024 * 1024 * 2;
constexpr size_t WS_W1 = WS_WO + (size_t)NL * 1024 * 1024 * 2;
constexpr size_t WS_W2 = WS_W1 + (size_t)NL * 2 * 256 * 2048 * 2;
constexpr size_t WS_WGU = WS_W2 + (size_t)NL * 2 * 64 * 256 * 2;
constexpr size_t WS_WD = WS_WGU + (size_t)NL * 16 * 1024 * 1024 * 2;
constexpr size_t WS_H = WS_WD + (size_t)NL * 16 * 1024 * 512 * 2;
constexpr size_t WS_Z = WS_H + (size_t)NTOK * 1024 * 2;
constexpr size_t Z_BYTES = (size_t)(NTOK + 64) * ZLD * 2;
constexpr size_t WS_Y = WS_Z;
constexpr size_t WS_SB = WS_Z + 64 * MiB;
constexpr size_t WS_AB = WS_Z + 64 * MiB;
constexpr size_t WS_R3 = WS_Z + Z_BYTES;
constexpr size_t WS_YB = WS_R3;
constexpr size_t WS_VT = WS_R3;
constexpr size_t WS_O = WS_R3 + 32 * MiB;
constexpr size_t WS_XB = WS_R3 + 136 * MiB;
constexpr size_t WS_TINFO = WS_XB + 64 * MiB;
constexpr size_t WS_YS = WS_R3;
constexpr size_t WS_H8 = WS_TINFO + 1 * MiB;
constexpr size_t WS_WM8 = WS_H8 + 32 * MiB;
constexpr size_t WS_END = WS_WM8 + 12 * MiB;
static_assert(64 * MiB + (size_t)AROWS * 512 * 2 <= Z_BYTES, "alias map");

constexpr int CW_Q = 4096;
constexpr int CW_GCNT = 6144;

__device__ __forceinline__ unsigned cvt_pk_bf16(float lo, float hi) { unsigned r; asm("v_cvt_pk_bf16_f32 %0, %1, %2" : "=v"(r) : "v"(lo), "v"(hi)); return r; }
__device__ __forceinline__ bf16_t f2bf(float f) { return (bf16_t)(cvt_pk_bf16(f, 0.f) & 0xffffu); }
__device__ __forceinline__ float bf_lo(unsigned u) { return __uint_as_float(u << 16); }
__device__ __forceinline__ float bf_hi(unsigned u) { return __uint_as_float(u & 0xffff0000u); }
__device__ __forceinline__ float bf2f(bf16_t b) { return __uint_as_float(((unsigned)b) << 16); }
__device__ __forceinline__ float fexp2(float x) { return __builtin_amdgcn_exp2f(x); }
__device__ __forceinline__ float flog2(float x) { return __builtin_amdgcn_logf(x); }
__device__ __forceinline__ float frcp(float x) { return __builtin_amdgcn_rcpf(x); }
__device__ __forceinline__ float sigmoidf_(float x) { return frcp(1.f + fexp2(-x * LOG2E)); }
template <int M> __device__ __forceinline__ int shxi(int v, int lane) {
    if constexpr (M < 32) return __builtin_amdgcn_ds_swizzle(v, (M << 10) | 0x1f);
    else return __builtin_amdgcn_ds_bpermute((lane ^ 32) << 2, v);
}
template <int M> __device__ __forceinline__ float shx(float v, int lane) { return __int_as_float(shxi<M>(__float_as_int(v), lane)); }
__device__ __forceinline__ float sum8_dpp(float v) {
    v += __int_as_float(__builtin_amdgcn_update_dpp(__float_as_int(v), __float_as_int(v), 0xB1, 0xf, 0xf, true));
    v += __int_as_float(__builtin_amdgcn_update_dpp(__float_as_int(v), __float_as_int(v), 0x4E, 0xf, 0xf, true));
    v += __int_as_float(__builtin_amdgcn_update_dpp(__float_as_int(v), __float_as_int(v), 0x141, 0xf, 0xf, true));
    return v;
}
__device__ __forceinline__ unsigned wave_umax(unsigned k, int lane) {
    unsigned o;
    o = (unsigned)__builtin_amdgcn_update_dpp((int)k, (int)k, 0xB1, 0xf, 0xf, true); k = k > o ? k : o;
    o = (unsigned)__builtin_amdgcn_update_dpp((int)k, (int)k, 0x4E, 0xf, 0xf, true); k = k > o ? k : o;
    o = (unsigned)__builtin_amdgcn_update_dpp((int)k, (int)k, 0x141, 0xf, 0xf, true); k = k > o ? k : o;
    o = (unsigned)__builtin_amdgcn_update_dpp((int)k, (int)k, 0x140, 0xf, 0xf, true); k = k > o ? k : o;
    o = (unsigned)shxi<16>((int)k, lane); k = k > o ? k : o;
    o = (unsigned)shxi<32>((int)k, lane); k = k > o ? k : o;
    return k;
}
__device__ __forceinline__ float wave_sum(float v, int lane) {
    v += shx<32>(v, lane); v += shx<16>(v, lane); v += shx<8>(v, lane); v += shx<4>(v, lane); v += shx<2>(v, lane); v += shx<1>(v, lane);
    return v;
}
__device__ __forceinline__ bf16x8 ldg8(const bf16_t* p) { return *(const GAS bf16x8*)p; }
__device__ __forceinline__ u32x4 ldg4u(const void* p) { return *(const GAS u32x4*)p; }
__device__ __forceinline__ u32x2 ldg2u(const void* p) { return *(const GAS u32x2*)p; }
__device__ __forceinline__ f32x4 ldg4f(const float* p) { return *(const GAS f32x4*)p; }
__device__ __forceinline__ void stg4u(void* p, u32x4 v) { *(GAS u32x4*)p = v; }
__device__ __forceinline__ void stg2u(void* p, u32x2 v) { *(GAS u32x2*)p = v; }
__device__ __forceinline__ void stg4f(float* p, f32x4 v) { *(GAS f32x4*)p = v; }

#define XB_TMO      128
#define XB_XCNT(j)  (256  + 64 * (j))
#define XB_XSUB(j)  (1280 + 64 * (j))
#define XB_XGEN(j)  (2304 + 64 * (j))
#define XB_TOP      3328
#define XB_TOPGEN   3392
#define XCD_BAR_WORDS 3456
#define XB_SPIN_CAP (1u << 18)
__device__ __forceinline__ unsigned xb_ld(unsigned* p)              { return __hip_atomic_load(p, __ATOMIC_RELAXED, __HIP_MEMORY_SCOPE_AGENT); }
__device__ __forceinline__ unsigned xb_add(unsigned* p, unsigned v) { return __hip_atomic_fetch_add(p, v, __ATOMIC_RELAXED, __HIP_MEMORY_SCOPE_AGENT); }
__device__ __forceinline__ unsigned xb_xcc_id() { return (unsigned)__builtin_amdgcn_s_getreg((3 << 11) | 20) & 0xFu; }
#define XB_SPIN(cond, bar) do { unsigned _sp = 0; while (cond) { __builtin_amdgcn_s_sleep(1); \
    if ((++_sp & 255u) == 0u) { if (xb_ld(&(bar)[XB_TMO])) break; if (_sp > XB_SPIN_CAP) { atomicAdd(&(bar)[XB_TMO], 1u); break; } } } } while (0)
constexpr int LDS_WTAB = 131072 + 12288;
__device__ __forceinline__ int tid_rebuild(const LAS unsigned char* lds) {
    const unsigned hw = (unsigned)__builtin_amdgcn_s_getreg((5 << 11) | 4) & 63u;
    const int wv = __builtin_amdgcn_readfirstlane(*(const LAS int*)(lds + LDS_WTAB + 4 * hw));
    int ln; asm volatile("v_mbcnt_lo_u32_b32 %0, -1, 0\n\tv_mbcnt_hi_u32_b32 %0, -1, %0" : "=v"(ln));
    return wv * 64 + ln;
}
struct XcdBarrier { unsigned* bar; unsigned x; volatile LAS unsigned* st; };
__device__ __forceinline__ XcdBarrier xcd_barrier_post(unsigned* bar, volatile LAS unsigned* st) {
    XcdBarrier b; b.bar = bar; b.x = xb_xcc_id(); b.st = st;
    if (tid_rebuild((const LAS unsigned char*)st - 131072) == 0) (void)xb_add(&bar[XB_XCNT(b.x)], 1u);
    return b;
}
__device__ __forceinline__ void xcd_barrier_complete(unsigned* bar, unsigned x, unsigned& nloc, unsigned& nx) {
    const unsigned G = gridDim.x * gridDim.y * gridDim.z;
    unsigned sum, cnt, mine, sp = 0u;
    for (;;) {
        sum = 0u; cnt = 0u; mine = 0u;
#pragma unroll
        for (unsigned j = 0; j < 16; ++j) { const unsigned c = xb_ld(&bar[XB_XCNT(j)]); sum += c; cnt += (c > 0u) ? 1u : 0u; mine = (j == x) ? c : mine; }
        if (sum == G) break;
        __builtin_amdgcn_s_sleep(1);
        if ((++sp & 255u) == 0u) { if (xb_ld(&bar[XB_TMO])) break; if (sp > XB_SPIN_CAP) { atomicAdd(&bar[XB_TMO], 1u); break; } }
    }
    nloc = mine > 0u ? mine : 1u; nx = cnt > 0u ? cnt : 1u;
}
__device__ __forceinline__ void xcd_barrier(const XcdBarrier& b) {
    asm volatile("s_waitcnt vmcnt(0)" ::: "memory");
    __syncthreads();
    if (tid_rebuild((const LAS unsigned char*)b.st - 131072) == 0) {
        unsigned* bar = b.bar;
        __builtin_amdgcn_s_waitcnt(0);
        unsigned nloc = b.st[0], nx = b.st[1];
        if (nloc == 0u) { xcd_barrier_complete(bar, b.x, nloc, nx); b.st[0] = nloc; b.st[1] = nx; }
        const unsigned old = xb_add(&bar[XB_XSUB(b.x)], 1u);
        const unsigned gen = old / nloc;
        if (old + 1u == (gen + 1u) * nloc) {
            __builtin_amdgcn_fence(__ATOMIC_RELEASE, "agent");
            asm volatile("s_waitcnt vmcnt(0)" ::: "memory");
            const unsigned og = xb_add(&bar[XB_TOP], 1u);
            const unsigned tg = og / nx;
            if (og + 1u == (tg + 1u) * nx) xb_add(&bar[XB_TOPGEN], 1u);
            else XB_SPIN(xb_ld(&bar[XB_TOPGEN]) == tg, bar);
            __builtin_amdgcn_fence(__ATOMIC_ACQUIRE, "agent");
            xb_add(&bar[XB_XGEN(b.x)], 1u);
            asm volatile("s_waitcnt vmcnt(0)" ::: "memory");
        } else {
            XB_SPIN(xb_ld(&bar[XB_XGEN(b.x)]) == gen, bar);
            __builtin_amdgcn_fence(__ATOMIC_ACQUIRE, "agent");
            asm volatile("s_waitcnt vmcnt(0)" ::: "memory");
        }
    }
    __syncthreads();
}

struct Params { const float* in[27]; float* out; unsigned char* ws; int step_lo, step_hi; };
struct Ctx { unsigned char* ws; float* out; LAS unsigned char* lds; int tid, bid, G; };
constexpr int LDS_PTAB = 131072 + 2048;
__device__ __forceinline__ unsigned long long uni64(unsigned long long v) {
    const unsigned lo = __builtin_amdgcn_readfirstlane((unsigned)v), hi = __builtin_amdgcn_readfirstlane((unsigned)(v >> 32)); return ((unsigned long long)hi << 32) | lo; }
__device__ __forceinline__ Ctx uni(Ctx X) { Ctx Y = X; int t = tid_rebuild(X.lds); asm volatile("" : "+v"(t)); Y.tid = t;
    unsigned long long w = (unsigned long long)X.ws; asm volatile("" : "+s"(w)); Y.ws = (unsigned char*)w;
    unsigned long long o = (unsigned long long)X.out; asm volatile("" : "+s"(o)); Y.out = (float*)o;
    int bb = blockIdx.x; asm volatile("" : "+s"(bb)); Y.bid = bb; int gg = gridDim.x; asm volatile("" : "+s"(gg)); Y.G = gg; return Y; }
__device__ __forceinline__ const float* ctx_in(const Ctx& X, int i) { return (const float*)uni64(*(const LAS unsigned long long*)(X.lds + LDS_PTAB + 8 * i)); }
#define INP(i) ctx_in(X, (i))
enum { I_X = 0, I_C, I_WADA, I_BADA, I_GMIX, I_GMOE, I_WIN, I_PEK, I_W1K, I_W2K, I_PEV, I_W1V, I_W2V, I_NQG, I_NKG, I_SQG, I_SKG, I_SINK,
       I_WBA, I_WBB, I_WBC, I_WOUT, I_WR, I_RB, I_WEG, I_WEU, I_WED };

#ifndef PRB_SEL
#define PRB_SEL 0
#endif
constexpr int CW_PRB = 7168;
#if PRB_SEL
#define PRB_DECL() unsigned long long prb_acc = 0ull, prb_t0 = 0ull; const unsigned long long prb_start = __builtin_readcyclecounter()
#define PRB_BEGIN(n) do { if ((n) == PRB_SEL) prb_t0 = __builtin_readcyclecounter(); } while (0)
#define PRB_END(n) do { if ((n) == PRB_SEL) prb_acc += __builtin_readcyclecounter() - prb_t0; } while (0)
#define PRB_FLUSH(X) do { if (((X).tid & 63) == 0) { unsigned* c_ = (unsigned*)((X).ws + WS_CTL); atomicAdd(c_ + CW_PRB, (unsigned)(prb_acc >> 8)); \
        atomicAdd(c_ + CW_PRB + 16, (unsigned)((__builtin_readcyclecounter() - prb_start) >> 8)); } } while (0)
#else
#define PRB_DECL() do {} while (0)
#define PRB_BEGIN(n) do {} while (0)
#define PRB_END(n) do {} while (0)
#define PRB_FLUSH(X) do {} while (0)
#endif

constexpr int CONV_PER_L = 576 + 768 + 256 + 256 + 256 + 8 + 4096 + 2048;
constexpr int CW_CVQ = 7680;
__device__ __forceinline__ void conv_tiles(const Ctx& X, LAS unsigned char* lds, int u0, int ustep, int uend) {
    unsigned char* ws = X.ws;
    const int tid = X.tid;
    LAS float* t32 = (LAS float*)lds;
    constexpr int PER_L = CONV_PER_L;
    const int lk = tid >> 3, lc8 = (tid & 7) * 8;
    const float* src = nullptr; const float* srcn = nullptr; bf16_t* dst = nullptr; bf16_t* dstn = nullptr; unsigned char* d8 = nullptr; unsigned char* d8n = nullptr;
    int src_ld = 0, dst_ld = 0, nvalid = 0, src_ldn = 0, dst_ldn = 0, nvalidn = 0;
    f32x4 va = (f32x4){0.f, 0.f, 0.f, 0.f}, vb = va, vna = va, vnb = va;
#define TDECODE(u, SRC, DST, SLD, DLD, NV, D8) do { \
            const int l = (u) / PER_L; int r = (u) % PER_L; NV = 64; D8 = nullptr; \
            if (r < 576) { const int n0 = (r / 16) * 64, k0 = (r % 16) * 64; int c0; \
                if (n0 < 896) c0 = n0; else if (n0 < 2176) c0 = n0 + 24; else if (n0 == 2176) { c0 = 896; NV = 24; } else { c0 = 0; NV = 0; } \
                SRC = INP(I_WIN) + ((size_t)l * 1024 + k0) * NIN + c0; SLD = NIN; DST = (bf16_t*)(ws + WS_WIN) + ((size_t)l * 2304 + n0) * 1024 + k0; DLD = 1024; } \
            else if ((r -= 576) < 768) { const int n0 = (r / 16) * 64, k0 = (r % 16) * 64; \
                SRC = INP(I_WIN) + ((size_t)l * 1024 + k0) * NIN + 2200 + n0; SLD = NIN; DST = (bf16_t*)(ws + WS_WM) + ((size_t)l * 3072 + n0) * 1024 + k0; DLD = 1024; \
                D8 = ws + WS_WM8 + ((size_t)l * 3072 + n0) * 1024 + k0; } \
            else if ((r -= 768) < 256) { const int n0 = (r / 16) * 64, k0 = (r % 16) * 64; \
                if (k0 < 512) SRC = INP(I_WBA) + ((size_t)l * 512 + k0) * 1024 + n0; \
                else if (k0 < 768) SRC = INP(I_WBB) + ((size_t)l * 256 + (k0 - 512)) * 1024 + n0; \
                else SRC = INP(I_WBC) + ((size_t)l * 256 + (k0 - 768)) * 1024 + n0; \
                SLD = 1024; DST = (bf16_t*)(ws + WS_WB) + ((size_t)l * 1024 + n0) * 1024 + k0; DLD = 1024; } \
            else if ((r -= 256) < 256) { const int n0 = (r / 16) * 64, k0 = (r % 16) * 64; \
                SRC = INP(I_WOUT) + ((size_t)l * 1024 + k0) * 1024 + n0; SLD = 1024; DST = (bf16_t*)(ws + WS_WO) + ((size_t)l * 1024 + n0) * 1024 + k0; DLD = 1024; } \
            else if ((r -= 256) < 256) { const int mat = r / 128, rr = r % 128, n0 = (rr / 32) * 64, k0 = (rr % 32) * 64; \
                SRC = INP(mat ? I_W1V : I_W1K) + ((size_t)l * 2048 + k0) * 256 + n0; SLD = 256; DST = (bf16_t*)(ws + WS_W1) + (((size_t)l * 2 + mat) * 256 + n0) * 2048 + k0; DLD = 2048; } \
            else if ((r -= 256) < 8) { const int mat = r / 4, k0 = (r % 4) * 64; \
                SRC = INP(mat ? I_W2V : I_W2K) + ((size_t)l * 256 + k0) * 64; SLD = 64; DST = (bf16_t*)(ws + WS_W2) + (((size_t)l * 2 + mat) * 64) * 256 + k0; DLD = 256; } \
            else if ((r -= 8) < 4096) { const int e = r / 256, rr = r % 256, n0 = (rr / 16) * 64, k0 = (rr % 16) * 64; \
                const int blk = n0 / 256, half = (n0 % 256) / 128, c0 = blk * 128 + (n0 % 128); \
                SRC = INP(half ? I_WEU : I_WEG) + (((size_t)l * 16 + e) * 1024 + k0) * 512 + c0; SLD = 512; DST = (bf16_t*)(ws + WS_WGU) + (((size_t)l * 16 + e) * 1024 + n0) * 1024 + k0; DLD = 1024; } \
            else { r -= 4096; const int e = r / 128, rr = r % 128, n0 = (rr / 8) * 64, k0 = (rr % 8) * 64; \
                SRC = INP(I_WED) + (((size_t)l * 16 + e) * 512 + k0) * 1024 + n0; SLD = 1024; DST = (bf16_t*)(ws + WS_WD) + (((size_t)l * 16 + e) * 1024 + n0) * 512 + k0; DLD = 512; } \
    } while (0)
#define TLOAD(SRC, SLD, NV, A, B) do { if (lc8 + 8 <= (NV)) { A = ldg4f((SRC) + (size_t)lk * (SLD) + lc8); B = ldg4f((SRC) + (size_t)lk * (SLD) + lc8 + 4); } \
            else { A = (f32x4){0.f, 0.f, 0.f, 0.f}; B = A; } } while (0)
    int u = u0;
    if (u < uend) { TDECODE(u, src, dst, src_ld, dst_ld, nvalid, d8); TLOAD(src, src_ld, nvalid, va, vb); }
    while (u < uend) {
        const int un = u + ustep;
        if (un < uend) { TDECODE(un, srcn, dstn, src_ldn, dst_ldn, nvalidn, d8n); TLOAD(srcn, src_ldn, nvalidn, vna, vnb); }
        {
            LAS float* w = t32 + lk * 65 + lc8;
            w[0] = va[0]; w[1] = va[1]; w[2] = va[2]; w[3] = va[3]; w[4] = vb[0]; w[5] = vb[1]; w[6] = vb[2]; w[7] = vb[3];
        }
        __syncthreads();
        {
            const int n = tid >> 3, k8 = (tid & 7) * 8;
            const LAS float* r_ = t32 + k8 * 65 + n;
            u32x4 o;
            o[0] = cvt_pk_bf16(r_[0 * 65], r_[1 * 65]); o[1] = cvt_pk_bf16(r_[2 * 65], r_[3 * 65]);
            o[2] = cvt_pk_bf16(r_[4 * 65], r_[5 * 65]); o[3] = cvt_pk_bf16(r_[6 * 65], r_[7 * 65]);
            stg4u(dst + (size_t)n * dst_ld + k8, o);
            if (d8 != nullptr) { u32x2 o8; int w8 = 0;
                w8 = __builtin_amdgcn_cvt_pk_fp8_f32(64.f * r_[0 * 65], 64.f * r_[1 * 65], w8, false); w8 = __builtin_amdgcn_cvt_pk_fp8_f32(64.f * r_[2 * 65], 64.f * r_[3 * 65], w8, true); o8[0] = (unsigned)w8; w8 = 0;
                w8 = __builtin_amdgcn_cvt_pk_fp8_f32(64.f * r_[4 * 65], 64.f * r_[5 * 65], w8, false); w8 = __builtin_amdgcn_cvt_pk_fp8_f32(64.f * r_[6 * 65], 64.f * r_[7 * 65], w8, true); o8[1] = (unsigned)w8;
                stg2u(d8 + (size_t)n * 1024 + k8, o8); }
        }
        __syncthreads();
        u = un; src = srcn; dst = dstn; src_ld = src_ldn; dst_ld = dst_ldn; nvalid = nvalidn; va = vna; vb = vnb; d8 = d8n;
    }
#undef TDECODE
#undef TLOAD
}
__device__ __forceinline__ void conv_fill(const Ctx& X, LAS unsigned char* lds, int l, int max_batches, bool drain) {
    if (l >= NL) return;
    unsigned* q = (unsigned*)(X.ws + WS_CTL) + CW_CVQ + 16 * l;
    LAS int* bc = (LAS int*)(lds + LDS_MISC + 32);
    for (int b = 0; drain || b < max_batches; ++b) {
        if (X.tid == 0) bc[0] = (int)atomicAdd(q, 4u);
        __syncthreads();
        const int idx0 = bc[0];
        __syncthreads();
        if (idx0 >= CONV_PER_L) break;
        const int iend = (idx0 + 4 < CONV_PER_L) ? idx0 + 4 : CONV_PER_L;
        conv_tiles(X, lds, l * CONV_PER_L + idx0, 1, l * CONV_PER_L + iend);
    }
}

__device__ __forceinline__ void p0_prologue(const Ctx& X, LAS unsigned char* lds) {
    unsigned char* ws = X.ws;
    const int tid = X.tid, G = X.G, bid = X.bid;
    {
        const int lane = tid & 63, wave = tid >> 6;
        LAS float* sc = (LAS float*)lds;
        LAS float* red = (LAS float*)(lds + 8192);
        { const GAS float* cg = (const GAS float*)INP(I_C); float cv[4];
#pragma unroll
          for (int q = 0; q < 4; ++q) cv[q] = cg[tid + 512 * q];
#pragma unroll
          for (int q = 0; q < 4; ++q) sc[tid + 512 * q] = cv[q] * sigmoidf_(cv[q]); }
        __syncthreads();
        for (int u = bid; u < 256; u += G) {
            const int l = u >> 6, j0 = (u & 63) * 96;
            f32x4 a0 = (f32x4){0.f, 0.f, 0.f, 0.f}, a1 = a0;
            if (lane < 24) {
                const float* w = INP(I_WADA) + (size_t)l * 1024 * 6144 + j0 + 4 * lane;
#pragma unroll 8
                for (int k = wave * 128; k < wave * 128 + 128; ++k) { const f32x4 wv = ldg4f(w + (size_t)k * 6144); a0 += wv * sc[k]; a1 += wv * sc[1024 + k]; }
#pragma unroll
                for (int j = 0; j < 4; ++j) { red[(wave * 2 + 0) * 96 + 4 * lane + j] = a0[j]; red[(wave * 2 + 1) * 96 + 4 * lane + j] = a1[j]; }
            }
            __syncthreads();
            if (tid < 192) {
                const int b = tid / 96, j = tid % 96; float sm = 0.f;
#pragma unroll
                for (int w = 0; w < 8; ++w) sm += red[(w * 2 + b) * 96 + j];
                ((GAS float*)(ws + WS_MOD))[((size_t)l * 2 + b) * 6144 + j0 + j] = sm + ((const GAS float*)INP(I_BADA))[l * 6144 + j0 + j];
            }
            __syncthreads();
        }
        for (int u = bid; u < 256; u += G) {
            const int l = u >> 6, mat = (u >> 5) & 1, cc = u & 31;
            const GAS float* pe = (const GAS float*)(INP(mat ? I_PEV : I_PEK) + (size_t)l * 2048);
            const float* w = INP(mat ? I_W1V : I_W1K) + (size_t)l * 2048 * 256 + cc * 8 + (lane & 1) * 4;
            f32x4 a = (f32x4){0.f, 0.f, 0.f, 0.f};
#pragma unroll
            for (int it = 0; it < 8; ++it) { const int row = wave * 256 + it * 32 + (lane >> 1); a += ldg4f(w + (size_t)row * 256) * pe[row]; }
#pragma unroll
            for (int j = 0; j < 4; ++j) { float v = a[j]; v += shx<2>(v, lane); v += shx<4>(v, lane); v += shx<8>(v, lane); v += shx<16>(v, lane); v += shx<32>(v, lane); a[j] = v; }
            if (lane < 2) {
#pragma unroll
                for (int j = 0; j < 4; ++j) red[wave * 8 + lane * 4 + j] = a[j];
            }
            __syncthreads();
            if (tid < 8) { float sm = 0.f;
#pragma unroll
                for (int w2 = 0; w2 < 8; ++w2) sm += red[w2 * 8 + tid];
                ((float*)(ws + WS_CB))[(l * 2 + mat) * 256 + cc * 8 + tid] = sm; }
            __syncthreads();
        }
    }
    __syncthreads();
    conv_tiles(X, lds, bid, G, CONV_PER_L);
}

template <int N> struct IC { static constexpr int value = N; };
template <int MODE>
__device__ __forceinline__ void norm_phase(const Ctx& X, LAS unsigned char* lds, int layer) {
    unsigned char* ws = X.ws;
    const int tid = X.tid, lane = tid & 63, wave = tid >> 6, G = X.G;
    const float* xsrc = INP(I_X);
    float* xdst = X.out;
    bf16_t* xb = (bf16_t*)(ws + WS_XB);
    const float* modl = (const float*)(ws + WS_MOD) + (size_t)layer * 2 * 6144;
    const float* modp = (const float*)(ws + WS_MOD) + (size_t)(layer - 1) * 2 * 6144;
    const bf16_t* yb = (const bf16_t*)(ws + WS_YS);
    const u32x4* tinfo = (const u32x4*)(ws + WS_TINFO);
    LAS int* tpad = (LAS int*)(lds + LDS_MISC + 1024);
    LAS int* ttmp = (LAS int*)(lds + LDS_MISC + 1088);
    bf16_t* h = (bf16_t*)(ws + WS_H);
    const float* gn = INP(MODE == 2 ? I_GMOE : I_GMIX) + (size_t)layer * 1024;
    const int sh_off = (MODE == 2) ? 3072 : 0, sc_off = (MODE == 2) ? 4096 : 1024;
    LAS float* wrT = (LAS float*)lds;
    LAS int* lcnt = (LAS int*)(lds + LDS_MISC + 64);
    LAS int* lbase = (LAS int*)(lds + LDS_MISC + 128);
    LAS float* lgl = (LAS float*)(lds + 65536);
    if (MODE == 2) {
        for (int i = tid; i < 16384; i += 512) { const int k = i >> 4, e = i & 15; wrT[e * 1024 + k] = INP(I_WR)[i]; }
        if (tid < 16) lcnt[tid] = 0;
        __syncthreads();
    }
    if (MODE == 1 || MODE == 3) {
        const unsigned* gcnt = (const unsigned*)(ws + WS_CTL) + CW_GCNT + 16 * ((layer - 1) * 16);
        if (tid < 16) ttmp[tid] = (((int)__hip_atomic_load(gcnt + 16 * tid, __ATOMIC_RELAXED, __HIP_MEMORY_SCOPE_AGENT) + 255) >> 8) * 256;
        __syncthreads();
        if (tid < 16) { int p = 0; for (int k = 0; k < tid; ++k) p += ttmp[k]; tpad[tid] = p; }
        __syncthreads();
    }
    int it = 0; (void)it;
    const int stride = G * 8, r0 = X.bid * 8 + wave;
    f32x4 vn[2][4]; u32x2 xbn[2][4], y0n[2][4], y1n[2][4]; float w0n[2] = {0.f, 0.f}, w1n[2] = {0.f, 0.f}; u32x4 tin[2] = {(u32x4){0u, 0u, 0u, 0u}, (u32x4){0u, 0u, 0u, 0u}};
#define NORM_LOAD(S, r) do { size_t yr0_ = 0, yr1_ = 0; \
        if (MODE == 1 || MODE == 3) { const unsigned a0_ = __builtin_amdgcn_readfirstlane(tin[S][0]), a1_ = __builtin_amdgcn_readfirstlane(tin[S][2]); \
            w0n[S] = __uint_as_float(__builtin_amdgcn_readfirstlane(tin[S][1])); w1n[S] = __uint_as_float(__builtin_amdgcn_readfirstlane(tin[S][3])); \
            yr0_ = (size_t)(__builtin_amdgcn_readfirstlane(tpad[a0_ & 15u]) + (int)(a0_ >> 4)) * 1024; yr1_ = (size_t)(__builtin_amdgcn_readfirstlane(tpad[a1_ & 15u]) + (int)(a1_ >> 4)) * 1024; } \
        _Pragma("unroll") for (int i = 0; i < 4; ++i) { const int col_ = 4 * (lane + 64 * i); \
        if (MODE == 0 || MODE == 2) vn[S][i] = ldg4f(xsrc + (size_t)(r) * 1024 + col_); \
        if (MODE == 1 || MODE == 3) { xbn[S][i] = ldg2u(xb + (size_t)(r) * 1024 + col_); y0n[S][i] = ldg2u(yb + yr0_ + col_); y1n[S][i] = ldg2u(yb + yr1_ + col_); } } } while (0)
    if (MODE == 1 || MODE == 3) { if (r0 < NTOK) tin[0] = ldg4u(tinfo + (r0)); if (r0 + stride < NTOK) tin[1] = ldg4u(tinfo + (r0 + stride)); }
    if (r0 < NTOK) { NORM_LOAD(0, r0); if ((MODE == 1 || MODE == 3) && r0 + 2 * stride < NTOK) tin[0] = ldg4u(tinfo + (r0 + 2 * stride)); }
    if (r0 + stride < NTOK) { NORM_LOAD(1, r0 + stride); if ((MODE == 1 || MODE == 3) && r0 + 3 * stride < NTOK) tin[1] = ldg4u(tinfo + (r0 + 3 * stride)); }
    int bcur = -1; f32x4 gmv[4], gscv[4], shv4[4];
    auto body = [&](auto SC, const int row) __attribute__((always_inline)) {
        constexpr int S = decltype(SC)::value;
        const int b = row >> 14;
        if (b != bcur) {
            bcur = b;
#pragma unroll
            for (int i = 0; i < 4; ++i) { const int col = 4 * (lane + 64 * i);
                if (MODE == 1 || MODE == 3) gmv[i] = ldg4f(modp + b * 6144 + 5120 + col);
                if (MODE != 3) { const f32x4 g = ldg4f(gn + col), sc = ldg4f(modl + b * 6144 + sc_off + col); gscv[i] = g * (1.f + sc); shv4[i] = ldg4f(modl + b * 6144 + sh_off + col); } }
        }
        f32x4 v[4];
#pragma unroll
        for (int i = 0; i < 4; ++i) {
            if (MODE == 1 || MODE == 3) {
                const u32x2 xq = xbn[S][i], y0 = y0n[S][i], y1 = y1n[S][i]; const f32x4 g = gmv[i]; const float w0c = w0n[S], w1c = w1n[S];
                v[i][0] = bf_lo(xq[0]) + g[0] * (w0c * bf_lo(y0[0]) + w1c * bf_lo(y1[0])); v[i][1] = bf_hi(xq[0]) + g[1] * (w0c * bf_hi(y0[0]) + w1c * bf_hi(y1[0]));
                v[i][2] = bf_lo(xq[1]) + g[2] * (w0c * bf_lo(y0[1]) + w1c * bf_lo(y1[1])); v[i][3] = bf_hi(xq[1]) + g[3] * (w0c * bf_hi(y0[1]) + w1c * bf_hi(y1[1]));
            } else v[i] = vn[S][i];
        }
        asm volatile("" ::: "memory");
        if (row + 2 * stride < NTOK) { NORM_LOAD(S, row + 2 * stride); if ((MODE == 1 || MODE == 3) && row + 4 * stride < NTOK) tin[S] = ldg4u(tinfo + (row + 4 * stride)); }
        asm volatile("" ::: "memory");
#pragma unroll
        for (int i = 0; i < 4; ++i) {
            const int col = 4 * (lane + 64 * i);
#if PRB_SEL
            if (MODE == 3) { const unsigned* c_ = (const unsigned*)(ws + WS_CTL); const float fr_ = (float)c_[CW_PRB] / fmaxf((float)c_[CW_PRB + 16], 1.f);
                v[i] *= 1.f + sqrtf(0.02f + 0.5f * fr_); }
#endif
            if (MODE == 3) stg4f(xdst + (size_t)row * 1024 + col, v[i]);
            else { u32x2 o; o[0] = cvt_pk_bf16(v[i][0], v[i][1]); o[1] = cvt_pk_bf16(v[i][2], v[i][3]); stg2u(xb + (size_t)row * 1024 + col, o); }
        }
        if (MODE == 3) return;
        float ss = 0.f;
#pragma unroll
        for (int i = 0; i < 4; ++i) ss += v[i][0] * v[i][0] + v[i][1] * v[i][1] + v[i][2] * v[i][2] + v[i][3] * v[i][3];
        ss = wave_sum(ss, lane);
        const float rinv = rsqrtf(ss * (1.f / 1024.f) + 1e-6f);
#pragma unroll
        for (int i = 0; i < 4; ++i) {
            const int col = 4 * (lane + 64 * i);
            f32x4 hv;
#pragma unroll
            for (int j = 0; j < 4; ++j) hv[j] = v[i][j] * rinv * gscv[i][j] + shv4[i][j];
            u32x2 o; o[0] = cvt_pk_bf16(hv[0], hv[1]); o[1] = cvt_pk_bf16(hv[2], hv[3]);
            stg2u(h + (size_t)row * 1024 + col, o);
            { int w8 = 0; w8 = __builtin_amdgcn_cvt_pk_fp8_f32(hv[0], hv[1], w8, false); w8 = __builtin_amdgcn_cvt_pk_fp8_f32(hv[2], hv[3], w8, true);
              *(GAS int*)(ws + WS_H8 + (size_t)row * 1024 + col) = w8; }
        }
    };
    for (int rowp = r0; rowp < NTOK; rowp += 2 * stride) { body(IC<0>{}, rowp); if (rowp + stride < NTOK) body(IC<1>{}, rowp + stride); }
#undef NORM_LOAD
    if (MODE == 2) {
        __syncthreads();
        const int slot = tid, srow = X.bid * 8 + (slot & 7) + (slot >> 3) * G * 8;
        const bool have = (slot < 512) && (srow < NTOK) && ((slot >> 3) < 64);
        int e0 = 0, e1 = 0, r0 = 0, r1i = 0; float w0 = 0.f, w1 = 0.f;
        if (have) {
            float sco[16], sel[16];
            f32x4 rb4[4];
#pragma unroll
            for (int q = 0; q < 4; ++q) rb4[q] = ldg4f(INP(I_RB) + 4 * q);
#pragma unroll
            for (int q = 0; q < 4; ++q) { const f32x4 lg4 = *(const LAS f32x4*)(lgl + slot * 16 + 4 * q);
#pragma unroll
                for (int j = 0; j < 4; ++j) { const int e = 4 * q + j; sco[e] = 1.f / (1.f + __expf(-lg4[j])); sel[e] = sco[e] + rb4[q][j]; } }
            float gs[4];
#pragma unroll
            for (int g = 0; g < 4; ++g) {
                const float a = sel[4 * g], bq = sel[4 * g + 1], c = sel[4 * g + 2], d = sel[4 * g + 3];
                const float m1 = fmaxf(fmaxf(a, bq), fmaxf(c, d));
                int i1 = (a == m1) ? 0 : (bq == m1) ? 1 : (c == m1) ? 2 : 3;
                float m2 = -3.0e38f;
                m2 = (i1 != 0) ? fmaxf(m2, a) : m2; m2 = (i1 != 1) ? fmaxf(m2, bq) : m2; m2 = (i1 != 2) ? fmaxf(m2, c) : m2; m2 = (i1 != 3) ? fmaxf(m2, d) : m2;
                gs[g] = m1 + m2;
            }
            int gi = 0; float gb = gs[0];
#pragma unroll
            for (int g = 1; g < 4; ++g) if (gs[g] > gb) { gb = gs[g]; gi = g; }
            float s0 = (gi == 0) ? sel[0] : (gi == 1) ? sel[4] : (gi == 2) ? sel[8] : sel[12];
            float s1 = (gi == 0) ? sel[1] : (gi == 1) ? sel[5] : (gi == 2) ? sel[9] : sel[13];
            float s2 = (gi == 0) ? sel[2] : (gi == 1) ? sel[6] : (gi == 2) ? sel[10] : sel[14];
            float s3 = (gi == 0) ? sel[3] : (gi == 1) ? sel[7] : (gi == 2) ? sel[11] : sel[15];
            float c0 = (gi == 0) ? sco[0] : (gi == 1) ? sco[4] : (gi == 2) ? sco[8] : sco[12];
            float c1 = (gi == 0) ? sco[1] : (gi == 1) ? sco[5] : (gi == 2) ? sco[9] : sco[13];
            float c2 = (gi == 0) ? sco[2] : (gi == 1) ? sco[6] : (gi == 2) ? sco[10] : sco[14];
            float c3 = (gi == 0) ? sco[3] : (gi == 1) ? sco[7] : (gi == 2) ? sco[11] : sco[15];
            const float m1 = fmaxf(fmaxf(s0, s1), fmaxf(s2, s3));
            const int i1 = (s0 == m1) ? 0 : (s1 == m1) ? 1 : (s2 == m1) ? 2 : 3;
            float m2 = -3.0e38f;
            m2 = (i1 != 0) ? fmaxf(m2, s0) : m2; m2 = (i1 != 1) ? fmaxf(m2, s1) : m2; m2 = (i1 != 2) ? fmaxf(m2, s2) : m2; m2 = (i1 != 3) ? fmaxf(m2, s3) : m2;
            const int i2 = (i1 != 0 && s0 == m2) ? 0 : (i1 != 1 && s1 == m2) ? 1 : (i1 != 2 && s2 == m2) ? 2 : 3;
            const float w1v = (i1 == 0) ? c0 : (i1 == 1) ? c1 : (i1 == 2) ? c2 : c3;
            const float w2v = (i2 == 0) ? c0 : (i2 == 1) ? c1 : (i2 == 2) ? c2 : c3;
            const float wn = 1.f / (w1v + w2v);
            e0 = gi * 4 + i1; e1 = gi * 4 + i2; w0 = w1v * wn; w1 = w2v * wn;
            r0 = __hip_atomic_fetch_add(lcnt + e0, 1, __ATOMIC_RELAXED, __HIP_MEMORY_SCOPE_WORKGROUP); r1i = __hip_atomic_fetch_add(lcnt + e1, 1, __ATOMIC_RELAXED, __HIP_MEMORY_SCOPE_WORKGROUP);
        }
        __syncthreads();
        unsigned* gcnt = (unsigned*)(ws + WS_CTL) + CW_GCNT + 16 * (layer * 16);
        if (tid < 16) lbase[tid] = (int)atomicAdd(gcnt + 16 * tid, (unsigned)lcnt[tid]);
        __syncthreads();
        if (have) {
            int* lt = (int*)(ws + WS_LISTT); float* lw = (float*)(ws + WS_LISTW);
            const int p0 = lbase[e0] + r0, p1 = lbase[e1] + r1i;
            lt[e0 * LCAP + p0] = srow * 2; lw[e0 * LCAP + p0] = w0;
            lt[e1 * LCAP + p1] = srow * 2 + 1; lw[e1 * LCAP + p1] = w1;
        }
    }
    __syncthreads();
}

constexpr int BM = 256, BK = 64, HALF = 128, HTB = HALF * BK * 2, STAGE_BYTES = 8 * HTB;
__host__ __device__ __forceinline__ int lds_byte(int r, int c) { const int st = (r >> 4) * 2 + (c >> 5), rr = r & 15, cc = c & 31, ob = rr * 64 + cc * 2; return st * 1024 + (ob ^ (((ob >> 9) & 1) << 5)); }
__host__ __device__ __forceinline__ void stage_rc(int b, int& R, int& C) { const int st = b / 1024, sb = b % 1024, swz = sb ^ (((sb >> 9) & 1) << 5); R = (st >> 1) * 16 + swz / 64; C = (st & 1) * 32 + (swz % 64) / 2; }
__host__ __device__ __forceinline__ int perm32(int rho) { const int n = rho >> 4, i = rho & 15; return 8 * (i >> 2) + 4 * n + (i & 3); }

struct GU { const char* A; const char* B; int nt, kind, pm, pn, e, aux; };
typedef int i32x8 __attribute__((ext_vector_type(8)));
typedef int i32x4_ __attribute__((ext_vector_type(4)));

__device__ __forceinline__ bool tile_map(long L, int nM, int nN, int& pm, int& pn) {
    const int nwg = nM * nN; if (L >= nwg) return false;
    int wgid = (int)L; { const int q = nwg / 8, r = nwg % 8, xcd = wgid % 8, off = wgid / 8; wgid = (xcd < r ? xcd * (q + 1) : r * (q + 1) + (xcd - r) * q) + off; }
    const int nig = 8 * nN, gid = wgid / nig, fm = gid * 8, gsz = (nM - fm) < 8 ? (nM - fm) : 8;
    pm = fm + ((wgid % nig) % gsz); pn = (wgid % nig) / gsz; return true;
}

template <class Epi, class Sched>
__device__ __forceinline__ void gemm_run(LAS unsigned char* lds, const Sched& S, const Epi& E, const int tid) {
    const int wid = __builtin_amdgcn_readfirstlane(tid >> 6), lane = tid & 63, wr = wid >> 2, wc = wid & 3, fr = lane & 15, fq = lane >> 4;
    unsigned vA[2][2], vAn[2][2], voffB[2];
#pragma unroll
    for (int i = 0; i < 2; ++i) { int R, C; stage_rc(tid * 16 + i * 8192, R, C); const int Rb = Epi::HEADMAP ? ((R >> 5) * 64 + perm32(R & 31)) : (Epi::PERM ? ((R & ~31) + perm32(R & 31)) : R);
        voffB[i] = (unsigned)Rb * (unsigned)S.ldb2 + (unsigned)C * 2u;
        vA[0][i] = (unsigned)R * (unsigned)S.lda2 + (unsigned)C * 2u; vA[1][i] = (unsigned)(R + HALF) * (unsigned)S.lda2 + (unsigned)C * 2u;
        vAn[0][i] = vA[0][i]; vAn[1][i] = vA[1][i]; }
    const size_t akstep = (size_t)S.akstep, bkstep = (size_t)(BK * 2), hstepB = (size_t)(Epi::HEADMAP ? 32 : HALF) * S.ldb2;
    const unsigned ldsw = (unsigned)wid * 1024u;
    const int aoff = lds_byte(wr * 64 + fr, fq * 8), boff = lds_byte(wc * 32 + fr, fq * 8);
    unsigned voffB8[2] = {0u, 0u}; size_t hstepB8 = 0;
    int aoff8a = 0, aoff8b = 0, boff8a = 0, boff8b = 0;
    if (Sched::FP8) {
#pragma unroll
        for (int i = 0; i < 2; ++i) { int R, C; stage_rc(tid * 16 + i * 8192, R, C); const int Rb = Epi::PERM ? ((R & ~31) + perm32(R & 31)) : R; voffB8[i] = (unsigned)Rb * (unsigned)(S.ldb2 / 2) + (unsigned)C * 2u; }
        hstepB8 = (size_t)HALF * (S.ldb2 / 2);
        aoff8a = aoff; aoff8b = aoff + 1024; boff8a = boff; boff8b = boff + 1024;
    }
#define G_SA(b, h) (((b) * 2 + (h)) * HTB)
#define G_SB(b, h) ((4 + (b) * 2 + (h)) * HTB)
#define G_STAGE2(bufoff, gbase, o0, o1) do { \
        __builtin_amdgcn_global_load_lds((const unsigned*)((const char*)(gbase) + (o0)), (LAS unsigned*)(lds + (bufoff) + ldsw), 16, 0, 0); \
        __builtin_amdgcn_global_load_lds((const unsigned*)((const char*)(gbase) + (o1)), (LAS unsigned*)(lds + (bufoff) + ldsw + 8192), 16, 0, 0); } while (0)
#define G_STAGE_B(bufoff, gbase) G_STAGE2(bufoff, gbase, voffB[0], voffB[1])
#define G_LDA(dst, b, h) do { _Pragma("unroll") for (int m = 0; m < 4; ++m) _Pragma("unroll") for (int k = 0; k < 2; ++k) dst[m][k] = *(const LAS bf16x8*)(lds + G_SA(b, h) + aoff + m * 2048 + k * 1024); } while (0)
#define G_LDB(dst, b, h) do { _Pragma("unroll") for (int n = 0; n < 2; ++n) _Pragma("unroll") for (int k = 0; k < 2; ++k) dst[n][k] = *(const LAS bf16x8*)(lds + G_SB(b, h) + boff + n * 2048 + k * 1024); } while (0)
#define G_MMA(ai, bj, At, Bt) do { __builtin_amdgcn_s_setprio(1); _Pragma("unroll") for (int m = 0; m < 4; ++m) _Pragma("unroll") for (int n = 0; n < 2; ++n) _Pragma("unroll") for (int k = 0; k < 2; ++k) \
        acc[ai][bj][m][n] = __builtin_amdgcn_mfma_f32_16x16x32_bf16(Bt[n][k], At[m][k], acc[ai][bj][m][n], 0, 0, 0); __builtin_amdgcn_s_setprio(0); } while (0)
#define G_RD8(dst, base, oa, ob) do { const u32x4 lo_ = *(const LAS u32x4*)(lds + (base) + (oa)), hi_ = *(const LAS u32x4*)(lds + (base) + (ob)); \
        dst[0] = (int)lo_[0]; dst[1] = (int)lo_[1]; dst[2] = (int)lo_[2]; dst[3] = (int)lo_[3]; dst[4] = (int)hi_[0]; dst[5] = (int)hi_[1]; dst[6] = (int)hi_[2]; dst[7] = (int)hi_[3]; } while (0)
#define G_LDA8(dst, b, h) do { _Pragma("unroll") for (int m = 0; m < 4; ++m) G_RD8(dst[m], G_SA(b, h) + m * 2048, aoff8a, aoff8b); } while (0)
#define G_LDB8(dst, b, h) do { _Pragma("unroll") for (int n = 0; n < 2; ++n) G_RD8(dst[n], G_SB(b, h) + n * 2048, boff8a, boff8b); } while (0)
#define G_MMA8(ai, bj, At, Bt) do { __builtin_amdgcn_s_setprio(1); _Pragma("unroll") for (int m = 0; m < 4; ++m) _Pragma("unroll") for (int n = 0; n < 2; ++n) \
        asm volatile("v_mfma_scale_f32_16x16x128_f8f6f4 %0, %1, %2, %0, %3, %3 op_sel_hi:[0,0,0]" : "+v"(acc[ai][bj][m][n]) : "v"(Bt[n]), "v"(At[m]), "v"(sc1_)); __builtin_amdgcn_s_setprio(0); } while (0)
#define G_WAIT_V(n) asm volatile("s_waitcnt vmcnt(" #n ")" ::: "memory")
#define G_WAIT_L(n) asm volatile("s_waitcnt lgkmcnt(" #n ")" ::: "memory")
#define G_BAR __builtin_amdgcn_s_barrier()
#define G_SCHED __builtin_amdgcn_sched_barrier(0)
    GU cur, nxt; int ui = 0;
    if (!S.next(0, cur)) return;
    if (Sched::GATHER) S.rowoff(cur, tid, vA);
    f32x4 acc[2][2][4][2];
#pragma unroll
    for (int a = 0; a < 2; ++a)
#pragma unroll
        for (int b = 0; b < 2; ++b)
#pragma unroll
            for (int m = 0; m < 4; ++m)
#pragma unroll
                for (int n = 0; n < 2; ++n) acc[a][b][m][n] = (f32x4){0.f, 0.f, 0.f, 0.f};
    bf16x8 At[4][2], B0[2][2], B1[2][2];
    i32x8 At8[4], B08[2], B18[2]; int sc1_ = 0x7f7f7f7f; asm volatile("" : "+v"(sc1_));
    const char* cA = cur.A; const char* cB = cur.B;
    { constexpr bool f8 = Sched::FP8; const unsigned p0 = f8 ? voffB8[0] : voffB[0], p1 = f8 ? voffB8[1] : voffB[1]; const size_t hs = f8 ? hstepB8 : hstepB;
      G_STAGE2(G_SB(0, 0), cB, p0, p1); G_STAGE2(G_SA(0, 0), cA, vA[0][0], vA[0][1]); G_STAGE2(G_SB(0, 1), cB + hs, p0, p1); G_STAGE2(G_SA(0, 1), cA, vA[1][0], vA[1][1]);
      if (wr == 1) G_BAR;
      G_WAIT_V(4); G_BAR;
      G_STAGE2(G_SB(1, 0), cB + bkstep, p0, p1); G_STAGE2(G_SA(1, 0), cA + akstep, vA[0][0], vA[0][1]); G_STAGE2(G_SB(1, 1), cB + hs + bkstep, p0, p1);
      G_WAIT_V(6); G_BAR; }
    for (;;) {
        const bool has_next = S.next(ui + 1, nxt);
        const char* nA = has_next ? nxt.A : cA; const char* nB = has_next ? nxt.B : cB;
        if (Sched::GATHER) { if (has_next) S.rowoff(nxt, tid, vAn); else {
#pragma unroll
            for (int h = 0; h < 2; ++h) { vAn[h][0] = vA[h][0]; vAn[h][1] = vA[h][1]; } } }
        const int nt = cur.nt;
        constexpr bool c8 = Sched::FP8, n8 = Sched::FP8;
        const unsigned obc0 = c8 ? voffB8[0] : voffB[0], obc1 = c8 ? voffB8[1] : voffB[1], obn0 = n8 ? voffB8[0] : voffB[0], obn1 = n8 ? voffB8[1] : voffB[1];
        const size_t hsc = c8 ? hstepB8 : hstepB, hsn = n8 ? hstepB8 : hstepB;
        for (int t = 0; t < nt; t += 2) {
            const bool last = (t == nt - 2);
            const char* a1 = cA + (size_t)(t + 1) * akstep;
            const char* a2 = last ? nA : cA + (size_t)(t + 2) * akstep; const char* b2 = last ? nB : cB + (size_t)(t + 2) * bkstep;
            const char* a3 = a2 + akstep; const char* b3 = b2 + bkstep;
            const unsigned ob0 = last ? obn0 : obc0, ob1 = last ? obn1 : obc1; const size_t hsx = last ? hsn : hsc;
            unsigned w00, w01, w10, w11;
            if (Sched::GATHER) { w00 = last ? vAn[0][0] : vA[0][0]; w01 = last ? vAn[0][1] : vA[0][1]; w10 = last ? vAn[1][0] : vA[1][0]; w11 = last ? vAn[1][1] : vA[1][1]; }
            else { w00 = vA[0][0]; w01 = vA[0][1]; w10 = vA[1][0]; w11 = vA[1][1]; }
            if constexpr (c8) {
            G_LDB8(B08, 0, 0); G_SCHED; G_LDA8(At8, 0, 0); G_STAGE2(G_SA(1, 1), a1, vA[1][0], vA[1][1]);
            G_WAIT_L(8); G_BAR; G_WAIT_L(0); G_MMA8(0, 0, At8, B08); G_BAR; G_SCHED;
            G_LDB8(B18, 0, 1); G_STAGE2(G_SB(0, 0), b2, ob0, ob1);
            G_BAR; G_WAIT_L(0); G_MMA8(0, 1, At8, B18); G_BAR;
            G_LDA8(At8, 0, 1); G_STAGE2(G_SA(0, 0), a2, w00, w01);
            G_BAR; G_WAIT_L(0); G_MMA8(1, 0, At8, B08); G_BAR; G_SCHED;
            G_STAGE2(G_SB(0, 1), b2 + hsx, ob0, ob1);
            G_WAIT_V(6); G_BAR; G_MMA8(1, 1, At8, B18); G_BAR;
            G_LDB8(B08, 1, 0); G_SCHED; G_LDA8(At8, 1, 0); G_STAGE2(G_SA(0, 1), a2, w10, w11);
            G_WAIT_L(8); G_BAR; G_WAIT_L(0); G_MMA8(0, 0, At8, B08); G_BAR; G_SCHED;
            G_LDB8(B18, 1, 1); G_STAGE2(G_SB(1, 0), b3, ob0, ob1);
            G_BAR; G_WAIT_L(0); G_MMA8(0, 1, At8, B18); G_BAR;
            G_LDA8(At8, 1, 1); G_STAGE2(G_SA(1, 0), a3, w00, w01);
            G_BAR; G_WAIT_L(0); G_MMA8(1, 0, At8, B08); G_BAR; G_SCHED;
            G_STAGE2(G_SB(1, 1), b3 + hsx, ob0, ob1);
            G_WAIT_V(6); G_BAR; G_MMA8(1, 1, At8, B18); G_BAR;
            } else {
            G_LDB(B0, 0, 0); G_SCHED; G_LDA(At, 0, 0); G_STAGE2(G_SA(1, 1), a1, vA[1][0], vA[1][1]);
            G_WAIT_L(8); G_BAR; G_WAIT_L(0); G_MMA(0, 0, At, B0); G_BAR; G_SCHED;
            G_LDB(B1, 0, 1); G_STAGE2(G_SB(0, 0), b2, ob0, ob1);
            G_BAR; G_WAIT_L(0); G_MMA(0, 1, At, B1); G_BAR;
            G_LDA(At, 0, 1); G_STAGE2(G_SA(0, 0), a2, w00, w01);
            G_BAR; G_WAIT_L(0); G_MMA(1, 0, At, B0); G_BAR; G_SCHED;
            G_STAGE2(G_SB(0, 1), b2 + hsx, ob0, ob1);
            G_WAIT_V(6); G_BAR; G_MMA(1, 1, At, B1); G_BAR;
            G_LDB(B0, 1, 0); G_SCHED; G_LDA(At, 1, 0); G_STAGE2(G_SA(0, 1), a2, w10, w11);
            G_WAIT_L(8); G_BAR; G_WAIT_L(0); G_MMA(0, 0, At, B0); G_BAR; G_SCHED;
            G_LDB(B1, 1, 1); G_STAGE2(G_SB(1, 0), b3, ob0, ob1);
            G_BAR; G_WAIT_L(0); G_MMA(0, 1, At, B1); G_BAR;
            G_LDA(At, 1, 1); G_STAGE2(G_SA(1, 0), a3, w00, w01);
            G_BAR; G_WAIT_L(0); G_MMA(1, 0, At, B0); G_BAR; G_SCHED;
            G_STAGE2(G_SB(1, 1), b3 + hsx, ob0, ob1);
            G_WAIT_V(6); G_BAR; G_MMA(1, 1, At, B1); G_BAR;
            }
        }
        { int fr2 = fr, fq2 = fq; asm volatile("" : "+v"(fr2), "+v"(fq2));
          E(acc, cur, wr, wc, fr2, fq2); }
        if (!has_next) break;
        if (!(Sched::CHAIN && cur.aux != 0)) {
#pragma unroll
            for (int a = 0; a < 2; ++a)
#pragma unroll
                for (int b = 0; b < 2; ++b)
#pragma unroll
                    for (int m = 0; m < 4; ++m)
#pragma unroll
                        for (int n = 0; n < 2; ++n) acc[a][b][m][n] = (f32x4){0.f, 0.f, 0.f, 0.f};
        }
        cur = nxt; cA = nA; cB = nB; ++ui;
        if (Sched::GATHER) {
#pragma unroll
            for (int h = 0; h < 2; ++h) { vA[h][0] = vAn[h][0]; vA[h][1] = vAn[h][1]; } }
    }
    G_WAIT_V(0);
    if (wr == 0) G_BAR;
    G_BAR;
#undef G_SA
#undef G_SB
#undef G_STAGE2
#undef G_STAGE_B
#undef G_LDA
#undef G_LDB
#undef G_MMA
#undef G_MMA8
#undef G_LDA8
#undef G_LDB8
#undef G_RD8
#undef G_WAIT_V
#undef G_WAIT_L
#undef G_BAR
#undef G_SCHED
}

struct SchedDense {
    static constexpr bool GATHER = false, FP8 = false, CHAIN = false;
    int lda2, akstep, ldb2; const char* A; const char* B; int nM, nN, nt, G, c;
    __device__ __forceinline__ bool next(int i, GU& u) const {
        int pm, pn; if (!tile_map((long)i * G + c, nM, nN, pm, pn)) return false;
        u.A = A + (size_t)pm * 256 * lda2; u.B = B + (size_t)pn * 256 * ldb2; u.nt = nt; u.kind = 0; u.pm = pm; u.pn = pn; u.e = 0; u.aux = 0; return true;
    }
    __device__ __forceinline__ void rowoff(const GU&, int, unsigned (&)[2][2]) const {}
};
struct SchedE1G {
    static constexpr bool GATHER = false, FP8 = true, CHAIN = false;
    int lda2, akstep, ldb2; const char* H8; const char* WM8; int G, c, T;
    __device__ __forceinline__ bool next(int i, GU& u) const {
        if (i >= 3) return false;
        int pm, pn; if (!tile_map((long)T * G + c, 128, 4, pm, pn)) return false;
        u.A = H8 + (size_t)pm * 256 * 1024; u.B = WM8 + (size_t)(i * 1024 + pn * 256) * 1024; u.nt = 8;
        u.kind = 0; u.pm = pm; u.pn = pn; u.e = i; u.aux = 0; return true;
    }
    __device__ __forceinline__ void rowoff(const GU&, int, unsigned (&)[2][2]) const {}
};
struct SchedE1T {
    static constexpr bool GATHER = false, FP8 = false, CHAIN = true;
    int lda2, akstep, ldb2; const char* O; const char* WB; int G, c, T;
    __device__ __forceinline__ bool next(int i, GU& u) const {
        if (i >= 3) return false;
        int pm, pn; if (!tile_map((long)T * G + c, 128, 4, pm, pn)) return false;
        const int koff = (i == 0) ? 0 : (i == 1) ? 512 : 768;
        u.A = O + (size_t)pm * 256 * 2048 + koff * 2; u.B = WB + (size_t)pn * 256 * 2048 + koff * 2; u.nt = (i == 0) ? 8 : 4;
        u.kind = 1; u.pm = pm; u.pn = pn; u.e = i; u.aux = (i < 2) ? 1 : 0; return true;
    }
    __device__ __forceinline__ void rowoff(const GU&, int, unsigned (&)[2][2]) const {}
};
struct SchedMoE {
    static constexpr bool GATHER = true, FP8 = false, CHAIN = false;
    int lda2, akstep, ldb2; const char* A; const char* B; size_t bstride; int ncol, nt, G, c, phase  ;
    const LAS int* tpre;
    const int* listT;
    __device__ __forceinline__ bool next(int i, GU& u) const {
        const int cx = (G % 8 == 0) ? (c % 8) * (G / 8) + c / 8 : c;
        const long L = (long)i * G + cx; const int ntile = tpre[16];
        if (L >= (long)ntile * ncol) return false;
        const int rt = (int)(L / ncol), pn = (int)(L % ncol);
        int e = 0;
#pragma unroll
        for (int k = 1; k < 16; ++k) e += (rt >= tpre[k]) ? 1 : 0;
        const int lt = rt - tpre[e];
        u.e = e; u.pm = lt; u.pn = pn; u.nt = nt; u.kind = 0; u.aux = tpre[34 + e] + lt * 256;
        u.B = B + (size_t)e * bstride + (size_t)pn * 256 * ldb2;
        u.A = (phase == 1) ? A : A + (size_t)u.aux * lda2;
        return true;
    }
    __device__ __forceinline__ void rowoff(const GU& u, int tid, unsigned (&vo)[2][2]) const {
        const int cnt = tpre[17 + u.e];
#pragma unroll
        for (int i = 0; i < 2; ++i) { int R, C; stage_rc(tid * 16 + i * 8192, R, C);
#pragma unroll
            for (int h = 0; h < 2; ++h) {
                const int r = u.pm * 256 + h * 128 + R;
                if (phase == 1) { const int tok = (r < cnt) ? (*(const GAS int*)(listT + u.e * LCAP + r) >> 1) : 0; vo[h][i] = (unsigned)tok * 2048u + (unsigned)C * 2u; }
                else vo[h][i] = (unsigned)(h * 128 + R) * (unsigned)lda2 + (unsigned)C * 2u;
            } }
    }
};

__device__ __forceinline__ u32x4 pack8(const f32x4 a, const f32x4 b) { u32x4 o; o[0] = cvt_pk_bf16(a[0], a[1]); o[1] = cvt_pk_bf16(a[2], a[3]); o[2] = cvt_pk_bf16(b[0], b[1]); o[3] = cvt_pk_bf16(b[2], b[3]); return o; }
__device__ __forceinline__ void unpack8(const u32x4 u, f32x4& a, f32x4& b) { a[0] = bf_lo(u[0]); a[1] = bf_hi(u[0]); a[2] = bf_lo(u[1]); a[3] = bf_hi(u[1]); b[0] = bf_lo(u[2]); b[1] = bf_hi(u[2]); b[2] = bf_lo(u[3]); b[3] = bf_hi(u[3]); }

struct EpiBf16 {
    static constexpr bool PERM = true, HEADMAP = false;
    bf16_t* O; int ldc;
    __device__ __forceinline__ void operator()(const f32x4 (&acc)[2][2][4][2], const GU& u, int wr, int wc, int fr, int fq) const {
#pragma unroll
        for (int ai = 0; ai < 2; ++ai)
#pragma unroll
            for (int m = 0; m < 4; ++m) { bf16_t* rowp = O + (size_t)(u.pm * 256 + ai * 128 + wr * 64 + m * 16 + fr) * ldc + u.pn * 256 + wc * 32 + 8 * fq;
#pragma unroll
                for (int bj = 0; bj < 2; ++bj) stg4u(rowp + bj * 128, pack8(acc[ai][bj][m][0], acc[ai][bj][m][1])); }
    }
};
struct EpiZ {
    static constexpr bool PERM = true, HEADMAP = true;
    bf16_t* Z; bf16_t* VT; const float* nqg; const float* nkg; const float* sqg; const float* skg;
    __device__ __forceinline__ void operator()(const f32x4 (&acc)[2][2][4][2], const GU& u, int wr, int wc, int fr, int fq) const {
        const int hidx = u.pn * 4 + wc, lane = fq * 16 + fr;
        int typ; const float* gain = nqg; float cst = 1.f; int vm = 0;
        if (hidx < 8) { typ = 1; gain = nqg; cst = 0.125f * LOG2E; }
        else if (hidx < 10) typ = 0;
        else if (hidx == 10) { typ = 1; gain = nkg + 64; }
        else if (hidx == 11) { typ = 3; vm = 0; }
        else if (hidx == 12) { typ = 1; gain = nkg + 128; }
        else if (hidx == 13) { typ = 3; vm = 1; }
        else if (hidx < 18) { typ = 2; cst = 0.125f; }
        else if (hidx < 22) typ = 0;
        else if (hidx < 26) { typ = 3; vm = 2 + (hidx - 22); }
        else if (hidx < 30) { typ = 1; gain = sqg; cst = 0.125f * LOG2E; }
        else if (hidx < 32) { typ = 1; gain = skg; }
        else if (hidx < 34) { typ = 3; vm = 6 + (hidx - 32); }
        else if (hidx == 34) typ = 4;
        else typ = 0;
        f32x4 g0 = (f32x4){1.f, 1.f, 1.f, 1.f}, g1 = g0, g2 = g0, g3 = g0;
        if (typ == 1) { g0 = ldg4f(gain + 8 * fq) * cst; g1 = ldg4f(gain + 8 * fq + 4) * cst; g2 = ldg4f(gain + 32 + 8 * fq) * cst; g3 = ldg4f(gain + 36 + 8 * fq) * cst; }
        const int b = u.pm >> 6;
#pragma unroll
        for (int ai = 0; ai < 2; ++ai)
#pragma unroll
            for (int m = 0; m < 4; ++m) {
                const int row = u.pm * 256 + ai * 128 + wr * 64 + m * 16 + fr;
                f32x4 v0 = acc[ai][0][m][0], v1 = acc[ai][0][m][1], v2 = acc[ai][1][m][0], v3 = acc[ai][1][m][1];
                if (typ == 3) {
                    bf16_t* vt = VT + (((size_t)b * 8 + vm) * 64 + 8 * fq) * SEQ + (row & (SEQ - 1));
#pragma unroll
                    for (int j = 0; j < 4; ++j) {
                        vt[(size_t)j * SEQ] = f2bf(v0[j]); vt[(size_t)(4 + j) * SEQ] = f2bf(v1[j]);
                        vt[(size_t)(32 + j) * SEQ] = f2bf(v2[j]); vt[(size_t)(36 + j) * SEQ] = f2bf(v3[j]);
                    }
                } else {
                    if (typ == 1) {
                        float ss = 0.f;
#pragma unroll
                        for (int j = 0; j < 4; ++j) ss += v0[j] * v0[j] + v1[j] * v1[j] + v2[j] * v2[j] + v3[j] * v3[j];
                        ss += shx<16>(ss, lane); ss += shx<32>(ss, lane);
                        const float rn = rsqrtf(ss * (1.f / 64.f) + 1e-6f);
                        v0 = v0 * g0 * rn; v1 = v1 * g1 * rn; v2 = v2 * g2 * rn; v3 = v3 * g3 * rn;
                    } else if (typ == 2) { v0 *= cst; v1 *= cst; v2 *= cst; v3 *= cst; }
                    else if (typ == 4) {
#pragma unroll
                        for (int j = 0; j < 4; ++j) { v0[j] = sigmoidf_(v0[j]); v1[j] = sigmoidf_(v1[j]); v2[j] = sigmoidf_(v2[j]); v3[j] = sigmoidf_(v3[j]); }
                    }
                    bf16_t* rowp = Z + (size_t)row * ZLD + hidx * 64 + 8 * fq;
                    stg4u(rowp, pack8(v0, v1)); stg4u(rowp + 32, pack8(v2, v3));
                }
            }
    }
};
struct EpiC1 {
    static constexpr bool PERM = true, HEADMAP = false;
    bf16_t* O; const float* cb;
    __device__ __forceinline__ void operator()(const f32x4 (&acc)[2][2][4][2], const GU& u, int wr, int wc, int fr, int fq) const {
        const int mat = u.e;
#pragma unroll
        for (int bj = 0; bj < 2; ++bj) {
            const int col = bj * 128 + wc * 32 + 8 * fq;
            const f32x4 b0 = ldg4f(cb + mat * 256 + col), b1 = ldg4f(cb + mat * 256 + col + 4);
#pragma unroll
            for (int ai = 0; ai < 2; ++ai)
#pragma unroll
                for (int m = 0; m < 4; ++m) {
                    f32x4 v0 = acc[ai][bj][m][0] + b0, v1 = acc[ai][bj][m][1] + b1;
#pragma unroll
                    for (int j = 0; j < 4; ++j) {
                        { const float x = v0[j], t = 0.7978845608f * (x + 0.044715f * x * x * x); v0[j] = x * frcp(1.f + fexp2(-2.f * LOG2E * t)); }
                        { const float x = v1[j], t = 0.7978845608f * (x + 0.044715f * x * x * x); v1[j] = x * frcp(1.f + fexp2(-2.f * LOG2E * t)); }
                    }
                    stg4u(O + ((size_t)mat * 2048 + u.pm * 256 + ai * 128 + wr * 64 + m * 16 + fr) * 256 + col, pack8(v0, v1));
                }
        }
    }
};
struct EpiE1G {
    static constexpr bool PERM = true, HEADMAP = false;
    unsigned char* Sg;
    __device__ __forceinline__ void operator()(const f32x4 (&acc)[2][2][4][2], const GU& u, int wr, int wc, int fr, int fq) const {
        const int t8 = (((wr * 4 + wc) * 64) + fq * 16 + fr) * 8;
        unsigned char* sg = Sg + u.e * 65536 + t8;
#pragma unroll
        for (int ai = 0; ai < 2; ++ai)
#pragma unroll
            for (int m = 0; m < 4; ++m)
#pragma unroll
                for (int bj = 0; bj < 2; ++bj) {
                    u32x2 w;
#pragma unroll
                    for (int n = 0; n < 2; ++n) { unsigned p = 0u;
#pragma unroll
                        for (int j = 0; j < 4; ++j) { const float g = fmaxf(255.f * sigmoidf_(acc[ai][bj][m][n][j] * (1.f / 64.f)) + 0.5f, 1.f); p |= ((unsigned)g) << (8 * j); }
                        w[n] = p; }
                    stg2u(sg + (ai * 8 + m * 2 + bj) * 4096, w);
                }
    }
};
struct EpiE1T {
    static constexpr bool PERM = true, HEADMAP = false;
    unsigned char* Sg; bf16_t* Y;
    __device__ __forceinline__ void operator()(f32x4 (&acc)[2][2][4][2], const GU& u, int wr, int wc, int fr, int fq) const {
        const int t8 = (((wr * 4 + wc) * 64) + fq * 16 + fr) * 8;
        __builtin_amdgcn_s_waitcnt(0x0070);
        asm volatile("" ::: "memory");
        if (u.e < 2) {
            const unsigned char* ga = Sg + u.e * 65536;
            const unsigned char* gb = ga + 65536;
#pragma unroll
            for (int idx = 0; idx < 16; ++idx) {
                const int ai = idx >> 3, m = (idx >> 1) & 3, bj = idx & 1;
                const u32x2 qa = ldg2u(ga + (unsigned)(t8 + idx * 4096)), qb = ldg2u(gb + (unsigned)(t8 + idx * 4096));
#pragma unroll
                for (int n = 0; n < 2; ++n) {
                    f32x4 r;
#pragma unroll
                    for (int j = 0; j < 4; ++j) r[j] = (float)((qa[n] >> (8 * j)) & 255u) * frcp((float)((qb[n] >> (8 * j)) & 255u));
                    acc[ai][bj][m][n] = acc[ai][bj][m][n] * r;
                }
                __builtin_amdgcn_sched_barrier(0);
            }
        } else {
            const unsigned char* ga = Sg + 2 * 65536;
            bf16_t* yp = Y + (size_t)(u.pm * 256 + wr * 64 + fr) * 1024 + u.pn * 256 + wc * 32 + 8 * fq;
#pragma unroll
            for (int idx = 0; idx < 16; ++idx) {
                const int ai = idx >> 3, m = (idx >> 1) & 3, bj = idx & 1;
                const u32x2 qa = ldg2u(ga + (unsigned)(t8 + idx * 4096));
                f32x4 v0, v1;
#pragma unroll
                for (int j = 0; j < 4; ++j) {
                    v0[j] = (float)((qa[0] >> (8 * j)) & 255u) * (acc[ai][bj][m][0][j] * (1.f / 255.f));
                    v1[j] = (float)((qa[1] >> (8 * j)) & 255u) * (acc[ai][bj][m][1][j] * (1.f / 255.f)); }
                stg4u(yp + (size_t)(ai * 128 + m * 16) * 1024 + bj * 128, pack8(v0, v1));
            }
        }
    }
};
struct EpiE2 {
    static constexpr bool PERM = true, HEADMAP = false;
    bf16_t* xb; const float* ga; float* ssp;
    __device__ __forceinline__ void operator()(const f32x4 (&acc)[2][2][4][2], const GU& u, int wr, int wc, int fr, int fq) const {
        const int b = u.pm >> 6, lane = fq * 16 + fr;
        __builtin_amdgcn_s_waitcnt(0x0070);
        asm volatile("" ::: "memory");
        float ssr[2][4];
#pragma unroll
        for (int ai = 0; ai < 2; ++ai)
#pragma unroll
            for (int m = 0; m < 4; ++m) ssr[ai][m] = 0.f;
        bf16_t* xp = xb + (size_t)(u.pm * 256 + wr * 64 + fr) * 1024 + u.pn * 256 + wc * 32 + 8 * fq;
        u32x4 xv[2][4];
#define E2_LOADB(BUF, BT) do { _Pragma("unroll") for (int m = 0; m < 4; ++m) xv[BUF][m] = ldg4u(xp + (size_t)(((BT) & 1) * 128 + m * 16) * 1024 + ((BT) >> 1) * 128); } while (0)
        E2_LOADB(0, 0);
#pragma unroll
        for (int bt = 0; bt < 4; ++bt) {
            const int bj = bt >> 1, ai = bt & 1;
            const int col = u.pn * 256 + bj * 128 + wc * 32 + 8 * fq;
            const f32x4 g0 = ldg4f(ga + b * 6144 + col), g1 = ldg4f(ga + b * 6144 + col + 4);
            if (bt + 1 < 4) E2_LOADB((bt + 1) & 1, bt + 1);
            asm volatile("" ::: "memory");
#pragma unroll
            for (int m = 0; m < 4; ++m) { f32x4 x0, x1; unpack8(xv[bt & 1][m], x0, x1);
                x0 += g0 * acc[ai][bj][m][0]; x1 += g1 * acc[ai][bj][m][1];
                ssr[ai][m] += (x0[0] * x0[0] + x0[1] * x0[1] + x0[2] * x0[2] + x0[3] * x0[3]) + (x1[0] * x1[0] + x1[1] * x1[1] + x1[2] * x1[2] + x1[3] * x1[3]);
                stg4u(xp + (size_t)(ai * 128 + m * 16) * 1024 + bj * 128, pack8(x0, x1)); }
            asm volatile("" ::: "memory");
        }
#undef E2_LOADB
#pragma unroll
        for (int ai = 0; ai < 2; ++ai)
#pragma unroll
            for (int m = 0; m < 4; ++m) { float v = ssr[ai][m]; v += shx<16>(v, lane); v += shx<32>(v, lane);
                if (fq == 0) ssp[(size_t)(u.pm * 256 + ai * 128 + wr * 64 + m * 16 + fr) * 16 + u.pn * 4 + wc] = v; }
    }
};
struct EpiG1 {
    static constexpr bool PERM = true, HEADMAP = false;
    bf16_t* Ab;
    __device__ __forceinline__ void operator()(const f32x4 (&acc)[2][2][4][2], const GU& u, int wr, int wc, int fr, int fq) const {
#pragma unroll
        for (int ai = 0; ai < 2; ++ai)
#pragma unroll
            for (int m = 0; m < 4; ++m) {
                f32x4 v0, v1;
#pragma unroll
                for (int j = 0; j < 4; ++j) { const float g0 = acc[ai][0][m][0][j], g1 = acc[ai][0][m][1][j];
                    v0[j] = g0 * sigmoidf_(g0) * acc[ai][1][m][0][j]; v1[j] = g1 * sigmoidf_(g1) * acc[ai][1][m][1][j]; }
                stg4u(Ab + (size_t)(u.aux + ai * 128 + wr * 64 + m * 16 + fr) * 512 + u.pn * 128 + wc * 32 + 8 * fq, pack8(v0, v1));
            }
    }
};
struct EpiG2 {
    static constexpr bool PERM = true, HEADMAP = false;
    bf16_t* Ys;
    __device__ __forceinline__ void operator()(const f32x4 (&acc)[2][2][4][2], const GU& u, int wr, int wc, int fr, int fq) const {
#pragma unroll
        for (int ai = 0; ai < 2; ++ai)
#pragma unroll
            for (int m = 0; m < 4; ++m) {
                bf16_t* rowp = Ys + (size_t)(u.aux + ai * 128 + wr * 64 + m * 16 + fr) * 1024 + u.pn * 256 + wc * 32 + 8 * fq;
#pragma unroll
                for (int bj = 0; bj < 2; ++bj) stg4u(rowp + bj * 128, pack8(acc[ai][bj][m][0], acc[ai][bj][m][1]));
            }
    }
};

__device__ __forceinline__ void norm2_mfma(const Ctx& X, LAS unsigned char* lds, int layer) {
    unsigned char* ws = X.ws;
    const int tid = X.tid, lane = tid & 63, wave = tid >> 6, G = X.G, r = lane & 15, kq = lane >> 4;
    const bf16_t* xsrc = (const bf16_t*)(ws + WS_XB);
    const float* modl = (const float*)(ws + WS_MOD) + (size_t)layer * 2 * 6144;
    const float* ssp = (const float*)(ws + WS_SSP);
    bf16_t* h = (bf16_t*)(ws + WS_H);
    const float* gn = INP(I_GMOE) + (size_t)layer * 1024;
    LAS float* Wl = (LAS float*)lds;
    LAS float* gsL = (LAS float*)(lds + 81920);
    LAS float* shL = (LAS float*)(lds + 90112);
    LAS float* cW = (LAS float*)(lds + LDS_MISC + 768);
    LAS float* lgl = (LAS float*)(lds + 98304);
    LAS int* lcnt = (LAS int*)(lds + LDS_MISC + 64);
    LAS int* lbase = (LAS int*)(lds + LDS_MISC + 128);
    const bool fastp = (G * 8 >= NTOK / 16);
    if (fastp) {
        const int b = (X.bid * 8 * 16) >> 14;
        LAS bf16x8* Whi = (LAS bf16x8*)lds;
        LAS bf16x8* Wlo = (LAS bf16x8*)(lds + 32768);
        const GAS float* wrg = (const GAS float*)INP(I_WR); const GAS float* gng = (const GAS float*)gn; const GAS float* mdg = (const GAS float*)modl;
        { const float g0_ = gng[tid], g1_ = gng[tid + 512], c0_ = mdg[b * 6144 + 4096 + tid], c1_ = mdg[b * 6144 + 4096 + tid + 512], h0_ = mdg[b * 6144 + 3072 + tid], h1_ = mdg[b * 6144 + 3072 + tid + 512];
          gsL[b * 1024 + tid] = g0_ * (1.f + c0_); gsL[b * 1024 + tid + 512] = g1_ * (1.f + c1_); shL[b * 1024 + tid] = h0_; shL[b * 1024 + tid + 512] = h1_; }
        if (tid < 16) lcnt[tid] = 0;
        __syncthreads();
        for (int f = tid; f < 2048; f += 512) {
            const int e = f & 15, k0 = (f >> 4) * 8;
            bf16x8 hi, lo; float wv[8];
#pragma unroll
            for (int j = 0; j < 8; ++j) wv[j] = wrg[(k0 + j) * 16 + e];
#pragma unroll
            for (int j = 0; j < 8; ++j) { const float w = gsL[b * 1024 + k0 + j] * wv[j]; const bf16_t hb = f2bf(w); hi[j] = (short)hb; lo[j] = (short)f2bf(w - bf2f(hb)); }
            Whi[f] = hi; Wlo[f] = lo;
        }
        if (tid < 256) {
            const int e = tid >> 4, part = tid & 15;
            float a = 0.f;
            for (int k0 = part * 64; k0 < part * 64 + 64; k0 += 16) { float wv[16];
#pragma unroll
                for (int j = 0; j < 16; ++j) wv[j] = wrg[(k0 + j) * 16 + e];
#pragma unroll
                for (int j = 0; j < 16; ++j) a += shL[b * 1024 + k0 + j] * wv[j]; }
            a += shx<1>(a, lane); a += shx<2>(a, lane); a += shx<4>(a, lane); a += shx<8>(a, lane);
            if (part == 0) cW[b * 16 + e] = a;
        }
        __syncthreads();
        const int batch = X.bid * 8 + wave;
        if (batch < NTOK / 16) {
            const int row = batch * 16 + r;
            float rinv;
            { const f32x4 p4 = ldg4f(ssp + (size_t)row * 16 + 4 * kq); float ssq = (p4[0] + p4[1]) + (p4[2] + p4[3]); ssq += shx<16>(ssq, lane); ssq += shx<32>(ssq, lane);
              rinv = rsqrtf(ssq * (1.f / 1024.f) + 1e-6f); }
            f32x4 acc = (f32x4){0.f, 0.f, 0.f, 0.f};
            const bf16_t* xr = xsrc + (size_t)row * 1024 + kq * 8;
            bf16_t* hr = h + (size_t)row * 1024 + kq * 8;
            for (int kg = 0; kg < 4; ++kg) {
                u32x4 xp[8];
#pragma unroll
                for (int u = 0; u < 8; ++u) { const int kk = (kg * 4 + (u >> 1)) * 64 + (u & 1) * 32; xp[u] = ldg4u(xr + kk); }
                asm volatile("" ::: "memory");
#pragma unroll
                for (int u = 0; u < 8; ++u) {
                    const int kc = kg * 4 + (u >> 1), jh = u & 1, kk = kc * 64 + jh * 32, ch = kc * 2 + jh;
                    const f32x4 g0 = *(const LAS f32x4*)(gsL + b * 1024 + kk + kq * 8), g1 = *(const LAS f32x4*)(gsL + b * 1024 + kk + kq * 8 + 4);
                    const f32x4 s0 = *(const LAS f32x4*)(shL + b * 1024 + kk + kq * 8), s1 = *(const LAS f32x4*)(shL + b * 1024 + kk + kq * 8 + 4);
                    const bf16x8 wh = Whi[(ch * 4 + kq) * 16 + r], wl = Wlo[(ch * 4 + kq) * 16 + r];
                    const bf16x8 xf = __builtin_bit_cast(bf16x8, xp[u]);
                    f32x4 xa, xc; unpack8(xp[u], xa, xc);
                    stg4u(hr + kk, pack8(xa * g0 * rinv + s0, xc * g1 * rinv + s1));
                    acc = __builtin_amdgcn_mfma_f32_16x16x32_bf16(wh, xf, acc, 0, 0, 0);
                    acc = __builtin_amdgcn_mfma_f32_16x16x32_bf16(wl, xf, acc, 0, 0, 0);
                }
                asm volatile("" ::: "memory");
            }
            f32x4 lg;
#pragma unroll
            for (int i = 0; i < 4; ++i) lg[i] = rinv * acc[i] + cW[b * 16 + 4 * kq + i];
            *(LAS f32x4*)(lgl + (wave * 16 + r) * 16 + 4 * kq) = lg;
        }
    } else {
    for (int i = tid; i < 16384; i += 512) { const int k = i >> 4, e = i & 15; Wl[(((k >> 5) * 4 + ((k >> 3) & 3)) * 16 + e) * 8 + (k & 7)] = INP(I_WR)[i]; }
    for (int i = tid; i < 2048; i += 512) { const int b = i >> 10, k = i & 1023; gsL[i] = gn[k] * (1.f + modl[b * 6144 + 4096 + k]); shL[i] = modl[b * 6144 + 3072 + k]; }
    if (tid < 16) lcnt[tid] = 0;
    __syncthreads();
    {
        const int be = tid >> 4, part = tid & 15, b = be >> 4, e = be & 15;
        float a = 0.f;
        for (int k = part * 64; k < part * 64 + 64; ++k) a += shL[b * 1024 + k] * Wl[(((k >> 5) * 4 + ((k >> 3) & 3)) * 16 + e) * 8 + (k & 7)];
        a += shx<1>(a, lane); a += shx<2>(a, lane); a += shx<4>(a, lane); a += shx<8>(a, lane);
        if (part == 0) cW[be] = a;
    }
    __syncthreads();
    int it = 0;
    for (int batch = X.bid * 8 + wave; batch < NTOK / 16; batch += G * 8, ++it) {
        const int row = batch * 16 + r, b = row >> 14;
        float rinv;
        { const f32x4 p4 = ldg4f(ssp + (size_t)row * 16 + 4 * kq); float ssq = (p4[0] + p4[1]) + (p4[2] + p4[3]); ssq += shx<16>(ssq, lane); ssq += shx<32>(ssq, lane);
          rinv = rsqrtf(ssq * (1.f / 1024.f) + 1e-6f); }
        f32x4 acc = (f32x4){0.f, 0.f, 0.f, 0.f};
        const bf16_t* xr = xsrc + (size_t)row * 1024 + kq * 8;
        bf16_t* hr = h + (size_t)row * 1024 + kq * 8;
        for (int kg = 0; kg < 4; ++kg) {
            u32x4 xp[8];
#pragma unroll
            for (int u = 0; u < 8; ++u) { const int kk = (kg * 4 + (u >> 1)) * 64 + (u & 1) * 32; xp[u] = ldg4u(xr + kk); }
            asm volatile("" ::: "memory");
#pragma unroll
            for (int u = 0; u < 8; ++u) {
                const int kc = kg * 4 + (u >> 1), jh = u & 1, kk = kc * 64 + jh * 32;
                const f32x4 g0 = *(const LAS f32x4*)(gsL + b * 1024 + kk + kq * 8), g1 = *(const LAS f32x4*)(gsL + b * 1024 + kk + kq * 8 + 4);
                const f32x4 s0 = *(const LAS f32x4*)(shL + b * 1024 + kk + kq * 8), s1 = *(const LAS f32x4*)(shL + b * 1024 + kk + kq * 8 + 4);
                const LAS float* wp = Wl + (((kc * 2 + jh) * 4 + kq) * 16 + r) * 8;
                const f32x4 w0 = *(const LAS f32x4*)wp, w1 = *(const LAS f32x4*)(wp + 4);
                f32x4 xa, xc; unpack8(xp[u], xa, xc);
                const f32x4 x0 = xa * g0, x1 = xc * g1;
                stg4u(hr + kk, pack8(x0 * rinv + s0, x1 * rinv + s1));
#pragma unroll
                for (int q = 0; q < 4; ++q) acc = __builtin_amdgcn_mfma_f32_16x16x4f32(w0[q], x0[q], acc, 0, 0, 0);
#pragma unroll
                for (int q = 0; q < 4; ++q) acc = __builtin_amdgcn_mfma_f32_16x16x4f32(w1[q], x1[q], acc, 0, 0, 0);
            }
            asm volatile("" ::: "memory");
        }
        if (it < 4) {
            f32x4 lg;
#pragma unroll
            for (int i = 0; i < 4; ++i) lg[i] = rinv * acc[i] + cW[b * 16 + 4 * kq + i];
            *(LAS f32x4*)(lgl + ((it * 8 + wave) * 16 + r) * 16 + 4 * kq) = lg;
        }
    }
    }
    __syncthreads();
    {
        const int slot = tid, sb = slot >> 4, srow = ((X.bid * 8 + (sb & 7)) + (sb >> 3) * G * 8) * 16 + (slot & 15);
        const bool have = (srow < NTOK) && ((sb >> 3) < 4);
        int e0 = 0, e1 = 0, r0 = 0, r1i = 0; float w0 = 0.f, w1 = 0.f;
        if (have) {
            float sco[16], sel[16];
            f32x4 rb4[4];
#pragma unroll
            for (int q = 0; q < 4; ++q) rb4[q] = ldg4f(INP(I_RB) + 4 * q);
#pragma unroll
            for (int q = 0; q < 4; ++q) { const f32x4 lg4 = *(const LAS f32x4*)(lgl + slot * 16 + 4 * q);
#pragma unroll
                for (int j = 0; j < 4; ++j) { const int e = 4 * q + j; sco[e] = 1.f / (1.f + __expf(-lg4[j])); sel[e] = sco[e] + rb4[q][j]; } }
            float gs[4];
#pragma unroll
            for (int g = 0; g < 4; ++g) {
                const float a = sel[4 * g], bq = sel[4 * g + 1], c = sel[4 * g + 2], d = sel[4 * g + 3];
                const float m1 = fmaxf(fmaxf(a, bq), fmaxf(c, d));
                int i1 = (a == m1) ? 0 : (bq == m1) ? 1 : (c == m1) ? 2 : 3;
                float m2 = -3.0e38f;
                m2 = (i1 != 0) ? fmaxf(m2, a) : m2; m2 = (i1 != 1) ? fmaxf(m2, bq) : m2; m2 = (i1 != 2) ? fmaxf(m2, c) : m2; m2 = (i1 != 3) ? fmaxf(m2, d) : m2;
                gs[g] = m1 + m2;
            }
            int gi = 0; float gb = gs[0];
#pragma unroll
            for (int g = 1; g < 4; ++g) if (gs[g] > gb) { gb = gs[g]; gi = g; }
            float s0 = (gi == 0) ? sel[0] : (gi == 1) ? sel[4] : (gi == 2) ? sel[8] : sel[12];
            float s1 = (gi == 0) ? sel[1] : (gi == 1) ? sel[5] : (gi == 2) ? sel[9] : sel[13];
            float s2 = (gi == 0) ? sel[2] : (gi == 1) ? sel[6] : (gi == 2) ? sel[10] : sel[14];
            float s3 = (gi == 0) ? sel[3] : (gi == 1) ? sel[7] : (gi == 2) ? sel[11] : sel[15];
            float c0 = (gi == 0) ? sco[0] : (gi == 1) ? sco[4] : (gi == 2) ? sco[8] : sco[12];
            float c1 = (gi == 0) ? sco[1] : (gi == 1) ? sco[5] : (gi == 2) ? sco[9] : sco[13];
            float c2 = (gi == 0) ? sco[2] : (gi == 1) ? sco[6] : (gi == 2) ? sco[10] : sco[14];
            float c3 = (gi == 0) ? sco[3] : (gi == 1) ? sco[7] : (gi == 2) ? sco[11] : sco[15];
            const float m1 = fmaxf(fmaxf(s0, s1), fmaxf(s2, s3));
            const int i1 = (s0 == m1) ? 0 : (s1 == m1) ? 1 : (s2 == m1) ? 2 : 3;
            float m2 = -3.0e38f;
            m2 = (i1 != 0) ? fmaxf(m2, s0) : m2; m2 = (i1 != 1) ? fmaxf(m2, s1) : m2; m2 = (i1 != 2) ? fmaxf(m2, s2) : m2; m2 = (i1 != 3) ? fmaxf(m2, s3) : m2;
            const int i2 = (i1 != 0 && s0 == m2) ? 0 : (i1 != 1 && s1 == m2) ? 1 : (i1 != 2 && s2 == m2) ? 2 : 3;
            const float w1v = (i1 == 0) ? c0 : (i1 == 1) ? c1 : (i1 == 2) ? c2 : c3;
            const float w2v = (i2 == 0) ? c0 : (i2 == 1) ? c1 : (i2 == 2) ? c2 : c3;
            const float wn = 1.f / (w1v + w2v);
            e0 = gi * 4 + i1; e1 = gi * 4 + i2; w0 = w1v * wn; w1 = w2v * wn;
            r0 = __hip_atomic_fetch_add(lcnt + e0, 1, __ATOMIC_RELAXED, __HIP_MEMORY_SCOPE_WORKGROUP); r1i = __hip_atomic_fetch_add(lcnt + e1, 1, __ATOMIC_RELAXED, __HIP_MEMORY_SCOPE_WORKGROUP);
        }
        __syncthreads();
        unsigned* gcnt = (unsigned*)(ws + WS_CTL) + CW_GCNT + 16 * (layer * 16);
        if (tid < 16) lbase[tid] = (int)atomicAdd(gcnt + 16 * tid, (unsigned)lcnt[tid]);
        __syncthreads();
        if (have) {
            int* lt = (int*)(ws + WS_LISTT); float* lw = (float*)(ws + WS_LISTW);
            const int p0 = lbase[e0] + r0, p1 = lbase[e1] + r1i;
            lt[e0 * LCAP + p0] = srow * 2; lw[e0 * LCAP + p0] = w0;
            lt[e1 * LCAP + p1] = srow * 2 + 1; lw[e1 * LCAP + p1] = w1;
            u32x4 ti; ti[0] = (unsigned)e0 | ((unsigned)p0 << 4); ti[1] = __float_as_uint(w0); ti[2] = (unsigned)e1 | ((unsigned)p1 << 4); ti[3] = __float_as_uint(w1);
            *(GAS u32x4*)((u32x4*)(ws + WS_TINFO) + srow) = ti;
        }
    }
    __syncthreads();
}

__device__ __forceinline__ void cmp2_unit(const Ctx& X, int layer, int u) {
    unsigned char* ws = X.ws;
    const int lane = X.tid & 63, c = lane & 15, g = lane >> 4;
    const int mat = u >> 7, r0 = (u & 127) * 16;
    const bf16_t* hid = (const bf16_t*)(ws + WS_HID) + ((size_t)mat * 2048 + r0) * 256;
    const bf16_t* w2 = (const bf16_t*)(ws + WS_W2) + ((size_t)layer * 2 + mat) * 64 * 256;
    f32x4 acc[4];
#pragma unroll
    for (int nt = 0; nt < 4; ++nt) acc[nt] = (f32x4){0.f, 0.f, 0.f, 0.f};
#pragma unroll
    for (int ks = 0; ks < 8; ++ks) {
        const bf16x8 a = ldg8(hid + c * 256 + ks * 32 + 8 * g);
#pragma unroll
        for (int nt = 0; nt < 4; ++nt) { const bf16x8 b = ldg8(w2 + (nt * 16 + c) * 256 + ks * 32 + 8 * g); acc[nt] = __builtin_amdgcn_mfma_f32_16x16x32_bf16(a, b, acc[nt], 0, 0, 0); }
    }
    if (mat == 0) {
        const GAS float* kg = (const GAS float*)(INP(I_NKG) + layer * 192);
        GAS bf16_t* kc = (GAS bf16_t*)(ws + WS_KCMP);
        float kgv[4];
#pragma unroll
        for (int nt = 0; nt < 4; ++nt) kgv[nt] = kg[nt * 16 + c];
#pragma unroll
        for (int i = 0; i < 4; ++i) {
            float ss = acc[0][i] * acc[0][i] + acc[1][i] * acc[1][i] + acc[2][i] * acc[2][i] + acc[3][i] * acc[3][i];
            ss += shx<1>(ss, lane); ss += shx<2>(ss, lane); ss += shx<4>(ss, lane); ss += shx<8>(ss, lane);
            const float rn = rsqrtf(ss * (1.f / 64.f) + 1e-6f);
#pragma unroll
            for (int nt = 0; nt < 4; ++nt) kc[(size_t)(r0 + 4 * g + i) * 64 + nt * 16 + c] = f2bf(acc[nt][i] * rn * kgv[nt]);
        }
    } else {
        bf16_t* vt = (bf16_t*)(ws + WS_VCMPT);
        const int b = r0 >> 10, cb0 = (r0 & 1023) + 4 * g;
#pragma unroll
        for (int nt = 0; nt < 4; ++nt) { u32x2 o; o[0] = cvt_pk_bf16(acc[nt][0], acc[nt][1]); o[1] = cvt_pk_bf16(acc[nt][2], acc[nt][3]);
            stg2u(vt + ((size_t)b * 64 + nt * 16 + c) * 1024 + cb0, o); }
    }
}

template <int NCT>
__device__ __forceinline__ void qk_tile(const bf16_t* kp, int kstride, const bf16x8 (&qf)[NCT][2], f32x4 (&s)[2][2][NCT]) {
#pragma unroll
    for (int ch = 0; ch < 2; ++ch)
#pragma unroll
        for (int T = 0; T < 2; ++T) {
            const bf16_t* p = kp + (size_t)(32 * ch + 4 * T) * kstride;
            const bf16x8 k0 = ldg8(p), k1 = ldg8(p + 32);
#pragma unroll
            for (int ct = 0; ct < NCT; ++ct) {
                f32x4 a = (f32x4){0.f, 0.f, 0.f, 0.f};
                a = __builtin_amdgcn_mfma_f32_16x16x32_bf16(k0, qf[ct][0], a, 0, 0, 0);
                a = __builtin_amdgcn_mfma_f32_16x16x32_bf16(k1, qf[ct][1], a, 0, 0, 0);
                s[ch][T][ct] = a;
            }
        }
}
template <int NCT>
__device__ __forceinline__ void pv_tile(const bf16_t* vp, size_t vstride, const bf16x8 (&pb)[2][NCT], f32x4 (&o)[4][NCT]) {
#pragma unroll
    for (int ch = 0; ch < 2; ++ch)
#pragma unroll
        for (int dt = 0; dt < 4; ++dt) {
            const bf16x8 v = ldg8(vp + (size_t)(16 * dt) * vstride + 32 * ch);
#pragma unroll
            for (int ct = 0; ct < NCT; ++ct) o[dt][ct] = __builtin_amdgcn_mfma_f32_16x16x32_bf16(v, pb[ch][ct], o[dt][ct], 0, 0, 0);
        }
}
struct KFrag { bf16x8 k[2][2][2]; };
struct VFrag { bf16x8 v[2][4]; };
__device__ __forceinline__ void ld_ktile(const bf16_t* kp, int kstride, KFrag& f) {
#pragma unroll
    for (int ch = 0; ch < 2; ++ch)
#pragma unroll
        for (int T = 0; T < 2; ++T) { const bf16_t* p = kp + (size_t)(32 * ch + 4 * T) * kstride; f.k[ch][T][0] = ldg8(p); f.k[ch][T][1] = ldg8(p + 32); }
}
__device__ __forceinline__ void ld_vtile(const bf16_t* vp, size_t vstride, VFrag& f) {
#pragma unroll
    for (int ch = 0; ch < 2; ++ch)
#pragma unroll
        for (int dt = 0; dt < 4; ++dt) f.v[ch][dt] = ldg8(vp + (size_t)(16 * dt) * vstride + 32 * ch);
}
template <int NCT>
__device__ __forceinline__ void qk_from(const KFrag& f, const bf16x8 (&qf)[NCT][2], f32x4 (&s)[2][2][NCT]) {
#pragma unroll
    for (int ch = 0; ch < 2; ++ch)
#pragma unroll
        for (int T = 0; T < 2; ++T)
#pragma unroll
            for (int ct = 0; ct < NCT; ++ct) {
                f32x4 a = (f32x4){0.f, 0.f, 0.f, 0.f};
                a = __builtin_amdgcn_mfma_f32_16x16x32_bf16(f.k[ch][T][0], qf[ct][0], a, 0, 0, 0);
                a = __builtin_amdgcn_mfma_f32_16x16x32_bf16(f.k[ch][T][1], qf[ct][1], a, 0, 0, 0);
                s[ch][T][ct] = a;
            }
}
template <int NCT>
__device__ __forceinline__ void pv_from(const VFrag& f, const bf16x8 (&pb)[2][NCT], f32x4 (&o)[4][NCT]) {
#pragma unroll
    for (int ch = 0; ch < 2; ++ch)
#pragma unroll
        for (int dt = 0; dt < 4; ++dt)
#pragma unroll
            for (int ct = 0; ct < NCT; ++ct) o[dt][ct] = __builtin_amdgcn_mfma_f32_16x16x32_bf16(f.v[ch][dt], pb[ch][ct], o[dt][ct], 0, 0, 0);
}
__device__ __forceinline__ bf16x8 pack_p(const f32x4 a, const f32x4 b) {
    union { u32x4 u; bf16x8 h; } x; x.u = pack8(a, b); return x.h;
}
template <int NCT> struct SmState { f32x4 o[4][NCT]; float m[NCT], l[NCT]; };

template <int NCT> __device__ __forceinline__ void sm_init(SmState<NCT>& st) {
#pragma unroll
    for (int ct = 0; ct < NCT; ++ct) { st.m[ct] = -1e30f; st.l[ct] = 0.f;
#pragma unroll
        for (int dt = 0; dt < 4; ++dt) st.o[dt][ct] = (f32x4){0.f, 0.f, 0.f, 0.f}; }
}
template <int NCT> __device__ __forceinline__ void sm_finish(SmState<NCT>& st, const int lane) {
#pragma unroll
    for (int ct = 0; ct < NCT; ++ct) {
        float l = st.l[ct]; l += shx<16>(l, lane); l += shx<32>(l, lane);
        const float inv = (l > 0.f) ? 1.f / l : 0.f;
#pragma unroll
        for (int dt = 0; dt < 4; ++dt) st.o[dt][ct] *= inv;
    }
}

constexpr int TROW = 72, TILE_E = 64 * TROW;
template <int NCT>
__device__ __forceinline__ void qk_tile_l(const LAS bf16_t* Kb, int c, int g, const bf16x8 (&qf)[NCT][2], f32x4 (&s)[2][2][NCT]) {
#pragma unroll
    for (int ch = 0; ch < 2; ++ch)
#pragma unroll
        for (int T = 0; T < 2; ++T) {
            const LAS bf16_t* p = Kb + (32 * ch + 8 * (c >> 2) + 4 * T + (c & 3)) * TROW + 8 * g;
            const bf16x8 k0 = *(const LAS bf16x8*)p, k1 = *(const LAS bf16x8*)(p + 32);
#pragma unroll
            for (int ct = 0; ct < NCT; ++ct) {
                f32x4 a = (f32x4){0.f, 0.f, 0.f, 0.f};
                a = __builtin_amdgcn_mfma_f32_16x16x32_bf16(k0, qf[ct][0], a, 0, 0, 0);
                a = __builtin_amdgcn_mfma_f32_16x16x32_bf16(k1, qf[ct][1], a, 0, 0, 0);
                s[ch][T][ct] = a;
            }
        }
}
template <int NCT>
__device__ __forceinline__ void pv_tile_l(const LAS bf16_t* Vb, int c, int g, const bf16x8 (&pb)[2][NCT], f32x4 (&o)[4][NCT]) {
#pragma unroll
    for (int ch = 0; ch < 2; ++ch)
#pragma unroll
        for (int dt = 0; dt < 4; ++dt) {
            const bf16x8 v = *(const LAS bf16x8*)(Vb + (16 * dt + c) * TROW + 32 * ch + 8 * g);
#pragma unroll
            for (int ct = 0; ct < NCT; ++ct) o[dt][ct] = __builtin_amdgcn_mfma_f32_16x16x32_bf16(v, pb[ch][ct], o[dt][ct], 0, 0, 0);
        }
}
template <int NCT, int STEP>
__device__ __forceinline__ void sm_soft(SmState<NCT>& st, f32x4 (&s)[2][2][NCT], bf16x8 (&pb)[2][NCT], const int (&d0)[NCT], const float (&slope)[NCT], const unsigned (&W)[NCT], const int lane) {
#pragma unroll
    for (int ct = 0; ct < NCT; ++ct) {
        float mx = -1e30f;
#pragma unroll
        for (int ch = 0; ch < 2; ++ch)
#pragma unroll
            for (int T = 0; T < 2; ++T)
#pragma unroll
                for (int i = 0; i < 4; ++i) {
                    const int dist = d0[ct] - STEP * (32 * ch + 4 * T + i);
                    const float v = ((unsigned)dist < W[ct]) ? (s[ch][T][ct][i] - slope[ct] * (float)dist) : -1e30f;
                    s[ch][T][ct][i] = v; mx = fmaxf(mx, v);
                }
        mx = fmaxf(mx, shx<16>(mx, lane)); mx = fmaxf(mx, shx<32>(mx, lane));
        const float mn = fmaxf(st.m[ct], mx), alpha = fexp2(st.m[ct] - mn);
        float sum = 0.f;
#pragma unroll
        for (int ch = 0; ch < 2; ++ch) {
#pragma unroll
            for (int T = 0; T < 2; ++T)
#pragma unroll
                for (int i = 0; i < 4; ++i) { const float v = s[ch][T][ct][i]; const float p = (v > -1e29f) ? fexp2(v - mn) : 0.f; s[ch][T][ct][i] = p; sum += p; }
            pb[ch][ct] = pack_p(s[ch][0][ct], s[ch][1][ct]);
        }
        st.m[ct] = mn; st.l[ct] = st.l[ct] * alpha + sum;
#pragma unroll
        for (int dt = 0; dt < 4; ++dt) st.o[dt][ct] *= alpha;
    }
}

template <int NCT, int STEP>
__device__ __forceinline__ void sm_tile(SmState<NCT>& st, f32x4 (&s)[2][2][NCT], const int (&d0)[NCT], const float (&slope)[NCT], unsigned W, const bf16_t* vp, size_t vstride, const int lane) {
    bf16x8 pb[2][NCT]; unsigned Wv[NCT];
#pragma unroll
    for (int ct = 0; ct < NCT; ++ct) Wv[ct] = W;
    sm_soft<NCT, STEP>(st, s, pb, d0, slope, Wv, lane);
    pv_tile<NCT>(vp, vstride, pb, st.o);
}

__device__ __forceinline__ f32x4 add_sle(const f32x4 v, const float sl, const int e0, const int step) {
    f32x4 r; r[0] = fmaf(sl, (float)(step * e0), v[0]); r[1] = fmaf(sl, (float)(step * (e0 + 1)), v[1]); r[2] = fmaf(sl, (float)(step * (e0 + 2)), v[2]); r[3] = fmaf(sl, (float)(step * (e0 + 3)), v[3]); return r; }
template <int NCT>
__device__ __forceinline__ void sm_fast(SmState<NCT>& st, f32x4 (&s)[2][2][NCT], bf16x8 (&pb)[2][NCT], const float sl, const float (&base)[NCT], const bool (&en)[NCT], const int lane) {
#pragma unroll
    for (int ct = 0; ct < NCT; ++ct) {
        const f32x4 u00 = add_sle(s[0][0][ct], sl, 0, 1), u01 = add_sle(s[0][1][ct], sl, 4, 1), u10 = add_sle(s[1][0][ct], sl, 32, 1), u11 = add_sle(s[1][1][ct], sl, 36, 1);
        const f32x4 m4 = __builtin_elementwise_max(__builtin_elementwise_max(u00, u01), __builtin_elementwise_max(u10, u11));
        float mx = fmaxf(fmaxf(m4[0], m4[1]), fmaxf(m4[2], m4[3])) + base[ct];
        mx = fmaxf(mx, shx<16>(mx, lane)); mx = fmaxf(mx, shx<32>(mx, lane));
        const float mn = en[ct] ? fmaxf(st.m[ct], mx) : st.m[ct], alpha = fexp2(st.m[ct] - mn);
        const float off = en[ct] ? (base[ct] - mn) : -1e30f;
        f32x4 p00 = u00 + off, p01 = u01 + off, p10 = u10 + off, p11 = u11 + off;
#pragma unroll
        for (int i = 0; i < 4; ++i) { p00[i] = fexp2(p00[i]); p01[i] = fexp2(p01[i]); p10[i] = fexp2(p10[i]); p11[i] = fexp2(p11[i]); }
        const f32x4 s4 = (p00 + p01) + (p10 + p11);
        const float sum = (s4[0] + s4[1]) + (s4[2] + s4[3]);
        pb[0][ct] = pack_p(p00, p01); pb[1][ct] = pack_p(p10, p11);
        st.m[ct] = mn; st.l[ct] = st.l[ct] * alpha + sum;
#pragma unroll
        for (int dt = 0; dt < 4; ++dt) st.o[dt][ct] *= alpha;
    }
}

__device__ __forceinline__ void nsa_block(const Ctx& X, LAS unsigned char* lds, int unit, int layer, unsigned long long& prb_acc, unsigned* qhead, int& nxt_idx, const float mref_in) {
    unsigned long long prb_t0 = 0ull; (void)prb_t0; (void)prb_acc;
    unsigned char* ws = X.ws;
    const int tid = X.tid, lane = tid & 63, wave = tid >> 6, c = lane & 15, g = lane >> 4, h = c & 7, qq = c >> 3;
    const int b = unit >> 9, t0 = (unit & 511) * 32;
    const bf16_t* z = (const bf16_t*)(ws + WS_Z) + (size_t)b * SEQ * ZLD;
    const bf16_t* vT = (const bf16_t*)(ws + WS_VT) + (size_t)b * 8 * 64 * SEQ;
    const bf16_t* kcmp = (const bf16_t*)(ws + WS_KCMP) + (size_t)b * 1024 * 64;
    const bf16_t* vcT = (const bf16_t*)(ws + WS_VCMPT) + (size_t)b * 64 * 1024;
    LAS float* impA = (LAS float*)(lds + wave * 8192);
    LAS float* impB = impA + 1024;
    LAS bf16_t* KV = (LAS bf16_t*)(lds + 65536);
    LAS int* sell = (LAS int*)(lds + 114688);
    LAS unsigned* qmask = (LAS unsigned*)(lds + 115712);
    LAS unsigned* ubits = (LAS unsigned*)(lds + 116736);
    LAS int* ulist = (LAS int*)(lds + 116800);
    const int prho = tid >> 3, pcp = tid & 7;
    const int krow = (prho & ~9) | ((prho >> 3) & 1) | ((prho & 1) << 3), kchk = pcp ^ (2 * (krow & 3));
    const int vrow = (prho & ~5) | ((prho >> 2) & 1) | ((prho & 1) << 2), vchk = pcp ^ (2 * (vrow & 3));
    const int wv512 = __builtin_amdgcn_readfirstlane(wave) * 512;
    const int fp = c & 3, fcl = g ^ (2 * (fp & 1)), fph = fp >> 1;
    const int krow0 = 8 * (c >> 2) + fp, krho0 = (krow0 & ~9) | ((krow0 >> 3) & 1) | ((krow0 & 1) << 3);
    const int kofA = krho0 * 64 + (fcl + 4 * (0 ^ fph)) * 8, kofB = krho0 * 64 + (fcl + 4 * (1 ^ fph)) * 8;
    const int vrho0 = (c & ~5) | ((c >> 2) & 1) | ((c & 1) << 2);
    const int vofA = vrho0 * 64 + (fcl + 4 * (0 ^ fph)) * 8, vofB = vrho0 * 64 + (fcl + 4 * (1 ^ fph)) * 8;
#define T_DMAK(kbase, kstride, k0, buf) __builtin_amdgcn_global_load_lds((const unsigned*)((kbase) + (size_t)((k0) + krow) * (kstride) + kchk * 8), (LAS unsigned*)(KV + (buf) * 8192 + wv512), 16, 0, 0)
#define T_DMAV(vbase, vstride, k0, buf) __builtin_amdgcn_global_load_lds((const unsigned*)((vbase) + (size_t)vrow * (vstride) + (k0) + vchk * 8), (LAS unsigned*)(KV + (buf) * 8192 + 4096 + wv512), 16, 0, 0)
#define T_KB(buf) (KV + (buf) * 8192)
#define T_DMAKP(kbase, kstride, k0, dst) __builtin_amdgcn_global_load_lds((const unsigned*)((kbase) + (size_t)((k0) + krow) * (kstride) + kchk * 8), (LAS unsigned*)((dst) + wv512), 16, 0, 0)
#define T_VB(buf) (KV + (buf) * 8192 + 4096)
#define T_WAIT(n) asm volatile("s_waitcnt vmcnt(" #n ")" ::: "memory")
#define T_BAR() do { asm volatile("" ::: "memory"); __builtin_amdgcn_s_barrier(); asm volatile("" ::: "memory"); } while (0)
#define QK2I(buf, S, OFF, STEP) QK2IP(T_KB(buf), S, OFF, STEP)
#define QK2IP(kptr, S, OFF, STEP) do { _Pragma("unroll") for (int ch = 0; ch < 2; ++ch) _Pragma("unroll") for (int T = 0; T < 2; ++T) { \
        const LAS bf16_t* p_ = (kptr) + (4 * T + 32 * ch) * 64; const bf16x8 k0_ = *(const LAS bf16x8*)(p_ + kofA), k1_ = *(const LAS bf16x8*)(p_ + kofB); \
        _Pragma("unroll") for (int ct = 0; ct < 2; ++ct) { f32x4 a_; \
            _Pragma("unroll") for (int i = 0; i < 4; ++i) a_[i] = fmaf(sl, (float)((STEP) * (32 * ch + 4 * T + i)), OFF[ct]); \
            a_ = __builtin_amdgcn_mfma_f32_16x16x32_bf16(k0_, qf[ct][0], a_, 0, 0, 0); a_ = __builtin_amdgcn_mfma_f32_16x16x32_bf16(k1_, qf[ct][1], a_, 0, 0, 0); S[ch][T][ct] = a_; } } } while (0)
#define PV2(buf, PB, O) do { _Pragma("unroll") for (int dt = 0; dt < 4; ++dt) { const LAS bf16_t* p_ = T_VB(buf) + 16 * dt * 64; \
        const bf16x8 v0_ = *(const LAS bf16x8*)(p_ + vofA), v1_ = *(const LAS bf16x8*)(p_ + vofB); \
        _Pragma("unroll") for (int ct = 0; ct < 2; ++ct) { O[dt][ct] = __builtin_amdgcn_mfma_f32_16x16x32_bf16(v0_, PB[0][ct], O[dt][ct], 0, 0, 0); \
            O[dt][ct] = __builtin_amdgcn_mfma_f32_16x16x32_bf16(v1_, PB[1][ct], O[dt][ct], 0, 0, 0); } } } while (0)
#define LSUM(PB, L) do { _Pragma("unroll") for (int ct = 0; ct < 2; ++ct) { L[ct] = __builtin_amdgcn_mfma_f32_16x16x32_bf16(ones, PB[0][ct], L[ct], 0, 0, 0); \
        L[ct] = __builtin_amdgcn_mfma_f32_16x16x32_bf16(ones, PB[1][ct], L[ct], 0, 0, 0); } } while (0)
#define PEXP(S, PB, FULL, D0, W, STEP) do { _Pragma("unroll") for (int ct = 0; ct < 2; ++ct) { _Pragma("unroll") for (int ch = 0; ch < 2; ++ch) { \
        _Pragma("unroll") for (int T = 0; T < 2; ++T) _Pragma("unroll") for (int i = 0; i < 4; ++i) { const float e_ = fexp2(S[ch][T][ct][i]); \
            S[ch][T][ct][i] = (FULL) ? e_ : (((unsigned)(D0[ct] - (STEP) * (32 * ch + 4 * T + i)) < W[ct]) ? e_ : 0.f); } \
        PB[ch][ct] = pack_p(S[ch][0][ct], S[ch][1][ct]); } } } while (0)
    PRB_BEGIN(2);
    if (tid < 256) qmask[tid] = 0u;
    if (tid < 8) ubits[tid] = 0u;
    int tq[2]; bf16x8 qf[2][2]; bf16_t gate3[2][3]; u32x2 osum[2][4];
    const float sl = exp2f(-8.f * (float)(h + 5) / 12.f) * LOG2E;
#pragma unroll
    for (int ct = 0; ct < 2; ++ct) {
        tq[ct] = t0 + 4 * wave + 2 * ct + qq;
        const bf16_t* qp = z + (size_t)tq[ct] * ZLD + ZC_QA + h * 64 + 8 * g;
        qf[ct][0] = ldg8(qp); qf[ct][1] = ldg8(qp + 32);
#pragma unroll
        for (int k = 0; k < 3; ++k) gate3[ct][k] = *(const GAS bf16_t*)(z + (size_t)tq[ct] * ZLD + ZC_GA + h * 3 + k);
    }
    const float mref = mref_in;
    bf16x8 ones;
#pragma unroll
    for (int j = 0; j < 8; ++j) ones[j] = (c == 0) ? (short)0x3F80 : (short)0;
    const int t_lo = t0 + 4 * wave, t_hi = t_lo + 3;
    bf16_t* const og = (bf16_t*)(ws + WS_O) + (size_t)b * SEQ * 1024 + h * 64 + 4 * g;
    const int ncb = (t0 >> 4) + 1;
    const int ntile = (ncb + 63) >> 6;
    const unsigned WALL[2] = {0x7fffffffu, 0x7fffffffu};
    float l2inv[2];
    PRB_END(2); PRB_BEGIN(3);
    {
        f32x4 lacc[2] = {(f32x4){0.f, 0.f, 0.f, 0.f}, (f32x4){0.f, 0.f, 0.f, 0.f}};
        if (tid == 0) nxt_idx = (int)__hip_atomic_fetch_add((GAS unsigned*)qhead, 1u, __ATOMIC_RELAXED, __HIP_MEMORY_SCOPE_AGENT);
        T_BAR();
#pragma unroll
        for (int p = 0; p < 5; ++p) if (p < ntile) T_DMAKP(kcmp, 64, p * 64, KV + p * 4096);
        for (int kt = 0; kt < ntile; ++kt) {
            f32x4 s[2][2][2]; bf16x8 pb[2][2];
            const int k0 = kt * 64, s6 = kt % 6, rem = (ntile - 1 - kt < 4) ? ntile - 1 - kt : 4;
            if (rem == 4) T_WAIT(4); else if (rem == 3) T_WAIT(3); else if (rem == 2) T_WAIT(2); else if (rem == 1) T_WAIT(1); else T_WAIT(0);
            T_BAR();
            if (kt + 5 < ntile) T_DMAKP(kcmp, 64, k0 + 320, KV + ((kt + 5) % 6) * 4096);
            const int d0[2] = {tq[0] - 31 - 16 * (k0 + 8 * g), tq[1] - 31 - 16 * (k0 + 8 * g)};
            const float off[2] = {-sl * (float)d0[0] - mref, -sl * (float)d0[1] - mref};
            QK2IP(KV + s6 * 4096, s, off, 16);
            const bool full = (16 * (k0 + 63) + 31 <= t_lo);
            if (full) PEXP(s, pb, true, d0, WALL, 16); else PEXP(s, pb, false, d0, WALL, 16);
            LSUM(pb, lacc);
        }
#pragma unroll
        for (int ct = 0; ct < 2; ++ct) { float lt = lacc[ct][0]; lt += shx<16>(lt, lane); lt += shx<32>(lt, lane); l2inv[ct] = (lt > 0.f) ? -flog2(lt) : -1e30f; }
    }
    PRB_END(3); PRB_BEGIN(4);
    {
        f32x4 o[4][2];
#pragma unroll
        for (int dt = 0; dt < 4; ++dt) { o[dt][0] = (f32x4){0.f, 0.f, 0.f, 0.f}; o[dt][1] = (f32x4){0.f, 0.f, 0.f, 0.f}; }
        T_BAR();
        T_DMAK(kcmp, 64, 0, 0); T_DMAV(vcT, 1024, 0, 0); if (ntile > 1) { T_DMAK(kcmp, 64, 64, 1); T_DMAV(vcT, 1024, 64, 1); }
        for (int kt = 0; kt < ntile; ++kt) {
            f32x4 s[2][2][2]; bf16x8 pb[2][2];
            const int k0 = kt * 64, bi = kt % 3;
            if (kt + 1 < ntile) T_WAIT(2); else T_WAIT(0);
            T_BAR();
            if (kt + 2 < ntile) { T_DMAK(kcmp, 64, k0 + 128, (kt + 2) % 3); T_DMAV(vcT, 1024, k0 + 128, (kt + 2) % 3); }
            const int d0[2] = {tq[0] - 31 - 16 * (k0 + 8 * g), tq[1] - 31 - 16 * (k0 + 8 * g)};
            const float off[2] = {-sl * (float)d0[0] - mref + l2inv[0], -sl * (float)d0[1] - mref + l2inv[1]};
            QK2I(bi, s, off, 16);
            const bool full = (16 * (k0 + 63) + 31 <= t_lo);
            if (full) PEXP(s, pb, true, d0, WALL, 16); else PEXP(s, pb, false, d0, WALL, 16);
#pragma unroll
            for (int ct = 0; ct < 2; ++ct)
#pragma unroll
                for (int ch = 0; ch < 2; ++ch) {
                    float a0 = s[ch][0][ct][0] + s[ch][0][ct][1] + s[ch][0][ct][2] + 0.5f * s[ch][0][ct][3], b0 = 0.5f * s[ch][0][ct][3];
                    float a1 = s[ch][1][ct][0] + s[ch][1][ct][1] + s[ch][1][ct][2] + 0.5f * s[ch][1][ct][3], b1 = 0.5f * s[ch][1][ct][3];
                    a0 = sum8_dpp(a0); b0 = sum8_dpp(b0); a1 = sum8_dpp(a1); b1 = sum8_dpp(b1);
                    if (h == 0) {
                        const int js = (k0 + 32 * ch) / 4 + 2 * g, ql = 2 * ct + qq;
                        impA[ql * 256 + js] = a0; impB[ql * 256 + js] = b0; impA[ql * 256 + js + 1] = a1; impB[ql * 256 + js + 1] = b1;
                    }
                }
            PV2(bi, pb, o);
        }
#pragma unroll
        for (int ct = 0; ct < 2; ++ct) {
            const float g0 = bf2f(gate3[ct][0]);
#pragma unroll
            for (int dt = 0; dt < 4; ++dt) { const f32x4 v = o[dt][ct] * g0; osum[ct][dt][0] = cvt_pk_bf16(v[0], v[1]); osum[ct][dt][1] = cvt_pk_bf16(v[2], v[3]); }
        }
    }
    PRB_END(4); PRB_BEGIN(5);
    {
        f32x4 o[4][2]; f32x4 lacc[2] = {(f32x4){0.f, 0.f, 0.f, 0.f}, (f32x4){0.f, 0.f, 0.f, 0.f}};
#pragma unroll
        for (int dt = 0; dt < 4; ++dt) { o[dt][0] = (f32x4){0.f, 0.f, 0.f, 0.f}; o[dt][1] = (f32x4){0.f, 0.f, 0.f, 0.f}; }
        int kt0 = (t0 - 511) >> 6; if (kt0 < 0) kt0 = 0;
        const int kt1 = (t0 + 31) >> 6;
        const bf16_t* kb = z + ZC_KWN; const bf16_t* vb = vT + (size_t)(1 * 64) * SEQ;
        const unsigned W2[2] = {512u, 512u};
        T_BAR();
        T_DMAK(kb, ZLD, kt0 * 64, 0); T_DMAV(vb, SEQ, kt0 * 64, 0); if (kt0 < kt1) { T_DMAK(kb, ZLD, kt0 * 64 + 64, 1); T_DMAV(vb, SEQ, kt0 * 64 + 64, 1); }
        for (int kt = kt0; kt <= kt1; ++kt) {
            const int k0 = kt * 64, bi = (kt - kt0) % 3;
            f32x4 s[2][2][2]; bf16x8 pb[2][2];
            if (kt < kt1) T_WAIT(2); else T_WAIT(0);
            T_BAR();
            if (kt + 2 <= kt1) { T_DMAK(kb, ZLD, k0 + 128, (kt - kt0 + 2) % 3); T_DMAV(vb, SEQ, k0 + 128, (kt - kt0 + 2) % 3); }
            const int d0[2] = {tq[0] - (k0 + 8 * g), tq[1] - (k0 + 8 * g)};
            const float off[2] = {-sl * (float)d0[0] - mref, -sl * (float)d0[1] - mref};
            QK2I(bi, s, off, 1);
            const bool full = (k0 + 63 <= t_lo && k0 >= t_hi - 511);
            if (full) PEXP(s, pb, true, d0, W2, 1); else PEXP(s, pb, false, d0, W2, 1);
            PV2(bi, pb, o); LSUM(pb, lacc);
        }
        asm volatile("s_waitcnt vmcnt(0)" ::: "memory");
#pragma unroll
        for (int ct = 0; ct < 2; ++ct) {
            float lt = lacc[ct][0]; lt += shx<16>(lt, lane); lt += shx<32>(lt, lane);
            const float g2 = bf2f(gate3[ct][2]) * ((lt > 0.f) ? 1.f / lt : 0.f);
#pragma unroll
            for (int dt = 0; dt < 4; ++dt) { const f32x4 v = o[dt][ct] * g2; const u32x2 t = osum[ct][dt];
                osum[ct][dt][0] = cvt_pk_bf16(bf_lo(t[0]) + v[0], bf_hi(t[0]) + v[1]); osum[ct][dt][1] = cvt_pk_bf16(bf_lo(t[1]) + v[2], bf_hi(t[1]) + v[3]); }
        }
    }
    PRB_END(5); PRB_BEGIN(6);
    T_BAR();
    T_DMAK(z + ZC_KSL, ZLD, 0, 0); T_DMAV(vT, SEQ, 0, 0);
#pragma unroll
    for (int ql = 0; ql < 4; ++ql) {
        const int qi = 4 * wave + ql, t = t0 + qi, cur = t >> 6;
        if (cur <= 7) {
            if (lane < 8) sell[qi * 8 + lane] = (lane <= cur) ? lane : -1;
        } else {
            unsigned kk[4];
#pragma unroll
            for (int i = 0; i < 4; ++i) { const int j = lane + 64 * i;
                kk[i] = (j >= 1 && j <= cur - 2) ? ((__float_as_uint(impA[ql * 256 + j] + impB[ql * 256 + j - 1]) & 0xFFFFFF00u) | (unsigned)(255 - j)) : 0u; }
            if (lane == 0) { sell[qi * 8 + 0] = 0; sell[qi * 8 + 1] = cur - 1; sell[qi * 8 + 2] = cur; }
#pragma unroll
            for (int r = 0; r < 5; ++r) {
                unsigned m = kk[0] > kk[1] ? kk[0] : kk[1]; const unsigned m2 = kk[2] > kk[3] ? kk[2] : kk[3]; m = m > m2 ? m : m2;
                m = wave_umax(m, lane);
#pragma unroll
                for (int i = 0; i < 4; ++i) kk[i] = (kk[i] == m) ? 0u : kk[i];
                if (lane == 0) sell[qi * 8 + 3 + r] = 255 - (int)(m & 255u);
            }
        }
        if (lane < 8) {
            const int blk = sell[qi * 8 + lane];
            if (blk >= 0) { __hip_atomic_fetch_or(qmask + qi * 8 + (blk >> 5), 1u << (blk & 31), __ATOMIC_RELAXED, __HIP_MEMORY_SCOPE_WORKGROUP);
                            __hip_atomic_fetch_or(ubits + (blk >> 5), 1u << (blk & 31), __ATOMIC_RELAXED, __HIP_MEMORY_SCOPE_WORKGROUP); }
        }
    }
    __syncthreads();
    int nU = 0;
    {
        unsigned wbits[8]; int below = 0;
#pragma unroll
        for (int w = 0; w < 8; ++w) { wbits[w] = ubits[w]; nU += __builtin_popcount(wbits[w]); }
        if (tid < 256) {
            unsigned mine = 0u;
#pragma unroll
            for (int w = 0; w < 8; ++w) { if (w < (tid >> 5)) below += __builtin_popcount(wbits[w]); if (w == (tid >> 5)) mine = wbits[w]; }
            if ((mine >> (tid & 31)) & 1u) { below += __builtin_popcount(mine & ((1u << (tid & 31)) - 1u)); ulist[below] = tid; }
        }
    }
    __syncthreads();
    PRB_END(6); PRB_BEGIN(7);
    {
        f32x4 o[4][2]; f32x4 lacc[2] = {(f32x4){0.f, 0.f, 0.f, 0.f}, (f32x4){0.f, 0.f, 0.f, 0.f}};
#pragma unroll
        for (int dt = 0; dt < 4; ++dt) { o[dt][0] = (f32x4){0.f, 0.f, 0.f, 0.f}; o[dt][1] = (f32x4){0.f, 0.f, 0.f, 0.f}; }
        const bf16_t* kb = z + ZC_KSL; const bf16_t* vb = vT;
        const int q0i = 4 * wave + qq;
        if (nU > 1) { const int k1 = ulist[1] * 64; T_DMAK(kb, ZLD, k1, 1); T_DMAV(vb, SEQ, k1, 1); }
        for (int it = 0; it < nU; ++it) {
            const int blk = ulist[it], k0 = blk * 64, bi = it % 3;
            f32x4 s[2][2][2]; bf16x8 pb[2][2];
            if (it + 1 < nU) T_WAIT(2); else T_WAIT(0);
            T_BAR();
            if (it + 2 < nU) { const int k2 = ulist[it + 2] * 64; T_DMAK(kb, ZLD, k2, (it + 2) % 3); T_DMAV(vb, SEQ, k2, (it + 2) % 3); }
            unsigned W2[2]; float off[2];
            const int d0[2] = {tq[0] - (k0 + 8 * g), tq[1] - (k0 + 8 * g)};
#pragma unroll
            for (int ct = 0; ct < 2; ++ct) {
                const bool member = ((qmask[(q0i + 2 * ct) * 8 + (blk >> 5)] >> (blk & 31)) & 1u) != 0u;
                W2[ct] = member ? 0x7fffffffu : 0u;
                off[ct] = member ? (-sl * (float)d0[ct] - mref) : -1e30f;
            }
            QK2I(bi, s, off, 1);
            const bool full = (k0 + 63 <= t_lo);
            if (full) PEXP(s, pb, true, d0, W2, 1); else PEXP(s, pb, false, d0, W2, 1);
            PV2(bi, pb, o); LSUM(pb, lacc);
        }
        asm volatile("s_waitcnt vmcnt(0)" ::: "memory");
#pragma unroll
        for (int ct = 0; ct < 2; ++ct) {
            float lt = lacc[ct][0]; lt += shx<16>(lt, lane); lt += shx<32>(lt, lane);
            const float g1 = bf2f(gate3[ct][1]) * ((lt > 0.f) ? 1.f / lt : 0.f);
#pragma unroll
            for (int dt = 0; dt < 4; ++dt) { const f32x4 v = o[dt][ct] * g1; bf16_t* op = og + (size_t)tq[ct] * 1024 + 16 * dt; const u32x2 t = osum[ct][dt]; u32x2 w;
                w[0] = cvt_pk_bf16(bf_lo(t[0]) + v[0], bf_hi(t[0]) + v[1]); w[1] = cvt_pk_bf16(bf_lo(t[1]) + v[2], bf_hi(t[1]) + v[3]); stg2u(op, w); }
        }
    }
    PRB_END(7);
#undef T_DMAK
#undef T_DMAV
#undef T_KB
#undef T_VB
#undef T_WAIT
#undef T_BAR
#undef QK2I
#undef QK2IP
#undef T_DMAKP
#undef PV2
#undef LSUM
#undef PEXP
}

__device__ __forceinline__ void sb_unit(const Ctx& X, int unit) {
    unsigned char* ws = X.ws;
    const int lane = X.tid & 63, c = lane & 15, g = lane >> 4;
    const int b = unit >> 11, hd = (unit >> 9) & 3, t0 = (unit & 511) * 32;
    const bf16_t* z = (const bf16_t*)(ws + WS_Z) + (size_t)b * SEQ * ZLD;
    const bf16_t* vT = (const bf16_t*)(ws + WS_VT) + ((size_t)b * 8 + 2 + hd) * 64 * SEQ;
    int tq[2]; bf16x8 qf[2][2]; float R[2] = {1.f, 1.f};
    f32x4 o[4][2];
#pragma unroll
    for (int ct = 0; ct < 2; ++ct) {
        tq[ct] = t0 + 16 * ct + c;
        const bf16_t* qp = z + (size_t)tq[ct] * ZLD + ZC_QB + hd * 64 + 8 * g;
        qf[ct][0] = ldg8(qp); qf[ct][1] = ldg8(qp + 32);
#pragma unroll
        for (int dt = 0; dt < 4; ++dt) o[dt][ct] = (f32x4){0.f, 0.f, 0.f, 0.f};
    }
    const bf16_t* kbase = z + (size_t)(8 * (c >> 2) + (c & 3)) * ZLD + ZC_KB + hd * 64 + 8 * g;
    KFrag kf; VFrag vf;
    ld_ktile(kbase + (size_t)(((t0 + 31) >> 6) * 64) * ZLD, ZLD, kf);
    for (int kt = (t0 + 31) >> 6; kt >= 0; --kt) {
        const int k0 = kt * 64;
        f32x4 s[2][2][2]; bf16x8 pb[2][2];
        ld_vtile(vT + (size_t)c * SEQ + k0 + 8 * g, SEQ, vf);
        qk_from<2>(kf, qf, s);
        if (kt > 0) ld_ktile(kbase + (size_t)(k0 - 64) * ZLD, ZLD, kf);
#pragma unroll
        for (int ct = 0; ct < 2; ++ct) {
            const int d0 = tq[ct] - (k0 + 8 * g);
            float pex[2][8], tot[2], above[2];
#pragma unroll
            for (int ch = 1; ch >= 0; --ch) {
                float run = 1.f;
#pragma unroll
                for (int jj = 7; jj >= 0; --jj) {
                    const int T = jj >> 2, i = jj & 3;
                    const float zc = __builtin_amdgcn_fmed3f(s[ch][T][ct][i], -80.f, 80.f);
                    const bool ok = (d0 - (32 * ch + jj)) > 0;
                    const float t = fexp2(-zc * LOG2E), r = frcp(1.f + t);
                    s[ch][T][ct][i] = ok ? r : 0.f;
                    pex[ch][jj] = run;
                    run *= ok ? t * r : 1.f;
                }
                const float x16 = shx<16>(run, lane), a2 = run * x16, x32 = shx<32>(a2, lane);
                above[ch] = (g == 3) ? 1.f : (g == 2) ? x16 : (g == 1) ? x32 : x16 * x32;
                tot[ch] = a2 * x32;
            }
#pragma unroll
            for (int ch = 0; ch < 2; ++ch) {
                const float base = R[ct] * above[ch] * ((ch == 0) ? tot[1] : 1.f);
#pragma unroll
                for (int jj = 0; jj < 8; ++jj) { const int T = jj >> 2, i = jj & 3; s[ch][T][ct][i] *= base * pex[ch][jj]; }
                pb[ch][ct] = pack_p(s[ch][0][ct], s[ch][1][ct]);
            }
            R[ct] *= tot[0] * tot[1];
        }
        pv_from<2>(vf, pb, o);
        if (__all((R[0] == 0.f) && (R[1] == 0.f))) break;
    }
    bf16_t* ob = (bf16_t*)(ws + WS_O) + (size_t)b * SEQ * 1024 + 512 + hd * 64;
#pragma unroll
    for (int ct = 0; ct < 2; ++ct)
#pragma unroll
        for (int dt = 0; dt < 4; ++dt) {
            u32x2 w; w[0] = cvt_pk_bf16(o[dt][ct][0], o[dt][ct][1]); w[1] = cvt_pk_bf16(o[dt][ct][2], o[dt][ct][3]);
            stg2u(ob + (size_t)tq[ct] * 1024 + 16 * dt + 4 * g, w);
        }
}

__device__ __forceinline__ void swa_unit(const Ctx& X, int layer, int unit) {
    unsigned char* ws = X.ws;
    const int lane = X.tid & 63, c = lane & 15, g = lane >> 4, hg = c & 1;
    const int b = unit >> 11, gk = (unit >> 10) & 1, t0 = (unit & 1023) * 16;
    const int hd = gk * 2 + hg;
    const bf16_t* z = (const bf16_t*)(ws + WS_Z) + (size_t)b * SEQ * ZLD;
    const bf16_t* vT = (const bf16_t*)(ws + WS_VT) + ((size_t)b * 8 + 6 + gk) * 64 * SEQ;
    int tq[2]; float slope[2]; bf16x8 qf[2][2];
    const float sl = exp2f(-8.f * (float)(hd + 1) / 12.f) * LOG2E;
    const float sink = INP(I_SINK)[layer * 4 + hd] * LOG2E;
    SmState<2> st; sm_init<2>(st);
#pragma unroll
    for (int ct = 0; ct < 2; ++ct) {
        tq[ct] = t0 + 8 * ct + (c >> 1); slope[ct] = sl;
        const bf16_t* qp = z + (size_t)tq[ct] * ZLD + ZC_QC + hd * 64 + 8 * g;
        qf[ct][0] = ldg8(qp); qf[ct][1] = ldg8(qp + 32);
        st.m[ct] = sink; st.l[ct] = (g == 0) ? 1.f : 0.f;
    }
    int kt0 = (t0 - 127) >> 6; if (kt0 < 0) kt0 = 0;
    const int kt1 = (t0 + 15) >> 6;
    const bf16_t* kbase = z + (size_t)(8 * (c >> 2) + (c & 3)) * ZLD + ZC_KC + gk * 64 + 8 * g;
    KFrag kf; VFrag vf;
    ld_ktile(kbase + (size_t)(kt0 * 64) * ZLD, ZLD, kf);
    for (int kt = kt0; kt <= kt1; ++kt) {
        const int k0 = kt * 64;
        f32x4 s[2][2][2]; bf16x8 pb[2][2];
        ld_vtile(vT + (size_t)c * SEQ + k0 + 8 * g, SEQ, vf);
        qk_from<2>(kf, qf, s);
        if (kt < kt1) ld_ktile(kbase + (size_t)(k0 + 64) * ZLD, ZLD, kf);
        const int d0[2] = {tq[0] - (k0 + 8 * g), tq[1] - (k0 + 8 * g)};
        const unsigned Wv[2] = {128u, 128u};
        sm_soft<2, 1>(st, s, pb, d0, slope, Wv, lane);
        pv_from<2>(vf, pb, st.o);
    }
    sm_finish<2>(st, lane);
    bf16_t* oc = (bf16_t*)(ws + WS_O) + (size_t)b * SEQ * 1024 + 768 + hd * 64;
#pragma unroll
    for (int ct = 0; ct < 2; ++ct)
#pragma unroll
        for (int dt = 0; dt < 4; ++dt) {
            u32x2 w; w[0] = cvt_pk_bf16(st.o[dt][ct][0], st.o[dt][ct][1]); w[1] = cvt_pk_bf16(st.o[dt][ct][2], st.o[dt][ct][3]);
            stg2u(oc + (size_t)tq[ct] * 1024 + 16 * dt + 4 * g, w);
        }
}

#define STG_CONSTS() \
    const int prho = tid >> 3, pcp = tid & 7; \
    const int krow = (prho & ~9) | ((prho >> 3) & 1) | ((prho & 1) << 3), kchk = pcp ^ (2 * (krow & 3)); \
    const int vrow = (prho & ~5) | ((prho >> 2) & 1) | ((prho & 1) << 2), vchk = pcp ^ (2 * (vrow & 3)); \
    const int wv512 = __builtin_amdgcn_readfirstlane(wave) * 512; \
    const int fp = c & 3, fcl = g ^ (2 * (fp & 1)), fph = fp >> 1; \
    const int krow0 = 8 * (c >> 2) + fp, krho0 = (krow0 & ~9) | ((krow0 >> 3) & 1) | ((krow0 & 1) << 3); \
    const int kofA = krho0 * 64 + (fcl + 4 * (0 ^ fph)) * 8, kofB = krho0 * 64 + (fcl + 4 * (1 ^ fph)) * 8; \
    const int vrho0 = (c & ~5) | ((c >> 2) & 1) | ((c & 1) << 2); \
    const int vofA = vrho0 * 64 + (fcl + 4 * (0 ^ fph)) * 8, vofB = vrho0 * 64 + (fcl + 4 * (1 ^ fph)) * 8
#define T_DMAK(kbase, kstride, k0, buf) __builtin_amdgcn_global_load_lds((const unsigned*)((kbase) + (size_t)((k0) + krow) * (kstride) + kchk * 8), (LAS unsigned*)(KV + (buf) * 8192 + wv512), 16, 0, 0)
#define T_DMAV(vbase, vstride, k0, buf) __builtin_amdgcn_global_load_lds((const unsigned*)((vbase) + (size_t)vrow * (vstride) + (k0) + vchk * 8), (LAS unsigned*)(KV + (buf) * 8192 + 4096 + wv512), 16, 0, 0)
#define T_KB(buf) (KV + (buf) * 8192)
#define T_VB(buf) (KV + (buf) * 8192 + 4096)
#define T_WAIT(n) asm volatile("s_waitcnt vmcnt(" #n ")" ::: "memory")
#define T_BAR() do { asm volatile("" ::: "memory"); __builtin_amdgcn_s_barrier(); asm volatile("" ::: "memory"); } while (0)
#define QK2Z(buf, S) do { _Pragma("unroll") for (int ch = 0; ch < 2; ++ch) _Pragma("unroll") for (int T = 0; T < 2; ++T) { \
        const LAS bf16_t* p_ = T_KB(buf) + (4 * T + 32 * ch) * 64; const bf16x8 k0_ = *(const LAS bf16x8*)(p_ + kofA), k1_ = *(const LAS bf16x8*)(p_ + kofB); \
        _Pragma("unroll") for (int ct = 0; ct < 2; ++ct) { f32x4 a_ = (f32x4){0.f, 0.f, 0.f, 0.f}; \
            a_ = __builtin_amdgcn_mfma_f32_16x16x32_bf16(k0_, qf[ct][0], a_, 0, 0, 0); a_ = __builtin_amdgcn_mfma_f32_16x16x32_bf16(k1_, qf[ct][1], a_, 0, 0, 0); S[ch][T][ct] = a_; } } } while (0)
#define PV2(buf, PB, O) do { _Pragma("unroll") for (int dt = 0; dt < 4; ++dt) { const LAS bf16_t* p_ = T_VB(buf) + 16 * dt * 64; \
        const bf16x8 v0_ = *(const LAS bf16x8*)(p_ + vofA), v1_ = *(const LAS bf16x8*)(p_ + vofB); \
        _Pragma("unroll") for (int ct = 0; ct < 2; ++ct) { O[dt][ct] = __builtin_amdgcn_mfma_f32_16x16x32_bf16(v0_, PB[0][ct], O[dt][ct], 0, 0, 0); \
            O[dt][ct] = __builtin_amdgcn_mfma_f32_16x16x32_bf16(v1_, PB[1][ct], O[dt][ct], 0, 0, 0); } } } while (0)

__device__ __forceinline__ void sb_block(const Ctx& X, LAS unsigned char* lds, int unit) {
    unsigned char* ws = X.ws;
    const int tid = X.tid, lane = tid & 63, wave = tid >> 6, c = lane & 15, g = lane >> 4;
    const int b = unit >> 8, hd = (unit >> 6) & 3, t0 = (unit & 63) * 256;
    const bf16_t* z = (const bf16_t*)(ws + WS_Z) + (size_t)b * SEQ * ZLD;
    const bf16_t* vb = (const bf16_t*)(ws + WS_VT) + ((size_t)b * 8 + 2 + hd) * 64 * SEQ;
    const bf16_t* kb = z + ZC_KB + hd * 64;
    LAS bf16_t* KV = (LAS bf16_t*)lds;
    LAS int* flg = (LAS int*)(lds + LDS_MISC + 4096);
    STG_CONSTS();
    int tq[2]; bf16x8 qf[2][2]; float R[2] = {1.f, 1.f};
    f32x4 o[4][2];
#pragma unroll
    for (int ct = 0; ct < 2; ++ct) {
        tq[ct] = t0 + 32 * wave + 16 * ct + c;
        const bf16_t* qp = z + (size_t)tq[ct] * ZLD + ZC_QB + hd * 64 + 8 * g;
        qf[ct][0] = ldg8(qp); qf[ct][1] = ldg8(qp + 32);
#pragma unroll
        for (int dt = 0; dt < 4; ++dt) o[dt][ct] = (f32x4){0.f, 0.f, 0.f, 0.f};
    }
    const int kt_hi = (t0 + 255) >> 6, ktw = (t0 + 32 * wave + 31) >> 6;
    bool mydone = false;
    T_BAR();
    T_DMAK(kb, ZLD, kt_hi * 64, 0); T_DMAV(vb, SEQ, kt_hi * 64, 0);
    if (kt_hi >= 1) { T_DMAK(kb, ZLD, (kt_hi - 1) * 64, 1); T_DMAV(vb, SEQ, (kt_hi - 1) * 64, 1); }
    int stp = 0;
    for (int kt = kt_hi; kt >= 0; --kt, ++stp) {
        const int k0 = kt * 64, bi = stp % 3;
        if (kt >= 1) T_WAIT(2); else T_WAIT(0);
        T_BAR();
        if (stp > 0) {
            const LAS int* f = flg + ((stp - 1) & 1) * 8;
            if ((f[0] | f[1] | f[2] | f[3] | f[4] | f[5] | f[6] | f[7]) == 0) break;
        }
        if (kt >= 2) { T_DMAK(kb, ZLD, k0 - 128, (stp + 2) % 3); T_DMAV(vb, SEQ, k0 - 128, (stp + 2) % 3); }
        if (kt <= ktw && !mydone) {
            f32x4 s[2][2][2]; bf16x8 pb[2][2];
            QK2Z(bi, s);
#pragma unroll
            for (int ct = 0; ct < 2; ++ct) {
                const int d0 = tq[ct] - (k0 + 8 * g);
                float pex[2][8], tot[2], above[2];
#pragma unroll
                for (int ch = 1; ch >= 0; --ch) {
                    float run = 1.f;
#pragma unroll
                    for (int jj = 7; jj >= 0; --jj) {
                        const int T = jj >> 2, i = jj & 3;
                        const float zc = __builtin_amdgcn_fmed3f(s[ch][T][ct][i], -80.f, 80.f);
                        const bool ok = (d0 - (32 * ch + jj)) > 0;
                        const float t = fexp2(-zc * LOG2E), r = frcp(1.f + t);
                        s[ch][T][ct][i] = ok ? r : 0.f;
                        pex[ch][jj] = run;
                        run *= ok ? t * r : 1.f;
                    }
                    const float x16 = shx<16>(run, lane), a2 = run * x16, x32 = shx<32>(a2, lane);
                    above[ch] = (g == 3) ? 1.f : (g == 2) ? x16 : (g == 1) ? x32 : x16 * x32;
                    tot[ch] = a2 * x32;
                }
#pragma unroll
                for (int ch = 0; ch < 2; ++ch) {
                    const float base = R[ct] * above[ch] * ((ch == 0) ? tot[1] : 1.f);
#pragma unroll
                    for (int jj = 0; jj < 8; ++jj) { const int T = jj >> 2, i = jj & 3; s[ch][T][ct][i] *= base * pex[ch][jj]; }
                    pb[ch][ct] = pack_p(s[ch][0][ct], s[ch][1][ct]);
                }
                R[ct] *= tot[0] * tot[1];
            }
            PV2(bi, pb, o);
            mydone = __all((R[0] == 0.f) && (R[1] == 0.f)) != 0;
        }
        if (lane == 0) flg[(stp & 1) * 8 + wave] = (!mydone && kt > 0) ? 1 : 0;
        asm volatile("s_waitcnt lgkmcnt(0)" ::: "memory");
    }
    T_WAIT(0);
    bf16_t* ob = (bf16_t*)(ws + WS_O) + (size_t)b * SEQ * 1024 + 512 + hd * 64;
#pragma unroll
    for (int ct = 0; ct < 2; ++ct)
#pragma unroll
        for (int dt = 0; dt < 4; ++dt) {
            u32x2 w; w[0] = cvt_pk_bf16(o[dt][ct][0], o[dt][ct][1]); w[1] = cvt_pk_bf16(o[dt][ct][2], o[dt][ct][3]);
            stg2u(ob + (size_t)tq[ct] * 1024 + 16 * dt + 4 * g, w);
        }
}

__device__ __forceinline__ void swa_block(const Ctx& X, LAS unsigned char* lds, int layer, int unit) {
    unsigned char* ws = X.ws;
    const int tid = X.tid, lane = tid & 63, wave = tid >> 6, c = lane & 15, g = lane >> 4, hg = c & 1;
    const int b = unit >> 8, gk = (unit >> 7) & 1, t0 = (unit & 127) * 128;
    const int hd = gk * 2 + hg;
    const bf16_t* z = (const bf16_t*)(ws + WS_Z) + (size_t)b * SEQ * ZLD;
    const bf16_t* vb = (const bf16_t*)(ws + WS_VT) + ((size_t)b * 8 + 6 + gk) * 64 * SEQ;
    const bf16_t* kb = z + ZC_KC + gk * 64;
    LAS bf16_t* KV = (LAS bf16_t*)lds;
    STG_CONSTS();
    int tq[2]; float slope[2]; bf16x8 qf[2][2];
    const float sl = exp2f(-8.f * (float)(hd + 1) / 12.f) * LOG2E;
    const float sink = INP(I_SINK)[layer * 4 + hd] * LOG2E;
    SmState<2> st; sm_init<2>(st);
#pragma unroll
    for (int ct = 0; ct < 2; ++ct) {
        tq[ct] = t0 + 16 * wave + 8 * ct + (c >> 1); slope[ct] = sl;
        const bf16_t* qp = z + (size_t)tq[ct] * ZLD + ZC_QC + hd * 64 + 8 * g;
        qf[ct][0] = ldg8(qp); qf[ct][1] = ldg8(qp + 32);
        st.m[ct] = sink; st.l[ct] = (g == 0) ? 1.f : 0.f;
    }
    const int t_lo = t0 + 16 * wave, t_hi = t_lo + 15;
    int kt0 = (t0 - 127) >> 6; if (kt0 < 0) kt0 = 0;
    const int kt1 = (t0 + 127) >> 6;
    const unsigned Wv[2] = {128u, 128u};
    T_BAR();
    T_DMAK(kb, ZLD, kt0 * 64, 0); T_DMAV(vb, SEQ, kt0 * 64, 0); if (kt0 < kt1) { T_DMAK(kb, ZLD, kt0 * 64 + 64, 1); T_DMAV(vb, SEQ, kt0 * 64 + 64, 1); }
    for (int kt = kt0; kt <= kt1; ++kt) {
        const int k0 = kt * 64, bi = (kt - kt0) % 3;
        if (kt < kt1) T_WAIT(2); else T_WAIT(0);
        T_BAR();
        if (kt + 2 <= kt1) { T_DMAK(kb, ZLD, k0 + 128, (kt - kt0 + 2) % 3); T_DMAV(vb, SEQ, k0 + 128, (kt - kt0 + 2) % 3); }
        if (k0 <= t_hi && k0 + 63 >= t_lo - 127) {
            f32x4 s[2][2][2]; bf16x8 pb[2][2];
            QK2Z(bi, s);
            const int d0[2] = {tq[0] - (k0 + 8 * g), tq[1] - (k0 + 8 * g)};
            sm_soft<2, 1>(st, s, pb, d0, slope, Wv, lane);
            PV2(bi, pb, st.o);
        }
    }
    sm_finish<2>(st, lane);
    bf16_t* oc = (bf16_t*)(ws + WS_O) + (size_t)b * SEQ * 1024 + 768 + hd * 64;
#pragma unroll
    for (int ct = 0; ct < 2; ++ct)
#pragma unroll
        for (int dt = 0; dt < 4; ++dt) {
            u32x2 w; w[0] = cvt_pk_bf16(st.o[dt][ct][0], st.o[dt][ct][1]); w[1] = cvt_pk_bf16(st.o[dt][ct][2], st.o[dt][ct][3]);
            stg2u(oc + (size_t)tq[ct] * 1024 + 16 * dt + 4 * g, w);
        }
}
#undef STG_CONSTS
#undef T_DMAK
#undef T_DMAV
#undef T_KB
#undef T_VB
#undef T_WAIT
#undef T_BAR
#undef QK2Z
#undef PV2

struct SchedC1 {
    static constexpr bool GATHER = false, FP8 = false, CHAIN = false;
    int lda2, akstep, ldb2; const char* Z; const char* W1; int G, c;
    __device__ __forceinline__ bool next(int i, GU& u) const {
        const int L = i * G + c; if (L >= 16) return false;
        const int mat = L >> 3, pm = L & 7;
        u.A = Z + (size_t)pm * 256 * lda2 + (mat ? ZC_VCS : ZC_KCS) * 2; u.B = W1 + (size_t)mat * 256 * 2048 * 2; u.nt = 32; u.kind = 0; u.pm = pm; u.pn = 0; u.e = mat; u.aux = 0; return true;
    }
    __device__ __forceinline__ void rowoff(const GU&, int, unsigned (&)[2][2]) const {}
};

#ifndef MK_PER_STEP
#define MK_PER_STEP 0
#endif
constexpr int NSTEP = 2 + 10 * NL;
#define PHASE_FN __device__ __forceinline__

PHASE_FN void f_prologue(Ctx Xa) { const Ctx X = uni(Xa); p0_prologue(X, X.lds); }
PHASE_FN void f_norm0(Ctx Xa, int l) { const Ctx X = uni(Xa); norm_phase<0>(X, X.lds, l); }
PHASE_FN void f_norm1(Ctx Xa, int l) { const Ctx X = uni(Xa); norm_phase<1>(X, X.lds, l); }
PHASE_FN void f_norm2(Ctx Xa, int l) { const Ctx X = uni(Xa); norm2_mfma(X, X.lds, l); }
PHASE_FN void f_norm3(Ctx Xa, int l) { const Ctx X = uni(Xa); norm_phase<3>(X, X.lds, l); }
PHASE_FN void f_inproj(Ctx Xa, int la) {
    const Ctx X = uni(Xa); const int l = la; unsigned char* ws = X.ws;
    SchedDense S{2048, 128, 2048, (const char*)(ws + WS_H), (const char*)(ws + WS_WIN) + (size_t)l * 2304 * 2048, 128, 9, 16, X.G, X.bid};
    EpiZ E{(bf16_t*)(ws + WS_Z), (bf16_t*)(ws + WS_VT), INP(I_NQG) + l * 64, INP(I_NKG) + l * 192, INP(I_SQG) + l * 64, INP(I_SKG) + l * 64};
    gemm_run(X.lds, S, E, X.tid);
    { const int nunits = 128 * 9, rounds = (nunits + X.G - 1) / X.G;
      if (nunits % X.G != 0 && X.bid >= nunits - (rounds - 1) * X.G) conv_fill(X, X.lds, l + 1, 4, false); }
}
PHASE_FN void f_cmp1(Ctx Xa, int la) {
    const Ctx X = uni(Xa); const int l = la; unsigned char* ws = X.ws;
    SchedC1 S{16 * ZLD * 2, ZLD * 2, 4096, (const char*)(ws + WS_Z), (const char*)(ws + WS_W1) + (size_t)l * 2 * 256 * 2048 * 2, X.G, X.bid};
    EpiC1 E{(bf16_t*)(ws + WS_HID), (const float*)(ws + WS_CB) + l * 512};
    gemm_run(X.lds, S, E, X.tid);
    if (X.bid < 16) {
        __builtin_amdgcn_fence(__ATOMIC_RELEASE, "workgroup"); __syncthreads(); __builtin_amdgcn_fence(__ATOMIC_ACQUIRE, "workgroup");
        for (int L = X.bid; L < 16; L += X.G)
            for (int j = X.tid >> 6; j < 16; j += 8) cmp2_unit(X, l, (L >> 3) * 128 + (L & 7) * 16 + j);
    }
}
PHASE_FN void f_cmp2(Ctx Xa, int la) {
    const Ctx X = uni(Xa); const int l = la;
    for (int u = X.bid * 8 + (X.tid >> 6); u < 256; u += X.G * 8) cmp2_unit(X, l, u);
}
PHASE_FN void f_nsa(Ctx Xa, int la, int qk) {
    const Ctx X = uni(Xa); const int l = la;
    unsigned* ctl = (unsigned*)(X.ws + WS_CTL);
    LAS int* bc = (LAS int*)(X.lds + LDS_MISC + 32);
    PRB_DECL();
#if !PRB_SEL
    unsigned long long prb_acc = 0ull;
#endif
    unsigned* qhead = ctl + CW_Q + 64 * (l * 4 + qk);
    float mref;
    { const int lane = X.tid & 63, layer = l;
        float gq = fabsf(INP(I_NQG)[layer * 64 + lane]);
        const float* kg = INP(I_NKG) + layer * 192;
        float gk = fmaxf(fmaxf(fabsf(kg[lane]), fabsf(kg[64 + lane])), fabsf(kg[128 + lane]));
        gq = fmaxf(gq, shx<32>(gq, lane)); gq = fmaxf(gq, shx<16>(gq, lane)); gq = fmaxf(gq, shx<8>(gq, lane)); gq = fmaxf(gq, shx<4>(gq, lane)); gq = fmaxf(gq, shx<2>(gq, lane)); gq = fmaxf(gq, shx<1>(gq, lane));
        gk = fmaxf(gk, shx<32>(gk, lane)); gk = fmaxf(gk, shx<16>(gk, lane)); gk = fmaxf(gk, shx<8>(gk, lane)); gk = fmaxf(gk, shx<4>(gk, lane)); gk = fmaxf(gk, shx<2>(gk, lane)); gk = fmaxf(gk, shx<1>(gk, lane));
        mref = 8.f * LOG2E * 1.01f * gq * gk;
    }
    int nxt = 0;
    if (X.tid == 0) nxt = (int)atomicAdd(qhead, 1u);
    for (;;) {
        PRB_BEGIN(1);
        if (X.tid == 0) bc[0] = nxt;
        __syncthreads();
        const int idx = bc[0];
        __syncthreads();
        PRB_END(1);
        if (idx >= 1024) break;
        nsa_block(X, X.lds, (idx & 1) * 512 + (511 - (idx >> 1)), l, prb_acc, qhead, nxt, mref);
    }
    PRB_FLUSH(X);
}
PHASE_FN void f_sbswa(Ctx Xa, int la, int qk) {
    const Ctx X = uni(Xa); const int l = la;
    unsigned* ctl = (unsigned*)(X.ws + WS_CTL);
    LAS int* bc = (LAS int*)(X.lds + LDS_MISC + 32);
    for (;;) {
        if (X.tid == 0) bc[0] = (int)atomicAdd(ctl + CW_Q + 64 * (l * 4 + qk) + 16, 1u);
        __syncthreads();
        const int idx = bc[0];
        __syncthreads();
        if (idx >= 1024) break;
        if (idx < 512) sb_block(X, X.lds, idx);
        else swa_block(X, X.lds, l, idx - 512);
    }
}
PHASE_FN void f_e1(Ctx Xa, int la) {
    const Ctx X = uni(Xa); const int l = la; unsigned char* ws = X.ws;
    EpiE1G EG{(unsigned char*)(ws + WS_SB) + (size_t)X.bid * 262144};
    EpiE1T ET{(unsigned char*)(ws + WS_SB) + (size_t)X.bid * 262144, (bf16_t*)(ws + WS_Y)};
    for (int T = 0; T * X.G < 512; ++T) {
        SchedE1G SG{1024, 128, 2048, (const char*)(ws + WS_H8), (const char*)(ws + WS_WM8) + (size_t)l * 3072 * 1024, X.G, X.bid, T};
        gemm_run(X.lds, SG, EG, X.tid);
        SchedE1T ST{2048, 128, 2048, (const char*)(ws + WS_O), (const char*)(ws + WS_WB) + (size_t)l * 1024 * 2048, X.G, X.bid, T};
        gemm_run(X.lds, ST, ET, X.tid);
    }
}
PHASE_FN void f_e2(Ctx Xa, int la) {
    const Ctx X = uni(Xa); const int l = la; unsigned char* ws = X.ws;
    const float* modl = (const float*)(ws + WS_MOD) + (size_t)l * 2 * 6144;
    SchedDense S{2048, 128, 2048, (const char*)(ws + WS_Y), (const char*)(ws + WS_WO) + (size_t)l * 1024 * 2048, 128, 4, 16, X.G, X.bid};
    EpiE2 E{(bf16_t*)(ws + WS_XB), modl + 2048, (float*)(ws + WS_SSP)};
    gemm_run(X.lds, S, E, X.tid);
}
__device__ __forceinline__ void moe_table(const Ctx& X, int l) {
    LAS int* tpre = (LAS int*)(X.lds + LDS_MISC + 256);
    if (X.tid < 16) {
        const unsigned* gcnt = (const unsigned*)(X.ws + WS_CTL) + CW_GCNT + 16 * (l * 16);
        tpre[17 + X.tid] = (int)__hip_atomic_load((GAS unsigned*)(gcnt + 16 * X.tid), __ATOMIC_RELAXED, __HIP_MEMORY_SCOPE_AGENT);
    }
    __syncthreads();
    if (X.tid < 17) {
        int run = 0;
        for (int e = 0; e < X.tid; ++e) run += (tpre[17 + e] + 255) >> 8;
        tpre[X.tid] = run;
        if (X.tid < 16) tpre[34 + X.tid] = run * 256;
    }
    __syncthreads();
}
PHASE_FN void f_g1(Ctx Xa, int la) {
    const Ctx X = uni(Xa); const int l = la; unsigned char* ws = X.ws;
    moe_table(X, l);
    const LAS int* tpre = (const LAS int*)(X.lds + LDS_MISC + 256);
    SchedMoE S{2048, 128, 2048, (const char*)(ws + WS_H), (const char*)(ws + WS_WGU) + (size_t)l * 16 * 1024 * 2048, (size_t)1024 * 2048, 4, 16, X.G, X.bid, 1, tpre, (const int*)(ws + WS_LISTT)};
    EpiG1 E{(bf16_t*)(ws + WS_AB)};
    gemm_run(X.lds, S, E, X.tid);
    { const int nunits = tpre[16] * 4, rounds = (nunits + X.G - 1) / X.G, cx = (X.G % 8 == 0) ? (X.bid % 8) * (X.G / 8) + X.bid / 8 : X.bid;
      if (nunits % X.G != 0 && cx >= nunits - (rounds - 1) * X.G) conv_fill(X, X.lds, l + 1, 4, false); }
}
PHASE_FN void f_g2(Ctx Xa, int la) {
    const Ctx X = uni(Xa); const int l = la; unsigned char* ws = X.ws;
    moe_table(X, l);
    const LAS int* tpre = (const LAS int*)(X.lds + LDS_MISC + 256);
    SchedMoE S{1024, 128, 1024, (const char*)(ws + WS_AB), (const char*)(ws + WS_WD) + (size_t)l * 16 * 1024 * 1024, (size_t)1024 * 1024, 4, 8, X.G, X.bid, 2, tpre, (const int*)(ws + WS_LISTT)};
    EpiG2 E{(bf16_t*)(ws + WS_YS)};
    gemm_run(X.lds, S, E, X.tid);
    conv_fill(X, X.lds, l + 1, 0, true);
}

__global__ void __launch_bounds__(512, 2) mega_fwd(Params P) {
    extern __shared__ __attribute__((aligned(16))) unsigned char lds_raw[];
    LAS unsigned char* lds = (LAS unsigned char*)lds_raw;
    const int tid = threadIdx.x;
    unsigned* ctl = (unsigned*)(P.ws + WS_CTL);
    if (tid < 64) ((LAS unsigned*)(lds + LDS_MISC))[tid] = 0u;
    if (tid < 27) *(LAS unsigned long long*)(lds + LDS_PTAB + 8 * tid) = (unsigned long long)P.in[tid];
    if ((tid & 63) == 0) *(LAS int*)(lds + LDS_WTAB + 4 * ((unsigned)__builtin_amdgcn_s_getreg((5 << 11) | 4) & 63u)) = tid >> 6;
    __syncthreads();
    XcdBarrier bar = xcd_barrier_post(ctl, (volatile LAS unsigned*)(lds + LDS_MISC));
    Ctx X; X.ws = P.ws; X.out = P.out; X.lds = lds; X.tid = 0; X.bid = 0; X.G = 0;
    const int lo = P.step_lo, hi = P.step_hi;
#define IN(s) (lo <= (s) && (s) < hi)
#define SEAM(s) do { if ((s) + 1 < hi) xcd_barrier(bar); } while (0)
#ifndef DBL
#define DBL 0
#endif
    if (IN(0)) { f_prologue(X); if (DBL & 1) f_prologue(X); SEAM(0); }
    for (int l = 0; l < NL; ++l) {
        const int s0 = 1 + 10 * l;
        if (IN(s0 + 0)) { if (l == 0) f_norm0(X, l); else f_norm1(X, l); SEAM(s0 + 0); }
        if (IN(s0 + 1)) { f_inproj(X, l); if (DBL & 2) f_inproj(X, l); SEAM(s0 + 1); }
        if (IN(s0 + 2)) { f_cmp1(X, l); __syncthreads(); f_sbswa(X, l, 1); if (DBL & 64) f_sbswa(X, l, 2); SEAM(s0 + 2); }
        if (IN(s0 + 4)) { f_nsa(X, l, 1); if (DBL & 4) f_nsa(X, l, 2); SEAM(s0 + 4); }
        if (IN(s0 + 5)) { f_e1(X, l); if (DBL & 8) f_e1(X, l); SEAM(s0 + 5); }
        if (IN(s0 + 6)) { f_e2(X, l); SEAM(s0 + 6); }
        if (IN(s0 + 7)) { f_norm2(X, l); SEAM(s0 + 7); }
        if (IN(s0 + 8)) { f_g1(X, l); if (DBL & 16) f_g1(X, l); SEAM(s0 + 8); }
        if (IN(s0 + 9)) { f_g2(X, l); if (DBL & 32) f_g2(X, l); SEAM(s0 + 9); }
    }
    if (IN(NSTEP - 1)) f_norm3(X, NL);
#undef IN
#undef SEAM
}

extern "C" void kernel_launch(void* const* d_in, const int* in_sizes, int n_in, void* d_out, int out_size, void* d_ws, size_t ws_size, hipStream_t stream) {
    static int grid = 0;
    if (grid == 0) {
        if (n_in != 27 || out_size != NTOK * DM || ws_size < WS_END) { fprintf(stderr, "kernel_launch: unexpected shapes/workspace (n_in %d out %d ws %zu need %zu)\n", n_in, out_size, ws_size, (size_t)WS_END); grid = -1; return; }
        int dev = 0, cus = 0, per_cu = 0;
        if (hipGetDevice(&dev) != hipSuccess || hipDeviceGetAttribute(&cus, hipDeviceAttributeMultiprocessorCount, dev) != hipSuccess) { grid = -1; return; }
        if (hipFuncSetAttribute((const void*)mega_fwd, hipFuncAttributeMaxDynamicSharedMemorySize, LDS_BYTES) != hipSuccess) { fprintf(stderr, "kernel_launch: hipFuncSetAttribute failed\n"); grid = -1; return; }
        if (hipOccupancyMaxActiveBlocksPerMultiprocessor(&per_cu, (const void*)mega_fwd, 512, LDS_BYTES) != hipSuccess || per_cu < 1) { fprintf(stderr, "kernel_launch: occupancy query says %d\n", per_cu); }
        (void)hipGetLastError();
        grid = cus;
        if (grid > 256) grid = 256;
        if (grid < 64) { grid = -1; return; }
    }
    if (grid < 0) return;
    if (hipMemsetAsync((char*)d_ws + WS_CTL, 0, 64 * 1024, stream) != hipSuccess) return;
    Params p{};
    for (int i = 0; i < 27; ++i) p.in[i] = (const float*)d_in[i];
    p.out = (float*)d_out; p.ws = (unsigned char*)d_ws;
#if MK_PER_STEP
    for (int s = 0; s < NSTEP; ++s) { p.step_lo = s; p.step_hi = s + 1; hipLaunchKernelGGL(mega_fwd, dim3(grid), dim3(512), LDS_BYTES, stream, p); }
#else
    p.step_lo = 0; p.step_hi = NSTEP;
    hipLaunchKernelGGL(mega_fwd, dim3(grid), dim3(512), LDS_BYTES, stream, p);
#endif
}
```
